# Optimizing an MI355X kernel written in HIP

```python
import jax, jax.numpy as jnp
from jax import lax
import numpy as np

D_MODEL = 1024
BATCH = 8
SEQ = 2048
DEPTH = 2

CHUNK = 64
Q_BLOCK = 128
N_MIXERS = 2
EPS = 1e-6
A_HEADS = 8
A_LAT = 128
IDX_HEADS = 8
IDX_DIM = 64
TOPK_MAX = 256
A_Q_COLS = A_HEADS * A_LAT
A_IN_COLS = A_Q_COLS + A_LAT + IDX_HEADS * IDX_DIM + IDX_DIM + IDX_HEADS
B_HEADS = D_MODEL // 256
B_DK = D_MODEL // B_HEADS
B_DV = 2 * B_DK
B_IN_COLS = 2 * D_MODEL + 2 * (B_HEADS * B_DV)
ROPE_BASE = 10000.0
D_FF = 2816
CONV_W = 3
N_A = (DEPTH + N_MIXERS - 1) // N_MIXERS
N_B = DEPTH // N_MIXERS

kernel_name = 'hybrid_dsa_retention_convffn'


def rms_norm(x, g):
    xf = x.astype(jnp.float32)
    y = xf * lax.rsqrt(jnp.mean(xf * xf, axis=-1, keepdims=True) + EPS)
    return (y * g.astype(jnp.float32)).astype(x.dtype)


def dsa_mixer(h, w_in, q_g, k_g, iq_g, ik_g, w_out):
    bsz, seq, _ = h.shape
    topk = min(TOPK_MAX, seq // 4)
    proj = h @ w_in
    o1 = A_Q_COLS
    o2 = o1 + A_LAT
    o3 = o2 + IDX_HEADS * IDX_DIM
    o4 = o3 + IDX_DIM
    q = proj[..., :o1].reshape(bsz, seq, A_HEADS, A_LAT)
    c = proj[..., o1:o2]
    qi = proj[..., o2:o3].reshape(bsz, seq, IDX_HEADS, IDX_DIM)
    ki = rms_norm(proj[..., o3:o4], ik_g)
    wi = proj[..., o4:] * (IDX_HEADS ** -0.5 * IDX_DIM ** -0.5)
    q = rms_norm(q, q_g) * (A_LAT ** -0.5)
    k = rms_norm(c, k_g)
    qi = rms_norm(qi, iq_g)

    nb = seq // Q_BLOCK

    def to_blocks(a):
        return a.reshape(bsz, nb, Q_BLOCK, *a.shape[2:]).swapaxes(0, 1)

    t_blk = jnp.arange(seq, dtype=jnp.int32).reshape(nb, Q_BLOCK)
    key_pos = jnp.arange(seq, dtype=jnp.int32)
    gather = jax.vmap(lambda a, idx: a[idx])

    def block(args):
        qb, qib, wb, tb = args
        limit = (tb // CHUNK + 1) * CHUNK
        admissible = key_pos[None, :] < limit[:, None]
        rel = jax.nn.relu(jnp.einsum('bqhd,bsd->bqhs', qib, ki).astype(jnp.float32))
        score = jnp.einsum('bqhs,bqh->bqs', rel, wb.astype(jnp.float32))
        score = jnp.where(admissible[None], score, -jnp.inf)
        _, idx = lax.top_k(score, topk)
        valid = idx < limit[None, :, None]
        k_sel = gather(k, idx)
        v_sel = gather(c, idx)
        logits = jnp.einsum('bqhd,bqkd->bqhk', qb, k_sel).astype(jnp.float32)
        logits = jnp.where(valid[:, :, None, :], logits, -jnp.inf)
        p = jax.nn.softmax(logits, axis=-1).astype(v_sel.dtype)
        return jnp.einsum('bqhk,bqkd->bqhd', p, v_sel)

    o = lax.map(block, (to_blocks(q), to_blocks(qi), to_blocks(wi), t_blk))
    o = o.swapaxes(0, 1).reshape(bsz, seq, A_Q_COLS)
    return o @ w_out


def rotary(x):
    seq, d = x.shape[1], x.shape[-1]
    inv = 1.0 / (ROPE_BASE ** (jnp.arange(0, d, 2, dtype=jnp.float32) / d))
    ang = jnp.arange(seq, dtype=jnp.float32)[:, None] * inv[None, :]
    cos = jnp.cos(ang)[None, :, None, :]
    sin = jnp.sin(ang)[None, :, None, :]
    xf = x.astype(jnp.float32)
    x1, x2 = xf[..., : d // 2], xf[..., d // 2:]
    return jnp.concatenate([x1 * cos - x2 * sin, x1 * sin + x2 * cos], axis=-1)


def retention_mixer(h, w_in, out_g, w_out):
    bsz, seq, _ = h.shape
    nc = seq // CHUNK
    proj = h @ w_in
    dq = B_HEADS * B_DK
    dv = B_HEADS * B_DV
    q = rotary(proj[..., :dq].reshape(bsz, seq, B_HEADS, B_DK))
    k = rotary(proj[..., dq:2 * dq].reshape(bsz, seq, B_HEADS, B_DK)) * (B_DK ** -0.5)
    v = proj[..., 2 * dq:2 * dq + dv].reshape(bsz, seq, B_HEADS, B_DV).astype(jnp.float32)
    g = proj[..., 2 * dq + dv:]

    log_gamma = jnp.log1p(-(2.0 ** (-5.0 - jnp.arange(B_HEADS, dtype=jnp.float32))))
    pos = jnp.arange(CHUNK, dtype=jnp.float32)
    diff = pos[:, None] - pos[None, :]
    decay_intra = jnp.where(diff[None] >= 0,
                            jnp.exp(jnp.maximum(diff, 0.0)[None] * log_gamma[:, None, None]), 0.0)
    xi = jnp.exp((pos + 1.0)[:, None] * log_gamma[None, :])
    zeta = jnp.exp((CHUNK - 1.0 - pos)[:, None] * log_gamma[None, :])
    gamma_c = jnp.exp(CHUNK * log_gamma)

    qc = q.reshape(bsz, nc, CHUNK, B_HEADS, B_DK)
    kc = k.reshape(bsz, nc, CHUNK, B_HEADS, B_DK)
    vc = v.reshape(bsz, nc, CHUNK, B_HEADS, B_DV)
    s = jnp.einsum('bnqhd,bnkhd->bnhqk', qc, kc) * decay_intra[None, None]
    intra = jnp.einsum('bnhqk,bnkhe->bnqhe', s, vc)

    def step(state, inp):
        qn, kn, vn = inp
        cross = jnp.einsum('bqhd,bhde->bqhe', qn, state) * xi[None, :, :, None]
        state = state * gamma_c[None, :, None, None] + jnp.einsum(
            'bkhd,bkhe->bhde', kn * zeta[None, :, :, None], vn)
        return state, cross

    state0 = jnp.zeros((bsz, B_HEADS, B_DK, B_DV), jnp.float32)
    _, cross = lax.scan(step, state0, (qc.swapaxes(0, 1), kc.swapaxes(0, 1), vc.swapaxes(0, 1)))
    ret = (intra + cross.swapaxes(0, 1)).reshape(bsz, seq, B_HEADS, B_DV)
    ret = rms_norm(ret, out_g.reshape(B_HEADS, B_DV)).reshape(bsz, seq, dv)
    y = ret * jax.nn.silu(g.astype(jnp.float32))
    return y.astype(h.dtype) @ w_out


def conv_ffn(h, w_up, conv_w, conv_b, w_down):
    seq = h.shape[1]
    u = h @ w_up
    up = jnp.pad(u, ((0, 0), (CONV_W - 1, 0), (0, 0)))
    u = sum(up[:, j:j + seq] * conv_w[j] for j in range(CONV_W)) + conv_b
    a, b = u[..., :D_FF], u[..., D_FF:]
    return (jax.nn.silu(a) * b) @ w_down


def setup_inputs(seed: int = 0) -> dict:
    key = jax.random.key(seed)
    ks = jax.random.split(key, 16)

    def nrm(k, shape, scale):
        return jax.random.normal(k, shape, jnp.float32) * scale

    return {
        'x': nrm(ks[0], (BATCH, SEQ, D_MODEL), 1.0),
        'norm_mix_g': 1.0 + nrm(ks[1], (DEPTH, D_MODEL), 0.02),
        'norm_ffn_g': 1.0 + nrm(ks[2], (DEPTH, D_MODEL), 0.02),
        'a_w_in': nrm(ks[3], (N_A, D_MODEL, A_IN_COLS), D_MODEL ** -0.5),
        'a_q_g': 1.0 + nrm(ks[4], (N_A, A_LAT), 0.02),
        'a_k_g': 1.0 + nrm(ks[5], (N_A, A_LAT), 0.02),
        'a_iq_g': 1.0 + nrm(ks[6], (N_A, IDX_DIM), 0.02),
        'a_ik_g': 1.0 + nrm(ks[7], (N_A, IDX_DIM), 0.02),
        'a_w_out': nrm(ks[8], (N_A, A_Q_COLS, D_MODEL), A_Q_COLS ** -0.5),
        'b_w_in': nrm(ks[9], (N_B, D_MODEL, B_IN_COLS), D_MODEL ** -0.5),
        'b_out_g': 1.0 + nrm(ks[10], (N_B, B_HEADS * B_DV), 0.02),
        'b_w_out': nrm(ks[11], (N_B, B_HEADS * B_DV, D_MODEL), (B_HEADS * B_DV) ** -0.5),
        'f_w_up': nrm(ks[12], (DEPTH, D_MODEL, 2 * D_FF), D_MODEL ** -0.5),
        'f_conv_w': nrm(ks[13], (DEPTH, CONV_W, 2 * D_FF), CONV_W ** -0.5),
        'f_conv_b': nrm(ks[14], (DEPTH, 2 * D_FF), 0.01),
        'f_w_down': nrm(ks[15], (DEPTH, D_FF, D_MODEL), D_FF ** -0.5),
    }


def reference(x, norm_mix_g, norm_ffn_g, a_w_in, a_q_g, a_k_g, a_iq_g, a_ik_g, a_w_out,
              b_w_in, b_out_g, b_w_out, f_w_up, f_conv_w, f_conv_b, f_w_down):
    for i in range(DEPTH):
        h = rms_norm(x, norm_mix_g[i])
        j = i // N_MIXERS
        if i % N_MIXERS == 0:
            x = x + dsa_mixer(h, a_w_in[j], a_q_g[j], a_k_g[j], a_iq_g[j], a_ik_g[j], a_w_out[j])
        else:
            x = x + retention_mixer(h, b_w_in[j], b_out_g[j], b_w_out[j])
        x = x + conv_ffn(rms_norm(x, norm_ffn_g[i]), f_w_up[i], f_conv_w[i], f_conv_b[i], f_w_down[i])
    return x
```

```cpp
#include <hip/hip_runtime.h>
#include <stdint.h>
#include <stdio.h>

typedef unsigned short bf16_t;
typedef short bf16x8 __attribute__((ext_vector_type(8)));
typedef float f32x4 __attribute__((ext_vector_type(4)));

constexpr int BATCH = 8, SEQ = 2048, DM = 1024, M = BATCH * SEQ;
constexpr int A_HEADS = 8, A_LAT = 128, IDX_HEADS = 8, IDX_DIM = 64, TOPK = 256;
constexpr int A_Q_COLS = 1024, A_IN_COLS = 1736, A_IN_PAD = 1792;
constexpr int O1 = 1024, O2 = 1152, O3 = 1664, O4 = 1728;
constexpr int B_HEADS = 4, B_DK = 256, B_DV = 512, B_IN_COLS = 6144;
constexpr int D_FF = 2816, FF2 = 5632;
constexpr float EPS = 1e-6f;

constexpr size_t MiB = 1u << 20;
constexpr size_t WS_CTL = 0;
constexpr size_t WS_SS = 1 * MiB;
constexpr size_t WS_RC = WS_SS + 256 * 1024;
constexpr size_t WS_WI = WS_RC + 64 * 1024;
constexpr size_t WS_ROPE = 2 * MiB;
constexpr size_t WS_SSR = 4 * MiB;
constexpr size_t WS_WBIN = 8 * MiB;
constexpr size_t WS_WBOUT = 20 * MiB;
constexpr size_t WS_XB = 24 * MiB;
constexpr size_t WS_DYN = 56 * MiB;
constexpr size_t WS_WAIN = 56 * MiB;
constexpr size_t WS_WAOUT = 60 * MiB;
constexpr size_t WS_QH = 64 * MiB;
constexpr size_t WS_AO = 96 * MiB;
constexpr size_t WS_QI = 128 * MiB;
constexpr size_t WS_C = 144 * MiB;
constexpr size_t WS_KI = 148 * MiB;
constexpr size_t WS_WFUP0 = 232 * MiB;
constexpr size_t WS_WFDN0 = 243 * MiB;
constexpr size_t WS_H0 = 64 * MiB;
constexpr size_t WS_QT = 56 * MiB;
constexpr size_t WS_KT = 88 * MiB;
constexpr size_t WS_VT = 120 * MiB;
constexpr size_t WS_RET = 184 * MiB;
constexpr size_t WS_WFUP1 = 56 * MiB;
constexpr size_t WS_WFDN1 = 67 * MiB;
constexpr size_t WS_H1 = 88 * MiB;

__device__ __forceinline__ unsigned short f2bf(float f) { unsigned u = __float_as_uint(f); return (unsigned short)((u + 0x7fffu + ((u >> 16) & 1u)) >> 16); }
__device__ __forceinline__ float bf2f(unsigned short h) { return __uint_as_float(((unsigned)h) << 16); }
__device__ __forceinline__ float wave_sum(float v) {
#pragma unroll
    for (int o = 1; o < 64; o <<= 1) v += __shfl_xor(v, o);
    return v;
}
__device__ __forceinline__ float siluf(float x) { return x / (1.0f + __expf(-x)); }

enum { WM_NAT = 0, WM_AIN = 1, WM_FUP = 2 };
__device__ __forceinline__ int wmap(int mode, int n) {
    if (mode == WM_NAT) return n;
    if (mode == WM_AIN) {
        if (n < 1152) return n;
        if (n < 1216) return O3 + (n - 1152);
        if (n < 1224) return O4 + (n - 1216);
        if (n < 1280) return -1;
        return O2 + (n - 1280);
    }
    const int p = n >> 8, bj = (n >> 7) & 1, i = n & 127;
    return bj * D_FF + 128 * p + i;
}
__global__ void __launch_bounds__(256) k_wconv(const float* __restrict__ W, int K, int Nsrc, int N, int mode, const float* __restrict__ gain, bf16_t* __restrict__ out) {
    __shared__ float tile[64][65];
    const int n0 = blockIdx.x * 64, k0 = blockIdx.y * 64, tid = threadIdx.x;
    for (int e = tid; e < 64 * 64; e += 256) {
        const int kk = e >> 6, nn = e & 63, src = wmap(mode, n0 + nn);
        float v = 0.f;
        if (src >= 0) v = W[(size_t)(k0 + kk) * Nsrc + src] * (gain ? gain[k0 + kk] : 1.0f);
        tile[kk][nn] = v;
    }
    __syncthreads();
    for (int e = tid; e < 64 * 64; e += 256) {
        const int nn = e >> 6, kk = e & 63;
        out[(size_t)(n0 + nn) * K + k0 + kk] = f2bf(tile[kk][nn]);
    }
}

__global__ void __launch_bounds__(256) k_xprep(const float* __restrict__ x, bf16_t* __restrict__ xb, float* __restrict__ ss) {
    const int row = blockIdx.x * 4 + (threadIdx.x >> 6), lane = threadIdx.x & 63;
    const float4* xr = (const float4*)(x + (size_t)row * DM);
#pragma unroll
    for (int q = 0; q < 4; ++q) {
        const float4 v = xr[q * 64 + lane];
        float s = v.x * v.x + v.y * v.y + v.z * v.z + v.w * v.w;
        s = wave_sum(s);
        if (lane == 0) ss[row * 4 + q] = s;
        uint2 o; o.x = f2bf(v.x) | ((unsigned)f2bf(v.y) << 16); o.y = f2bf(v.z) | ((unsigned)f2bf(v.w) << 16);
        *(uint2*)(xb + (size_t)row * DM + q * 256 + lane * 4) = o;
    }
}

__global__ void k_rope(float2* __restrict__ rope) {
    const int e = blockIdx.x * 256 + threadIdx.x; if (e >= 2048 * 128) return;
    const int t = e >> 7, i = e & 127;
    const double inv = pow(10000.0, -(double)(2 * i) / 256.0), ang = (double)t * inv;
    rope[e] = make_float2((float)cos(ang), (float)sin(ang));
}

struct GArgs {
    const bf16_t* A; const bf16_t* Bt; int K; int layer;
    const float* ss; float* out_f32; bf16_t* o0; bf16_t* o1; bf16_t* o2; bf16_t* o3; float* f0; float* f1;
    const float* p0; const float* p1; const float* p2; const float* p3;
};
enum { EPI_A1 = 0, EPI_RES = 1, EPI_F1 = 2, EPI_B1 = 3, EPI_GATE = 4 };
constexpr int TP = 257;

__device__ __forceinline__ float row_rstd(const float* ss, int row) {
    const float4 s = *(const float4*)(ss + (size_t)row * 4);
    return rsqrtf((s.x + s.y + s.z + s.w) * (1.0f / DM) + EPS);
}
__device__ __forceinline__ float gamma_log(int h) { return log1pf(-exp2f(-5.0f - (float)h)); }

template <int EPI>
__global__ void __launch_bounds__(256) k_gemm_v0(GArgs g) {
    extern __shared__ float T[];
    constexpr bool HALO = (EPI == EPI_F1);
    const int tid = threadIdx.x, wave = tid >> 6, lane = tid & 63, fr = lane & 15, fq = lane >> 4;
    const int pn = blockIdx.x, col0 = pn * 256, row0 = blockIdx.y * 64, K = g.K;
    f32x4 acc[5][4];
#pragma unroll
    for (int a = 0; a < 5; ++a)
#pragma unroll
        for (int b = 0; b < 4; ++b) acc[a][b] = (f32x4){0.f, 0.f, 0.f, 0.f};
    const bf16_t* ap[5]; const bf16_t* bp[4];
#pragma unroll
    for (int a = 0; a < 5; ++a) { int r = row0 - 16 + 16 * a + fr; if (r < 0) r = 0; ap[a] = g.A + (size_t)r * K + 8 * fq; }
#pragma unroll
    for (int b = 0; b < 4; ++b) bp[b] = g.Bt + (size_t)(col0 + wave * 64 + b * 16 + fr) * K + 8 * fq;
    for (int k0 = 0; k0 < K; k0 += 32) {
        bf16x8 af[5], bfr[4];
#pragma unroll
        for (int a = (HALO ? 0 : 1); a < 5; ++a) af[a] = *(const bf16x8*)(ap[a] + k0);
#pragma unroll
        for (int b = 0; b < 4; ++b) bfr[b] = *(const bf16x8*)(bp[b] + k0);
#pragma unroll
        for (int a = (HALO ? 0 : 1); a < 5; ++a)
#pragma unroll
            for (int b = 0; b < 4; ++b) acc[a][b] = __builtin_amdgcn_mfma_f32_16x16x32_bf16(af[a], bfr[b], acc[a][b], 0, 0, 0);
    }
#pragma unroll
    for (int a = 0; a < 5; ++a)
#pragma unroll
        for (int b = 0; b < 4; ++b)
#pragma unroll
            for (int r = 0; r < 4; ++r) T[(16 * a + 4 * fq + r) * TP + wave * 64 + b * 16 + fr] = acc[a][b][r];
    __syncthreads();
    if constexpr (EPI == EPI_A1) {
        const float* q_g = g.p0; const float* k_g = g.p1; const float* iq_g = g.p2; const float* ik_g = g.p3;
        if (pn < 4) {
            for (int it = tid; it < 128; it += 256) {
                const int r = it >> 1, bj = it & 1, row = row0 + r; const float rs = row_rstd(g.ss, row);
                const float* t = T + (16 + r) * TP + bj * 128; float s = 0.f;
                for (int i = 0; i < 128; ++i) { const float v = t[i] * rs; s += v * v; }
                const float rn = rsqrtf(s * (1.0f / 128.0f) + EPS) * 0.08838834764831845f;
                bf16_t* o = g.o0 + (size_t)row * 1024 + pn * 256 + bj * 128;
                for (int i = 0; i < 128; ++i) o[i] = f2bf(t[i] * rs * rn * q_g[i] * k_g[i]);
            }
        } else if (pn == 4) {
            for (int it = tid; it < 192; it += 256) {
                const int r = it / 3, part = it % 3, row = row0 + r; const float rs = row_rstd(g.ss, row);
                const float* t = T + (16 + r) * TP;
                if (part == 0) {
                    float s = 0.f; for (int i = 0; i < 128; ++i) { const float v = t[i] * rs; s += v * v; }
                    g.f0[row] = rsqrtf(s * (1.0f / 128.0f) + EPS);
                    bf16_t* o = g.o1 + (size_t)row * 128; for (int i = 0; i < 128; ++i) o[i] = f2bf(t[i] * rs);
                } else if (part == 1) {
                    float s = 0.f; for (int i = 0; i < 64; ++i) { const float v = t[128 + i] * rs; s += v * v; }
                    const float rn = rsqrtf(s * (1.0f / 64.0f) + EPS);
                    bf16_t* o = g.o3 + (size_t)row * 64; for (int i = 0; i < 64; ++i) o[i] = f2bf(t[128 + i] * rs * rn * ik_g[i]);
                } else {
                    for (int i = 0; i < 8; ++i) g.f1[(size_t)row * 8 + i] = t[192 + i] * rs * 0.044194173824159216f;
                }
            }
        } else {
            for (int it = tid; it < 256; it += 256) {
                const int r = it >> 2, gq = it & 3, row = row0 + r; const float rs = row_rstd(g.ss, row);
                const float* t = T + (16 + r) * TP + gq * 64; float s = 0.f;
                for (int i = 0; i < 64; ++i) { const float v = t[i] * rs; s += v * v; }
                const float rn = rsqrtf(s * (1.0f / 64.0f) + EPS);
                bf16_t* o = g.o2 + (size_t)row * 512 + (pn - 5) * 256 + gq * 64;
                for (int i = 0; i < 64; ++i) o[i] = f2bf(t[i] * rs * rn * iq_g[i]);
            }
        }
    } else if constexpr (EPI == EPI_RES) {
        for (int r = wave * 16; r < wave * 16 + 16; ++r) {
            const int row = row0 + r; float s = 0.f;
#pragma unroll
            for (int j = 0; j < 4; ++j) {
                const int c = j * 64 + lane; const size_t o = (size_t)row * 1024 + col0 + c;
                const float v = g.out_f32[o] + T[(16 + r) * TP + c];
                g.out_f32[o] = v; g.o0[o] = f2bf(v); s += v * v;
            }
            s = wave_sum(s);
            if (lane == 0) g.f0[(size_t)row * 4 + pn] = s;
        }
    } else if constexpr (EPI == EPI_F1) {
        const float* cw = g.p0 + (size_t)g.layer * 3 * FF2; const float* cb = g.p1 + (size_t)g.layer * FF2;
        for (int e = tid; e < 64 * 128; e += 256) {
            const int r = e >> 7, i = e & 127, row = row0 + r, tb = row & (SEQ - 1);
            float av = cb[128 * pn + i], bv = cb[D_FF + 128 * pn + i];
#pragma unroll
            for (int j = 0; j < 3; ++j) {
                const int d = 2 - j;
                if (tb - d >= 0) {
                    const float rs = row_rstd(g.ss, row - d);
                    av += T[(16 + r - d) * TP + i] * rs * cw[(size_t)j * FF2 + 128 * pn + i];
                    bv += T[(16 + r - d) * TP + 128 + i] * rs * cw[(size_t)j * FF2 + D_FF + 128 * pn + i];
                }
            }
            g.o0[(size_t)row * D_FF + 128 * pn + i] = f2bf(siluf(av) * bv);
        }
    } else if constexpr (EPI == EPI_B1) {
        const float2* rope = (const float2*)g.p0;
        if (pn < 8) {
            const int h = pn & 3; const bool isk = pn >= 4; const float lg = gamma_log(h);
            bf16_t* dst = isk ? g.o1 : g.o0;
            for (int e = tid; e < 64 * 128; e += 256) {
                const int r = e >> 7, i = e & 127, row = row0 + r, t = row & (SEQ - 1), pos = t & 63;
                const float rs = row_rstd(g.ss, row);
                const float x1 = T[(16 + r) * TP + i] * rs, x2 = T[(16 + r) * TP + 128 + i] * rs;
                const float2 cs = rope[t * 128 + i];
                const float sc = isk ? 0.0625f * __expf(-(float)(pos + 1) * lg) : __expf((float)(pos + 1) * lg);
                dst[(size_t)row * 1024 + h * 256 + i] = f2bf((x1 * cs.x - x2 * cs.y) * sc);
                dst[(size_t)row * 1024 + h * 256 + 128 + i] = f2bf((x1 * cs.y + x2 * cs.x) * sc);
            }
        } else {
            const int b = row0 / SEQ, t0 = row0 & (SEQ - 1);
            for (int e = tid; e < 64 * 256; e += 256) {
                const int c = e >> 6, r = e & 63;
                const float rs = row_rstd(g.ss, row0 + r);
                g.o2[((size_t)b * 2048 + (pn - 8) * 256 + c) * SEQ + t0 + r] = f2bf(T[(16 + r) * TP + c] * rs);
            }
        }
    } else if constexpr (EPI == EPI_GATE) {
        for (int e = tid; e < 64 * 256; e += 256) {
            const int r = e >> 8, c = e & 255, row = row0 + r, head = pn >> 1;
            const float rs = row_rstd(g.ss, row);
            const float* sp = g.p0 + ((size_t)row * 4 + head) * 8; float s = 0.f;
#pragma unroll
            for (int j = 0; j < 8; ++j) s += sp[j];
            const float rh = rsqrtf(s * (1.0f / 512.0f) + EPS);
            const size_t o = (size_t)row * 2048 + col0 + c;
            g.o0[o] = f2bf(bf2f(g.o0[o]) * rh * siluf(T[(16 + r) * TP + c] * rs));
        }
    }
}

__global__ void __launch_bounds__(256) k_dsa_v0(const bf16_t* __restrict__ QH, const bf16_t* __restrict__ Cb, const float* __restrict__ RC, const bf16_t* __restrict__ QI,
                                                const bf16_t* __restrict__ KI, const float* __restrict__ WI, bf16_t* __restrict__ AO) {
    __shared__ float qi[8][64]; __shared__ float wi[8]; __shared__ float sc[2048]; __shared__ unsigned short idx[256];
    __shared__ float qh[8][128]; __shared__ float p[8][257]; __shared__ unsigned red[256]; __shared__ float fred[8][4]; __shared__ float mh[8], lh[8];
    const int tg = blockIdx.x, b = tg / SEQ, t = tg % SEQ, limit = ((t >> 6) + 1) * 64, tid = threadIdx.x, lane = tid & 63, wave = tid >> 6;
    for (int e = tid; e < 512; e += 256) qi[e >> 6][e & 63] = bf2f(QI[(size_t)tg * 512 + e]);
    if (tid < 8) wi[tid] = WI[(size_t)tg * 8 + tid];
    for (int e = tid; e < 1024; e += 256) qh[e >> 7][e & 127] = bf2f(QH[(size_t)tg * 1024 + e]);
    __syncthreads();
    for (int s = tid; s < limit; s += 256) {
        const bf16_t* kr = KI + ((size_t)b * SEQ + s) * 64; float kf[64];
#pragma unroll
        for (int i = 0; i < 64; ++i) kf[i] = bf2f(kr[i]);
        float tot = 0.f;
        for (int h = 0; h < 8; ++h) { float d = 0.f;
#pragma unroll
            for (int i = 0; i < 64; ++i) d += qi[h][i] * kf[i];
            tot += fmaxf(d, 0.f) * wi[h]; }
        sc[s] = tot + 0.0f;
    }
    __syncthreads();
    int count;
    if (limit <= TOPK) { count = limit; for (int j = tid; j < limit; j += 256) idx[j] = (unsigned short)j; __syncthreads(); }
    else {
        count = TOPK;
        unsigned key[8];
#pragma unroll
        for (int j = 0; j < 8; ++j) { const int s = tid * 8 + j; unsigned k = 0u; if (s < limit) { const unsigned u = __float_as_uint(sc[s]); k = (u & 0x80000000u) ? ~u : (u | 0x80000000u); } key[j] = k; }
        unsigned Tk = 0u;
        for (int bit = 31; bit >= 0; --bit) {
            const unsigned cand = Tk | (1u << bit); int c = 0;
#pragma unroll
            for (int j = 0; j < 8; ++j) c += (key[j] >= cand) ? 1 : 0;
            c = (int)wave_sum((float)c);
            if (lane == 0) red[wave] = (unsigned)c;
            __syncthreads();
            const int tot = (int)(red[0] + red[1] + red[2] + red[3]);
            __syncthreads();
            if (tot >= TOPK) Tk = cand;
        }
        int ngt = 0, neq = 0;
#pragma unroll
        for (int j = 0; j < 8; ++j) { ngt += (key[j] > Tk) ? 1 : 0; neq += (key[j] == Tk) ? 1 : 0; }
        red[tid] = ((unsigned)ngt << 16) | (unsigned)neq;
        __syncthreads();
        int tot_gt = 0, eq_before = 0;
        for (int j = 0; j < 256; ++j) { const unsigned v = red[j]; tot_gt += (int)(v >> 16); if (j < tid) eq_before += (int)(v & 0xffffu); }
        __syncthreads();
        const int need_eq = TOPK - tot_gt;
        unsigned selm = 0u; int nsel = 0, eqr = eq_before;
#pragma unroll
        for (int j = 0; j < 8; ++j) { bool s = key[j] > Tk; if (key[j] == Tk) { s = eqr < need_eq; ++eqr; } if (s) { selm |= 1u << j; ++nsel; } }
        red[tid] = (unsigned)nsel;
        __syncthreads();
        int base = 0; for (int j = 0; j < tid; ++j) base += (int)red[j];
#pragma unroll
        for (int j = 0; j < 8; ++j) if (selm & (1u << j)) idx[base++] = (unsigned short)(tid * 8 + j);
        __syncthreads();
    }
    float lg[8];
    if (tid < count) {
        const int key = idx[tid]; const bf16_t* cr = Cb + ((size_t)b * SEQ + key) * 128; const float rc = RC[(size_t)b * SEQ + key];
#pragma unroll
        for (int h = 0; h < 8; ++h) lg[h] = 0.f;
        for (int d0 = 0; d0 < 128; d0 += 8) { float cf[8];
#pragma unroll
            for (int i = 0; i < 8; ++i) cf[i] = bf2f(cr[d0 + i]);
#pragma unroll
            for (int h = 0; h < 8; ++h)
#pragma unroll
                for (int i = 0; i < 8; ++i) lg[h] += qh[h][d0 + i] * cf[i]; }
#pragma unroll
        for (int h = 0; h < 8; ++h) lg[h] *= rc;
    } else {
#pragma unroll
        for (int h = 0; h < 8; ++h) lg[h] = -INFINITY;
    }
#pragma unroll
    for (int h = 0; h < 8; ++h) { float m = lg[h];
#pragma unroll
        for (int o = 1; o < 64; o <<= 1) m = fmaxf(m, __shfl_xor(m, o));
        if (lane == 0) fred[h][wave] = m; }
    __syncthreads();
    if (tid < 8) mh[tid] = fmaxf(fmaxf(fred[tid][0], fred[tid][1]), fmaxf(fred[tid][2], fred[tid][3]));
    __syncthreads();
#pragma unroll
    for (int h = 0; h < 8; ++h) { const float e = (tid < count) ? __expf(lg[h] - mh[h]) : 0.f; p[h][tid] = e; const float s = wave_sum(e); if (lane == 0) fred[h][wave] = s; }
    __syncthreads();
    if (tid < 8) lh[tid] = (fred[tid][0] + fred[tid][1]) + (fred[tid][2] + fred[tid][3]);
    __syncthreads();
    { const int h = tid >> 5, d = (tid & 31) * 4; float a0 = 0.f, a1 = 0.f, a2 = 0.f, a3 = 0.f;
        for (int j = 0; j < count; ++j) { const float pj = p[h][j]; const uint2 cv = *(const uint2*)(Cb + ((size_t)b * SEQ + idx[j]) * 128 + d);
            a0 += pj * bf2f((unsigned short)(cv.x & 0xffff)); a1 += pj * bf2f((unsigned short)(cv.x >> 16)); a2 += pj * bf2f((unsigned short)(cv.y & 0xffff)); a3 += pj * bf2f((unsigned short)(cv.y >> 16)); }
        const float inv = 1.0f / lh[h]; uint2 o; o.x = f2bf(a0 * inv) | ((unsigned)f2bf(a1 * inv) << 16); o.y = f2bf(a2 * inv) | ((unsigned)f2bf(a3 * inv) << 16);
        *(uint2*)(AO + (size_t)tg * 1024 + h * 128 + d) = o; }
}

__global__ void __launch_bounds__(256) k_ret_v0(const bf16_t* __restrict__ QT, const bf16_t* __restrict__ KT, const bf16_t* __restrict__ VT, bf16_t* __restrict__ RET, float* __restrict__ SSR) {
    extern __shared__ unsigned char smem[];
    bf16_t* Qs = (bf16_t*)smem;
    bf16_t* Ks = Qs + 64 * 256;
    bf16_t* Vs = Ks + 64 * 256;
    float* Ss = (float*)(Vs + 64 * 64);
    float* St = Ss + 64 * 65;
    const int u = blockIdx.x, blk = u & 7, h = (u >> 3) & 3, b = u >> 5, tid = threadIdx.x, dv = tid & 63, kq = tid >> 6;
    const float g64 = __expf(64.0f * gamma_log(h));
    for (int e = tid; e < 256 * 64; e += 256) St[e] = 0.f;
    for (int n = 0; n < 32; ++n) {
        const size_t row0 = (size_t)b * SEQ + n * 64;
        __syncthreads();
        for (int e = tid; e < 64 * 32; e += 256) { const int r = e >> 5, c8 = e & 31;
            *(uint4*)(Qs + r * 256 + c8 * 8) = *(const uint4*)(QT + (row0 + r) * 1024 + h * 256 + c8 * 8);
            *(uint4*)(Ks + r * 256 + c8 * 8) = *(const uint4*)(KT + (row0 + r) * 1024 + h * 256 + c8 * 8); }
        for (int e = tid; e < 64 * 64; e += 256) { const int dd = e >> 6, key = e & 63; Vs[key * 64 + dd] = VT[((size_t)b * 2048 + h * 512 + blk * 64 + dd) * SEQ + n * 64 + key]; }
        __syncthreads();
        { const int q = tid >> 2, kg = tid & 3;
            for (int key = kg * 16; key < kg * 16 + 16; ++key) { float d = 0.f;
                if (key <= q) for (int i = 0; i < 256; ++i) d += bf2f(Qs[q * 256 + i]) * bf2f(Ks[key * 256 + i]);
                Ss[q * 65 + key] = d; } }
        __syncthreads();
        for (int q = kq * 16; q < kq * 16 + 16; ++q) { float r = 0.f;
            for (int key = 0; key <= q; ++key) r += Ss[q * 65 + key] * bf2f(Vs[key * 64 + dv]);
            for (int i = 0; i < 256; ++i) r += bf2f(Qs[q * 256 + i]) * St[i * 64 + dv];
            RET[(row0 + q) * 2048 + h * 512 + blk * 64 + dv] = f2bf(r);
            const float s = wave_sum(r * r);
            if (dv == 0) SSR[((row0 + q) * 4 + h) * 8 + blk] = s; }
        __syncthreads();
        for (int i = 0; i < 64; ++i) { const int dk = kq * 64 + i; float s = St[dk * 64 + dv];
            for (int key = 0; key < 64; ++key) s += bf2f(Ks[key * 256 + dk]) * bf2f(Vs[key * 64 + dv]);
            St[dk * 64 + dv] = s * g64; }
    }
}

extern "C" void kernel_launch(void* const* d_in, const int* in_sizes, int n_in, void* d_out, int out_size, void* d_ws, size_t ws_size, hipStream_t stream) {
    static int init = 0;
    constexpr int TILE_LDS = 80 * TP * 4;
    constexpr int RET_LDS = 64 * 256 * 2 * 2 + 64 * 64 * 2 + 64 * 65 * 4 + 256 * 64 * 4;
    if (!init) {
        init = 1;
        hipFuncSetAttribute((const void*)k_gemm_v0<EPI_A1>, hipFuncAttributeMaxDynamicSharedMemorySize, TILE_LDS);
        hipFuncSetAttribute((const void*)k_gemm_v0<EPI_RES>, hipFuncAttributeMaxDynamicSharedMemorySize, TILE_LDS);
        hipFuncSetAttribute((const void*)k_gemm_v0<EPI_F1>, hipFuncAttributeMaxDynamicSharedMemorySize, TILE_LDS);
        hipFuncSetAttribute((const void*)k_gemm_v0<EPI_B1>, hipFuncAttributeMaxDynamicSharedMemorySize, TILE_LDS);
        hipFuncSetAttribute((const void*)k_gemm_v0<EPI_GATE>, hipFuncAttributeMaxDynamicSharedMemorySize, TILE_LDS);
        hipFuncSetAttribute((const void*)k_ret_v0, hipFuncAttributeMaxDynamicSharedMemorySize, RET_LDS);
    }
    const float* x = (const float*)d_in[0]; const float* norm_mix_g = (const float*)d_in[1]; const float* norm_ffn_g = (const float*)d_in[2];
    const float* a_w_in = (const float*)d_in[3]; const float* a_q_g = (const float*)d_in[4]; const float* a_k_g = (const float*)d_in[5];
    const float* a_iq_g = (const float*)d_in[6]; const float* a_ik_g = (const float*)d_in[7]; const float* a_w_out = (const float*)d_in[8];
    const float* b_w_in = (const float*)d_in[9]; const float* b_out_g = (const float*)d_in[10]; const float* b_w_out = (const float*)d_in[11];
    const float* f_w_up = (const float*)d_in[12]; const float* f_conv_w = (const float*)d_in[13]; const float* f_conv_b = (const float*)d_in[14]; const float* f_w_down = (const float*)d_in[15];
    unsigned char* ws = (unsigned char*)d_ws; float* out = (float*)d_out;
    float* SS = (float*)(ws + WS_SS); float* RC = (float*)(ws + WS_RC); float* WI = (float*)(ws + WS_WI); float2* ROPE = (float2*)(ws + WS_ROPE); float* SSR = (float*)(ws + WS_SSR);
    bf16_t* XB = (bf16_t*)(ws + WS_XB);
    auto wconv = [&](const float* W, int K, int Nsrc, int N, int mode, const float* gain, size_t off) {
        hipLaunchKernelGGL(k_wconv, dim3(N / 64, K / 64), dim3(256), 0, stream, W, K, Nsrc, N, mode, gain, (bf16_t*)(ws + off)); };
    wconv(a_w_in, 1024, A_IN_COLS, A_IN_PAD, WM_AIN, norm_mix_g, WS_WAIN);
    wconv(a_w_out, 1024, 1024, 1024, WM_NAT, nullptr, WS_WAOUT);
    wconv(b_w_in, 1024, B_IN_COLS, B_IN_COLS, WM_NAT, norm_mix_g + 1024, WS_WBIN);
    wconv(b_w_out, 2048, 1024, 1024, WM_NAT, b_out_g, WS_WBOUT);
    wconv(f_w_up, 1024, FF2, FF2, WM_FUP, norm_ffn_g, WS_WFUP0);
    wconv(f_w_down, 2816, 1024, 1024, WM_NAT, nullptr, WS_WFDN0);
    hipLaunchKernelGGL(k_rope, dim3(1024), dim3(256), 0, stream, ROPE);
    hipMemcpyAsync(out, x, (size_t)M * DM * 4, hipMemcpyDeviceToDevice, stream);
    hipLaunchKernelGGL(k_xprep, dim3(M / 4), dim3(256), 0, stream, x, XB, SS);
    auto gemm = [&](int epi, int N, GArgs g) {
        const dim3 grid(N / 256, M / 64), blk(256);
        switch (epi) {
            case EPI_A1: hipLaunchKernelGGL(k_gemm_v0<EPI_A1>, grid, blk, TILE_LDS, stream, g); break;
            case EPI_RES: hipLaunchKernelGGL(k_gemm_v0<EPI_RES>, grid, blk, TILE_LDS, stream, g); break;
            case EPI_F1: hipLaunchKernelGGL(k_gemm_v0<EPI_F1>, grid, blk, TILE_LDS, stream, g); break;
            case EPI_B1: hipLaunchKernelGGL(k_gemm_v0<EPI_B1>, grid, blk, TILE_LDS, stream, g); break;
            default: hipLaunchKernelGGL(k_gemm_v0<EPI_GATE>, grid, blk, TILE_LDS, stream, g); break;
        } };
    { GArgs g{}; g.A = XB; g.Bt = (bf16_t*)(ws + WS_WAIN); g.K = 1024; g.ss = SS; g.o0 = (bf16_t*)(ws + WS_QH); g.o1 = (bf16_t*)(ws + WS_C); g.o2 = (bf16_t*)(ws + WS_QI); g.o3 = (bf16_t*)(ws + WS_KI);
      g.f0 = RC; g.f1 = WI; g.p0 = a_q_g; g.p1 = a_k_g; g.p2 = a_iq_g; g.p3 = a_ik_g; gemm(EPI_A1, A_IN_PAD, g); }
    hipLaunchKernelGGL(k_dsa_v0, dim3(M), dim3(256), 0, stream, (const bf16_t*)(ws + WS_QH), (const bf16_t*)(ws + WS_C), (const float*)RC, (const bf16_t*)(ws + WS_QI), (const bf16_t*)(ws + WS_KI), (const float*)WI, (bf16_t*)(ws + WS_AO));
    { GArgs g{}; g.A = (bf16_t*)(ws + WS_AO); g.Bt = (bf16_t*)(ws + WS_WAOUT); g.K = 1024; g.out_f32 = out; g.o0 = XB; g.f0 = SS; gemm(EPI_RES, 1024, g); }
    { GArgs g{}; g.A = XB; g.Bt = (bf16_t*)(ws + WS_WFUP0); g.K = 1024; g.layer = 0; g.ss = SS; g.o0 = (bf16_t*)(ws + WS_H0); g.p0 = f_conv_w; g.p1 = f_conv_b; gemm(EPI_F1, FF2, g); }
    { GArgs g{}; g.A = (bf16_t*)(ws + WS_H0); g.Bt = (bf16_t*)(ws + WS_WFDN0); g.K = 2816; g.out_f32 = out; g.o0 = XB; g.f0 = SS; gemm(EPI_RES, 1024, g); }
    { GArgs g{}; g.A = XB; g.Bt = (bf16_t*)(ws + WS_WBIN); g.K = 1024; g.ss = SS; g.o0 = (bf16_t*)(ws + WS_QT); g.o1 = (bf16_t*)(ws + WS_KT); g.o2 = (bf16_t*)(ws + WS_VT); g.p0 = (const float*)ROPE; gemm(EPI_B1, 4096, g); }
    hipLaunchKernelGGL(k_ret_v0, dim3(256), dim3(256), RET_LDS, stream, (const bf16_t*)(ws + WS_QT), (const bf16_t*)(ws + WS_KT), (const bf16_t*)(ws + WS_VT), (bf16_t*)(ws + WS_RET), SSR);
    { GArgs g{}; g.A = XB; g.Bt = (bf16_t*)(ws + WS_WBIN) + (size_t)4096 * 1024; g.K = 1024; g.ss = SS; g.o0 = (bf16_t*)(ws + WS_RET); g.p0 = SSR; gemm(EPI_GATE, 2048, g); }
    wconv(f_w_up + (size_t)1024 * FF2, 1024, FF2, FF2, WM_FUP, norm_ffn_g + 1024, WS_WFUP1);
    wconv(f_w_down + (size_t)2816 * 1024, 2816, 1024, 1024, WM_NAT, nullptr, WS_WFDN1);
    { GArgs g{}; g.A = (bf16_t*)(ws + WS_RET); g.Bt = (bf16_t*)(ws + WS_WBOUT); g.K = 2048; g.out_f32 = out; g.o0 = XB; g.f0 = SS; gemm(EPI_RES, 1024, g); }
    { GArgs g{}; g.A = XB; g.Bt = (bf16_t*)(ws + WS_WFUP1); g.K = 1024; g.layer = 1; g.ss = SS; g.o0 = (bf16_t*)(ws + WS_H1); g.p0 = f_conv_w; g.p1 = f_conv_b; gemm(EPI_F1, FF2, g); }
    { GArgs g{}; g.A = (bf16_t*)(ws + WS_H1); g.Bt = (bf16_t*)(ws + WS_WFDN1); g.K = 2816; g.out_f32 = out; g.o0 = XB; g.f0 = SS; gemm(EPI_RES, 1024, g); }
}
```

```cpp
#include <hip/hip_runtime.h>
#include <stdint.h>
#include <stdio.h>

typedef unsigned short bf16_t;
typedef short bf16x8 __attribute__((ext_vector_type(8)));
typedef float f32x4 __attribute__((ext_vector_type(4)));
typedef unsigned u32x4 __attribute__((ext_vector_type(4)));
typedef unsigned u32x2 __attribute__((ext_vector_type(2)));

#ifndef MK_LAUNCH_MODE
#define MK_LAUNCH_MODE 1
#endif

constexpr int BATCH = 8, SEQ = 2048, DM = 1024, M = BATCH * SEQ;
constexpr int TOPK = 256;
constexpr int A_IN_COLS = 1736, A_IN_PAD = 1792;
constexpr int O2 = 1152, O3 = 1664, O4 = 1728;
constexpr int B_IN_COLS = 6144;
constexpr int D_FF = 2816, FF2 = 5632;
constexpr float EPS = 1e-6f;

constexpr size_t MiB = 1u << 20;
constexpr size_t WS_CTL = 0, CTL_ZERO_BYTES = 65536;
constexpr size_t WS_SS = 1 * MiB;
constexpr size_t WS_WI = 2 * MiB;
constexpr size_t WS_CSC = 2 * MiB + 512 * 1024;
constexpr size_t WS_ROPE = 3 * MiB;
constexpr size_t WS_SSR = 249 * MiB;
constexpr size_t WS_WBIN = 8 * MiB;
constexpr size_t WS_WBOUT = 20 * MiB;
constexpr size_t WS_XB = 24 * MiB;
constexpr size_t WS_WAIN = 56 * MiB;
constexpr size_t WS_WAOUT = 60 * MiB;
constexpr size_t WS_QH = 64 * MiB;
constexpr size_t WS_AO = 96 * MiB;
constexpr size_t WS_QI = 128 * MiB;
constexpr size_t WS_C = 144 * MiB;
constexpr size_t WS_KI = 148 * MiB;
constexpr size_t WS_PS = 150 * MiB;
constexpr size_t WS_WFUP0 = 232 * MiB;
constexpr size_t WS_WFDN0 = 243 * MiB;
constexpr size_t WS_H0 = 64 * MiB;
constexpr size_t WS_PART0 = 152 * MiB;
constexpr size_t WS_HALO0 = 155 * MiB;
constexpr size_t WS_QT = 56 * MiB;
constexpr size_t WS_KT = 88 * MiB;
constexpr size_t WS_VT = 120 * MiB;
constexpr size_t WS_RET = 184 * MiB;
constexpr size_t WS_WFUP1 = 56 * MiB;
constexpr size_t WS_WFDN1 = 67 * MiB;
constexpr size_t WS_H1 = 88 * MiB;
constexpr size_t WS_PART1 = 176 * MiB;
constexpr size_t WS_HALO1 = 179 * MiB;

__device__ __forceinline__ unsigned short f2bf(float f) { unsigned u = __float_as_uint(f); return (unsigned short)((u + 0x7fffu + ((u >> 16) & 1u)) >> 16); }
__device__ __forceinline__ float bf2f(unsigned short h) { return __uint_as_float(((unsigned)h) << 16); }
__device__ __forceinline__ float bflo(unsigned w) { return __uint_as_float(w << 16); }
__device__ __forceinline__ float bfhi(unsigned w) { return __uint_as_float(w & 0xffff0000u); }
typedef __bf16 bf16x2_t __attribute__((ext_vector_type(2)));
typedef float f32x2_t __attribute__((ext_vector_type(2)));
__device__ __forceinline__ unsigned pk2(float lo, float hi) { const f32x2_t v = {lo, hi}; return __builtin_bit_cast(unsigned, __builtin_convertvector(v, bf16x2_t)); }
__device__ __forceinline__ float wave_sum(float v) {
#pragma unroll
    for (int o = 1; o < 64; o <<= 1) v += __shfl_xor(v, o);
    return v;
}
__device__ __forceinline__ float siluf(float x) { return x * __builtin_amdgcn_rcpf(1.0f + __builtin_amdgcn_exp2f(-1.4426950408889634f * x)); }
__device__ __forceinline__ float gamma_log(int h) { return h == 0 ? -0.031748698314580301f : h == 1 ? -0.015748356968139168f : h == 2 ? -0.0078431774610258787f : -0.0039138993211363287f; }

enum { WM_NAT = 0, WM_AIN = 1, WM_FUP = 2 };
__device__ __forceinline__ int wmap(int mode, int n) {
    if (mode == WM_NAT) return n;
    if (mode == WM_AIN) {
        if (n < 1152) return n;
        if (n < 1216) return O3 + (n - 1152);
        if (n < 1224) return O4 + (n - 1216);
        if (n < 1280) return -1;
        return O2 + (n - 1280);
    }
    const int p = n >> 8, bj = (n >> 7) & 1, i = n & 127;
    return bj * D_FF + 128 * p + i;
}

__global__ void __launch_bounds__(256) k_dsa_v0(const bf16_t* __restrict__ QH, const bf16_t* __restrict__ Cb, const float* __restrict__ PS, const bf16_t* __restrict__ QI,
                                                const bf16_t* __restrict__ KI, const float* __restrict__ WI, bf16_t* __restrict__ AO) {
    __shared__ float qi[8][64]; __shared__ float wi[8]; __shared__ float sc[2048]; __shared__ unsigned short idx[256];
    __shared__ float qh[8][128]; __shared__ float p[8][257]; __shared__ unsigned red[256]; __shared__ float fred[8][4]; __shared__ float mh[8], lh[8], rq[8];
    const int tg = blockIdx.x, b = tg / SEQ, t = tg % SEQ, limit = ((t >> 6) + 1) * 64, tid = threadIdx.x, lane = tid & 63, wave = tid >> 6;
    for (int e = tid; e < 512; e += 256) qi[e >> 6][e & 63] = bf2f(QI[(size_t)tg * 512 + e]);
    if (tid < 8) { const int h = tid; const float* ps = PS + (size_t)tg * 56;
        const int qb = (5 + (h >> 2)) * 8 + ((h >> 1) & 1) * 4 + 2 * (h & 1);
        wi[h] = WI[(size_t)tg * 8 + h] * rsqrtf((ps[qb] + ps[qb + 1]) * (1.0f / 64.0f) + EPS);
        const int hb = (h >> 1) * 8 + (h & 1) * 4;
        rq[h] = rsqrtf((ps[hb] + ps[hb + 1] + ps[hb + 2] + ps[hb + 3]) * (1.0f / 128.0f) + EPS); }
    for (int e = tid; e < 1024; e += 256) qh[e >> 7][e & 127] = bf2f(QH[(size_t)tg * 1024 + e]);
    __syncthreads();
    for (int s = tid; s < limit; s += 256) {
        const bf16_t* kr = KI + ((size_t)b * SEQ + s) * 64; float kf[64];
#pragma unroll
        for (int i = 0; i < 64; ++i) kf[i] = bf2f(kr[i]);
        const float* ps = PS + ((size_t)b * SEQ + s) * 56; const float rk = rsqrtf((ps[36] + ps[37]) * (1.0f / 64.0f) + EPS);
        float tot = 0.f;
        for (int h = 0; h < 8; ++h) { float d = 0.f;
#pragma unroll
            for (int i = 0; i < 64; ++i) d += qi[h][i] * kf[i];
            tot += fmaxf(d, 0.f) * wi[h]; }
        sc[s] = tot * rk + 0.0f;
    }
    __syncthreads();
    int count;
    if (limit <= TOPK) { count = limit; for (int j = tid; j < limit; j += 256) idx[j] = (unsigned short)j; __syncthreads(); }
    else {
        count = TOPK;
        unsigned key[8];
#pragma unroll
        for (int j = 0; j < 8; ++j) { const int s = tid * 8 + j; unsigned k = 0u; if (s < limit) { const unsigned u = __float_as_uint(sc[s]); k = (u & 0x80000000u) ? ~u : (u | 0x80000000u); } key[j] = k; }
        unsigned Tk = 0u;
        for (int bit = 31; bit >= 0; --bit) {
            const unsigned cand = Tk | (1u << bit); int c = 0;
#pragma unroll
            for (int j = 0; j < 8; ++j) c += (key[j] >= cand) ? 1 : 0;
            c = (int)wave_sum((float)c);
            if (lane == 0) red[wave] = (unsigned)c;
            __syncthreads();
            const int tot = (int)(red[0] + red[1] + red[2] + red[3]);
            __syncthreads();
            if (tot >= TOPK) Tk = cand;
        }
        int ngt = 0, neq = 0;
#pragma unroll
        for (int j = 0; j < 8; ++j) { ngt += (key[j] > Tk) ? 1 : 0; neq += (key[j] == Tk) ? 1 : 0; }
        red[tid] = ((unsigned)ngt << 16) | (unsigned)neq;
        __syncthreads();
        int tot_gt = 0, eq_before = 0;
        for (int j = 0; j < 256; ++j) { const unsigned v = red[j]; tot_gt += (int)(v >> 16); if (j < tid) eq_before += (int)(v & 0xffffu); }
        __syncthreads();
        const int need_eq = TOPK - tot_gt;
        unsigned selm = 0u; int nsel = 0, eqr = eq_before;
#pragma unroll
        for (int j = 0; j < 8; ++j) { bool s = key[j] > Tk; if (key[j] == Tk) { s = eqr < need_eq; ++eqr; } if (s) { selm |= 1u << j; ++nsel; } }
        red[tid] = (unsigned)nsel;
        __syncthreads();
        int base = 0; for (int j = 0; j < tid; ++j) base += (int)red[j];
#pragma unroll
        for (int j = 0; j < 8; ++j) if (selm & (1u << j)) idx[base++] = (unsigned short)(tid * 8 + j);
        __syncthreads();
    }
    float lg[8];
    if (tid < count) {
        const int key = idx[tid]; const bf16_t* cr = Cb + ((size_t)b * SEQ + key) * 128;
        const float* ps = PS + ((size_t)b * SEQ + key) * 56 + 32; const float rc = rsqrtf((ps[0] + ps[1] + ps[2] + ps[3]) * (1.0f / 128.0f) + EPS);
#pragma unroll
        for (int h = 0; h < 8; ++h) lg[h] = 0.f;
        for (int d0 = 0; d0 < 128; d0 += 8) { float cf[8];
#pragma unroll
            for (int i = 0; i < 8; ++i) cf[i] = bf2f(cr[d0 + i]);
#pragma unroll
            for (int h = 0; h < 8; ++h)
#pragma unroll
                for (int i = 0; i < 8; ++i) lg[h] += qh[h][d0 + i] * cf[i]; }
#pragma unroll
        for (int h = 0; h < 8; ++h) lg[h] *= rc * rq[h];
    } else {
#pragma unroll
        for (int h = 0; h < 8; ++h) lg[h] = -INFINITY;
    }
#pragma unroll
    for (int h = 0; h < 8; ++h) { float m = lg[h];
#pragma unroll
        for (int o = 1; o < 64; o <<= 1) m = fmaxf(m, __shfl_xor(m, o));
        if (lane == 0) fred[h][wave] = m; }
    __syncthreads();
    if (tid < 8) mh[tid] = fmaxf(fmaxf(fred[tid][0], fred[tid][1]), fmaxf(fred[tid][2], fred[tid][3]));
    __syncthreads();
#pragma unroll
    for (int h = 0; h < 8; ++h) { const float e = (tid < count) ? __expf(lg[h] - mh[h]) : 0.f; p[h][tid] = e; const float s = wave_sum(e); if (lane == 0) fred[h][wave] = s; }
    __syncthreads();
    if (tid < 8) lh[tid] = (fred[tid][0] + fred[tid][1]) + (fred[tid][2] + fred[tid][3]);
    __syncthreads();
    { const int h = tid >> 5, d = (tid & 31) * 4; float a0 = 0.f, a1 = 0.f, a2 = 0.f, a3 = 0.f;
        for (int j = 0; j < count; ++j) { const float pj = p[h][j]; const uint2 cv = *(const uint2*)(Cb + ((size_t)b * SEQ + idx[j]) * 128 + d);
            a0 += pj * bflo(cv.x); a1 += pj * bfhi(cv.x); a2 += pj * bflo(cv.y); a3 += pj * bfhi(cv.y); }
        const float inv = 1.0f / lh[h]; uint2 o; o.x = f2bf(a0 * inv) | ((unsigned)f2bf(a1 * inv) << 16); o.y = f2bf(a2 * inv) | ((unsigned)f2bf(a3 * inv) << 16);
        *(uint2*)(AO + (size_t)tg * 1024 + h * 128 + d) = o; }
}

__global__ void __launch_bounds__(256) k_ret_v0(const bf16_t* __restrict__ QT, const bf16_t* __restrict__ KT, const bf16_t* __restrict__ VT, bf16_t* __restrict__ RET, float* __restrict__ SSR) {
    extern __shared__ unsigned char smem[];
    bf16_t* Qs = (bf16_t*)smem;
    bf16_t* Ks = Qs + 64 * 256;
    bf16_t* Vs = Ks + 64 * 256;
    float* Ss = (float*)(Vs + 64 * 64);
    float* St = Ss + 64 * 65;
    const int u = blockIdx.x, blk = u & 7, h = (u >> 3) & 3, b = u >> 5, tid = threadIdx.x, dv = tid & 63, kq = tid >> 6;
    const float g64 = __expf(64.0f * gamma_log(h));
    for (int e = tid; e < 256 * 64; e += 256) St[e] = 0.f;
    for (int n = 0; n < 32; ++n) {
        const size_t row0 = (size_t)b * SEQ + n * 64;
        __syncthreads();
        for (int e = tid; e < 64 * 32; e += 256) { const int r = e >> 5, c8 = e & 31;
            *(uint4*)(Qs + r * 256 + c8 * 8) = *(const uint4*)(QT + (row0 + r) * 1024 + h * 256 + c8 * 8);
            *(uint4*)(Ks + r * 256 + c8 * 8) = *(const uint4*)(KT + (row0 + r) * 1024 + h * 256 + c8 * 8); }
        for (int e = tid; e < 64 * 64; e += 256) { const int dd = e >> 6, key = e & 63; Vs[key * 64 + dd] = VT[((size_t)b * 2048 + h * 512 + blk * 64 + dd) * SEQ + n * 64 + key]; }
        __syncthreads();
        { const int q = tid >> 2, kg = tid & 3;
            for (int key = kg * 16; key < kg * 16 + 16; ++key) { float d = 0.f;
                if (key <= q) for (int i = 0; i < 256; ++i) d += bf2f(Qs[q * 256 + i]) * bf2f(Ks[key * 256 + i]);
                Ss[q * 65 + key] = d; } }
        __syncthreads();
        for (int q = kq * 16; q < kq * 16 + 16; ++q) { float r = 0.f;
            for (int key = 0; key <= q; ++key) r += Ss[q * 65 + key] * bf2f(Vs[key * 64 + dv]);
            for (int i = 0; i < 256; ++i) r += bf2f(Qs[q * 256 + i]) * St[i * 64 + dv];
            RET[(row0 + q) * 2048 + h * 512 + blk * 64 + dv] = f2bf(r);
            const float s = wave_sum(r * r);
            if (dv < 2) SSR[((row0 + q) * 4 + h) * 16 + blk * 2 + dv] = dv == 0 ? s : 0.f; }
        __syncthreads();
        for (int i = 0; i < 64; ++i) { const int dk = kq * 64 + i; float s = St[dk * 64 + dv];
            for (int key = 0; key < 64; ++key) s += bf2f(Ks[key * 256 + dk]) * bf2f(Vs[key * 64 + dv]);
            St[dk * 64 + dv] = s * g64; }
    }
}

namespace pg8 {
#define PG8_LAS __attribute__((address_space(3)))
constexpr int BM = 256, BK = 64, HALF = 128, HTB = HALF * BK * 2, STAGE_BYTES = 8 * HTB, NXCD = 8, WGM = 8;
constexpr int XCH_OFF = 0, CWT_OFF = 2048, RT1_OFF = 6144, RT2_OFF = 14336;
__host__ __device__ __forceinline__ int lds_byte(int r, int c) { const int st = (r >> 4) * 2 + (c >> 5), rr = r & 15, cc = c & 31, ob = rr * 64 + cc * 2; return st * 1024 + (ob ^ (((ob >> 9) & 1) << 5)); }
__host__ __device__ __forceinline__ void stage_rc(int b, int& R, int& C) { const int st = b / 1024, sb = b % 1024, swz = sb ^ (((sb >> 9) & 1) << 5); R = (st >> 1) * 16 + swz / 64; C = (st & 1) * 32 + (swz % 64) / 2; }
__host__ __device__ __forceinline__ int perm32(int rho) { const int n = rho >> 4, i = rho & 15; return 8 * (i >> 2) + 4 * n + (i & 3); }
struct Unit { int pm, pn; };
struct Gemm { const bf16_t* A; const bf16_t* Bt; int M, N, K; };
struct StaticOrder {
    int nM, nN, nwg, G, c;
    __host__ __device__ __forceinline__ void init(int M_, int N_, int G_, int c_) { nM = M_ / BM; nN = N_ / BM; nwg = nM * nN; G = G_; c = c_; }
    __host__ __device__ __forceinline__ bool next(int i, Unit& u) const {
        const long L = (long)i * G + c; if (L >= nwg) return false;
        int wgid = (int)L; { const int q = nwg / NXCD, r = nwg % NXCD, xcd = wgid % NXCD, off = wgid / NXCD; wgid = (xcd < r ? xcd * (q + 1) : r * (q + 1) + (xcd - r) * q) + off; }
        const int nig = WGM * nN, gid = wgid / nig, fm = gid * WGM, gsz = (nM - fm) < WGM ? (nM - fm) : WGM;
        u.pm = fm + ((wgid % nig) % gsz); u.pn = (wgid % nig) / gsz; return true;
    }
};
__device__ __forceinline__ float rstd16(const float* ss16, int row) {
    const f32x4* p = (const f32x4*)(ss16 + (size_t)row * 16); const f32x4 a = p[0], b = p[1], c = p[2], d = p[3];
    const float s = ((a[0] + a[1]) + (a[2] + a[3])) + ((b[0] + b[1]) + (b[2] + b[3])) + ((c[0] + c[1]) + (c[2] + c[3])) + ((d[0] + d[1]) + (d[2] + d[3]));
    return rsqrtf(s * (1.0f / DM) + EPS);
}
__device__ __forceinline__ float ssq8(const f32x4 a, const f32x4 b) { return ((a[0] * a[0] + a[1] * a[1]) + (a[2] * a[2] + a[3] * a[3])) + ((b[0] * b[0] + b[1] * b[1]) + (b[2] * b[2] + b[3] * b[3])); }
__device__ __forceinline__ u32x4 pack8(const f32x4 a, const f32x4 b) { u32x4 w; w.x = pk2(a[0], a[1]); w.y = pk2(a[2], a[3]); w.z = pk2(b[0], b[1]); w.w = pk2(b[2], b[3]); return w; }

struct EpiRes {
    static constexpr bool AROWPERM = false;
    const float* base; float* out; bf16_t* xb; float* ss16; bool feed;
    static constexpr int NTAB = 0;
    __device__ __forceinline__ void fill(PG8_LAS unsigned char*, int, const Unit&, int) const {}
    __device__ __forceinline__ void operator()(f32x4 (&acc)[2][2][4][2], const Unit& u, int ui, int wr, int wc, int fr, int fq, PG8_LAS unsigned char*) const {
        const int row0 = u.pm * BM + wr * 64 + fr, colb = u.pn * BM + wc * 32 + 8 * fq;
#pragma unroll
        for (int ai = 0; ai < 2; ++ai) {
            f32x4 bv[4][2][2];
#pragma unroll
            for (int m = 0; m < 4; ++m)
#pragma unroll
                for (int bj = 0; bj < 2; ++bj) { const size_t o = (size_t)(row0 + ai * HALF + m * 16) * DM + colb + bj * HALF; bv[m][bj][0] = *(const f32x4*)(base + o); bv[m][bj][1] = *(const f32x4*)(base + o + 4); }
#pragma unroll
            for (int m = 0; m < 4; ++m) { const int row = row0 + ai * HALF + m * 16; float s = 0.f;
#pragma unroll
                for (int bj = 0; bj < 2; ++bj) { const size_t o = (size_t)row * DM + colb + bj * HALF;
                    const f32x4 v0 = acc[ai][bj][m][0] + bv[m][bj][0], v1 = acc[ai][bj][m][1] + bv[m][bj][1];
                    *(f32x4*)(out + o) = v0; *(f32x4*)(out + o + 4) = v1;
                    if (feed) { s += ssq8(v0, v1); *(u32x4*)(xb + o) = pack8(v0, v1); } }
                if (feed) { s += __shfl_xor(s, 16); s += __shfl_xor(s, 32);
                    if (fq == 0) ss16[(size_t)row * 16 + u.pn * 4 + wc] = s; } }
            asm volatile("" ::: "memory"); }
    }
};
struct EpiA1 {
    static constexpr bool AROWPERM = false;
    const float* ss16; const float* csc; bf16_t* Q; bf16_t* C; bf16_t* KI; bf16_t* QI; float* WI; float* PS;
    static constexpr int NTAB = 1;
    __device__ __forceinline__ void fill(PG8_LAS unsigned char* xl, int i, const Unit& u, int t) const { ((PG8_LAS float*)(xl + RT1_OFF))[i * 256 + t] = rstd16(ss16, u.pm * BM + t); }
    __device__ __forceinline__ void operator()(f32x4 (&acc)[2][2][4][2], const Unit& u, int ui, int wr, int wc, int fr, int fq, PG8_LAS unsigned char* xl) const {
        const int row0 = u.pm * BM + wr * 64 + fr, pn = u.pn;
        const PG8_LAS float* rt = (const PG8_LAS float*)(xl + RT1_OFF) + ui * 256 + wr * 64 + fr;
        float rs[2][4];
#pragma unroll
        for (int ai = 0; ai < 2; ++ai)
#pragma unroll
            for (int m = 0; m < 4; ++m) rs[ai][m] = rt[ai * HALF + m * 16];
#pragma unroll
        for (int bj = 0; bj < 2; ++bj) {
            const int cl = bj * HALF + wc * 32 + 8 * fq, gcol = pn * BM + cl;
            const f32x4 c0 = *(const f32x4*)(csc + gcol), c1 = *(const f32x4*)(csc + gcol + 4);
            bf16_t* dst; int ld; bool st16 = true, stwi = false;
            if (pn < 4) { dst = Q + gcol; ld = 1024; }
            else if (pn == 4) { if (bj == 0) { dst = C + cl; ld = 128; } else if (wc < 2) { dst = KI + (wc * 32 + 8 * fq); ld = 64; } else { dst = Q; ld = 0; st16 = false; stwi = (wc == 2) && (fq == 0); } }
            else { dst = QI + (pn - 5) * 256 + cl; ld = 512; }
#pragma unroll
            for (int ai = 0; ai < 2; ++ai)
#pragma unroll
                for (int m = 0; m < 4; ++m) { const int row = row0 + ai * HALF + m * 16; const float r = rs[ai][m];
                    const f32x4 v0 = acc[ai][bj][m][0] * r, v1 = acc[ai][bj][m][1] * r;
                    float s = ssq8(v0, v1); s += __shfl_xor(s, 16); s += __shfl_xor(s, 32);
                    if (fq == 0) PS[(size_t)row * 56 + pn * 8 + bj * 4 + wc] = s;
                    const f32x4 o0 = v0 * c0, o1 = v1 * c1;
                    if (st16) *(u32x4*)(dst + (size_t)row * ld) = pack8(o0, o1);
                    if (stwi) { *(f32x4*)(WI + (size_t)row * 8) = o0; *(f32x4*)(WI + (size_t)row * 8 + 4) = o1; }
                    if (m & 1) asm volatile("" ::: "memory"); }
        }
    }
};
struct EpiF1 {
    static constexpr bool AROWPERM = true;
    static constexpr int NTAB = 1;
    const float* ss16; const float* cw; const float* cb; bf16_t* H; float* PART; float* HALO;
    __device__ __forceinline__ void fill(PG8_LAS unsigned char* xl, int i, const Unit& u, int t) const { ((PG8_LAS float*)(xl + RT1_OFF))[i * 256 + t] = rstd16(ss16, u.pm * BM + t); }
    __device__ __forceinline__ void operator()(f32x4 (&acc)[2][2][4][2], const Unit& u, int ui, int wr, int wc, int fr, int fq, PG8_LAS unsigned char* xl) const {
        const int trow0 = 8 * (16 * wr + fr), grow0 = u.pm * BM + trow0, hcol = 128 * u.pn + 32 * wc + 8 * fq, tcol = 32 * wc + 8 * fq;
        const PG8_LAS float* rt = (const PG8_LAS float*)(xl + RT1_OFF) + ui * 256 + trow0;
        {   const f32x4 r0 = *(const PG8_LAS f32x4*)rt, r1 = *(const PG8_LAS f32x4*)(rt + 4);
#pragma unroll
            for (int m = 0; m < 4; ++m)
#pragma unroll
                for (int bj = 0; bj < 2; ++bj) { acc[0][bj][m][0] *= r0[m]; acc[0][bj][m][1] *= r0[m]; acc[1][bj][m][0] *= r1[m]; acc[1][bj][m][1] *= r1[m]; } }
        {   PG8_LAS float* cwt = (PG8_LAS float*)(xl + CWT_OFF); const int tid = ((wr * 4 + wc) * 4 + fq) * 16 + fr;
#pragma unroll
            for (int r = 0; r < 2; ++r) { const int idx = tid + r * 512, k = idx >> 8, c = idx & 255, orig = (c < 128) ? 128 * u.pn + c : D_FF + 128 * u.pn + (c - 128);
                cwt[idx] = (k < 3) ? cw[(size_t)k * FF2 + orig] : cb[orig]; } }
        PG8_LAS f32x4* X = (PG8_LAS f32x4*)(xl + XCH_OFF) + (wc * 4 + fq) * 8;
        if (wr == 0 && fr == 15) {
#pragma unroll
            for (int bj = 0; bj < 2; ++bj)
#pragma unroll
                for (int e = 0; e < 2; ++e)
#pragma unroll
                    for (int n = 0; n < 2; ++n) X[(bj * 2 + e) * 2 + n] = acc[1][bj][2 + e][n];
        }
        asm volatile("s_waitcnt vmcnt(0) lgkmcnt(0)" ::: "memory"); __builtin_amdgcn_s_barrier(); asm volatile("" ::: "memory");
        const bool need_fix = (wr == 0) && (fr == 0) && ((u.pm & 7) != 0);
        const bool give_halo = (wr == 1) && (fr == 15);
        const bool take_x = (wr == 1) && (fr == 0);
        float* part = PART + (size_t)u.pm * (2 * 2 * D_FF) + hcol;
        float* halo = HALO + (size_t)u.pm * (2 * 2 * D_FF) + hcol;
        const PG8_LAS float* cwt = (const PG8_LAS float*)(xl + CWT_OFF) + tcol;
#pragma unroll
        for (int n = 0; n < 2; ++n) {
            f32x4 pa[2], pb[2];
#pragma unroll
            for (int e = 0; e < 2; ++e) {
                f32x4 ha = (f32x4){0.f, 0.f, 0.f, 0.f}, hb = (f32x4){0.f, 0.f, 0.f, 0.f};
                if (take_x) { ha = X[(0 * 2 + e) * 2 + n]; hb = X[(1 * 2 + e) * 2 + n]; }
#pragma unroll
                for (int j = 0; j < 4; ++j) {
                    pa[e][j] = __int_as_float(__builtin_amdgcn_update_dpp(__float_as_int(ha[j]), __float_as_int(acc[1][0][2 + e][n][j]), 0x111, 0xf, 0xf, false));
                    pb[e][j] = __int_as_float(__builtin_amdgcn_update_dpp(__float_as_int(hb[j]), __float_as_int(acc[1][1][2 + e][n][j]), 0x111, 0xf, 0xf, false)); } }
            const f32x4 wa0 = *(const PG8_LAS f32x4*)(cwt + 4 * n), wa1 = *(const PG8_LAS f32x4*)(cwt + 256 + 4 * n), wa2 = *(const PG8_LAS f32x4*)(cwt + 512 + 4 * n), ba = *(const PG8_LAS f32x4*)(cwt + 768 + 4 * n);
            const f32x4 wb0 = *(const PG8_LAS f32x4*)(cwt + 128 + 4 * n), wb1 = *(const PG8_LAS f32x4*)(cwt + 384 + 4 * n), wb2 = *(const PG8_LAS f32x4*)(cwt + 640 + 4 * n), bb = *(const PG8_LAS f32x4*)(cwt + 896 + 4 * n);
            if (give_halo) {
                *(f32x4*)(halo + 4 * n) = acc[1][0][2][n]; *(f32x4*)(halo + D_FF + 4 * n) = acc[1][1][2][n];
                *(f32x4*)(halo + 2 * D_FF + 4 * n) = acc[1][0][3][n]; *(f32x4*)(halo + 3 * D_FF + 4 * n) = acc[1][1][3][n]; }
#pragma unroll
            for (int e = 0; e < 8; ++e) {
                const f32x4 ua = acc[e >> 2][0][e & 3][n], ub = acc[e >> 2][1][e & 3][n];
                const f32x4 ua1 = e >= 1 ? acc[(e - 1) >> 2][0][(e - 1) & 3][n] : pa[1], ub1 = e >= 1 ? acc[(e - 1) >> 2][1][(e - 1) & 3][n] : pb[1];
                const f32x4 ua2 = e >= 2 ? acc[(e - 2) >> 2][0][(e - 2) & 3][n] : pa[e], ub2 = e >= 2 ? acc[(e - 2) >> 2][1][(e - 2) & 3][n] : pb[e];
                const f32x4 av = ba + wa2 * ua + wa1 * ua1 + wa0 * ua2, bv = bb + wb2 * ub + wb1 * ub1 + wb0 * ub2;
                if (e < 2 && need_fix) { *(f32x4*)(part + (size_t)e * 2 * D_FF + 4 * n) = av; *(f32x4*)(part + (size_t)e * 2 * D_FF + D_FF + 4 * n) = bv; }
                u32x2 w; w.x = pk2(siluf(av[0]) * bv[0], siluf(av[1]) * bv[1]); w.y = pk2(siluf(av[2]) * bv[2], siluf(av[3]) * bv[3]);
                *(u32x2*)(H + (size_t)(grow0 + e) * D_FF + hcol + 4 * n) = w;
            }
            asm volatile("" ::: "memory");
        }
    }
};
struct EpiB1 {
    static constexpr bool AROWPERM = true;
    static constexpr int NTAB = 1;
    const float* ss16; const float2* rope; bf16_t* QT; bf16_t* KT; bf16_t* VT;
    __device__ __forceinline__ void fill(PG8_LAS unsigned char* xl, int i, const Unit& u, int t) const { ((PG8_LAS float*)(xl + RT1_OFF))[i * 256 + t] = rstd16(ss16, u.pm * BM + t); }
    __device__ __forceinline__ void operator()(f32x4 (&acc)[2][2][4][2], const Unit& u, int ui, int wr, int wc, int fr, int fq, PG8_LAS unsigned char* xl) const {
        const int trow0 = 8 * (16 * wr + fr), grow0 = u.pm * BM + trow0, pn = u.pn, t0 = grow0 & (SEQ - 1);
        const PG8_LAS float* rt = (const PG8_LAS float*)(xl + RT1_OFF) + ui * 256 + trow0;
        const f32x4 r0 = *(const PG8_LAS f32x4*)rt, r1 = *(const PG8_LAS f32x4*)(rt + 4);
        if (pn < 8) {
            const int h = pn & 3; const bool isk = pn >= 4; const float lg = gamma_log(h);
            bf16_t* dst = (isk ? KT : QT) + (size_t)grow0 * 1024 + h * 256 + 32 * wc + 8 * fq;
            const int i0 = 32 * wc + 8 * fq;
#pragma unroll
            for (int eh = 0; eh < 2; ++eh) {
                f32x4 rc[4][4];
#pragma unroll
                for (int e4 = 0; e4 < 4; ++e4) { const f32x4* rp = (const f32x4*)(rope + (size_t)(t0 + 4 * eh + e4) * 128 + i0);
#pragma unroll
                    for (int q = 0; q < 4; ++q) rc[e4][q] = rp[q]; }
#pragma unroll
                for (int e4 = 0; e4 < 4; ++e4) { const int e = 4 * eh + e4;
                    const int t = t0 + e, pos = t & 63;
                    const float dsc = isk ? 0.0625f * __expf(-(float)(pos + 1) * lg) : __expf((float)(pos + 1) * lg);
                    const float sc = (eh == 0 ? r0[e4] : r1[e4]) * dsc;
                    f32x4 o1[2], o2[2];
#pragma unroll
                    for (int n = 0; n < 2; ++n) { const f32x4 c0 = rc[e4][2 * n], c1 = rc[e4][2 * n + 1];
                        const f32x4 x1 = acc[eh][0][e4][n] * sc, x2 = acc[eh][1][e4][n] * sc;
                        o1[n][0] = x1[0] * c0[0] - x2[0] * c0[1]; o2[n][0] = x1[0] * c0[1] + x2[0] * c0[0];
                        o1[n][1] = x1[1] * c0[2] - x2[1] * c0[3]; o2[n][1] = x1[1] * c0[3] + x2[1] * c0[2];
                        o1[n][2] = x1[2] * c1[0] - x2[2] * c1[1]; o2[n][2] = x1[2] * c1[1] + x2[2] * c1[0];
                        o1[n][3] = x1[3] * c1[2] - x2[3] * c1[3]; o2[n][3] = x1[3] * c1[3] + x2[3] * c1[2]; }
                    *(u32x4*)(dst + (size_t)e * 1024) = pack8(o1[0], o1[1]); *(u32x4*)(dst + (size_t)e * 1024 + 128) = pack8(o2[0], o2[1]); }
                asm volatile("" ::: "memory");
            }
        } else {
            const int b = grow0 / SEQ;
            bf16_t* dst = VT + ((size_t)b * 2048 + (pn - 8) * 256 + 32 * wc + 8 * fq) * SEQ + t0;
#pragma unroll
            for (int bj = 0; bj < 2; ++bj)
#pragma unroll
                for (int n = 0; n < 2; ++n)
#pragma unroll
                    for (int j = 0; j < 4; ++j) { u32x4 w;
                        w.x = pk2(acc[0][bj][0][n][j] * r0[0], acc[0][bj][1][n][j] * r0[1]); w.y = pk2(acc[0][bj][2][n][j] * r0[2], acc[0][bj][3][n][j] * r0[3]);
                        w.z = pk2(acc[1][bj][0][n][j] * r1[0], acc[1][bj][1][n][j] * r1[1]); w.w = pk2(acc[1][bj][2][n][j] * r1[2], acc[1][bj][3][n][j] * r1[3]);
                        *(u32x4*)(dst + (size_t)(128 * bj + 4 * n + j) * SEQ) = w; }
        }
    }
};
struct EpiGate {
    static constexpr bool AROWPERM = false;
    static constexpr int NTAB = 1;
    const float* ss16; const float* ssr; bf16_t* RET;
    __device__ __forceinline__ void fill(PG8_LAS unsigned char* xl, int i, const Unit& u, int t) const {
        const int row = u.pm * BM + t;
        ((PG8_LAS float*)(xl + RT1_OFF))[i * 256 + t] = rstd16(ss16, row);
        const f32x4* sp = (const f32x4*)(ssr + ((size_t)row * 4 + (u.pn >> 1)) * 16); const f32x4 s0 = sp[0], s1 = sp[1], s2 = sp[2], s3 = sp[3];
        ((PG8_LAS float*)(xl + RT2_OFF))[i * 256 + t] = rsqrtf(((((s0[0] + s0[1]) + (s0[2] + s0[3])) + ((s1[0] + s1[1]) + (s1[2] + s1[3]))) + (((s2[0] + s2[1]) + (s2[2] + s2[3])) + ((s3[0] + s3[1]) + (s3[2] + s3[3])))) * (1.0f / 512.0f) + EPS);
    }
    __device__ __forceinline__ void operator()(f32x4 (&acc)[2][2][4][2], const Unit& u, int ui, int wr, int wc, int fr, int fq, PG8_LAS unsigned char* xl) const {
        const int row0 = u.pm * BM + wr * 64 + fr, colb = u.pn * BM + wc * 32 + 8 * fq;
        const PG8_LAS float* rt = (const PG8_LAS float*)(xl + RT1_OFF) + ui * 256 + wr * 64 + fr;
        const PG8_LAS float* rt2 = (const PG8_LAS float*)(xl + RT2_OFF) + ui * 256 + wr * 64 + fr;
        u32x4 rvv[2][4][2];
#pragma unroll
        for (int ai = 0; ai < 2; ++ai)
#pragma unroll
            for (int m = 0; m < 4; ++m)
#pragma unroll
                for (int bj = 0; bj < 2; ++bj) rvv[ai][m][bj] = *(const u32x4*)(RET + (size_t)(row0 + ai * HALF + m * 16) * 2048 + colb + bj * HALF);
#pragma unroll
        for (int ai = 0; ai < 2; ++ai)
#pragma unroll
            for (int m = 0; m < 4; ++m) { const int row = row0 + ai * HALF + m * 16; const float r = rt[ai * HALF + m * 16], rh = rt2[ai * HALF + m * 16];
#pragma unroll
                for (int bj = 0; bj < 2; ++bj) { bf16_t* p = RET + (size_t)row * 2048 + colb + bj * HALF; const u32x4 rv = rvv[ai][m][bj];
                    const f32x4 g0 = acc[ai][bj][m][0] * r, g1 = acc[ai][bj][m][1] * r; f32x4 y0, y1;
                    y0[0] = bflo(rv.x) * rh * siluf(g0[0]); y0[1] = bfhi(rv.x) * rh * siluf(g0[1]); y0[2] = bflo(rv.y) * rh * siluf(g0[2]); y0[3] = bfhi(rv.y) * rh * siluf(g0[3]);
                    y1[0] = bflo(rv.z) * rh * siluf(g1[0]); y1[1] = bfhi(rv.z) * rh * siluf(g1[1]); y1[2] = bflo(rv.w) * rh * siluf(g1[2]); y1[3] = bfhi(rv.w) * rh * siluf(g1[3]);
                    *(u32x4*)p = pack8(y0, y1); } }
    }
};

template <class Epi, class Sched>
__device__ __forceinline__ void gemm_phase(PG8_LAS unsigned char* lds, const Gemm g, const Sched& S, const Epi& E) {
    int tid_ = threadIdx.x; asm volatile("" : "+v"(tid_));
    const int tid = tid_, wid = __builtin_amdgcn_readfirstlane(tid >> 6), lane = tid & 63, wr = wid >> 2, wc = wid & 3, fr = lane & 15, fq = lane >> 4;
    const int K = g.K, nt = K / BK;
    unsigned voffA0[2], voffA1[2], voffB[2];
#pragma unroll
    for (int i = 0; i < 2; ++i) { int R, C; stage_rc(tid * 16 + i * 8192, R, C); const int Rb = (R & ~31) + perm32(R & 31);
        int ra0, ra1;
        if (Epi::AROWPERM) { const int base = ((R >> 6) * 16 + (R & 15)) * 8 + ((R >> 4) & 3); ra0 = base; ra1 = base + 4; } else { ra0 = R; ra1 = R + HALF; }
        voffA0[i] = (unsigned)(ra0 * K + C) * 2u; voffA1[i] = (unsigned)(ra1 * K + C) * 2u; voffB[i] = (unsigned)(Rb * K + C) * 2u; }
    const size_t kstep = (size_t)(BK * 2);
    const size_t hstep = (size_t)HALF * K * 2;
    const size_t tstep = 2 * hstep;
    const unsigned ldsw = (unsigned)wid * 1024u;
    const int aoff = lds_byte(wr * 64 + fr, fq * 8), boff = lds_byte(wc * 32 + fr, fq * 8);
#define PG8_SA(b, h) (((b) * 2 + (h)) * HTB)
#define PG8_SB(b, h) ((4 + (b) * 2 + (h)) * HTB)
#define PG8_STAGE(bufoff, gbase, voff) do { _Pragma("unroll") for (int _i = 0; _i < 2; ++_i) \
        __builtin_amdgcn_global_load_lds((const unsigned*)((const char*)(gbase) + (voff)[_i]), (PG8_LAS unsigned*)(lds + (bufoff) + ldsw + _i * 8192), 16, 0, 0); } while (0)
#define PG8_LDA(dst, b, h) do { _Pragma("unroll") for (int m = 0; m < 4; ++m) _Pragma("unroll") for (int k = 0; k < 2; ++k) dst[m][k] = *(const PG8_LAS bf16x8*)(lds + PG8_SA(b, h) + aoff + m * 2048 + k * 1024); } while (0)
#define PG8_LDB(dst, b, h) do { _Pragma("unroll") for (int n = 0; n < 2; ++n) _Pragma("unroll") for (int k = 0; k < 2; ++k) dst[n][k] = *(const PG8_LAS bf16x8*)(lds + PG8_SB(b, h) + boff + n * 2048 + k * 1024); } while (0)
#define PG8_MMA(ai, bj, At, Bt) do { __builtin_amdgcn_s_setprio(1); _Pragma("unroll") for (int m = 0; m < 4; ++m) _Pragma("unroll") for (int n = 0; n < 2; ++n) _Pragma("unroll") for (int k = 0; k < 2; ++k) \
        acc[ai][bj][m][n] = __builtin_amdgcn_mfma_f32_16x16x32_bf16(Bt[n][k], At[m][k], acc[ai][bj][m][n], 0, 0, 0); __builtin_amdgcn_s_setprio(0); } while (0)
#define PG8_WAIT_V(n) asm volatile("s_waitcnt vmcnt(" #n ")" ::: "memory")
#define PG8_WAIT_L(n) asm volatile("s_waitcnt lgkmcnt(" #n ")" ::: "memory")
#define PG8_BAR __builtin_amdgcn_s_barrier()
#define PG8_SCHED __builtin_amdgcn_sched_barrier(0)
    Unit cur, nxt; int ui = 0;
    if (!S.next(0, cur)) return;
    f32x4 acc[2][2][4][2];
#pragma unroll
    for (int a = 0; a < 2; ++a)
#pragma unroll
        for (int b = 0; b < 2; ++b)
#pragma unroll
            for (int m = 0; m < 4; ++m)
#pragma unroll
                for (int n = 0; n < 2; ++n) acc[a][b][m][n] = (f32x4){0.f, 0.f, 0.f, 0.f};
    bf16x8 At[4][2], B0[2][2], B1[2][2];
    const char* cA = (const char*)g.A + (size_t)cur.pm * tstep; const char* cB = (const char*)g.Bt + (size_t)cur.pn * tstep;
    PG8_STAGE(PG8_SB(0, 0), cB, voffB); PG8_STAGE(PG8_SB(0, 1), cB + hstep, voffB); PG8_STAGE(PG8_SA(0, 0), cA, voffA0); PG8_STAGE(PG8_SA(0, 1), cA, voffA1);
    if constexpr (Epi::NTAB > 0) {
#pragma unroll 1
        for (int i = tid >> 8; i < 8; i += 2) { Unit uu; if (!S.next(i, uu)) break; E.fill(lds + STAGE_BYTES, i, uu, tid & 255); asm volatile("" ::: "memory"); }
        asm volatile("s_waitcnt lgkmcnt(0)" ::: "memory");
    }
    if (wr == 1) PG8_BAR;
    PG8_WAIT_V(2); PG8_BAR;
    PG8_STAGE(PG8_SB(1, 0), cB + kstep, voffB); PG8_STAGE(PG8_SA(1, 0), cA + kstep, voffA0); PG8_STAGE(PG8_SB(1, 1), cB + hstep + kstep, voffB);
    PG8_WAIT_V(6); PG8_BAR;
    for (;;) {
        const bool has_next = S.next(ui + 1, nxt);
        const char* nA = has_next ? (const char*)g.A + (size_t)nxt.pm * tstep : cA; const char* nB = has_next ? (const char*)g.Bt + (size_t)nxt.pn * tstep : cB;
        for (int t = 0; t < nt; t += 2) {
            const bool last = (t == nt - 2);
            const char* a1 = cA + (size_t)(t + 1) * kstep;
            const char* a2 = last ? nA : cA + (size_t)(t + 2) * kstep; const char* b2 = last ? nB : cB + (size_t)(t + 2) * kstep;
            const char* a3 = a2 + kstep; const char* b3 = b2 + kstep;
            PG8_LDB(B0, 0, 0); PG8_LDB(B1, 0, 1); PG8_SCHED; PG8_LDA(At, 0, 0); PG8_STAGE(PG8_SA(1, 1), a1, voffA1);
            PG8_WAIT_V(8); PG8_WAIT_L(0); PG8_BAR; PG8_MMA(0, 0, At, B0); PG8_MMA(0, 1, At, B1); PG8_BAR; PG8_SCHED;
            PG8_LDA(At, 0, 1); PG8_STAGE(PG8_SB(0, 0), b2, voffB); PG8_STAGE(PG8_SB(0, 1), b2 + hstep, voffB); PG8_STAGE(PG8_SA(0, 0), a2, voffA0);
            PG8_WAIT_V(8); PG8_WAIT_L(0); PG8_BAR; PG8_MMA(1, 0, At, B0); PG8_MMA(1, 1, At, B1); PG8_BAR; PG8_SCHED;
            PG8_LDB(B0, 1, 0); PG8_LDB(B1, 1, 1); PG8_SCHED; PG8_LDA(At, 1, 0); PG8_STAGE(PG8_SA(0, 1), a2, voffA1);
            PG8_WAIT_V(8); PG8_WAIT_L(0); PG8_BAR; PG8_MMA(0, 0, At, B0); PG8_MMA(0, 1, At, B1); PG8_BAR; PG8_SCHED;
            PG8_LDA(At, 1, 1); PG8_STAGE(PG8_SB(1, 0), b3, voffB); PG8_STAGE(PG8_SB(1, 1), b3 + hstep, voffB); PG8_STAGE(PG8_SA(1, 0), a3, voffA0);
            PG8_WAIT_V(8); PG8_WAIT_L(0); PG8_BAR; PG8_MMA(1, 0, At, B0); PG8_MMA(1, 1, At, B1); PG8_BAR; PG8_SCHED;
        }
        if (wr == 0) PG8_BAR;
        E(acc, cur, ui, wr, wc, fr, fq, lds + STAGE_BYTES);
        if (!has_next) break;
#pragma unroll
        for (int a = 0; a < 2; ++a)
#pragma unroll
            for (int b = 0; b < 2; ++b)
#pragma unroll
                for (int m = 0; m < 4; ++m)
#pragma unroll
                    for (int n = 0; n < 2; ++n) acc[a][b][m][n] = (f32x4){0.f, 0.f, 0.f, 0.f};
        cur = nxt; cA = nA; cB = nB; ++ui;
        if (wr == 1) PG8_BAR;
    }
    PG8_WAIT_V(0);
    PG8_BAR;
#undef PG8_SA
#undef PG8_SB
#undef PG8_STAGE
#undef PG8_LDA
#undef PG8_LDB
#undef PG8_MMA
#undef PG8_WAIT_V
#undef PG8_WAIT_L
#undef PG8_BAR
#undef PG8_SCHED
}
}

constexpr int NWAVES = 8;
constexpr int RING_BYTES = 131072, LDS_BYTES = 163840, LDSCTL_OFF = LDS_BYTES - 512, MISC_OFF = LDSCTL_OFF + 320;
#define GAS __attribute__((address_space(1)))
#define LAS __attribute__((address_space(3)))
typedef GAS unsigned gu32;
#define RLX_AGENT __ATOMIC_RELAXED, __HIP_MEMORY_SCOPE_AGENT
#define LDS_WAIT() asm volatile("s_waitcnt lgkmcnt(0)" ::: "memory")
#define VM_WAIT() asm volatile("s_waitcnt vmcnt(0)" ::: "memory")
constexpr int CW_BAR = 4096;
#define XB_TMO      128
#define XB_XCNT(j)  (256  + 64 * (j))
#define XB_XSUB(j)  (1280 + 64 * (j))
#define XB_XGEN(j)  (2304 + 64 * (j))
#define XB_TOP      3328
#define XB_TOPGEN   3392
#define XCD_BAR_WORDS 3456
#define XB_SPIN_CAP (1u << 18)
__device__ __forceinline__ unsigned xb_ld(unsigned* p)              { return __hip_atomic_load(p, __ATOMIC_RELAXED, __HIP_MEMORY_SCOPE_AGENT); }
__device__ __forceinline__ unsigned xb_add(unsigned* p, unsigned v) { return __hip_atomic_fetch_add(p, v, __ATOMIC_RELAXED, __HIP_MEMORY_SCOPE_AGENT); }
__device__ __forceinline__ unsigned xb_xcc_id() { return (unsigned)__builtin_amdgcn_s_getreg((3 << 11) | 20) & 0xFu; }
#define XB_SPIN(cond, bar) do { unsigned _sp = 0; while (cond) { __builtin_amdgcn_s_sleep(1); \
    if ((++_sp & 255u) == 0u) { if (xb_ld(&(bar)[XB_TMO])) break; if (_sp > XB_SPIN_CAP) { atomicAdd(&(bar)[XB_TMO], 1u); break; } } } } while (0)
struct XcdBarrier { unsigned* bar; unsigned x; volatile LAS unsigned* st; };
__device__ __forceinline__ XcdBarrier xcd_barrier_post(unsigned* bar, volatile LAS unsigned* st) {
    XcdBarrier b; b.bar = bar; b.x = xb_xcc_id(); b.st = st;
    if (threadIdx.x == 0) (void)xb_add(&bar[XB_XCNT(b.x)], 1u);
    return b;
}
__device__ __forceinline__ void xcd_barrier_complete(unsigned* bar, unsigned x, unsigned& nloc, unsigned& nx) {
    const unsigned G = gridDim.x * gridDim.y * gridDim.z;
    unsigned sum, cnt, mine, sp = 0u;
    for (;;) {
        sum = 0u; cnt = 0u; mine = 0u;
#pragma unroll
        for (unsigned j = 0; j < 16; ++j) { const unsigned c = xb_ld(&bar[XB_XCNT(j)]); sum += c; cnt += (c > 0u) ? 1u : 0u; mine = (j == x) ? c : mine; }
        if (sum == G) break;
        __builtin_amdgcn_s_sleep(1);
        if ((++sp & 255u) == 0u) { if (xb_ld(&bar[XB_TMO])) break; if (sp > XB_SPIN_CAP) { atomicAdd(&bar[XB_TMO], 1u); break; } }
    }
    nloc = mine > 0u ? mine : 1u; nx = cnt > 0u ? cnt : 1u;
}
__device__ __forceinline__ void xcd_barrier(const XcdBarrier& b) {
    asm volatile("s_waitcnt vmcnt(0)" ::: "memory");
    __syncthreads();
    if (threadIdx.x == 0) {
        unsigned* bar = b.bar;
        __builtin_amdgcn_s_waitcnt(0);
        unsigned nloc = b.st[0], nx = b.st[1];
        if (nloc == 0u) { xcd_barrier_complete(bar, b.x, nloc, nx); b.st[0] = nloc; b.st[1] = nx; }
        const unsigned old = xb_add(&bar[XB_XSUB(b.x)], 1u);
        const unsigned gen = old / nloc;
        if (old + 1u == (gen + 1u) * nloc) {
            __builtin_amdgcn_fence(__ATOMIC_RELEASE, "agent");
            asm volatile("s_waitcnt vmcnt(0)" ::: "memory");
            const unsigned og = xb_add(&bar[XB_TOP], 1u);
            const unsigned tg = og / nx;
            if (og + 1u == (tg + 1u) * nx) xb_add(&bar[XB_TOPGEN], 1u);
            else XB_SPIN(xb_ld(&bar[XB_TOPGEN]) == tg, bar);
            __builtin_amdgcn_fence(__ATOMIC_ACQUIRE, "agent");
            xb_add(&bar[XB_XGEN(b.x)], 1u);
            asm volatile("s_waitcnt vmcnt(0)" ::: "memory");
        } else {
            XB_SPIN(xb_ld(&bar[XB_XGEN(b.x)]) == gen, bar);
            __builtin_amdgcn_fence(__ATOMIC_ACQUIRE, "agent");
            asm volatile("s_waitcnt vmcnt(0)" ::: "memory");
        }
    }
    __syncthreads();
}

struct Args { const float* in[16]; float* out; unsigned char* ws; int ph_lo, ph_hi, li, pad; };
enum { PH_PRO = 0, PH_A1, PH_A2, PH_A3, PH_F1A, PH_F2A, PH_B1, PH_B2, PH_GATE, PH_B3, PH_F1B, PH_F2B, PH_END };

__device__ __forceinline__ void p0_transpose_item(const float* W, int K, int Nsrc, int N, int mode, const float* gain, bf16_t* WT, LAS float* scr, int item, int lane) {
    const int nblk = N / 64, kb = item / nblk, nb = item % nblk, k0 = 64 * kb, n0 = 64 * nb;
    const int src = wmap(mode, n0 + lane);
    const float* wp = W + (size_t)k0 * Nsrc + (src >= 0 ? src : 0);
#pragma unroll
    for (int h = 0; h < 2; ++h) { float v[32];
#pragma unroll
        for (int i = 0; i < 32; ++i) v[i] = wp[(size_t)(32 * h + i) * Nsrc];
#pragma unroll
        for (int i = 0; i < 32; ++i) { float x = v[i]; if (gain) x *= gain[k0 + 32 * h + i]; if (src < 0) x = 0.f; scr[(32 * h + i) * 65 + lane] = x; } }
    LDS_WAIT(); asm volatile("" ::: "memory");
    const int kq = (lane & 3) * 16;
#pragma unroll
    for (int j = 0; j < 4; ++j) { const int n = (lane >> 2) + 16 * j; const LAS float* sp = scr + kq * 65 + n;
        u32x4 o0, o1;
        o0.x = pk2(sp[0 * 65], sp[1 * 65]); o0.y = pk2(sp[2 * 65], sp[3 * 65]); o0.z = pk2(sp[4 * 65], sp[5 * 65]); o0.w = pk2(sp[6 * 65], sp[7 * 65]);
        o1.x = pk2(sp[8 * 65], sp[9 * 65]); o1.y = pk2(sp[10 * 65], sp[11 * 65]); o1.z = pk2(sp[12 * 65], sp[13 * 65]); o1.w = pk2(sp[14 * 65], sp[15 * 65]);
        bf16_t* dst = WT + (size_t)(n0 + n) * K + k0 + kq; *(u32x4*)dst = o0; *(u32x4*)(dst + 8) = o1; }
    LDS_WAIT(); asm volatile("" ::: "memory");
}
__device__ __forceinline__ void ffn_fixup(int pm, const float* cw, const float* PART, const float* HALO, bf16_t* H) {
    if ((pm & 7) == 0) return;
    int tid = threadIdx.x; asm volatile("" : "+v"(tid));
    const float* part = PART + (size_t)pm * (4 * D_FF); const float* halo = HALO + (size_t)(pm - 1) * (4 * D_FF);
#pragma unroll
    for (int idx0 = 0; idx0 < 2 * D_FF; idx0 += NWAVES * 64) { const int idx = idx0 + tid; const int e = idx / D_FF, c = idx - e * D_FF;
        float a = part[(size_t)e * 2 * D_FF + c], b = part[(size_t)e * 2 * D_FF + D_FF + c];
        const float ha0 = halo[c], hb0 = halo[D_FF + c], ha1 = halo[2 * D_FF + c], hb1 = halo[3 * D_FF + c];
        const float wa0 = cw[c], wa1 = cw[FF2 + c], wb0 = cw[D_FF + c], wb1 = cw[FF2 + D_FF + c];
        if (e == 0) { a += wa1 * ha1 + wa0 * ha0; b += wb1 * hb1 + wb0 * hb0; } else { a += wa0 * ha1; b += wb0 * hb1; }
        H[(size_t)(pm * 256 + e) * D_FF + c] = f2bf(siluf(a) * b); }
}


__device__ __forceinline__ void dsa_slow_phase(LAS unsigned char* lds, const bf16_t* QH, const bf16_t* Cb, const float* PS, const bf16_t* QI, const bf16_t* KI, const float* WI, bf16_t* AO, int vcu, int G) {
    int tid_ = threadIdx.x; asm volatile("" : "+v"(tid_));
    const int tid = tid_, hf = tid >> 8, tl = tid & 255, lane = tid & 63, wv = (tid >> 6) & 3;
    LAS unsigned char* base = lds + hf * 32768;
    LAS float* qi = (LAS float*)base;
    LAS float* sc = qi + 512;
    LAS float* qh = sc + 2048;
    LAS float* p = qh + 1024;
    LAS unsigned* red = (LAS unsigned*)(p + 8 * 257);
    LAS float* fred = (LAS float*)(red + 256);
    LAS float* wi = fred + 32; LAS float* mh = wi + 8; LAS float* lh = mh + 8; LAS float* rq = lh + 8;
    LAS unsigned short* idx = (LAS unsigned short*)(rq + 8);
    const int npairs = M / 2;
    for (int pr = vcu; pr < npairs; pr += G) {
        const int tg = pr * 2 + hf, b = tg / SEQ, t = tg % SEQ, limit = ((t >> 6) + 1) * 64;
        __syncthreads();
        for (int e = tl; e < 512; e += 256) qi[e] = bf2f(QI[(size_t)tg * 512 + e]);
        if (tl < 8) { const int h = tl; const float* ps = PS + (size_t)tg * 56;
            const int qb = (5 + (h >> 2)) * 8 + ((h >> 1) & 1) * 4 + 2 * (h & 1);
            wi[h] = WI[(size_t)tg * 8 + h] * rsqrtf((ps[qb] + ps[qb + 1]) * (1.0f / 64.0f) + EPS);
            const int hb = (h >> 1) * 8 + (h & 1) * 4;
            rq[h] = rsqrtf((ps[hb] + ps[hb + 1] + ps[hb + 2] + ps[hb + 3]) * (1.0f / 128.0f) + EPS); }
        for (int e = tl; e < 1024; e += 256) qh[e] = bf2f(QH[(size_t)tg * 1024 + e]);
        __syncthreads();
        for (int s = tl; s < limit; s += 256) {
            const u32x4* kr = (const u32x4*)(KI + ((size_t)b * SEQ + s) * 64);
            const float* ps = PS + ((size_t)b * SEQ + s) * 56; const float rk = rsqrtf((ps[36] + ps[37]) * (1.0f / 64.0f) + EPS);
            float d[8];
#pragma unroll
            for (int h = 0; h < 8; ++h) d[h] = 0.f;
#pragma unroll 2
            for (int c8 = 0; c8 < 8; ++c8) { const u32x4 kv = kr[c8]; const float k0 = bflo(kv.x), k1 = bfhi(kv.x), k2 = bflo(kv.y), k3 = bfhi(kv.y), k4 = bflo(kv.z), k5 = bfhi(kv.z), k6 = bflo(kv.w), k7 = bfhi(kv.w);
#pragma unroll
                for (int h = 0; h < 8; ++h) { const LAS float* q = qi + h * 64 + c8 * 8;
                    d[h] += q[0] * k0 + q[1] * k1 + q[2] * k2 + q[3] * k3 + q[4] * k4 + q[5] * k5 + q[6] * k6 + q[7] * k7; } }
            float tot = 0.f;
#pragma unroll
            for (int h = 0; h < 8; ++h) tot += fmaxf(d[h], 0.f) * wi[h];
            sc[s] = tot * rk + 0.0f;
        }
        __syncthreads();
        int count;
        if (limit <= TOPK) { count = limit; for (int j = tl; j < limit; j += 256) idx[j] = (unsigned short)j; __syncthreads(); }
        else {
            count = TOPK;
            unsigned key[8];
#pragma unroll
            for (int j = 0; j < 8; ++j) { const int s = tl * 8 + j; unsigned k = 0u; if (s < limit) { const unsigned u = __float_as_uint(sc[s]); k = (u & 0x80000000u) ? ~u : (u | 0x80000000u); } key[j] = k; }
            unsigned Tk = 0u;
            for (int bit = 31; bit >= 0; --bit) {
                const unsigned cand = Tk | (1u << bit); int c = 0;
#pragma unroll
                for (int j = 0; j < 8; ++j) c += (key[j] >= cand) ? 1 : 0;
                c = (int)wave_sum((float)c);
                if (lane == 0) red[wv] = (unsigned)c;
                __syncthreads();
                const int tot = (int)(red[0] + red[1] + red[2] + red[3]);
                __syncthreads();
                if (tot >= TOPK) Tk = cand;
            }
            int ngt = 0, neq = 0;
#pragma unroll
            for (int j = 0; j < 8; ++j) { ngt += (key[j] > Tk) ? 1 : 0; neq += (key[j] == Tk) ? 1 : 0; }
            red[tl] = ((unsigned)ngt << 16) | (unsigned)neq;
            __syncthreads();
            int tot_gt = 0, eq_before = 0;
            for (int j = 0; j < 256; ++j) { const unsigned v = red[j]; tot_gt += (int)(v >> 16); if (j < tl) eq_before += (int)(v & 0xffffu); }
            __syncthreads();
            const int need_eq = TOPK - tot_gt;
            unsigned selm = 0u; int nsel = 0, eqr = eq_before;
#pragma unroll
            for (int j = 0; j < 8; ++j) { bool sl = key[j] > Tk; if (key[j] == Tk) { sl = eqr < need_eq; ++eqr; } if (sl) { selm |= 1u << j; ++nsel; } }
            red[tl] = (unsigned)nsel;
            __syncthreads();
            int bs = 0; for (int j = 0; j < tl; ++j) bs += (int)red[j];
#pragma unroll
            for (int j = 0; j < 8; ++j) if (selm & (1u << j)) idx[bs++] = (unsigned short)(tl * 8 + j);
            __syncthreads();
        }
        float lg[8];
#pragma unroll
        for (int h = 0; h < 8; ++h) lg[h] = 0.f;
        if (tl < count) {
            const int key = idx[tl]; const u32x4* cr = (const u32x4*)(Cb + ((size_t)b * SEQ + key) * 128);
            const float* ps = PS + ((size_t)b * SEQ + key) * 56 + 32; const float rc = rsqrtf((ps[0] + ps[1] + ps[2] + ps[3]) * (1.0f / 128.0f) + EPS);
#pragma unroll 2
            for (int c8 = 0; c8 < 16; ++c8) { const u32x4 cv = cr[c8]; const float k0 = bflo(cv.x), k1 = bfhi(cv.x), k2 = bflo(cv.y), k3 = bfhi(cv.y), k4 = bflo(cv.z), k5 = bfhi(cv.z), k6 = bflo(cv.w), k7 = bfhi(cv.w);
#pragma unroll
                for (int h = 0; h < 8; ++h) { const LAS float* q = qh + h * 128 + c8 * 8;
                    lg[h] += q[0] * k0 + q[1] * k1 + q[2] * k2 + q[3] * k3 + q[4] * k4 + q[5] * k5 + q[6] * k6 + q[7] * k7; } }
#pragma unroll
            for (int h = 0; h < 8; ++h) lg[h] *= rc * rq[h];
        } else {
#pragma unroll
            for (int h = 0; h < 8; ++h) lg[h] = -INFINITY;
        }
#pragma unroll
        for (int h = 0; h < 8; ++h) { float m = lg[h];
#pragma unroll
            for (int o = 1; o < 64; o <<= 1) m = fmaxf(m, __shfl_xor(m, o));
            if (lane == 0) fred[h * 4 + wv] = m; }
        __syncthreads();
        if (tl < 8) mh[tl] = fmaxf(fmaxf(fred[tl * 4], fred[tl * 4 + 1]), fmaxf(fred[tl * 4 + 2], fred[tl * 4 + 3]));
        __syncthreads();
#pragma unroll
        for (int h = 0; h < 8; ++h) { const float e = (tl < count) ? __expf(lg[h] - mh[h]) : 0.f; p[h * 257 + tl] = e; const float sm = wave_sum(e); if (lane == 0) fred[h * 4 + wv] = sm; }
        __syncthreads();
        if (tl < 8) lh[tl] = (fred[tl * 4] + fred[tl * 4 + 1]) + (fred[tl * 4 + 2] + fred[tl * 4 + 3]);
        __syncthreads();
        { const int h = tl >> 5, d = (tl & 31) * 4; float a0 = 0.f, a1 = 0.f, a2 = 0.f, a3 = 0.f;
            for (int j = 0; j < count; ++j) { const float pj = p[h * 257 + j]; const u32x2 cv = *(const u32x2*)(Cb + ((size_t)b * SEQ + idx[j]) * 128 + d);
                a0 += pj * bflo(cv.x); a1 += pj * bfhi(cv.x); a2 += pj * bflo(cv.y); a3 += pj * bfhi(cv.y); }
            const float inv = 1.0f / lh[h]; u32x2 o; o.x = pk2(a0 * inv, a1 * inv); o.y = pk2(a2 * inv, a3 * inv);
            *(u32x2*)(AO + (size_t)tg * 1024 + h * 128 + d) = o; }
    }
    __syncthreads();
}
__device__ __forceinline__ void ret_slow_phase(LAS unsigned char* lds, const bf16_t* QT, const bf16_t* KT, const bf16_t* VT, bf16_t* RET, float* SSR, int unit0, int G) {
    LAS bf16_t* Qs = (LAS bf16_t*)lds;
    LAS bf16_t* Ks = Qs + 64 * 256;
    LAS bf16_t* Vs = Ks + 64 * 256;
    LAS float* Ss = (LAS float*)(Vs + 64 * 64);
    LAS float* St = Ss + 64 * 65;
    int tid_ = threadIdx.x; asm volatile("" : "+v"(tid_));
    const int tid = tid_, dv = tid & 63, g8 = tid >> 6;
    for (int u = unit0; u < 256; u += G) {
        const int blk = u & 7, h = (u >> 3) & 3, b = u >> 5;
        const float g64 = __expf(64.0f * gamma_log(h));
        __syncthreads();
        for (int e = tid; e < 256 * 64; e += 512) St[e] = 0.f;
        for (int n = 0; n < 32; ++n) {
            const size_t row0 = (size_t)b * SEQ + n * 64;
            __syncthreads();
            for (int e = tid; e < 64 * 32; e += 512) { const int r = e >> 5, c8 = e & 31;
                *(LAS u32x4*)(Qs + r * 256 + c8 * 8) = *(const u32x4*)(QT + (row0 + r) * 1024 + h * 256 + c8 * 8);
                *(LAS u32x4*)(Ks + r * 256 + c8 * 8) = *(const u32x4*)(KT + (row0 + r) * 1024 + h * 256 + c8 * 8); }
            for (int e = tid; e < 64 * 64; e += 512) { const int dd = e >> 6, key = e & 63; Vs[key * 64 + dd] = VT[((size_t)b * 2048 + h * 512 + blk * 64 + dd) * SEQ + n * 64 + key]; }
            __syncthreads();
            { const int q = tid >> 3, kg = tid & 7;
                for (int key = kg * 8; key < kg * 8 + 8; ++key) { float d = 0.f;
                    if (key <= q) for (int i = 0; i < 256; ++i) d += bf2f(Qs[q * 256 + i]) * bf2f(Ks[key * 256 + i]);
                    Ss[q * 65 + key] = d; } }
            __syncthreads();
            for (int q = g8 * 8; q < g8 * 8 + 8; ++q) { float r = 0.f;
                for (int key = 0; key <= q; ++key) r += Ss[q * 65 + key] * bf2f(Vs[key * 64 + dv]);
                for (int i = 0; i < 256; ++i) r += bf2f(Qs[q * 256 + i]) * St[i * 64 + dv];
                RET[(row0 + q) * 2048 + h * 512 + blk * 64 + dv] = f2bf(r);
                const float sq = wave_sum(r * r);
                if (dv < 2) SSR[((row0 + q) * 4 + h) * 16 + blk * 2 + dv] = dv == 0 ? sq : 0.f; }
            __syncthreads();
            for (int i = 0; i < 32; ++i) { const int dk = g8 * 32 + i; float a = St[dk * 64 + dv];
                for (int key = 0; key < 64; ++key) a += bf2f(Ks[key * 256 + dk]) * bf2f(Vs[key * 64 + dv]);
                St[dk * 64 + dv] = a * g64; }
        }
    }
    __syncthreads();
}


__device__ __forceinline__ void glds16_asm(const void* gsrc, unsigned lds_dst) {
    unsigned keep; asm volatile("s_mov_b32 %0, m0\n\ts_mov_b32 m0, %2\n\ts_nop 0\n\tglobal_load_lds_dwordx4 %1, off\n\ts_mov_b32 m0, %0" : "=&s"(keep) : "v"(gsrc), "s"(lds_dst) : "memory"); }
__device__ __forceinline__ unsigned lds_addr(LAS unsigned char* p) { return (unsigned)__builtin_amdgcn_readfirstlane((int)(unsigned)(size_t)p); }

typedef short s16x4 __attribute__((ext_vector_type(4)));
__device__ __forceinline__ bf16x8 cat4(s16x4 a, s16x4 b) { bf16x8 r; r[0] = a[0]; r[1] = a[1]; r[2] = a[2]; r[3] = a[3]; r[4] = b[0]; r[5] = b[1]; r[6] = b[2]; r[7] = b[3]; return r; }
__device__ __forceinline__ void ret_fast_phase(LAS unsigned char* lds, const bf16_t* QT, const bf16_t* KT, const bf16_t* VT, bf16_t* RET, float* SSR, int unit) {
    int tid_ = threadIdx.x; asm volatile("" : "+v"(tid_));
    const int tid = tid_, lane = tid & 63, w = __builtin_amdgcn_readfirstlane(tid >> 6), li = lane & 15, g = lane >> 4;
    const int blk = unit & 7, h = (unit >> 3) & 3, b = unit >> 5;
    const float g64 = __expf(64.0f * gamma_log(h));
    const int qt = (w < 2) ? 0 : (w < 4) ? 1 : (w < 6) ? 3 : 2, dvh = w & 1;
    const int kt0 = (w == 3) ? 1 : (w == 5 || w == 7) ? 2 : 0;
    const int kt1 = (w == 0 || w == 2) ? 1 : (w == 1) ? 0 : (w == 3) ? 2 : (w == 4 || w == 6) ? 2 : (w == 5) ? 4 : 3;
    constexpr int KB = 0, VB = 65536, ST = 81920, SIMG = 147456;
    typedef __attribute__((address_space(3))) s16x4 lds_s16x4;
    for (int e = tid; e < 2048; e += 512) *(LAS u32x4*)(lds + ST + e * 16) = (u32x4){0u, 0u, 0u, 0u};
    f32x4 st[2][4];
#pragma unroll
    for (int d = 0; d < 2; ++d)
#pragma unroll
        for (int t = 0; t < 4; ++t) st[d][t] = (f32x4){0.f, 0.f, 0.f, 0.f};
    const size_t rowb = (size_t)b * SEQ;
    const bf16_t* kbase = KT + rowb * 1024 + h * 256;
    const bf16_t* qbase = QT + (rowb + 16 * qt + li) * 1024 + h * 256 + 8 * g;
    const bf16_t* vbase = VT + ((size_t)b * 2048 + h * 512 + blk * 64 + (tid >> 3)) * SEQ + 8 * (tid & 7);
    const unsigned vw_off = (unsigned)((tid >> 3) * 128 + (((2 * (tid & 7)) ^ ((tid >> 3) & 14)) * 8));
    unsigned ksrc[4];
#pragma unroll
    for (int i = 0; i < 4; ++i) { const int row = 2 * (4 * w + i) + (lane >> 5), p = lane & 31, c = p ^ ((row & 7) << 1); ksrc[i] = (unsigned)(row * 2048 + c * 16); }
#define RK_DMA(n_, buf_) do { const char* kb_ = (const char*)(kbase + (size_t)(n_) * 64 * 1024); const unsigned ld_ = lds_addr(lds + KB + (buf_) * 32768 + (4 * w) * 1024); _Pragma("unroll") for (int i = 0; i < 4; ++i) \
        glds16_asm(kb_ + ksrc[i], ld_ + i * 1024); } while (0)
    bf16x8 qf[8], qn[8]; u32x4 vreg;
    RK_DMA(0, 0);
    vreg = *(const u32x4*)(vbase);
#pragma unroll
    for (int ks = 0; ks < 8; ++ks) { qf[ks] = *(const bf16x8*)(qbase + 32 * ks); qn[ks] = qf[ks]; }
    *(LAS u32x4*)(lds + VB + vw_off) = vreg;
    asm volatile("s_waitcnt vmcnt(0) lgkmcnt(0)" ::: "memory"); __builtin_amdgcn_s_barrier(); asm volatile("" ::: "memory");
#pragma unroll 1
    for (int n = 0; n < 32; ++n) {
        const int cur = n & 1, nxt = cur ^ 1;
        LAS unsigned char* kb = lds + KB + cur * 32768; LAS unsigned char* vb = lds + VB + cur * 8192; LAS unsigned char* sb = lds + ST + cur * 32768;
#ifndef RET_PROBE
#define RET_PROBE 0
#endif
        if (n + 1 < 32) {
            RK_DMA(n + 1, nxt);
            if (RET_PROBE & 1) { RK_DMA(n + 1, nxt); }
            vreg = *(const u32x4*)(vbase + (size_t)(n + 1) * 64);
#pragma unroll
            for (int ks = 0; ks < 8; ++ks) qn[ks] = *(const bf16x8*)(qbase + (size_t)(n + 1) * 64 * 1024 + 32 * ks);
        }
#pragma unroll 1
        for (int kt2 = 2 * kt0; kt2 < 2 * kt1; kt2 += ((RET_PROBE & 2) ? 1 : 2)) { const int kt = kt2 >> 1;
            f32x4 acc = (f32x4){0.f, 0.f, 0.f, 0.f};
            const int row = 16 * kt + li; const LAS unsigned char* rp = kb + row * 512; const int sw = (row & 7) << 1;
            bf16x8 av[8];
#pragma unroll
            for (int ks = 0; ks < 8; ++ks) av[ks] = *(const LAS bf16x8*)(rp + (((4 * ks + g) ^ sw) * 16));
            __builtin_amdgcn_sched_barrier(0);
#pragma unroll
            for (int ks = 0; ks < 8; ++ks) acc = __builtin_amdgcn_mfma_f32_16x16x32_bf16(av[ks], qf[ks], acc, 0, 0, 0);
            if (kt == qt) {
#pragma unroll
                for (int r = 0; r < 4; ++r) acc[r] = (4 * g + r <= li) ? acc[r] : 0.f; }
            u32x2 pk; pk.x = pk2(acc[0], acc[1]); pk.y = pk2(acc[2], acc[3]);
            *(LAS u32x2*)(lds + SIMG + ((qt * 4 + kt) * 64 + lane) * 8) = pk;
        }
        bf16x8 vf[4][2];
#pragma unroll
        for (int t = 0; t < 4; ++t)
#pragma unroll
            for (int kp = 0; kp < 2; ++kp) { const int row = 16 * t + li; const LAS unsigned char* rp = vb + row * 128; const int f = row & 14;
                const s16x4 lo = *(const LAS s16x4*)(rp + (((8 * kp + g) ^ f) * 8)), hi = *(const LAS s16x4*)(rp + (((8 * kp + 4 + g) ^ f) * 8)); vf[t][kp] = cat4(lo, hi); }
        bf16x8 ua[2][2];
#pragma unroll
        for (int d = 0; d < 2; ++d)
#pragma unroll
            for (int kp = 0; kp < 2; ++kp) { const int dkt = 2 * w + d;
                const int r0 = 32 * kp + 4 * g + (li >> 2), r1 = r0 + 16;
                const int cch = 2 * dkt + ((li >> 1) & 1), hb = (li & 1) * 8;
                const s16x4 lo = __builtin_bit_cast(s16x4, __builtin_amdgcn_ds_read_tr16_b64_v4i16((lds_s16x4*)(kb + r0 * 512 + ((cch ^ ((r0 & 7) << 1)) * 16) + hb)));
                const s16x4 hi = __builtin_bit_cast(s16x4, __builtin_amdgcn_ds_read_tr16_b64_v4i16((lds_s16x4*)(kb + r1 * 512 + ((cch ^ ((r1 & 7) << 1)) * 16) + hb)));
                ua[d][kp] = cat4(lo, hi); }
        __builtin_amdgcn_sched_barrier(0);
#pragma unroll
        for (int d = 0; d < 2; ++d)
#pragma unroll
            for (int kp = 0; kp < 2; ++kp)
#pragma unroll
                for (int t = 0; t < 4; ++t) st[d][t] = __builtin_amdgcn_mfma_f32_16x16x32_bf16(ua[d][kp], vf[t][kp], st[d][t], 0, 0, 0);
        asm volatile("s_waitcnt lgkmcnt(0)" ::: "memory"); __builtin_amdgcn_s_barrier(); asm volatile("" ::: "memory");
        if (RET_PROBE & 8) { __builtin_amdgcn_s_barrier(); asm volatile("" ::: "memory"); __builtin_amdgcn_s_barrier(); asm volatile("" ::: "memory"); }
        float ssq = 0.f;
        bf16x8 sf[2]; bool sv[2];
#pragma unroll
        for (int kp = 0; kp < 2; ++kp) { sv[kp] = (2 * kp <= qt); sf[kp] = (bf16x8){0, 0, 0, 0, 0, 0, 0, 0};
            if (sv[kp]) { const s16x4 lo = *(const LAS s16x4*)(lds + SIMG + ((qt * 4 + 2 * kp) * 64 + lane) * 8);
                s16x4 hi = (s16x4){0, 0, 0, 0}; if (2 * kp + 1 <= qt) hi = *(const LAS s16x4*)(lds + SIMG + ((qt * 4 + 2 * kp + 1) * 64 + lane) * 8);
                sf[kp] = cat4(lo, hi); } }
#pragma unroll
        for (int dd2 = 0; dd2 < ((RET_PROBE & 4) ? 4 : 2); ++dd2) { const int dd = dd2 & 1; const int t = 2 * dvh + dd; if (dd2 == 2) ssq = 0.f;
            bf16x8 sa[8];
            {   const int row = 16 * t + li; const LAS unsigned char* rp = sb + row * 512; const int sw = (row & 7) << 1;
#pragma unroll
                for (int ks = 0; ks < 8; ++ks) sa[ks] = *(const LAS bf16x8*)(rp + (((4 * ks + g) ^ sw) * 16)); }
            __builtin_amdgcn_sched_barrier(0);
            f32x4 acc = (f32x4){0.f, 0.f, 0.f, 0.f};
#pragma unroll
            for (int kp = 0; kp < 2; ++kp) if (sv[kp]) {
                const bf16x8 va = dvh ? (dd ? vf[3][kp] : vf[2][kp]) : (dd ? vf[1][kp] : vf[0][kp]);
                acc = __builtin_amdgcn_mfma_f32_16x16x32_bf16(va, sf[kp], acc, 0, 0, 0); }
#pragma unroll
            for (int ks = 0; ks < 8; ++ks) acc = __builtin_amdgcn_mfma_f32_16x16x32_bf16(sa[ks], qf[ks], acc, 0, 0, 0);
            ssq += (acc[0] * acc[0] + acc[1] * acc[1]) + (acc[2] * acc[2] + acc[3] * acc[3]);
            u32x2 pk; pk.x = pk2(acc[0], acc[1]); pk.y = pk2(acc[2], acc[3]);
            *(u32x2*)(RET + (rowb + n * 64 + 16 * qt + li) * 2048 + h * 512 + blk * 64 + 16 * t + 4 * g) = pk;
            __builtin_amdgcn_sched_barrier(0); }
        ssq += __shfl_xor(ssq, 16); ssq += __shfl_xor(ssq, 32);
        if (g == 0) SSR[((rowb + n * 64 + 16 * qt + li) * 4 + h) * 16 + blk * 2 + dvh] = ssq;
        LAS unsigned char* sn = lds + ST + nxt * 32768;
#pragma unroll
        for (int d = 0; d < 2; ++d)
#pragma unroll
            for (int t = 0; t < 4; ++t) { st[d][t] *= g64; const int row = 16 * t + li, dkt = 2 * w + d;
                u32x2 pk; pk.x = pk2(st[d][t][0], st[d][t][1]); pk.y = pk2(st[d][t][2], st[d][t][3]);
                *(LAS u32x2*)(sn + row * 512 + (((2 * dkt + (g >> 1)) ^ ((row & 7) << 1)) * 16) + (g & 1) * 8) = pk; }
        if (n + 1 < 32) *(LAS u32x4*)(lds + VB + nxt * 8192 + vw_off) = vreg;
#pragma unroll
        for (int ks = 0; ks < 8; ++ks) qf[ks] = qn[ks];
        asm volatile("s_waitcnt vmcnt(0) lgkmcnt(0)" ::: "memory"); __builtin_amdgcn_s_barrier(); asm volatile("" ::: "memory");
    }
#undef RK_DMA
}


#ifndef DSA_REP
#define DSA_REP 0
#endif
constexpr int DSA_SC = 0, DSA_KST = 131072, DSA_IDX = 147456;
__device__ __forceinline__ unsigned fkey(float f) { const unsigned u = __float_as_uint(f); return (u & 0x80000000u) ? ~u : (u | 0x80000000u); }
__device__ __forceinline__ int bcnt(bool p) { return __popcll(__ballot(p)); }
#define SUMF(a_, b_) ((a_) + (b_))
#define WAVE_RED(OP, v) do { v = OP(v, __int_as_float(__builtin_amdgcn_update_dpp(__float_as_int(v), __float_as_int(v), 0xB1, 0xf, 0xf, true))); \
        v = OP(v, __int_as_float(__builtin_amdgcn_update_dpp(__float_as_int(v), __float_as_int(v), 0x4E, 0xf, 0xf, true))); \
        v = OP(v, __int_as_float(__builtin_amdgcn_update_dpp(__float_as_int(v), __float_as_int(v), 0x141, 0xf, 0xf, true))); \
        v = OP(v, __int_as_float(__builtin_amdgcn_update_dpp(__float_as_int(v), __float_as_int(v), 0x140, 0xf, 0xf, true))); \
        v = OP(OP(__int_as_float(__builtin_amdgcn_readlane(__float_as_int(v), 0)), __int_as_float(__builtin_amdgcn_readlane(__float_as_int(v), 16))), \
               OP(__int_as_float(__builtin_amdgcn_readlane(__float_as_int(v), 32)), __int_as_float(__builtin_amdgcn_readlane(__float_as_int(v), 48)))); } while (0)

template <int NB>
__device__ __forceinline__ void dsa_topk_t(const LAS float* sc, LAS unsigned short* il, int limit, int lane) {
    const int nb = limit >> 6;
    float v[NB];
#pragma unroll
    for (int i = 0; i < NB; ++i) v[i] = (i < nb) ? sc[64 * i + lane] : -INFINITY;
    float mn = INFINITY, mx = -INFINITY;
#pragma unroll
    for (int i = 0; i < NB; ++i) { mn = fminf(mn, (i < nb) ? v[i] : INFINITY); mx = fmaxf(mx, v[i]); }
    WAVE_RED(fminf, mn); WAVE_RED(fmaxf, mx);
    float lo = mn, hi = INFINITY; int clo = limit, chi = 0;
#pragma unroll 1
    for (int it = 0; it < 64 && clo - chi > 64; ++it) {
        const float top = (hi == INFINITY) ? mx : hi; const float mid = 0.5f * lo + 0.5f * top;
        if (!(mid > lo) || !(mid < hi)) break;
        int c = 0;
#pragma unroll
        for (int i = 0; i < NB; ++i) c += (v[i] >= mid) ? 1 : 0;
        float cf = (float)c; WAVE_RED(SUMF, cf); c = (int)cf;
        if (c >= TOPK) { lo = mid; clo = c; } else { hi = mid; chi = c; }
    }
    const int r = TOPK - chi; unsigned T; int ngt, neq;
    if (clo - chi <= 64) {
        int filled = 0;
#pragma unroll
        for (int i = 0; i < NB; ++i) { const bool in = (v[i] >= lo) && (v[i] < hi);
            const unsigned long long m = __ballot(in); const int pos = filled + __builtin_amdgcn_mbcnt_hi((unsigned)(m >> 32), __builtin_amdgcn_mbcnt_lo((unsigned)m, 0));
            if (in) ((LAS unsigned*)il)[pos] = fkey(v[i]);
            filled += __popcll(m); }
        asm volatile("s_waitcnt lgkmcnt(0)" ::: "memory");
        const unsigned ck = (lane < filled) ? ((LAS unsigned*)il)[lane] : 0u;
        T = 0u;
#pragma unroll 4
        for (int bit = 31; bit >= 0; --bit) { const unsigned cand = T | (1u << bit); if (bcnt(ck >= cand) >= r) T = cand; }
        ngt = chi + bcnt(ck > T); neq = bcnt(ck == T);
    } else {
        T = 0u;
#pragma unroll 1
        for (int bit = 31; bit >= 0; --bit) { const unsigned cand = T | (1u << bit); int c = 0;
#pragma unroll
            for (int i = 0; i < NB; ++i) c += bcnt(i < nb && fkey(v[i]) >= cand);
            if (c >= TOPK) T = cand; }
        ngt = 0; neq = 0;
#pragma unroll
        for (int i = 0; i < NB; ++i) { const unsigned k = fkey(v[i]); ngt += bcnt(i < nb && k > T); neq += bcnt(i < nb && k == T); }
    }
    const int need_eq = TOPK - ngt;
    asm volatile("s_waitcnt lgkmcnt(0)" ::: "memory");
    int base = 0, tb = 0;
    const bool alleq = (neq == need_eq);
#pragma unroll
    for (int i = 0; i < NB; ++i) if (i < nb) { const unsigned k = fkey(v[i]);
        bool f = k >= T;
        if (!alleq) { const bool eq = (k == T); const unsigned long long me = __ballot(eq);
            const int er = tb + __builtin_amdgcn_mbcnt_hi((unsigned)(me >> 32), __builtin_amdgcn_mbcnt_lo((unsigned)me, 0));
            f = (k > T) || (eq && er < need_eq); tb += __popcll(me); }
        const unsigned long long mf = __ballot(f); const int pos = base + __builtin_amdgcn_mbcnt_hi((unsigned)(mf >> 32), __builtin_amdgcn_mbcnt_lo((unsigned)mf, 0));
        if (f && pos < TOPK) il[pos] = (unsigned short)(64 * i + lane);
        base += __popcll(mf); }
}
__device__ __forceinline__ void dsa_topk(const LAS float* sc, LAS unsigned short* il, int limit, int lane) {
    if (limit <= 512) dsa_topk_t<8>(sc, il, limit, lane);
    else if (limit <= 1024) dsa_topk_t<16>(sc, il, limit, lane);
    else dsa_topk_t<32>(sc, il, limit, lane);
}

struct DsaQ { bf16x8 qf[4]; f32x4 ps; };
__device__ __forceinline__ DsaQ dsa_load_q(const bf16_t* QH, const float* PS, size_t trow, int lane) {
    const int li = lane & 15, g = lane >> 4; DsaQ q;
#pragma unroll
    for (int s = 0; s < 4; ++s) { q.qf[s] = (bf16x8){0, 0, 0, 0, 0, 0, 0, 0}; if (li < 8) q.qf[s] = *(const bf16x8*)(QH + trow * 1024 + li * 128 + 32 * s + 8 * g); }
    q.ps = (f32x4){1.f, 1.f, 1.f, 1.f}; if (li < 8) q.ps = *(const f32x4*)(PS + trow * 56 + (li >> 1) * 8 + (li & 1) * 4);
    return q;
}
__device__ __forceinline__ void dsa_attend(LAS unsigned char* wl, const LAS unsigned short* il, const LAS float* rctab, LAS float* rcl, const DsaQ& Q, const bf16_t* Cb, bf16_t* AO, size_t trow, int b, int count, float bound_l2, int lane) {
    const int li = lane & 15, g = lane >> 4;
    typedef __attribute__((address_space(3))) s16x4 lds_s16x4;
    bf16x8 qf[4];
#pragma unroll
    for (int s = 0; s < 4; ++s) qf[s] = Q.qf[s];
    const float rq = (li < 8) ? rsqrtf(((Q.ps[0] + Q.ps[1]) + (Q.ps[2] + Q.ps[3])) * (1.0f / 128.0f) + EPS) * 1.4426950408889634f : 0.f;
    const bf16_t* cbase = Cb + (size_t)b * SEQ * 128; const unsigned wlb = lds_addr(wl);
#define DSA_GATHER(ci_, buf_) do { const u32x4 kw_ = *(const LAS u32x4*)(il + 32 * (ci_) + 8 * (lane >> 4)); \
        _Pragma("unroll") for (int i = 0; i < 8; ++i) { const int row = 4 * i + (lane >> 4); const unsigned kk_ = (i < 2 ? kw_.x : i < 4 ? kw_.y : i < 6 ? kw_.z : kw_.w); const int key = (i & 1) ? (int)(kk_ >> 16) : (int)(kk_ & 0xffffu); \
        const int sc_ = (lane & 15) ^ ((row & 7) << 1); \
        glds16_asm(cbase + (size_t)key * 128 + sc_ * 8, wlb + (buf_) * 8192 + i * 1024); } } while (0)
    for (int pos = lane; pos < count; pos += 64) { const int e = pos & 31; rcl[(pos & ~31) + 4 * (e & 7) + (e >> 3)] = rctab[il[pos]]; }
    asm volatile("s_waitcnt lgkmcnt(0)" ::: "memory");
    f32x4 oacc[8];
#pragma unroll
    for (int d = 0; d < 8; ++d) oacc[d] = (f32x4){0.f, 0.f, 0.f, 0.f};
    float lsum = 0.f;
    const int nch = count >> 5;
    DSA_GATHER(0, 0);
#pragma unroll 1
    for (int ci = 0; ci < nch; ++ci) {
        const int cur = ci & 1;
        if (ci + 1 < nch) { DSA_GATHER(ci + 1, cur ^ 1); if (DSA_REP & 8) { DSA_GATHER(ci + 1, cur ^ 1); asm volatile("s_waitcnt vmcnt(16)" ::: "memory"); } else asm volatile("s_waitcnt vmcnt(8)" ::: "memory"); } else { asm volatile("s_waitcnt vmcnt(0)" ::: "memory"); }
        const LAS unsigned char* ct = wl + cur * 8192;
        f32x4 lt[2];
        bf16x8 ca[2][4];
#pragma unroll
        for (int T = 0; T < 2; ++T) { const int row = 16 * T + li; const LAS unsigned char* rp = ct + row * 256; const int sw = (row & 7) << 1;
#pragma unroll
            for (int s = 0; s < 4; ++s) ca[T][s] = *(const LAS bf16x8*)(rp + (((4 * s + g) ^ sw) * 16)); }
        f32x4 rcv[2];
#pragma unroll
        for (int T = 0; T < 2; ++T) rcv[T] = *(const LAS f32x4*)(rcl + 32 * ci + 16 * T + 4 * g);
        __builtin_amdgcn_sched_barrier(0);
#pragma unroll
        for (int T = 0; T < 2; ++T) { lt[T] = (f32x4){0.f, 0.f, 0.f, 0.f};
#pragma unroll
            for (int s = 0; s < 4; ++s) lt[T] = __builtin_amdgcn_mfma_f32_16x16x32_bf16(ca[T][s], qf[s], lt[T], 0, 0, 0); }
        bf16x8 cv[8];
#pragma unroll
        for (int dt = 0; dt < 8; ++dt) {
            const int r0 = 4 * g + (li >> 2), r1 = r0 + 16; const int cch = 2 * dt + ((li >> 1) & 1), hb = (li & 1) * 8;
            const s16x4 lo = __builtin_bit_cast(s16x4, __builtin_amdgcn_ds_read_tr16_b64_v4i16((lds_s16x4*)(ct + r0 * 256 + ((cch ^ ((r0 & 7) << 1)) * 16) + hb)));
            const s16x4 hi = __builtin_bit_cast(s16x4, __builtin_amdgcn_ds_read_tr16_b64_v4i16((lds_s16x4*)(ct + r1 * 256 + ((cch ^ ((r1 & 7) << 1)) * 16) + hb)));
            cv[dt] = cat4(lo, hi); }
        __builtin_amdgcn_sched_barrier(0);
        bf16x8 pf;
#pragma unroll
        for (int T = 0; T < 2; ++T) { float pv[4];
#pragma unroll
            for (int r = 0; r < 4; ++r) { pv[r] = __builtin_amdgcn_exp2f(lt[T][r] * rq * rcv[T][r] - bound_l2); lsum += pv[r]; }
            const unsigned w0 = pk2(pv[0], pv[1]), w1 = pk2(pv[2], pv[3]);
            pf[4 * T + 0] = (short)(w0 & 0xffff); pf[4 * T + 1] = (short)(w0 >> 16); pf[4 * T + 2] = (short)(w1 & 0xffff); pf[4 * T + 3] = (short)(w1 >> 16); }
#pragma unroll
        for (int dt = 0; dt < 8; ++dt) oacc[dt] = __builtin_amdgcn_mfma_f32_16x16x32_bf16(cv[dt], pf, oacc[dt], 0, 0, 0);
    }
#undef DSA_GATHER
    lsum += __shfl_xor(lsum, 16); lsum += __shfl_xor(lsum, 32);
    const float inv = 1.0f / lsum;
    if (li < 8) {
#pragma unroll
        for (int dt = 0; dt < 8; ++dt) { u32x2 o; o.x = pk2(oacc[dt][0] * inv, oacc[dt][1] * inv); o.y = pk2(oacc[dt][2] * inv, oacc[dt][3] * inv);
            *(u32x2*)(AO + trow * 1024 + li * 128 + 16 * dt + 4 * g) = o; }
    }
}

__device__ __forceinline__ void dsa_fast_phase(LAS unsigned char* lds, const bf16_t* QH, const bf16_t* Cb, const float* PS, const bf16_t* QI, const bf16_t* KI, const float* WI, const float* CSC, bf16_t* AO, int vcu, int G) {
    int tid_ = threadIdx.x; asm volatile("" : "+v"(tid_));
    const int tid = tid_, lane0 = tid & 63, w = __builtin_amdgcn_readfirstlane(tid >> 6);
    LAS unsigned char* wl = lds + DSA_SC + w * 16384; LAS float* rctab = (LAS float*)(lds + DSA_KST);
    LAS unsigned short* il0 = (LAS unsigned short*)(lds + DSA_IDX + (2 * w) * 512); LAS unsigned short* il1 = il0 + 256;
    float mxs = 0.f;
    for (int i = lane0; i < 128; i += 64) mxs = fmaxf(mxs, fabsf(CSC[i]));
#pragma unroll
    for (int o = 1; o < 64; o <<= 1) mxs = fmaxf(mxs, __shfl_xor(mxs, o));
    const float bound_l2 = mxs * 128.0f * 1.4426950408889634f;
    for (int wg = vcu; wg < 256; wg += G) {
        const int b = wg >> 5, r = wg & 31;
        __syncthreads();
        for (int k = tid; k < SEQ; k += NWAVES * 64) { const f32x4 p = *(const f32x4*)(PS + ((size_t)b * SEQ + k) * 56 + 32); rctab[k] = rsqrtf(((p[0] + p[1]) + (p[2] + p[3])) * (1.0f / 128.0f) + EPS); }
#pragma unroll 1
        for (int it = 0; it < 4; ++it) {
            int lane = lane0; asm volatile("" : "+v"(lane));
            const int li = lane & 15, g = lane >> 4;
            const int chunk = (it & 1) ? 31 - (r & 15) : (r & 15), sub = 2 * (r >> 4) + (it >> 1);
            const int t0 = chunk * 64 + sub * 16, limit = (chunk + 1) * 64;
            const size_t trow0 = (size_t)b * SEQ + t0 + 2 * w;
            const DsaQ Q0 = dsa_load_q(QH, PS, trow0, lane), Q1 = dsa_load_q(QH, PS, trow0 + 1, lane);
            __syncthreads();
            if (limit > TOPK) {
                for (int srep = 0; srep < 1 + (DSA_REP & 1); ++srep) {
                bf16x8 af[8][2]; float wq[8][4];
                const size_t trowi = (size_t)b * SEQ + t0;
#pragma unroll
                for (int p = 0; p < 8; ++p) {
#pragma unroll
                    for (int sidx = 0; sidx < 2; ++sidx) af[p][sidx] = *(const bf16x8*)(QI + (trowi + 2 * p + (li >> 3)) * 512 + (li & 7) * 64 + 32 * sidx + 8 * g);
                    const size_t row = trowi + 2 * p + (g >> 1); const int hb = 4 * (g & 1);
                    const f32x4 wv = *(const f32x4*)(WI + row * 8 + hb); const float* ps = PS + row * 56 + 40 + (g & 1) * 8;
                    const f32x4 p0 = *(const f32x4*)ps, p1 = *(const f32x4*)(ps + 4);
                    wq[p][0] = wv[0] * rsqrtf((p0[0] + p0[1]) * (1.0f / 64.0f) + EPS); wq[p][1] = wv[1] * rsqrtf((p0[2] + p0[3]) * (1.0f / 64.0f) + EPS);
                    wq[p][2] = wv[2] * rsqrtf((p1[0] + p1[1]) * (1.0f / 64.0f) + EPS); wq[p][3] = wv[3] * rsqrtf((p1[2] + p1[3]) * (1.0f / 64.0f) + EPS);
                    asm volatile("" ::: "memory"); }
                const int nst = limit >> 4;
                const bf16_t* kp = KI + ((size_t)b * SEQ + 16 * w + li) * 64 + 8 * g; const float* pp = PS + ((size_t)b * SEQ + 16 * w + li) * 56 + 36;
                bf16x8 b0 = *(const bf16x8*)kp, b1 = *(const bf16x8*)(kp + 32); f32x2_t pk = *(const f32x2_t*)pp;
                bf16x8 d0 = b0, d1 = b1; f32x2_t pk2v = pk;
                if (w + 8 < nst) { kp += 8 * 16 * 64; pp += 8 * 16 * 56; d0 = *(const bf16x8*)kp; d1 = *(const bf16x8*)(kp + 32); pk2v = *(const f32x2_t*)pp; }
#pragma unroll 1
                for (int st = w; st < nst; st += 8) {
                    const bf16x8 c0 = b0, c1 = b1; const float rk = rsqrtf((pk[0] + pk[1]) * (1.0f / 64.0f) + EPS);
                    b0 = d0; b1 = d1; pk = pk2v;
                    if (st + 16 < nst) { kp += 8 * 16 * 64; pp += 8 * 16 * 56; d0 = *(const bf16x8*)kp; d1 = *(const bf16x8*)(kp + 32); pk2v = *(const f32x2_t*)pp; }
                    LAS float* so = (LAS float*)(lds + DSA_SC) + (g >> 1) * 2048 + 16 * st + li;
#pragma unroll
                    for (int p = 0; p < 8; ++p) {
                        f32x4 acc = (f32x4){0.f, 0.f, 0.f, 0.f};
                        acc = __builtin_amdgcn_mfma_f32_16x16x32_bf16(af[p][0], c0, acc, 0, 0, 0); acc = __builtin_amdgcn_mfma_f32_16x16x32_bf16(af[p][1], c1, acc, 0, 0, 0);
                        float part = (fmaxf(acc[0], 0.f) * wq[p][0] + fmaxf(acc[1], 0.f) * wq[p][1]) + (fmaxf(acc[2], 0.f) * wq[p][2] + fmaxf(acc[3], 0.f) * wq[p][3]);
                        {   const auto sw = __builtin_amdgcn_permlane16_swap(__float_as_uint(part), __float_as_uint(part), false, false);
                            part = __uint_as_float(sw[0]) + __uint_as_float(sw[1]); }
                        if ((g & 1) == 0) so[p * 4096] = part * rk + 0.0f;
                    }
                }
                __syncthreads();
                }
                for (int trep = 0; trep < 1 + ((DSA_REP >> 1) & 1); ++trep) {
                dsa_topk((const LAS float*)wl, il0, limit, lane);
                dsa_topk((const LAS float*)wl + 2048, il1, limit, lane); }
            } else {
                for (int j = lane; j < limit; j += 64) { il0[j] = (unsigned short)j; il1[j] = (unsigned short)j; }
            }
            const int count = limit < TOPK ? limit : TOPK;
            for (int arep = 0; arep < 1 + ((DSA_REP >> 2) & 1); ++arep) {
            dsa_attend(wl, il0, rctab, (LAS float*)(lds + DSA_KST + 8192 + w * 1024), Q0, Cb, AO, trow0, b, count, bound_l2, lane);
            dsa_attend(wl, il1, rctab, (LAS float*)(lds + DSA_KST + 8192 + w * 1024), Q1, Cb, AO, trow0 + 1, b, count, bound_l2, lane); }
        }
    }
    __syncthreads();
}

typedef const __attribute__((address_space(4))) Args* ArgsP;
__device__ __forceinline__ ArgsP fresh_args() { ArgsP p = (ArgsP)__builtin_amdgcn_kernarg_segment_ptr(); asm volatile("" : "+s"(p)); return p; }

__device__ __forceinline__ int fresh_bx() { int v = blockIdx.x; asm volatile("" : "+s"(v)); return v; }
__device__ __forceinline__ int fresh_gx() { int v = gridDim.x; asm volatile("" : "+s"(v)); return v; }
__global__ void __launch_bounds__(NWAVES * 64, 2) mega(Args args_unused) {
    extern __shared__ __attribute__((aligned(16))) unsigned char lds_raw[];
    LAS unsigned char* lds = (LAS unsigned char*)lds_raw;
    const int tid = threadIdx.x;
    for (int u = tid; u < (LDS_BYTES - LDSCTL_OFF) / 4; u += NWAVES * 64) ((LAS unsigned*)(lds + LDSCTL_OFF))[u] = 0u;
    __syncthreads();
    int lo, hi;
    {   ArgsP A = fresh_args(); lo = A->ph_lo; hi = A->ph_hi;
        if (hi - lo > 1) (void)xcd_barrier_post((unsigned*)(A->ws + WS_CTL) + CW_BAR + A->li * XCD_BAR_WORDS, (volatile LAS unsigned*)(lds + MISC_OFF) + 8); }
#ifndef PHMASK
#define PHMASK 0xffff
#endif
#define IN(k) (((PHMASK >> (k)) & 1) && lo <= (k) && (k) < hi)
#define SEAM(k) do { if (lo <= (k) && (k) + 1 < hi) { ArgsP A_ = fresh_args(); XcdBarrier b_; b_.bar = (unsigned*)(A_->ws + WS_CTL) + CW_BAR + A_->li * XCD_BAR_WORDS; b_.x = xb_xcc_id(); \
        b_.st = (volatile LAS unsigned*)(lds + MISC_OFF) + 8; xcd_barrier(b_); } } while (0)
#ifndef REPMASK
#define REPMASK 0
#endif
#define GBAR() do { ArgsP A_ = fresh_args(); XcdBarrier b_; b_.bar = (unsigned*)(A_->ws + WS_CTL) + CW_BAR + A_->li * XCD_BAR_WORDS; b_.x = xb_xcc_id(); \
        b_.st = (volatile LAS unsigned*)(lds + MISC_OFF) + 8; xcd_barrier(b_); } while (0)
#define REPEAT(k) for (int rep_ = 0; rep_ < 1 + ((REPMASK >> (k)) & 1); ++rep_)
#define REPBAR() do { if (rep_) GBAR(); } while (0)
#define GWS int t_ = threadIdx.x; asm volatile("" : "+v"(t_)); const int lane = t_ & 63, wave = __builtin_amdgcn_readfirstlane(t_ >> 6); const int G = fresh_gx(), bx = fresh_bx(); const int vcu = (G % 8 == 0) ? (bx % 8) * (G / 8) + bx / 8 : bx; \
        const int gw = vcu * NWAVES + wave, NGW = G * NWAVES; LAS float* scr = (LAS float*)(lds + wave * 16640); (void)lane; (void)gw; (void)NGW; (void)scr;
#define WCONV(Wp, K_, Nsrc_, N_, mode_, gain_, WT_) do { const int items_ = ((K_) / 64) * ((N_) / 64); \
        for (int it = gw; it < items_; it += NGW) p0_transpose_item((Wp), (K_), (Nsrc_), (N_), (mode_), (gain_), (WT_), scr, it, lane); } while (0)

    if (IN(PH_PRO)) REPEAT(PH_PRO) { REPBAR();
        GWS; ArgsP A = fresh_args(); unsigned char* ws = A->ws;
        constexpr int I0 = 16 * 28, I1 = I0 + 16 * 16, I2 = I1 + 16 * 96, I3 = I2 + 32 * 16, I4 = I3 + 16 * 88, I5 = I4 + 44 * 16, IX = I5 + M / 4;
        {   const float* x = A->in[0]; float* SS = (float*)(ws + WS_SS); bf16_t* XB = (bf16_t*)(ws + WS_XB);
#pragma unroll 1
            for (int it = gw; it < IX; it += NGW) {
                if (it < I0) p0_transpose_item(A->in[3], 1024, A_IN_COLS, A_IN_PAD, WM_AIN, A->in[1], (bf16_t*)(ws + WS_WAIN), scr, it, lane);
                else if (it < I1) p0_transpose_item(A->in[8], 1024, 1024, 1024, WM_NAT, (const float*)nullptr, (bf16_t*)(ws + WS_WAOUT), scr, it - I0, lane);
                else if (it < I2) p0_transpose_item(A->in[9], 1024, B_IN_COLS, B_IN_COLS, WM_NAT, A->in[1] + 1024, (bf16_t*)(ws + WS_WBIN), scr, it - I1, lane);
                else if (it < I3) p0_transpose_item(A->in[11], 2048, 1024, 1024, WM_NAT, A->in[10], (bf16_t*)(ws + WS_WBOUT), scr, it - I2, lane);
                else if (it < I4) p0_transpose_item(A->in[12], 1024, FF2, FF2, WM_FUP, A->in[2], (bf16_t*)(ws + WS_WFUP0), scr, it - I3, lane);
                else if (it < I5) p0_transpose_item(A->in[15], 2816, 1024, 1024, WM_NAT, (const float*)nullptr, (bf16_t*)(ws + WS_WFDN0), scr, it - I4, lane);
                else { const int row0 = (it - I5) * 4;
                    f32x4 v[4][4];
#pragma unroll
                    for (int r = 0; r < 4; ++r)
#pragma unroll
                        for (int q = 0; q < 4; ++q) v[r][q] = ((const f32x4*)(x + (size_t)(row0 + r) * DM))[q * 64 + lane];
#pragma unroll
                    for (int r = 0; r < 4; ++r)
#pragma unroll
                        for (int q = 0; q < 4; ++q) { const f32x4 w = v[r][q]; float sq = (w[0] * w[0] + w[1] * w[1]) + (w[2] * w[2] + w[3] * w[3]); sq = wave_sum(sq);
                            if (lane < 4) SS[(size_t)(row0 + r) * 16 + q * 4 + lane] = lane == 0 ? sq : 0.f;
                            u32x2 o; o.x = pk2(w[0], w[1]); o.y = pk2(w[2], w[3]); *(u32x2*)(XB + (size_t)(row0 + r) * DM + q * 256 + lane * 4) = o; } } } }
        {   float2* ROPE = (float2*)(ws + WS_ROPE);
            for (int e = gw * 64 + lane; e < 2048 * 128; e += NGW * 64) { const int t = e >> 7, i = e & 127;
                const float inv = exp2f(-(float)(2 * i) * (13.287712379549449f / 256.0f)), ang = (float)t * inv; float sn, cs; sincosf(ang, &sn, &cs); ROPE[e] = make_float2(cs, sn); } }
        {   float* CSC = (float*)(ws + WS_CSC); const float* a_q_g = A->in[4]; const float* a_k_g = A->in[5]; const float* a_iq_g = A->in[6]; const float* a_ik_g = A->in[7];
            for (int n = gw * 64 + lane; n < A_IN_PAD; n += NGW * 64) { float v;
                if (n < 1024) v = a_q_g[n & 127] * a_k_g[n & 127] * 0.08838834764831845f; else if (n < 1152) v = 1.0f; else if (n < 1216) v = a_ik_g[n - 1152];
                else if (n < 1224) v = 0.044194173824159216f; else if (n < 1280) v = 0.f; else v = a_iq_g[(n - 1280) & 63];
                CSC[n] = v; } }
    }
    SEAM(PH_PRO);
    if (IN(PH_A1)) REPEAT(PH_A1) { REPBAR();
        ArgsP A = fresh_args(); unsigned char* ws = A->ws;
        pg8::Gemm g{(const bf16_t*)(ws + WS_XB), (const bf16_t*)(ws + WS_WAIN), M, A_IN_PAD, 1024}; pg8::StaticOrder S; S.init(M, A_IN_PAD, fresh_gx(), fresh_bx());
        pg8::EpiA1 E{(const float*)(ws + WS_SS), (const float*)(ws + WS_CSC), (bf16_t*)(ws + WS_QH), (bf16_t*)(ws + WS_C), (bf16_t*)(ws + WS_KI), (bf16_t*)(ws + WS_QI), (float*)(ws + WS_WI), (float*)(ws + WS_PS)};
        pg8::gemm_phase(lds, g, S, E);
    }
    SEAM(PH_A1);
    if (IN(PH_A2)) REPEAT(PH_A2) { REPBAR();
        ArgsP A = fresh_args(); unsigned char* ws = A->ws; const int G = fresh_gx(), bx = fresh_bx(); const int vcu = (G % 8 == 0) ? (bx % 8) * (G / 8) + bx / 8 : bx;
#if defined(DSA_SLOW)
        dsa_slow_phase(lds, (const bf16_t*)(ws + WS_QH), (const bf16_t*)(ws + WS_C), (const float*)(ws + WS_PS), (const bf16_t*)(ws + WS_QI), (const bf16_t*)(ws + WS_KI), (const float*)(ws + WS_WI), (bf16_t*)(ws + WS_AO), vcu, G);
#else
        dsa_fast_phase(lds, (const bf16_t*)(ws + WS_QH), (const bf16_t*)(ws + WS_C), (const float*)(ws + WS_PS), (const bf16_t*)(ws + WS_QI), (const bf16_t*)(ws + WS_KI), (const float*)(ws + WS_WI), (const float*)(ws + WS_CSC), (bf16_t*)(ws + WS_AO), vcu, G);
#endif
    }
    SEAM(PH_A2);
    if (IN(PH_A3)) REPEAT(PH_A3) { REPBAR();
        ArgsP A = fresh_args(); unsigned char* ws = A->ws;
        pg8::Gemm g{(const bf16_t*)(ws + WS_AO), (const bf16_t*)(ws + WS_WAOUT), M, 1024, 1024}; pg8::StaticOrder S; S.init(M, 1024, fresh_gx(), fresh_bx());
        pg8::EpiRes E{A->in[0], A->out, (bf16_t*)(ws + WS_XB), (float*)(ws + WS_SS), true};
        pg8::gemm_phase(lds, g, S, E);
    }
    SEAM(PH_A3);
#pragma unroll 1
    for (int layer = 0; layer < 2; ++layer) {
        const int ph1 = layer ? PH_F1B : PH_F1A, ph2 = layer ? PH_F2B : PH_F2A;
        if (layer == 1) {
            if (IN(PH_B1)) REPEAT(PH_B1) { REPBAR();
                ArgsP A = fresh_args(); unsigned char* ws = A->ws;
                pg8::Gemm g{(const bf16_t*)(ws + WS_XB), (const bf16_t*)(ws + WS_WBIN), M, 4096, 1024}; pg8::StaticOrder S; S.init(M, 4096, fresh_gx(), fresh_bx());
                pg8::EpiB1 E{(const float*)(ws + WS_SS), (const float2*)(ws + WS_ROPE), (bf16_t*)(ws + WS_QT), (bf16_t*)(ws + WS_KT), (bf16_t*)(ws + WS_VT)};
                pg8::gemm_phase(lds, g, S, E);
            }
            SEAM(PH_B1);
            if (IN(PH_B2)) REPEAT(PH_B2) { REPBAR();
                ArgsP A = fresh_args(); unsigned char* ws = A->ws;
#if defined(RET_SLOW)
                ret_slow_phase(lds, (const bf16_t*)(ws + WS_QT), (const bf16_t*)(ws + WS_KT), (const bf16_t*)(ws + WS_VT), (bf16_t*)(ws + WS_RET), (float*)(ws + WS_SSR), fresh_bx(), fresh_gx());
#else
                { const int G = fresh_gx(), bx = fresh_bx(); const int vcu = (G % 8 == 0) ? (bx % 8) * (G / 8) + bx / 8 : bx;
                  for (int u = vcu; u < 256; u += G) ret_fast_phase(lds, (const bf16_t*)(ws + WS_QT), (const bf16_t*)(ws + WS_KT), (const bf16_t*)(ws + WS_VT), (bf16_t*)(ws + WS_RET), (float*)(ws + WS_SSR), u); }
#endif
            }
            SEAM(PH_B2);
            if (IN(PH_GATE)) REPEAT(PH_GATE) { REPBAR();
                {   ArgsP A = fresh_args(); unsigned char* ws = A->ws;
                    pg8::Gemm g{(const bf16_t*)(ws + WS_XB), (const bf16_t*)(ws + WS_WBIN) + (size_t)4096 * 1024, M, 2048, 1024}; pg8::StaticOrder S; S.init(M, 2048, fresh_gx(), fresh_bx());
                    pg8::EpiGate E{(const float*)(ws + WS_SS), (const float*)(ws + WS_SSR), (bf16_t*)(ws + WS_RET)};
                    pg8::gemm_phase(lds, g, S, E); }
#if !defined(NO_WCONV2)
                {   GWS; ArgsP A = fresh_args(); unsigned char* ws = A->ws; constexpr int J0 = 16 * 88, J1 = J0 + 44 * 16;
#pragma unroll 1
                    for (int it = gw; it < J1; it += NGW) {
                        if (it < J0) p0_transpose_item(A->in[12] + (size_t)1024 * FF2, 1024, FF2, FF2, WM_FUP, A->in[2] + 1024, (bf16_t*)(ws + WS_WFUP1), scr, it, lane);
                        else p0_transpose_item(A->in[15] + (size_t)2816 * 1024, 2816, 1024, 1024, WM_NAT, (const float*)nullptr, (bf16_t*)(ws + WS_WFDN1), scr, it - J0, lane); } }
#endif
            }
            SEAM(PH_GATE);
            if (IN(PH_B3)) REPEAT(PH_B3) { REPBAR();
                ArgsP A = fresh_args(); unsigned char* ws = A->ws;
                pg8::Gemm g{(const bf16_t*)(ws + WS_RET), (const bf16_t*)(ws + WS_WBOUT), M, 1024, 2048}; pg8::StaticOrder S; S.init(M, 1024, fresh_gx(), fresh_bx());
                pg8::EpiRes E{A->out, A->out, (bf16_t*)(ws + WS_XB), (float*)(ws + WS_SS), true};
                pg8::gemm_phase(lds, g, S, E);
            }
            SEAM(PH_B3);
        }
        if (IN(ph1)) REPEAT(ph1) { REPBAR();
            ArgsP A = fresh_args(); unsigned char* ws = A->ws;
            pg8::Gemm g{(const bf16_t*)(ws + WS_XB), (const bf16_t*)(ws + (layer ? WS_WFUP1 : WS_WFUP0)), M, FF2, 1024}; pg8::StaticOrder S; S.init(M, FF2, fresh_gx(), fresh_bx());
            pg8::EpiF1 E{(const float*)(ws + WS_SS), A->in[13] + (size_t)layer * 3 * FF2, A->in[14] + (size_t)layer * FF2, (bf16_t*)(ws + (layer ? WS_H1 : WS_H0)),
                         (float*)(ws + (layer ? WS_PART1 : WS_PART0)), (float*)(ws + (layer ? WS_HALO1 : WS_HALO0))};
            pg8::gemm_phase(lds, g, S, E);
        }
        SEAM(ph1);
        if (IN(ph2)) {
            ArgsP A = fresh_args(); unsigned char* ws = A->ws; bf16_t* Hb = (bf16_t*)(ws + (layer ? WS_H1 : WS_H0));
            pg8::Gemm g{Hb, (const bf16_t*)(ws + (layer ? WS_WFDN1 : WS_WFDN0)), M, 1024, D_FF}; pg8::StaticOrder S; S.init(M, 1024, fresh_gx(), fresh_bx());
            {   pg8::Unit u0; if (S.next(0, u0)) ffn_fixup(u0.pm, A->in[13] + (size_t)layer * 3 * FF2, (const float*)(ws + (layer ? WS_PART1 : WS_PART0)), (const float*)(ws + (layer ? WS_HALO1 : WS_HALO0)), Hb);
                VM_WAIT(); __syncthreads(); }
            pg8::EpiRes E{A->out, A->out, (bf16_t*)(ws + WS_XB), (float*)(ws + WS_SS), layer == 0};
            pg8::gemm_phase(lds, g, S, E);
        }
        SEAM(ph2);
    }
#undef IN
#undef SEAM
}

extern "C" void kernel_launch(void* const* d_in, const int* in_sizes, int n_in, void* d_out, int out_size, void* d_ws, size_t ws_size, hipStream_t stream) {
    static int grid = 0;
    constexpr int RET_LDS = 64 * 256 * 2 * 2 + 64 * 64 * 2 + 64 * 65 * 4 + 256 * 64 * 4;
    if (grid == 0) {
        int dev = 0, cus = 0, per_cu = 0;
        (void)hipGetDevice(&dev); (void)hipDeviceGetAttribute(&cus, hipDeviceAttributeMultiprocessorCount, dev);
        (void)hipFuncSetAttribute((const void*)mega, hipFuncAttributeMaxDynamicSharedMemorySize, LDS_BYTES);
        (void)hipFuncSetAttribute((const void*)k_ret_v0, hipFuncAttributeMaxDynamicSharedMemorySize, RET_LDS);
        if (hipOccupancyMaxActiveBlocksPerMultiprocessor(&per_cu, (const void*)mega, NWAVES * 64, LDS_BYTES) != hipSuccess || per_cu < 1)
            fprintf(stderr, "kernel_launch: occupancy query reports %d workgroups per CU\n", per_cu);
        (void)hipGetLastError();
        grid = cus > 0 ? cus : 256;
        if (grid != 256) fprintf(stderr, "kernel_launch: %d CUs (built for 256)\n", grid);
    }
    unsigned char* ws = (unsigned char*)d_ws;
    (void)hipMemsetAsync(ws + WS_CTL, 0, CTL_ZERO_BYTES, stream);
    Args a{};
    for (int i = 0; i < 16; ++i) a.in[i] = (const float*)d_in[i];
    a.out = (float*)d_out; a.ws = ws;
    auto launch = [&](int lo, int hi, int li) { a.ph_lo = lo; a.ph_hi = hi; a.li = li; hipLaunchKernelGGL(mega, dim3(grid), dim3(NWAVES * 64), LDS_BYTES, stream, a); };
#if MK_LAUNCH_MODE == 1
    launch(0, PH_END, 0);
#else
    launch(PH_PRO, PH_PRO + 1, 0);
    launch(PH_A1, PH_A1 + 1, 0);
    hipLaunchKernelGGL(k_dsa_v0, dim3(M), dim3(256), 0, stream, (const bf16_t*)(ws + WS_QH), (const bf16_t*)(ws + WS_C), (const float*)(ws + WS_PS), (const bf16_t*)(ws + WS_QI), (const bf16_t*)(ws + WS_KI), (const float*)(ws + WS_WI), (bf16_t*)(ws + WS_AO));
    launch(PH_A3, PH_A3 + 1, 0);
    launch(PH_F1A, PH_F1A + 1, 0);
    launch(PH_F2A, PH_F2A + 1, 0);
    launch(PH_B1, PH_B1 + 1, 0);
    hipLaunchKernelGGL(k_ret_v0, dim3(256), dim3(256), RET_LDS, stream, (const bf16_t*)(ws + WS_QT), (const bf16_t*)(ws + WS_KT), (const bf16_t*)(ws + WS_VT), (bf16_t*)(ws + WS_RET), (float*)(ws + WS_SSR));
    launch(PH_GATE, PH_GATE + 1, 0);
    launch(PH_B3, PH_B3 + 1, 0);
    launch(PH_F1B, PH_F1B + 1, 0);
    launch(PH_F2B, PH_F2B + 1, 0);
#endif
}
```

```cpp
#include <hip/hip_runtime.h>
#include <stdint.h>
#include <stdio.h>

typedef unsigned short bf16_t;
typedef short bf16x8 __attribute__((ext_vector_type(8)));
typedef float f32x4 __attribute__((ext_vector_type(4)));
typedef unsigned u32x4 __attribute__((ext_vector_type(4)));
typedef unsigned u32x2 __attribute__((ext_vector_type(2)));

#ifndef MK_LAUNCH_MODE
#define MK_LAUNCH_MODE 1
#endif

constexpr int BATCH = 8, SEQ = 2048, DM = 1024, M = BATCH * SEQ;
constexpr int TOPK = 256;
constexpr int A_IN_COLS = 1736, A_IN_PAD = 1792;
constexpr int O2 = 1152, O3 = 1664, O4 = 1728;
constexpr int B_IN_COLS = 6144;
constexpr int D_FF = 2816, FF2 = 5632;
constexpr float EPS = 1e-6f;

constexpr size_t MiB = 1u << 20;
constexpr size_t WS_CTL = 0, CTL_ZERO_BYTES = 65536;
constexpr size_t WS_SS = 1 * MiB;
constexpr size_t WS_WI = 2 * MiB;
constexpr size_t WS_CSC = 2 * MiB + 512 * 1024;
constexpr size_t WS_ROPE = 3 * MiB;
constexpr size_t WS_SSR = 249 * MiB;
constexpr size_t WS_WBIN = 8 * MiB;
constexpr size_t WS_WBOUT = 20 * MiB;
constexpr size_t WS_XB = 24 * MiB;
constexpr size_t WS_WAIN = 56 * MiB;
constexpr size_t WS_WAOUT = 60 * MiB;
constexpr size_t WS_QH = 64 * MiB;
constexpr size_t WS_AO = 96 * MiB;
constexpr size_t WS_QI = 128 * MiB;
constexpr size_t WS_C = 144 * MiB;
constexpr size_t WS_KI = 148 * MiB;
constexpr size_t WS_PS = 150 * MiB;
constexpr size_t WS_WFUP0 = 232 * MiB;
constexpr size_t WS_WFDN0 = 243 * MiB;
constexpr size_t WS_H0 = 64 * MiB;
constexpr size_t WS_PART0 = 152 * MiB;
constexpr size_t WS_HALO0 = 155 * MiB;
constexpr size_t WS_QT = 56 * MiB;
constexpr size_t WS_KT = 88 * MiB;
constexpr size_t WS_VT = 120 * MiB;
constexpr size_t WS_RET = 184 * MiB;
constexpr size_t WS_WFUP1 = 56 * MiB;
constexpr size_t WS_WFDN1 = 67 * MiB;
constexpr size_t WS_H1 = 88 * MiB;
constexpr size_t WS_PART1 = 176 * MiB;
constexpr size_t WS_HALO1 = 179 * MiB;

__device__ __forceinline__ unsigned short f2bf(float f) { unsigned u = __float_as_uint(f); return (unsigned short)((u + 0x7fffu + ((u >> 16) & 1u)) >> 16); }
__device__ __forceinline__ float bf2f(unsigned short h) { return __uint_as_float(((unsigned)h) << 16); }
__device__ __forceinline__ float bflo(unsigned w) { return __uint_as_float(w << 16); }
__device__ __forceinline__ float bfhi(unsigned w) { return __uint_as_float(w & 0xffff0000u); }
typedef __bf16 bf16x2_t __attribute__((ext_vector_type(2)));
typedef float f32x2_t __attribute__((ext_vector_type(2)));
__device__ __forceinline__ unsigned pk2(float lo, float hi) { const f32x2_t v = {lo, hi}; return __builtin_bit_cast(unsigned, __builtin_convertvector(v, bf16x2_t)); }
__device__ __forceinline__ float wave_sum(float v) {
#pragma unroll
    for (int o = 1; o < 64; o <<= 1) v += __shfl_xor(v, o);
    return v;
}
__device__ __forceinline__ float siluf(float x) { return x * __builtin_amdgcn_rcpf(1.0f + __builtin_amdgcn_exp2f(-1.4426950408889634f * x)); }
__device__ __forceinline__ float gamma_log(int h) { return h == 0 ? -0.031748698314580301f : h == 1 ? -0.015748356968139168f : h == 2 ? -0.0078431774610258787f : -0.0039138993211363287f; }

enum { WM_NAT = 0, WM_AIN = 1, WM_FUP = 2 };
__device__ __forceinline__ int wmap(int mode, int n) {
    if (mode == WM_NAT) return n;
    if (mode == WM_AIN) {
        if (n < 1152) return n;
        if (n < 1216) return O3 + (n - 1152);
        if (n < 1224) return O4 + (n - 1216);
        if (n < 1280) return -1;
        return O2 + (n - 1280);
    }
    const int p = n >> 8, bj = (n >> 7) & 1, i = n & 127;
    return bj * D_FF + 128 * p + i;
}

__global__ void __launch_bounds__(256) k_dsa_v0(const bf16_t* __restrict__ QH, const bf16_t* __restrict__ Cb, const float* __restrict__ PS, const bf16_t* __restrict__ QI,
                                                const bf16_t* __restrict__ KI, const float* __restrict__ WI, bf16_t* __restrict__ AO) {
    __shared__ float qi[8][64]; __shared__ float wi[8]; __shared__ float sc[2048]; __shared__ unsigned short idx[256];
    __shared__ float qh[8][128]; __shared__ float p[8][257]; __shared__ unsigned red[256]; __shared__ float fred[8][4]; __shared__ float mh[8], lh[8], rq[8];
    const int tg = blockIdx.x, b = tg / SEQ, t = tg % SEQ, limit = ((t >> 6) + 1) * 64, tid = threadIdx.x, lane = tid & 63, wave = tid >> 6;
    for (int e = tid; e < 512; e += 256) qi[e >> 6][e & 63] = bf2f(QI[(size_t)tg * 512 + e]);
    if (tid < 8) { const int h = tid; const float* ps = PS + (size_t)tg * 56;
        const int qb = (5 + (h >> 2)) * 8 + ((h >> 1) & 1) * 4 + 2 * (h & 1);
        wi[h] = WI[(size_t)tg * 8 + h] * rsqrtf((ps[qb] + ps[qb + 1]) * (1.0f / 64.0f) + EPS);
        const int hb = (h >> 1) * 8 + (h & 1) * 4;
        rq[h] = rsqrtf((ps[hb] + ps[hb + 1] + ps[hb + 2] + ps[hb + 3]) * (1.0f / 128.0f) + EPS); }
    for (int e = tid; e < 1024; e += 256) qh[e >> 7][e & 127] = bf2f(QH[(size_t)tg * 1024 + e]);
    __syncthreads();
    for (int s = tid; s < limit; s += 256) {
        const bf16_t* kr = KI + ((size_t)b * SEQ + s) * 64; float kf[64];
#pragma unroll
        for (int i = 0; i < 64; ++i) kf[i] = bf2f(kr[i]);
        const float* ps = PS + ((size_t)b * SEQ + s) * 56; const float rk = rsqrtf((ps[36] + ps[37]) * (1.0f / 64.0f) + EPS);
        float tot = 0.f;
        for (int h = 0; h < 8; ++h) { float d = 0.f;
#pragma unroll
            for (int i = 0; i < 64; ++i) d += qi[h][i] * kf[i];
            tot += fmaxf(d, 0.f) * wi[h]; }
        sc[s] = tot * rk + 0.0f;
    }
    __syncthreads();
    int count;
    if (limit <= TOPK) { count = limit; for (int j = tid; j < limit; j += 256) idx[j] = (unsigned short)j; __syncthreads(); }
    else {
        count = TOPK;
        unsigned key[8];
#pragma unroll
        for (int j = 0; j < 8; ++j) { const int s = tid * 8 + j; unsigned k = 0u; if (s < limit) { const unsigned u = __float_as_uint(sc[s]); k = (u & 0x80000000u) ? ~u : (u | 0x80000000u); } key[j] = k; }
        unsigned Tk = 0u;
        for (int bit = 31; bit >= 0; --bit) {
            const unsigned cand = Tk | (1u << bit); int c = 0;
#pragma unroll
            for (int j = 0; j < 8; ++j) c += (key[j] >= cand) ? 1 : 0;
            c = (int)wave_sum((float)c);
            if (lane == 0) red[wave] = (unsigned)c;
            __syncthreads();
            const int tot = (int)(red[0] + red[1] + red[2] + red[3]);
            __syncthreads();
            if (tot >= TOPK) Tk = cand;
        }
        int ngt = 0, neq = 0;
#pragma unroll
        for (int j = 0; j < 8; ++j) { ngt += (key[j] > Tk) ? 1 : 0; neq += (key[j] == Tk) ? 1 : 0; }
        red[tid] = ((unsigned)ngt << 16) | (unsigned)neq;
        __syncthreads();
        int tot_gt = 0, eq_before = 0;
        for (int j = 0; j < 256; ++j) { const unsigned v = red[j]; tot_gt += (int)(v >> 16); if (j < tid) eq_before += (int)(v & 0xffffu); }
        __syncthreads();
        const int need_eq = TOPK - tot_gt;
        unsigned selm = 0u; int nsel = 0, eqr = eq_before;
#pragma unroll
        for (int j = 0; j < 8; ++j) { bool s = key[j] > Tk; if (key[j] == Tk) { s = eqr < need_eq; ++eqr; } if (s) { selm |= 1u << j; ++nsel; } }
        red[tid] = (unsigned)nsel;
        __syncthreads();
        int base = 0; for (int j = 0; j < tid; ++j) base += (int)red[j];
#pragma unroll
        for (int j = 0; j < 8; ++j) if (selm & (1u << j)) idx[base++] = (unsigned short)(tid * 8 + j);
        __syncthreads();
    }
    float lg[8];
    if (tid < count) {
        const int key = idx[tid]; const bf16_t* cr = Cb + ((size_t)b * SEQ + key) * 128;
        const float* ps = PS + ((size_t)b * SEQ + key) * 56 + 32; const float rc = rsqrtf((ps[0] + ps[1] + ps[2] + ps[3]) * (1.0f / 128.0f) + EPS);
#pragma unroll
        for (int h = 0; h < 8; ++h) lg[h] = 0.f;
        for (int d0 = 0; d0 < 128; d0 += 8) { float cf[8];
#pragma unroll
            for (int i = 0; i < 8; ++i) cf[i] = bf2f(cr[d0 + i]);
#pragma unroll
            for (int h = 0; h < 8; ++h)
#pragma unroll
                for (int i = 0; i < 8; ++i) lg[h] += qh[h][d0 + i] * cf[i]; }
#pragma unroll
        for (int h = 0; h < 8; ++h) lg[h] *= rc * rq[h];
    } else {
#pragma unroll
        for (int h = 0; h < 8; ++h) lg[h] = -INFINITY;
    }
#pragma unroll
    for (int h = 0; h < 8; ++h) { float m = lg[h];
#pragma unroll
        for (int o = 1; o < 64; o <<= 1) m = fmaxf(m, __shfl_xor(m, o));
        if (lane == 0) fred[h][wave] = m; }
    __syncthreads();
    if (tid < 8) mh[tid] = fmaxf(fmaxf(fred[tid][0], fred[tid][1]), fmaxf(fred[tid][2], fred[tid][3]));
    __syncthreads();
#pragma unroll
    for (int h = 0; h < 8; ++h) { const float e = (tid < count) ? __expf(lg[h] - mh[h]) : 0.f; p[h][tid] = e; const float s = wave_sum(e); if (lane == 0) fred[h][wave] = s; }
    __syncthreads();
    if (tid < 8) lh[tid] = (fred[tid][0] + fred[tid][1]) + (fred[tid][2] + fred[tid][3]);
    __syncthreads();
    { const int h = tid >> 5, d = (tid & 31) * 4; float a0 = 0.f, a1 = 0.f, a2 = 0.f, a3 = 0.f;
        for (int j = 0; j < count; ++j) { const float pj = p[h][j]; const uint2 cv = *(const uint2*)(Cb + ((size_t)b * SEQ + idx[j]) * 128 + d);
            a0 += pj * bflo(cv.x); a1 += pj * bfhi(cv.x); a2 += pj * bflo(cv.y); a3 += pj * bfhi(cv.y); }
        const float inv = 1.0f / lh[h]; uint2 o; o.x = f2bf(a0 * inv) | ((unsigned)f2bf(a1 * inv) << 16); o.y = f2bf(a2 * inv) | ((unsigned)f2bf(a3 * inv) << 16);
        *(uint2*)(AO + (size_t)tg * 1024 + h * 128 + d) = o; }
}

__global__ void __launch_bounds__(256) k_ret_v0(const bf16_t* __restrict__ QT, const bf16_t* __restrict__ KT, const bf16_t* __restrict__ VT, bf16_t* __restrict__ RET, float* __restrict__ SSR) {
    extern __shared__ unsigned char smem[];
    bf16_t* Qs = (bf16_t*)smem;
    bf16_t* Ks = Qs + 64 * 256;
    bf16_t* Vs = Ks + 64 * 256;
    float* Ss = (float*)(Vs + 64 * 64);
    float* St = Ss + 64 * 65;
    const int u = blockIdx.x, blk = u & 7, h = (u >> 3) & 3, b = u >> 5, tid = threadIdx.x, dv = tid & 63, kq = tid >> 6;
    const float g64 = __expf(64.0f * gamma_log(h));
    for (int e = tid; e < 256 * 64; e += 256) St[e] = 0.f;
    for (int n = 0; n < 32; ++n) {
        const size_t row0 = (size_t)b * SEQ + n * 64;
        __syncthreads();
        for (int e = tid; e < 64 * 32; e += 256) { const int r = e >> 5, c8 = e & 31;
            *(uint4*)(Qs + r * 256 + c8 * 8) = *(const uint4*)(QT + (row0 + r) * 1024 + h * 256 + c8 * 8);
            *(uint4*)(Ks + r * 256 + c8 * 8) = *(const uint4*)(KT + (row0 + r) * 1024 + h * 256 + c8 * 8); }
        for (int e = tid; e < 64 * 64; e += 256) { const int dd = e >> 6, key = e & 63; Vs[key * 64 + dd] = VT[((size_t)b * 2048 + h * 512 + blk * 64 + dd) * SEQ + n * 64 + key]; }
        __syncthreads();
        { const int q = tid >> 2, kg = tid & 3;
            for (int key = kg * 16; key < kg * 16 + 16; ++key) { float d = 0.f;
                if (key <= q) for (int i = 0; i < 256; ++i) d += bf2f(Qs[q * 256 + i]) * bf2f(Ks[key * 256 + i]);
                Ss[q * 65 + key] = d; } }
        __syncthreads();
        for (int q = kq * 16; q < kq * 16 + 16; ++q) { float r = 0.f;
            for (int key = 0; key <= q; ++key) r += Ss[q * 65 + key] * bf2f(Vs[key * 64 + dv]);
            for (int i = 0; i < 256; ++i) r += bf2f(Qs[q * 256 + i]) * St[i * 64 + dv];
            RET[(row0 + q) * 2048 + h * 512 + blk * 64 + dv] = f2bf(r);
            const float s = wave_sum(r * r);
            if (dv < 2) SSR[((row0 + q) * 4 + h) * 16 + blk * 2 + dv] = dv == 0 ? s : 0.f; }
        __syncthreads();
        for (int i = 0; i < 64; ++i) { const int dk = kq * 64 + i; float s = St[dk * 64 + dv];
            for (int key = 0; key < 64; ++key) s += bf2f(Ks[key * 256 + dk]) * bf2f(Vs[key * 64 + dv]);
            St[dk * 64 + dv] = s * g64; }
    }
}

namespace pg8 {
#define PG8_LAS __attribute__((address_space(3)))
constexpr int BM = 256, BK = 64, HALF = 128, HTB = HALF * BK * 2, STAGE_BYTES = 8 * HTB, NXCD = 8, WGM = 8;
constexpr int XCH_OFF = 0, CWT_OFF = 2048, RT1_OFF = 6144, RT2_OFF = 14336;
__host__ __device__ __forceinline__ int lds_byte(int r, int c) { const int st = (r >> 4) * 2 + (c >> 5), rr = r & 15, cc = c & 31, ob = rr * 64 + cc * 2; return st * 1024 + (ob ^ (((ob >> 9) & 1) << 5)); }
__host__ __device__ __forceinline__ void stage_rc(int b, int& R, int& C) { const int st = b / 1024, sb = b % 1024, swz = sb ^ (((sb >> 9) & 1) << 5); R = (st >> 1) * 16 + swz / 64; C = (st & 1) * 32 + (swz % 64) / 2; }
__host__ __device__ __forceinline__ int perm32(int rho) { const int n = rho >> 4, i = rho & 15; return 8 * (i >> 2) + 4 * n + (i & 3); }
struct Unit { int pm, pn; };
struct Gemm { const bf16_t* A; const bf16_t* Bt; int M, N, K; };
struct StaticOrder {
    int nM, nN, nwg, G, c;
    __host__ __device__ __forceinline__ void init(int M_, int N_, int G_, int c_) { nM = M_ / BM; nN = N_ / BM; nwg = nM * nN; G = G_; c = c_; }
    __host__ __device__ __forceinline__ bool next(int i, Unit& u) const {
        const long L = (long)i * G + c; if (L >= nwg) return false;
        int wgid = (int)L; { const int q = nwg / NXCD, r = nwg % NXCD, xcd = wgid % NXCD, off = wgid / NXCD; wgid = (xcd < r ? xcd * (q + 1) : r * (q + 1) + (xcd - r) * q) + off; }
        const int nig = WGM * nN, gid = wgid / nig, fm = gid * WGM, gsz = (nM - fm) < WGM ? (nM - fm) : WGM;
        u.pm = fm + ((wgid % nig) % gsz); u.pn = (wgid % nig) / gsz; return true;
    }
};
__device__ __forceinline__ float rstd16(const float* ss16, int row) {
    const f32x4* p = (const f32x4*)(ss16 + (size_t)row * 16); const f32x4 a = p[0], b = p[1], c = p[2], d = p[3];
    const float s = ((a[0] + a[1]) + (a[2] + a[3])) + ((b[0] + b[1]) + (b[2] + b[3])) + ((c[0] + c[1]) + (c[2] + c[3])) + ((d[0] + d[1]) + (d[2] + d[3]));
    return rsqrtf(s * (1.0f / DM) + EPS);
}
__device__ __forceinline__ float ssq8(const f32x4 a, const f32x4 b) { return ((a[0] * a[0] + a[1] * a[1]) + (a[2] * a[2] + a[3] * a[3])) + ((b[0] * b[0] + b[1] * b[1]) + (b[2] * b[2] + b[3] * b[3])); }
__device__ __forceinline__ u32x4 pack8(const f32x4 a, const f32x4 b) { u32x4 w; w.x = pk2(a[0], a[1]); w.y = pk2(a[2], a[3]); w.z = pk2(b[0], b[1]); w.w = pk2(b[2], b[3]); return w; }

template <int MODE>
struct EpiRes {
    static constexpr bool AROWPERM = false;
    const float* basef; float* out; bf16_t* xb; float* ss16;
    static constexpr int NTAB = 0;
    __device__ __forceinline__ void fill(PG8_LAS unsigned char*, int, const Unit&, int) const {}
    __device__ __forceinline__ void operator()(f32x4 (&acc)[2][2][4][2], const Unit& u, int ui, int wr, int wc, int fr, int fq, PG8_LAS unsigned char*) const {
        const int row0 = u.pm * BM + wr * 64 + fr, colb = u.pn * BM + wc * 32 + 8 * fq;
#pragma unroll
        for (int ai = 0; ai < 2; ++ai) {
            f32x4 bv[4][2][2];
#pragma unroll
            for (int m = 0; m < 4; ++m)
#pragma unroll
                for (int bj = 0; bj < 2; ++bj) { const size_t o = (size_t)(row0 + ai * HALF + m * 16) * DM + colb + bj * HALF;
                    if (MODE == 0) { bv[m][bj][0] = *(const f32x4*)(basef + o); bv[m][bj][1] = *(const f32x4*)(basef + o + 4); }
                    else { const u32x4 w = *(const u32x4*)(xb + o); bv[m][bj][0] = (f32x4){bflo(w.x), bfhi(w.x), bflo(w.y), bfhi(w.y)}; bv[m][bj][1] = (f32x4){bflo(w.z), bfhi(w.z), bflo(w.w), bfhi(w.w)}; } }
#pragma unroll
            for (int m = 0; m < 4; ++m) { const int row = row0 + ai * HALF + m * 16; float s = 0.f;
#pragma unroll
                for (int bj = 0; bj < 2; ++bj) { const size_t o = (size_t)row * DM + colb + bj * HALF;
                    const f32x4 v0 = acc[ai][bj][m][0] + bv[m][bj][0], v1 = acc[ai][bj][m][1] + bv[m][bj][1];
                    if (MODE == 2) { *(f32x4*)(out + o) = v0; *(f32x4*)(out + o + 4) = v1; }
                    else { s += ssq8(v0, v1); *(u32x4*)(xb + o) = pack8(v0, v1); } }
                if (MODE != 2) { s += __shfl_xor(s, 16); s += __shfl_xor(s, 32);
                    if (fq == 0) ss16[(size_t)row * 16 + u.pn * 4 + wc] = s; } }
            asm volatile("" ::: "memory"); }
    }
};
struct EpiA1 {
    static constexpr bool AROWPERM = false;
    const float* ss16; const float* csc; bf16_t* Q; bf16_t* C; bf16_t* KI; bf16_t* QI; float* WI; float* PS;
    static constexpr int NTAB = 1;
    __device__ __forceinline__ void fill(PG8_LAS unsigned char* xl, int i, const Unit& u, int t) const { ((PG8_LAS float*)(xl + RT1_OFF))[i * 256 + t] = rstd16(ss16, u.pm * BM + t); }
    __device__ __forceinline__ void operator()(f32x4 (&acc)[2][2][4][2], const Unit& u, int ui, int wr, int wc, int fr, int fq, PG8_LAS unsigned char* xl) const {
        const int row0 = u.pm * BM + wr * 64 + fr, pn = u.pn;
        const PG8_LAS float* rt = (const PG8_LAS float*)(xl + RT1_OFF) + ui * 256 + wr * 64 + fr;
        float rs[2][4];
#pragma unroll
        for (int ai = 0; ai < 2; ++ai)
#pragma unroll
            for (int m = 0; m < 4; ++m) rs[ai][m] = rt[ai * HALF + m * 16];
#pragma unroll
        for (int bj = 0; bj < 2; ++bj) {
            const int cl = bj * HALF + wc * 32 + 8 * fq, gcol = pn * BM + cl;
            const f32x4 c0 = *(const f32x4*)(csc + gcol), c1 = *(const f32x4*)(csc + gcol + 4);
            bf16_t* dst; int ld; bool st16 = true, stwi = false;
            if (pn < 4) { dst = Q + gcol; ld = 1024; }
            else if (pn == 4) { if (bj == 0) { dst = C + cl; ld = 128; } else if (wc < 2) { dst = KI + (wc * 32 + 8 * fq); ld = 64; } else { dst = Q; ld = 0; st16 = false; stwi = (wc == 2) && (fq == 0); } }
            else { dst = QI + (pn - 5) * 256 + cl; ld = 512; }
#pragma unroll
            for (int ai = 0; ai < 2; ++ai)
#pragma unroll
                for (int m = 0; m < 4; ++m) { const int row = row0 + ai * HALF + m * 16; const float r = rs[ai][m];
                    const f32x4 v0 = acc[ai][bj][m][0] * r, v1 = acc[ai][bj][m][1] * r;
                    float s = ssq8(v0, v1); s += __shfl_xor(s, 16); s += __shfl_xor(s, 32);
                    if (fq == 0) PS[(size_t)row * 56 + pn * 8 + bj * 4 + wc] = s;
                    const f32x4 o0 = v0 * c0, o1 = v1 * c1;
                    if (st16) *(u32x4*)(dst + (size_t)row * ld) = pack8(o0, o1);
                    if (stwi) { *(f32x4*)(WI + (size_t)row * 8) = o0; *(f32x4*)(WI + (size_t)row * 8 + 4) = o1; }
                    if (m & 1) asm volatile("" ::: "memory"); }
        }
    }
};
struct EpiF1 {
    static constexpr bool AROWPERM = true;
    static constexpr int NTAB = 1;
    const float* ss16; const float* cw; const float* cb; bf16_t* H; float* PART; float* HALO;
    __device__ __forceinline__ void fill(PG8_LAS unsigned char* xl, int i, const Unit& u, int t) const { ((PG8_LAS float*)(xl + RT1_OFF))[i * 256 + t] = rstd16(ss16, u.pm * BM + t); }
    __device__ __forceinline__ void operator()(f32x4 (&acc)[2][2][4][2], const Unit& u, int ui, int wr, int wc, int fr, int fq, PG8_LAS unsigned char* xl) const {
        const int trow0 = 8 * (16 * wr + fr), grow0 = u.pm * BM + trow0, hcol = 128 * u.pn + 32 * wc + 8 * fq, tcol = 32 * wc + 8 * fq;
        const PG8_LAS float* rt = (const PG8_LAS float*)(xl + RT1_OFF) + ui * 256 + trow0;
        {   const f32x4 r0 = *(const PG8_LAS f32x4*)rt, r1 = *(const PG8_LAS f32x4*)(rt + 4);
#pragma unroll
            for (int m = 0; m < 4; ++m)
#pragma unroll
                for (int bj = 0; bj < 2; ++bj) { acc[0][bj][m][0] *= r0[m]; acc[0][bj][m][1] *= r0[m]; acc[1][bj][m][0] *= r1[m]; acc[1][bj][m][1] *= r1[m]; } }
        {   PG8_LAS float* cwt = (PG8_LAS float*)(xl + CWT_OFF); const int tid = ((wr * 4 + wc) * 4 + fq) * 16 + fr;
#pragma unroll
            for (int r = 0; r < 2; ++r) { const int idx = tid + r * 512, k = idx >> 8, c = idx & 255, orig = (c < 128) ? 128 * u.pn + c : D_FF + 128 * u.pn + (c - 128);
                cwt[idx] = (k < 3) ? cw[(size_t)k * FF2 + orig] : cb[orig]; } }
        PG8_LAS f32x4* X = (PG8_LAS f32x4*)(xl + XCH_OFF) + (wc * 4 + fq) * 8;
        if (wr == 0 && fr == 15) {
#pragma unroll
            for (int bj = 0; bj < 2; ++bj)
#pragma unroll
                for (int e = 0; e < 2; ++e)
#pragma unroll
                    for (int n = 0; n < 2; ++n) X[(bj * 2 + e) * 2 + n] = acc[1][bj][2 + e][n];
        }
        asm volatile("s_waitcnt vmcnt(0) lgkmcnt(0)" ::: "memory"); __builtin_amdgcn_s_barrier(); asm volatile("" ::: "memory");
        const bool need_fix = (wr == 0) && (fr == 0) && ((u.pm & 7) != 0);
        const bool give_halo = (wr == 1) && (fr == 15);
        const bool take_x = (wr == 1) && (fr == 0);
        float* part = PART + (size_t)u.pm * (2 * 2 * D_FF) + hcol;
        float* halo = HALO + (size_t)u.pm * (2 * 2 * D_FF) + hcol;
        const PG8_LAS float* cwt = (const PG8_LAS float*)(xl + CWT_OFF) + tcol;
#pragma unroll
        for (int n = 0; n < 2; ++n) {
            f32x4 pa[2], pb[2];
#pragma unroll
            for (int e = 0; e < 2; ++e) {
                f32x4 ha = (f32x4){0.f, 0.f, 0.f, 0.f}, hb = (f32x4){0.f, 0.f, 0.f, 0.f};
                if (take_x) { ha = X[(0 * 2 + e) * 2 + n]; hb = X[(1 * 2 + e) * 2 + n]; }
#pragma unroll
                for (int j = 0; j < 4; ++j) {
                    pa[e][j] = __int_as_float(__builtin_amdgcn_update_dpp(__float_as_int(ha[j]), __float_as_int(acc[1][0][2 + e][n][j]), 0x111, 0xf, 0xf, false));
                    pb[e][j] = __int_as_float(__builtin_amdgcn_update_dpp(__float_as_int(hb[j]), __float_as_int(acc[1][1][2 + e][n][j]), 0x111, 0xf, 0xf, false)); } }
            const f32x4 wa0 = *(const PG8_LAS f32x4*)(cwt + 4 * n), wa1 = *(const PG8_LAS f32x4*)(cwt + 256 + 4 * n), wa2 = *(const PG8_LAS f32x4*)(cwt + 512 + 4 * n), ba = *(const PG8_LAS f32x4*)(cwt + 768 + 4 * n);
            const f32x4 wb0 = *(const PG8_LAS f32x4*)(cwt + 128 + 4 * n), wb1 = *(const PG8_LAS f32x4*)(cwt + 384 + 4 * n), wb2 = *(const PG8_LAS f32x4*)(cwt + 640 + 4 * n), bb = *(const PG8_LAS f32x4*)(cwt + 896 + 4 * n);
            if (give_halo) {
                *(f32x4*)(halo + 4 * n) = acc[1][0][2][n]; *(f32x4*)(halo + D_FF + 4 * n) = acc[1][1][2][n];
                *(f32x4*)(halo + 2 * D_FF + 4 * n) = acc[1][0][3][n]; *(f32x4*)(halo + 3 * D_FF + 4 * n) = acc[1][1][3][n]; }
#pragma unroll
            for (int e = 0; e < 8; ++e) {
                const f32x4 ua = acc[e >> 2][0][e & 3][n], ub = acc[e >> 2][1][e & 3][n];
                const f32x4 ua1 = e >= 1 ? acc[(e - 1) >> 2][0][(e - 1) & 3][n] : pa[1], ub1 = e >= 1 ? acc[(e - 1) >> 2][1][(e - 1) & 3][n] : pb[1];
                const f32x4 ua2 = e >= 2 ? acc[(e - 2) >> 2][0][(e - 2) & 3][n] : pa[e], ub2 = e >= 2 ? acc[(e - 2) >> 2][1][(e - 2) & 3][n] : pb[e];
                const f32x4 av = ba + wa2 * ua + wa1 * ua1 + wa0 * ua2, bv = bb + wb2 * ub + wb1 * ub1 + wb0 * ub2;
                if (e < 2 && need_fix) { *(f32x4*)(part + (size_t)e * 2 * D_FF + 4 * n) = av; *(f32x4*)(part + (size_t)e * 2 * D_FF + D_FF + 4 * n) = bv; }
                u32x2 w; w.x = pk2(siluf(av[0]) * bv[0], siluf(av[1]) * bv[1]); w.y = pk2(siluf(av[2]) * bv[2], siluf(av[3]) * bv[3]);
                *(u32x2*)(H + (size_t)(grow0 + e) * D_FF + hcol + 4 * n) = w;
            }
            asm volatile("" ::: "memory");
        }
    }
};
struct EpiB1 {
    static constexpr bool AROWPERM = true;
    static constexpr int NTAB = 1;
    const float* ss16; const float2* rope; bf16_t* QT; bf16_t* KT; bf16_t* VT;
    __device__ __forceinline__ void fill(PG8_LAS unsigned char* xl, int i, const Unit& u, int t) const { ((PG8_LAS float*)(xl + RT1_OFF))[i * 256 + t] = rstd16(ss16, u.pm * BM + t); }
    __device__ __forceinline__ void operator()(f32x4 (&acc)[2][2][4][2], const Unit& u, int ui, int wr, int wc, int fr, int fq, PG8_LAS unsigned char* xl) const {
        const int trow0 = 8 * (16 * wr + fr), grow0 = u.pm * BM + trow0, pn = u.pn, t0 = grow0 & (SEQ - 1);
        const PG8_LAS float* rt = (const PG8_LAS float*)(xl + RT1_OFF) + ui * 256 + trow0;
        const f32x4 r0 = *(const PG8_LAS f32x4*)rt, r1 = *(const PG8_LAS f32x4*)(rt + 4);
        if (pn < 8) {
            const int h = pn & 3; const bool isk = pn >= 4; const float lg = gamma_log(h);
            bf16_t* dst = (isk ? KT : QT) + (size_t)grow0 * 1024 + h * 256 + 32 * wc + 8 * fq;
            const int i0 = 32 * wc + 8 * fq;
#pragma unroll
            for (int eh = 0; eh < 2; ++eh) {
                f32x4 rc[4][4];
#pragma unroll
                for (int e4 = 0; e4 < 4; ++e4) { const f32x4* rp = (const f32x4*)(rope + (size_t)(t0 + 4 * eh + e4) * 128 + i0);
#pragma unroll
                    for (int q = 0; q < 4; ++q) rc[e4][q] = rp[q]; }
#pragma unroll
                for (int e4 = 0; e4 < 4; ++e4) { const int e = 4 * eh + e4;
                    const int t = t0 + e, pos = t & 63;
                    const float dsc = isk ? 0.0625f * __expf(-(float)(pos + 1) * lg) : __expf((float)(pos + 1) * lg);
                    const float sc = (eh == 0 ? r0[e4] : r1[e4]) * dsc;
                    f32x4 o1[2], o2[2];
#pragma unroll
                    for (int n = 0; n < 2; ++n) { const f32x4 c0 = rc[e4][2 * n], c1 = rc[e4][2 * n + 1];
                        const f32x4 x1 = acc[eh][0][e4][n] * sc, x2 = acc[eh][1][e4][n] * sc;
                        o1[n][0] = x1[0] * c0[0] - x2[0] * c0[1]; o2[n][0] = x1[0] * c0[1] + x2[0] * c0[0];
                        o1[n][1] = x1[1] * c0[2] - x2[1] * c0[3]; o2[n][1] = x1[1] * c0[3] + x2[1] * c0[2];
                        o1[n][2] = x1[2] * c1[0] - x2[2] * c1[1]; o2[n][2] = x1[2] * c1[1] + x2[2] * c1[0];
                        o1[n][3] = x1[3] * c1[2] - x2[3] * c1[3]; o2[n][3] = x1[3] * c1[3] + x2[3] * c1[2]; }
                    *(u32x4*)(dst + (size_t)e * 1024) = pack8(o1[0], o1[1]); *(u32x4*)(dst + (size_t)e * 1024 + 128) = pack8(o2[0], o2[1]); }
                asm volatile("" ::: "memory");
            }
        } else {
            const int b = grow0 / SEQ;
            bf16_t* dst = VT + ((size_t)b * 2048 + (pn - 8) * 256 + 32 * wc + 8 * fq) * SEQ + t0;
#pragma unroll
            for (int bj = 0; bj < 2; ++bj)
#pragma unroll
                for (int n = 0; n < 2; ++n)
#pragma unroll
                    for (int j = 0; j < 4; ++j) { u32x4 w;
                        w.x = pk2(acc[0][bj][0][n][j] * r0[0], acc[0][bj][1][n][j] * r0[1]); w.y = pk2(acc[0][bj][2][n][j] * r0[2], acc[0][bj][3][n][j] * r0[3]);
                        w.z = pk2(acc[1][bj][0][n][j] * r1[0], acc[1][bj][1][n][j] * r1[1]); w.w = pk2(acc[1][bj][2][n][j] * r1[2], acc[1][bj][3][n][j] * r1[3]);
                        *(u32x4*)(dst + (size_t)(128 * bj + 4 * n + j) * SEQ) = w; }
        }
    }
};
struct EpiGate {
    static constexpr bool AROWPERM = false;
    static constexpr int NTAB = 1;
    const float* ss16; const float* ssr; bf16_t* RET;
    __device__ __forceinline__ void fill(PG8_LAS unsigned char* xl, int i, const Unit& u, int t) const {
        const int row = u.pm * BM + t;
        ((PG8_LAS float*)(xl + RT1_OFF))[i * 256 + t] = rstd16(ss16, row);
        const f32x4* sp = (const f32x4*)(ssr + ((size_t)row * 4 + (u.pn >> 1)) * 16); const f32x4 s0 = sp[0], s1 = sp[1], s2 = sp[2], s3 = sp[3];
        ((PG8_LAS float*)(xl + RT2_OFF))[i * 256 + t] = rsqrtf(((((s0[0] + s0[1]) + (s0[2] + s0[3])) + ((s1[0] + s1[1]) + (s1[2] + s1[3]))) + (((s2[0] + s2[1]) + (s2[2] + s2[3])) + ((s3[0] + s3[1]) + (s3[2] + s3[3])))) * (1.0f / 512.0f) + EPS);
    }
    __device__ __forceinline__ void operator()(f32x4 (&acc)[2][2][4][2], const Unit& u, int ui, int wr, int wc, int fr, int fq, PG8_LAS unsigned char* xl) const {
        const int row0 = u.pm * BM + wr * 64 + fr, colb = u.pn * BM + wc * 32 + 8 * fq;
        const PG8_LAS float* rt = (const PG8_LAS float*)(xl + RT1_OFF) + ui * 256 + wr * 64 + fr;
        const PG8_LAS float* rt2 = (const PG8_LAS float*)(xl + RT2_OFF) + ui * 256 + wr * 64 + fr;
        u32x4 rvv[2][4][2];
#pragma unroll
        for (int ai = 0; ai < 2; ++ai)
#pragma unroll
            for (int m = 0; m < 4; ++m)
#pragma unroll
                for (int bj = 0; bj < 2; ++bj) rvv[ai][m][bj] = *(const u32x4*)(RET + (size_t)(row0 + ai * HALF + m * 16) * 2048 + colb + bj * HALF);
#pragma unroll
        for (int ai = 0; ai < 2; ++ai)
#pragma unroll
            for (int m = 0; m < 4; ++m) { const int row = row0 + ai * HALF + m * 16; const float r = rt[ai * HALF + m * 16], rh = rt2[ai * HALF + m * 16];
#pragma unroll
                for (int bj = 0; bj < 2; ++bj) { bf16_t* p = RET + (size_t)row * 2048 + colb + bj * HALF; const u32x4 rv = rvv[ai][m][bj];
                    const f32x4 g0 = acc[ai][bj][m][0] * r, g1 = acc[ai][bj][m][1] * r; f32x4 y0, y1;
                    y0[0] = bflo(rv.x) * rh * siluf(g0[0]); y0[1] = bfhi(rv.x) * rh * siluf(g0[1]); y0[2] = bflo(rv.y) * rh * siluf(g0[2]); y0[3] = bfhi(rv.y) * rh * siluf(g0[3]);
                    y1[0] = bflo(rv.z) * rh * siluf(g1[0]); y1[1] = bfhi(rv.z) * rh * siluf(g1[1]); y1[2] = bflo(rv.w) * rh * siluf(g1[2]); y1[3] = bfhi(rv.w) * rh * siluf(g1[3]);
                    *(u32x4*)p = pack8(y0, y1); } }
    }
};

template <class Epi, class Sched>
__device__ __forceinline__ void gemm_phase(PG8_LAS unsigned char* lds, const Gemm g, const Sched& S, const Epi& E) {
    int tid_ = threadIdx.x; asm volatile("" : "+v"(tid_));
    const int tid = tid_, wid = __builtin_amdgcn_readfirstlane(tid >> 6), lane = tid & 63, wr = wid >> 2, wc = wid & 3, fr = lane & 15, fq = lane >> 4;
    const int K = g.K, nt = K / BK;
    unsigned voffA0[2], voffA1[2], voffB[2];
#pragma unroll
    for (int i = 0; i < 2; ++i) { int R, C; stage_rc(tid * 16 + i * 8192, R, C); const int Rb = (R & ~31) + perm32(R & 31);
        int ra0, ra1;
        if (Epi::AROWPERM) { const int base = ((R >> 6) * 16 + (R & 15)) * 8 + ((R >> 4) & 3); ra0 = base; ra1 = base + 4; } else { ra0 = R; ra1 = R + HALF; }
        voffA0[i] = (unsigned)(ra0 * K + C) * 2u; voffA1[i] = (unsigned)(ra1 * K + C) * 2u; voffB[i] = (unsigned)(Rb * K + C) * 2u; }
    const size_t kstep = (size_t)(BK * 2);
    const size_t hstep = (size_t)HALF * K * 2;
    const size_t tstep = 2 * hstep;
    const unsigned ldsw = (unsigned)wid * 1024u;
    const int aoff = lds_byte(wr * 64 + fr, fq * 8), boff = lds_byte(wc * 32 + fr, fq * 8);
#define PG8_SA(b, h) (((b) * 2 + (h)) * HTB)
#define PG8_SB(b, h) ((4 + (b) * 2 + (h)) * HTB)
#define PG8_STAGE(bufoff, gbase, voff) do { _Pragma("unroll") for (int _i = 0; _i < 2; ++_i) \
        __builtin_amdgcn_global_load_lds((const unsigned*)((const char*)(gbase) + (voff)[_i]), (PG8_LAS unsigned*)(lds + (bufoff) + ldsw + _i * 8192), 16, 0, 0); } while (0)
#define PG8_LDA(dst, b, h) do { _Pragma("unroll") for (int m = 0; m < 4; ++m) _Pragma("unroll") for (int k = 0; k < 2; ++k) dst[m][k] = *(const PG8_LAS bf16x8*)(lds + PG8_SA(b, h) + aoff + m * 2048 + k * 1024); } while (0)
#define PG8_LDB(dst, b, h) do { _Pragma("unroll") for (int n = 0; n < 2; ++n) _Pragma("unroll") for (int k = 0; k < 2; ++k) dst[n][k] = *(const PG8_LAS bf16x8*)(lds + PG8_SB(b, h) + boff + n * 2048 + k * 1024); } while (0)
#define PG8_MMA(ai, bj, At, Bt) do { __builtin_amdgcn_s_setprio(1); _Pragma("unroll") for (int m = 0; m < 4; ++m) _Pragma("unroll") for (int n = 0; n < 2; ++n) _Pragma("unroll") for (int k = 0; k < 2; ++k) \
        acc[ai][bj][m][n] = __builtin_amdgcn_mfma_f32_16x16x32_bf16(Bt[n][k], At[m][k], acc[ai][bj][m][n], 0, 0, 0); __builtin_amdgcn_s_setprio(0); } while (0)
#define PG8_WAIT_V(n) asm volatile("s_waitcnt vmcnt(" #n ")" ::: "memory")
#define PG8_WAIT_L(n) asm volatile("s_waitcnt lgkmcnt(" #n ")" ::: "memory")
#define PG8_BAR __builtin_amdgcn_s_barrier()
#define PG8_SCHED __builtin_amdgcn_sched_barrier(0)
    Unit cur, nxt; int ui = 0;
    if (!S.next(0, cur)) return;
    f32x4 acc[2][2][4][2];
#pragma unroll
    for (int a = 0; a < 2; ++a)
#pragma unroll
        for (int b = 0; b < 2; ++b)
#pragma unroll
            for (int m = 0; m < 4; ++m)
#pragma unroll
                for (int n = 0; n < 2; ++n) acc[a][b][m][n] = (f32x4){0.f, 0.f, 0.f, 0.f};
    bf16x8 At[4][2], B0[2][2], B1[2][2];
    const char* cA = (const char*)g.A + (size_t)cur.pm * tstep; const char* cB = (const char*)g.Bt + (size_t)cur.pn * tstep;
    PG8_STAGE(PG8_SB(0, 0), cB, voffB); PG8_STAGE(PG8_SB(0, 1), cB + hstep, voffB); PG8_STAGE(PG8_SA(0, 0), cA, voffA0); PG8_STAGE(PG8_SA(0, 1), cA, voffA1);
    if constexpr (Epi::NTAB > 0) {
#pragma unroll 1
        for (int i = tid >> 8; i < 8; i += 2) { Unit uu; if (!S.next(i, uu)) break; E.fill(lds + STAGE_BYTES, i, uu, tid & 255); asm volatile("" ::: "memory"); }
        asm volatile("s_waitcnt lgkmcnt(0)" ::: "memory");
    }
    if (wr == 1) PG8_BAR;
    PG8_WAIT_V(2); PG8_BAR;
    PG8_STAGE(PG8_SB(1, 0), cB + kstep, voffB); PG8_STAGE(PG8_SA(1, 0), cA + kstep, voffA0); PG8_STAGE(PG8_SB(1, 1), cB + hstep + kstep, voffB);
    PG8_WAIT_V(6); PG8_BAR;
    for (;;) {
        const bool has_next = S.next(ui + 1, nxt);
        const char* nA = has_next ? (const char*)g.A + (size_t)nxt.pm * tstep : cA; const char* nB = has_next ? (const char*)g.Bt + (size_t)nxt.pn * tstep : cB;
        for (int t = 0; t < nt; t += 2) {
            const bool last = (t == nt - 2);
            const char* a1 = cA + (size_t)(t + 1) * kstep;
            const char* a2 = last ? nA : cA + (size_t)(t + 2) * kstep; const char* b2 = last ? nB : cB + (size_t)(t + 2) * kstep;
            const char* a3 = a2 + kstep; const char* b3 = b2 + kstep;
            PG8_LDB(B0, 0, 0); PG8_LDB(B1, 0, 1); PG8_SCHED; PG8_LDA(At, 0, 0); PG8_STAGE(PG8_SA(1, 1), a1, voffA1);
            PG8_WAIT_V(8); PG8_WAIT_L(0); PG8_BAR; PG8_MMA(0, 0, At, B0); PG8_MMA(0, 1, At, B1); PG8_BAR; PG8_SCHED;
            PG8_LDA(At, 0, 1); PG8_STAGE(PG8_SB(0, 0), b2, voffB); PG8_STAGE(PG8_SB(0, 1), b2 + hstep, voffB); PG8_STAGE(PG8_SA(0, 0), a2, voffA0);
            PG8_WAIT_V(8); PG8_WAIT_L(0); PG8_BAR; PG8_MMA(1, 0, At, B0); PG8_MMA(1, 1, At, B1); PG8_BAR; PG8_SCHED;
            PG8_LDB(B0, 1, 0); PG8_LDB(B1, 1, 1); PG8_SCHED; PG8_LDA(At, 1, 0); PG8_STAGE(PG8_SA(0, 1), a2, voffA1);
            PG8_WAIT_V(8); PG8_WAIT_L(0); PG8_BAR; PG8_MMA(0, 0, At, B0); PG8_MMA(0, 1, At, B1); PG8_BAR; PG8_SCHED;
            PG8_LDA(At, 1, 1); PG8_STAGE(PG8_SB(1, 0), b3, voffB); PG8_STAGE(PG8_SB(1, 1), b3 + hstep, voffB); PG8_STAGE(PG8_SA(1, 0), a3, voffA0);
            PG8_WAIT_V(8); PG8_WAIT_L(0); PG8_BAR; PG8_MMA(1, 0, At, B0); PG8_MMA(1, 1, At, B1); PG8_BAR; PG8_SCHED;
        }
        if (wr == 0) PG8_BAR;
        E(acc, cur, ui, wr, wc, fr, fq, lds + STAGE_BYTES);
        if (!has_next) break;
#pragma unroll
        for (int a = 0; a < 2; ++a)
#pragma unroll
            for (int b = 0; b < 2; ++b)
#pragma unroll
                for (int m = 0; m < 4; ++m)
#pragma unroll
                    for (int n = 0; n < 2; ++n) acc[a][b][m][n] = (f32x4){0.f, 0.f, 0.f, 0.f};
        cur = nxt; cA = nA; cB = nB; ++ui;
        if (wr == 1) PG8_BAR;
    }
    PG8_WAIT_V(0);
    PG8_BAR;
#undef PG8_SA
#undef PG8_SB
#undef PG8_STAGE
#undef PG8_LDA
#undef PG8_LDB
#undef PG8_MMA
#undef PG8_WAIT_V
#undef PG8_WAIT_L
#undef PG8_BAR
#undef PG8_SCHED
}
}

constexpr int NWAVES = 8;
constexpr int RING_BYTES = 131072, LDS_BYTES = 163840, LDSCTL_OFF = LDS_BYTES - 512, MISC_OFF = LDSCTL_OFF + 320;
#define GAS __attribute__((address_space(1)))
#define LAS __attribute__((address_space(3)))
typedef GAS unsigned gu32;
#define RLX_AGENT __ATOMIC_RELAXED, __HIP_MEMORY_SCOPE_AGENT
#define LDS_WAIT() asm volatile("s_waitcnt lgkmcnt(0)" ::: "memory")
#define VM_WAIT() asm volatile("s_waitcnt vmcnt(0)" ::: "memory")
constexpr int CW_BAR = 4096;
#define XB_TMO      128
#define XB_XCNT(j)  (256  + 64 * (j))
#define XB_XSUB(j)  (1280 + 64 * (j))
#define XB_XGEN(j)  (2304 + 64 * (j))
#define XB_TOP      3328
#define XB_TOPGEN   3392
#define XCD_BAR_WORDS 3456
#define XB_SPIN_CAP (1u << 18)
__device__ __forceinline__ unsigned xb_ld(unsigned* p)              { return __hip_atomic_load(p, __ATOMIC_RELAXED, __HIP_MEMORY_SCOPE_AGENT); }
__device__ __forceinline__ unsigned xb_add(unsigned* p, unsigned v) { return __hip_atomic_fetch_add(p, v, __ATOMIC_RELAXED, __HIP_MEMORY_SCOPE_AGENT); }
__device__ __forceinline__ unsigned xb_xcc_id() { return (unsigned)__builtin_amdgcn_s_getreg((3 << 11) | 20) & 0xFu; }
#define XB_SPIN(cond, bar) do { unsigned _sp = 0; while (cond) { __builtin_amdgcn_s_sleep(1); \
    if ((++_sp & 255u) == 0u) { if (xb_ld(&(bar)[XB_TMO])) break; if (_sp > XB_SPIN_CAP) { atomicAdd(&(bar)[XB_TMO], 1u); break; } } } } while (0)
struct XcdBarrier { unsigned* bar; unsigned x; volatile LAS unsigned* st; };
__device__ __forceinline__ XcdBarrier xcd_barrier_post(unsigned* bar, volatile LAS unsigned* st) {
    XcdBarrier b; b.bar = bar; b.x = xb_xcc_id(); b.st = st;
    if (threadIdx.x == 0) (void)xb_add(&bar[XB_XCNT(b.x)], 1u);
    return b;
}
__device__ __forceinline__ void xcd_barrier_complete(unsigned* bar, unsigned x, unsigned& nloc, unsigned& nx) {
    const unsigned G = gridDim.x * gridDim.y * gridDim.z;
    unsigned sum, cnt, mine, sp = 0u;
    for (;;) {
        sum = 0u; cnt = 0u; mine = 0u;
#pragma unroll
        for (unsigned j = 0; j < 16; ++j) { const unsigned c = xb_ld(&bar[XB_XCNT(j)]); sum += c; cnt += (c > 0u) ? 1u : 0u; mine = (j == x) ? c : mine; }
        if (sum == G) break;
        __builtin_amdgcn_s_sleep(1);
        if ((++sp & 255u) == 0u) { if (xb_ld(&bar[XB_TMO])) break; if (sp > XB_SPIN_CAP) { atomicAdd(&bar[XB_TMO], 1u); break; } }
    }
    nloc = mine > 0u ? mine : 1u; nx = cnt > 0u ? cnt : 1u;
}
__device__ __forceinline__ void xcd_barrier(const XcdBarrier& b) {
    asm volatile("s_waitcnt vmcnt(0)" ::: "memory");
    __syncthreads();
    if (threadIdx.x == 0) {
        unsigned* bar = b.bar;
        __builtin_amdgcn_s_waitcnt(0);
        unsigned nloc = b.st[0], nx = b.st[1];
        if (nloc == 0u) { xcd_barrier_complete(bar, b.x, nloc, nx); b.st[0] = nloc; b.st[1] = nx; }
        const unsigned old = xb_add(&bar[XB_XSUB(b.x)], 1u);
        const unsigned gen = old / nloc;
        if (old + 1u == (gen + 1u) * nloc) {
            __builtin_amdgcn_fence(__ATOMIC_RELEASE, "agent");
            asm volatile("s_waitcnt vmcnt(0)" ::: "memory");
            const unsigned og = xb_add(&bar[XB_TOP], 1u);
            const unsigned tg = og / nx;
            if (og + 1u == (tg + 1u) * nx) xb_add(&bar[XB_TOPGEN], 1u);
            else XB_SPIN(xb_ld(&bar[XB_TOPGEN]) == tg, bar);
            __builtin_amdgcn_fence(__ATOMIC_ACQUIRE, "agent");
            xb_add(&bar[XB_XGEN(b.x)], 1u);
            asm volatile("s_waitcnt vmcnt(0)" ::: "memory");
        } else {
            XB_SPIN(xb_ld(&bar[XB_XGEN(b.x)]) == gen, bar);
            __builtin_amdgcn_fence(__ATOMIC_ACQUIRE, "agent");
            asm volatile("s_waitcnt vmcnt(0)" ::: "memory");
        }
    }
    __syncthreads();
}

struct Args { const float* in[16]; float* out; unsigned char* ws; int ph_lo, ph_hi, li, pad; };
enum { PH_PRO = 0, PH_A1, PH_A2, PH_A3, PH_F1A, PH_F2A, PH_B1, PH_B2, PH_GATE, PH_B3, PH_F1B, PH_F2B, PH_END };

__device__ __forceinline__ void p0_transpose_item(const float* W, int K, int Nsrc, int N, int mode, const float* gain, bf16_t* WT, LAS float* scr, int item, int lane) {
    const int nblk = N / 64, kb = item / nblk, nb = item % nblk, k0 = 64 * kb, n0 = 64 * nb;
    const int src = wmap(mode, n0 + lane);
    const float* wp = W + (size_t)k0 * Nsrc + (src >= 0 ? src : 0);
#pragma unroll
    for (int h = 0; h < 2; ++h) { float v[32];
#pragma unroll
        for (int i = 0; i < 32; ++i) v[i] = wp[(size_t)(32 * h + i) * Nsrc];
#pragma unroll
        for (int i = 0; i < 32; ++i) { float x = v[i]; if (gain) x *= gain[k0 + 32 * h + i]; if (src < 0) x = 0.f; scr[(32 * h + i) * 65 + lane] = x; } }
    LDS_WAIT(); asm volatile("" ::: "memory");
    const int kq = (lane & 3) * 16;
#pragma unroll
    for (int j = 0; j < 4; ++j) { const int n = (lane >> 2) + 16 * j; const LAS float* sp = scr + kq * 65 + n;
        u32x4 o0, o1;
        o0.x = pk2(sp[0 * 65], sp[1 * 65]); o0.y = pk2(sp[2 * 65], sp[3 * 65]); o0.z = pk2(sp[4 * 65], sp[5 * 65]); o0.w = pk2(sp[6 * 65], sp[7 * 65]);
        o1.x = pk2(sp[8 * 65], sp[9 * 65]); o1.y = pk2(sp[10 * 65], sp[11 * 65]); o1.z = pk2(sp[12 * 65], sp[13 * 65]); o1.w = pk2(sp[14 * 65], sp[15 * 65]);
        bf16_t* dst = WT + (size_t)(n0 + n) * K + k0 + kq; *(u32x4*)dst = o0; *(u32x4*)(dst + 8) = o1; }
    LDS_WAIT(); asm volatile("" ::: "memory");
}
__device__ __forceinline__ void ffn_fixup(int pm, const float* cw, const float* PART, const float* HALO, bf16_t* H) {
    if ((pm & 7) == 0) return;
    int tid = threadIdx.x; asm volatile("" : "+v"(tid));
    const float* part = PART + (size_t)pm * (4 * D_FF); const float* halo = HALO + (size_t)(pm - 1) * (4 * D_FF);
#pragma unroll
    for (int idx0 = 0; idx0 < 2 * D_FF; idx0 += NWAVES * 64) { const int idx = idx0 + tid; const int e = idx / D_FF, c = idx - e * D_FF;
        float a = part[(size_t)e * 2 * D_FF + c], b = part[(size_t)e * 2 * D_FF + D_FF + c];
        const float ha0 = halo[c], hb0 = halo[D_FF + c], ha1 = halo[2 * D_FF + c], hb1 = halo[3 * D_FF + c];
        const float wa0 = cw[c], wa1 = cw[FF2 + c], wb0 = cw[D_FF + c], wb1 = cw[FF2 + D_FF + c];
        if (e == 0) { a += wa1 * ha1 + wa0 * ha0; b += wb1 * hb1 + wb0 * hb0; } else { a += wa0 * ha1; b += wb0 * hb1; }
        H[(size_t)(pm * 256 + e) * D_FF + c] = f2bf(siluf(a) * b); }
}


__device__ __forceinline__ void dsa_slow_phase(LAS unsigned char* lds, const bf16_t* QH, const bf16_t* Cb, const float* PS, const bf16_t* QI, const bf16_t* KI, const float* WI, bf16_t* AO, int vcu, int G) {
    int tid_ = threadIdx.x; asm volatile("" : "+v"(tid_));
    const int tid = tid_, hf = tid >> 8, tl = tid & 255, lane = tid & 63, wv = (tid >> 6) & 3;
    LAS unsigned char* base = lds + hf * 32768;
    LAS float* qi = (LAS float*)base;
    LAS float* sc = qi + 512;
    LAS float* qh = sc + 2048;
    LAS float* p = qh + 1024;
    LAS unsigned* red = (LAS unsigned*)(p + 8 * 257);
    LAS float* fred = (LAS float*)(red + 256);
    LAS float* wi = fred + 32; LAS float* mh = wi + 8; LAS float* lh = mh + 8; LAS float* rq = lh + 8;
    LAS unsigned short* idx = (LAS unsigned short*)(rq + 8);
    const int npairs = M / 2;
    for (int pr = vcu; pr < npairs; pr += G) {
        const int tg = pr * 2 + hf, b = tg / SEQ, t = tg % SEQ, limit = ((t >> 6) + 1) * 64;
        __syncthreads();
        for (int e = tl; e < 512; e += 256) qi[e] = bf2f(QI[(size_t)tg * 512 + e]);
        if (tl < 8) { const int h = tl; const float* ps = PS + (size_t)tg * 56;
            const int qb = (5 + (h >> 2)) * 8 + ((h >> 1) & 1) * 4 + 2 * (h & 1);
            wi[h] = WI[(size_t)tg * 8 + h] * rsqrtf((ps[qb] + ps[qb + 1]) * (1.0f / 64.0f) + EPS);
            const int hb = (h >> 1) * 8 + (h & 1) * 4;
            rq[h] = rsqrtf((ps[hb] + ps[hb + 1] + ps[hb + 2] + ps[hb + 3]) * (1.0f / 128.0f) + EPS); }
        for (int e = tl; e < 1024; e += 256) qh[e] = bf2f(QH[(size_t)tg * 1024 + e]);
        __syncthreads();
        for (int s = tl; s < limit; s += 256) {
            const u32x4* kr = (const u32x4*)(KI + ((size_t)b * SEQ + s) * 64);
            const float* ps = PS + ((size_t)b * SEQ + s) * 56; const float rk = rsqrtf((ps[36] + ps[37]) * (1.0f / 64.0f) + EPS);
            float d[8];
#pragma unroll
            for (int h = 0; h < 8; ++h) d[h] = 0.f;
#pragma unroll 2
            for (int c8 = 0; c8 < 8; ++c8) { const u32x4 kv = kr[c8]; const float k0 = bflo(kv.x), k1 = bfhi(kv.x), k2 = bflo(kv.y), k3 = bfhi(kv.y), k4 = bflo(kv.z), k5 = bfhi(kv.z), k6 = bflo(kv.w), k7 = bfhi(kv.w);
#pragma unroll
                for (int h = 0; h < 8; ++h) { const LAS float* q = qi + h * 64 + c8 * 8;
                    d[h] += q[0] * k0 + q[1] * k1 + q[2] * k2 + q[3] * k3 + q[4] * k4 + q[5] * k5 + q[6] * k6 + q[7] * k7; } }
            float tot = 0.f;
#pragma unroll
            for (int h = 0; h < 8; ++h) tot += fmaxf(d[h], 0.f) * wi[h];
            sc[s] = tot * rk + 0.0f;
        }
        __syncthreads();
        int count;
        if (limit <= TOPK) { count = limit; for (int j = tl; j < limit; j += 256) idx[j] = (unsigned short)j; __syncthreads(); }
        else {
            count = TOPK;
            unsigned key[8];
#pragma unroll
            for (int j = 0; j < 8; ++j) { const int s = tl * 8 + j; unsigned k = 0u; if (s < limit) { const unsigned u = __float_as_uint(sc[s]); k = (u & 0x80000000u) ? ~u : (u | 0x80000000u); } key[j] = k; }
            unsigned Tk = 0u;
            for (int bit = 31; bit >= 0; --bit) {
                const unsigned cand = Tk | (1u << bit); int c = 0;
#pragma unroll
                for (int j = 0; j < 8; ++j) c += (key[j] >= cand) ? 1 : 0;
                c = (int)wave_sum((float)c);
                if (lane == 0) red[wv] = (unsigned)c;
                __syncthreads();
                const int tot = (int)(red[0] + red[1] + red[2] + red[3]);
                __syncthreads();
                if (tot >= TOPK) Tk = cand;
            }
            int ngt = 0, neq = 0;
#pragma unroll
            for (int j = 0; j < 8; ++j) { ngt += (key[j] > Tk) ? 1 : 0; neq += (key[j] == Tk) ? 1 : 0; }
            red[tl] = ((unsigned)ngt << 16) | (unsigned)neq;
            __syncthreads();
            int tot_gt = 0, eq_before = 0;
            for (int j = 0; j < 256; ++j) { const unsigned v = red[j]; tot_gt += (int)(v >> 16); if (j < tl) eq_before += (int)(v & 0xffffu); }
            __syncthreads();
            const int need_eq = TOPK - tot_gt;
            unsigned selm = 0u; int nsel = 0, eqr = eq_before;
#pragma unroll
            for (int j = 0; j < 8; ++j) { bool sl = key[j] > Tk; if (key[j] == Tk) { sl = eqr < need_eq; ++eqr; } if (sl) { selm |= 1u << j; ++nsel; } }
            red[tl] = (unsigned)nsel;
            __syncthreads();
            int bs = 0; for (int j = 0; j < tl; ++j) bs += (int)red[j];
#pragma unroll
            for (int j = 0; j < 8; ++j) if (selm & (1u << j)) idx[bs++] = (unsigned short)(tl * 8 + j);
            __syncthreads();
        }
        float lg[8];
#pragma unroll
        for (int h = 0; h < 8; ++h) lg[h] = 0.f;
        if (tl < count) {
            const int key = idx[tl]; const u32x4* cr = (const u32x4*)(Cb + ((size_t)b * SEQ + key) * 128);
            const float* ps = PS + ((size_t)b * SEQ + key) * 56 + 32; const float rc = rsqrtf((ps[0] + ps[1] + ps[2] + ps[3]) * (1.0f / 128.0f) + EPS);
#pragma unroll 2
            for (int c8 = 0; c8 < 16; ++c8) { const u32x4 cv = cr[c8]; const float k0 = bflo(cv.x), k1 = bfhi(cv.x), k2 = bflo(cv.y), k3 = bfhi(cv.y), k4 = bflo(cv.z), k5 = bfhi(cv.z), k6 = bflo(cv.w), k7 = bfhi(cv.w);
#pragma unroll
                for (int h = 0; h < 8; ++h) { const LAS float* q = qh + h * 128 + c8 * 8;
                    lg[h] += q[0] * k0 + q[1] * k1 + q[2] * k2 + q[3] * k3 + q[4] * k4 + q[5] * k5 + q[6] * k6 + q[7] * k7; } }
#pragma unroll
            for (int h = 0; h < 8; ++h) lg[h] *= rc * rq[h];
        } else {
#pragma unroll
            for (int h = 0; h < 8; ++h) lg[h] = -INFINITY;
        }
#pragma unroll
        for (int h = 0; h < 8; ++h) { float m = lg[h];
#pragma unroll
            for (int o = 1; o < 64; o <<= 1) m = fmaxf(m, __shfl_xor(m, o));
            if (lane == 0) fred[h * 4 + wv] = m; }
        __syncthreads();
        if (tl < 8) mh[tl] = fmaxf(fmaxf(fred[tl * 4], fred[tl * 4 + 1]), fmaxf(fred[tl * 4 + 2], fred[tl * 4 + 3]));
        __syncthreads();
#pragma unroll
        for (int h = 0; h < 8; ++h) { const float e = (tl < count) ? __expf(lg[h] - mh[h]) : 0.f; p[h * 257 + tl] = e; const float sm = wave_sum(e); if (lane == 0) fred[h * 4 + wv] = sm; }
        __syncthreads();
        if (tl < 8) lh[tl] = (fred[tl * 4] + fred[tl * 4 + 1]) + (fred[tl * 4 + 2] + fred[tl * 4 + 3]);
        __syncthreads();
        { const int h = tl >> 5, d = (tl & 31) * 4; float a0 = 0.f, a1 = 0.f, a2 = 0.f, a3 = 0.f;
            for (int j = 0; j < count; ++j) { const float pj = p[h * 257 + j]; const u32x2 cv = *(const u32x2*)(Cb + ((size_t)b * SEQ + idx[j]) * 128 + d);
                a0 += pj * bflo(cv.x); a1 += pj * bfhi(cv.x); a2 += pj * bflo(cv.y); a3 += pj * bfhi(cv.y); }
            const float inv = 1.0f / lh[h]; u32x2 o; o.x = pk2(a0 * inv, a1 * inv); o.y = pk2(a2 * inv, a3 * inv);
            *(u32x2*)(AO + (size_t)tg * 1024 + h * 128 + d) = o; }
    }
    __syncthreads();
}
__device__ __forceinline__ void ret_slow_phase(LAS unsigned char* lds, const bf16_t* QT, const bf16_t* KT, const bf16_t* VT, bf16_t* RET, float* SSR, int unit0, int G) {
    LAS bf16_t* Qs = (LAS bf16_t*)lds;
    LAS bf16_t* Ks = Qs + 64 * 256;
    LAS bf16_t* Vs = Ks + 64 * 256;
    LAS float* Ss = (LAS float*)(Vs + 64 * 64);
    LAS float* St = Ss + 64 * 65;
    int tid_ = threadIdx.x; asm volatile("" : "+v"(tid_));
    const int tid = tid_, dv = tid & 63, g8 = tid >> 6;
    for (int u = unit0; u < 256; u += G) {
        const int blk = u & 7, h = (u >> 3) & 3, b = u >> 5;
        const float g64 = __expf(64.0f * gamma_log(h));
        __syncthreads();
        for (int e = tid; e < 256 * 64; e += 512) St[e] = 0.f;
        for (int n = 0; n < 32; ++n) {
            const size_t row0 = (size_t)b * SEQ + n * 64;
            __syncthreads();
            for (int e = tid; e < 64 * 32; e += 512) { const int r = e >> 5, c8 = e & 31;
                *(LAS u32x4*)(Qs + r * 256 + c8 * 8) = *(const u32x4*)(QT + (row0 + r) * 1024 + h * 256 + c8 * 8);
                *(LAS u32x4*)(Ks + r * 256 + c8 * 8) = *(const u32x4*)(KT + (row0 + r) * 1024 + h * 256 + c8 * 8); }
            for (int e = tid; e < 64 * 64; e += 512) { const int dd = e >> 6, key = e & 63; Vs[key * 64 + dd] = VT[((size_t)b * 2048 + h * 512 + blk * 64 + dd) * SEQ + n * 64 + key]; }
            __syncthreads();
            { const int q = tid >> 3, kg = tid & 7;
                for (int key = kg * 8; key < kg * 8 + 8; ++key) { float d = 0.f;
                    if (key <= q) for (int i = 0; i < 256; ++i) d += bf2f(Qs[q * 256 + i]) * bf2f(Ks[key * 256 + i]);
                    Ss[q * 65 + key] = d; } }
            __syncthreads();
            for (int q = g8 * 8; q < g8 * 8 + 8; ++q) { float r = 0.f;
                for (int key = 0; key <= q; ++key) r += Ss[q * 65 + key] * bf2f(Vs[key * 64 + dv]);
                for (int i = 0; i < 256; ++i) r += bf2f(Qs[q * 256 + i]) * St[i * 64 + dv];
                RET[(row0 + q) * 2048 + h * 512 + blk * 64 + dv] = f2bf(r);
                const float sq = wave_sum(r * r);
                if (dv < 2) SSR[((row0 + q) * 4 + h) * 16 + blk * 2 + dv] = dv == 0 ? sq : 0.f; }
            __syncthreads();
            for (int i = 0; i < 32; ++i) { const int dk = g8 * 32 + i; float a = St[dk * 64 + dv];
                for (int key = 0; key < 64; ++key) a += bf2f(Ks[key * 256 + dk]) * bf2f(Vs[key * 64 + dv]);
                St[dk * 64 + dv] = a * g64; }
        }
    }
    __syncthreads();
}


__device__ __forceinline__ void glds16_asm(const void* gsrc, unsigned lds_dst) {
    unsigned keep; asm volatile("s_mov_b32 %0, m0\n\ts_mov_b32 m0, %2\n\ts_nop 0\n\tglobal_load_lds_dwordx4 %1, off\n\ts_mov_b32 m0, %0" : "=&s"(keep) : "v"(gsrc), "s"(lds_dst) : "memory"); }
__device__ __forceinline__ unsigned lds_addr(LAS unsigned char* p) { return (unsigned)__builtin_amdgcn_readfirstlane((int)(unsigned)(size_t)p); }

typedef short s16x4 __attribute__((ext_vector_type(4)));
__device__ __forceinline__ bf16x8 cat4(s16x4 a, s16x4 b) { bf16x8 r; r[0] = a[0]; r[1] = a[1]; r[2] = a[2]; r[3] = a[3]; r[4] = b[0]; r[5] = b[1]; r[6] = b[2]; r[7] = b[3]; return r; }
__device__ __forceinline__ void ret_fast_phase(LAS unsigned char* lds, const bf16_t* QT, const bf16_t* KT, const bf16_t* VT, bf16_t* RET, float* SSR, int unit) {
    int tid_ = threadIdx.x; asm volatile("" : "+v"(tid_));
    const int tid = tid_, lane = tid & 63, w = __builtin_amdgcn_readfirstlane(tid >> 6), li = lane & 15, g = lane >> 4;
    const int blk = unit & 7, h = (unit >> 3) & 3, b = unit >> 5;
    const float g64 = __expf(64.0f * gamma_log(h));
    const int qt = (w < 2) ? 0 : (w < 4) ? 1 : (w < 6) ? 3 : 2, dvh = w & 1;
    const int kt0 = (w == 3) ? 1 : (w == 5 || w == 7) ? 2 : 0;
    const int kt1 = (w == 0 || w == 2) ? 1 : (w == 1) ? 0 : (w == 3) ? 2 : (w == 4 || w == 6) ? 2 : (w == 5) ? 4 : 3;
    constexpr int KB = 0, VB = 65536, ST = 81920, SIMG = 147456;
    typedef __attribute__((address_space(3))) s16x4 lds_s16x4;
    for (int e = tid; e < 2048; e += 512) *(LAS u32x4*)(lds + ST + e * 16) = (u32x4){0u, 0u, 0u, 0u};
    f32x4 st[2][4];
#pragma unroll
    for (int d = 0; d < 2; ++d)
#pragma unroll
        for (int t = 0; t < 4; ++t) st[d][t] = (f32x4){0.f, 0.f, 0.f, 0.f};
    const size_t rowb = (size_t)b * SEQ;
    const bf16_t* kbase = KT + rowb * 1024 + h * 256;
    const bf16_t* qbase = QT + (rowb + 16 * qt + li) * 1024 + h * 256 + 8 * g;
    const bf16_t* vbase = VT + ((size_t)b * 2048 + h * 512 + blk * 64 + (tid >> 3)) * SEQ + 8 * (tid & 7);
    const unsigned vw_off = (unsigned)((tid >> 3) * 128 + (((2 * (tid & 7)) ^ ((tid >> 3) & 14)) * 8));
    unsigned ksrc[4];
#pragma unroll
    for (int i = 0; i < 4; ++i) { const int row = 2 * (4 * w + i) + (lane >> 5), p = lane & 31, c = p ^ ((row & 7) << 1); ksrc[i] = (unsigned)(row * 2048 + c * 16); }
#define RK_DMA(n_, buf_) do { const char* kb_ = (const char*)(kbase + (size_t)(n_) * 64 * 1024); const unsigned ld_ = lds_addr(lds + KB + (buf_) * 32768 + (4 * w) * 1024); _Pragma("unroll") for (int i = 0; i < 4; ++i) \
        glds16_asm(kb_ + ksrc[i], ld_ + i * 1024); } while (0)
    bf16x8 qf[8], qn[8]; u32x4 vreg;
    RK_DMA(0, 0);
    vreg = *(const u32x4*)(vbase);
#pragma unroll
    for (int ks = 0; ks < 8; ++ks) { qf[ks] = *(const bf16x8*)(qbase + 32 * ks); qn[ks] = qf[ks]; }
    *(LAS u32x4*)(lds + VB + vw_off) = vreg;
    asm volatile("s_waitcnt vmcnt(0) lgkmcnt(0)" ::: "memory"); __builtin_amdgcn_s_barrier(); asm volatile("" ::: "memory");
#pragma unroll 1
    for (int n = 0; n < 32; ++n) {
        const int cur = n & 1, nxt = cur ^ 1;
        LAS unsigned char* kb = lds + KB + cur * 32768; LAS unsigned char* vb = lds + VB + cur * 8192; LAS unsigned char* sb = lds + ST + cur * 32768;
#ifndef RET_PROBE
#define RET_PROBE 0
#endif
        if (n + 1 < 32) {
            RK_DMA(n + 1, nxt);
            if (RET_PROBE & 1) { RK_DMA(n + 1, nxt); }
            vreg = *(const u32x4*)(vbase + (size_t)(n + 1) * 64);
#pragma unroll
            for (int ks = 0; ks < 8; ++ks) qn[ks] = *(const bf16x8*)(qbase + (size_t)(n + 1) * 64 * 1024 + 32 * ks);
        }
#pragma unroll 1
        for (int kt2 = 2 * kt0; kt2 < 2 * kt1; kt2 += ((RET_PROBE & 2) ? 1 : 2)) { const int kt = kt2 >> 1;
            f32x4 acc = (f32x4){0.f, 0.f, 0.f, 0.f};
            const int row = 16 * kt + li; const LAS unsigned char* rp = kb + row * 512; const int sw = (row & 7) << 1;
            bf16x8 av[8];
#pragma unroll
            for (int ks = 0; ks < 8; ++ks) av[ks] = *(const LAS bf16x8*)(rp + (((4 * ks + g) ^ sw) * 16));
            __builtin_amdgcn_sched_barrier(0);
#pragma unroll
            for (int ks = 0; ks < 8; ++ks) acc = __builtin_amdgcn_mfma_f32_16x16x32_bf16(av[ks], qf[ks], acc, 0, 0, 0);
            if (kt == qt) {
#pragma unroll
                for (int r = 0; r < 4; ++r) acc[r] = (4 * g + r <= li) ? acc[r] : 0.f; }
            u32x2 pk; pk.x = pk2(acc[0], acc[1]); pk.y = pk2(acc[2], acc[3]);
            *(LAS u32x2*)(lds + SIMG + ((qt * 4 + kt) * 64 + lane) * 8) = pk;
        }
        bf16x8 vf[4][2];
#pragma unroll
        for (int t = 0; t < 4; ++t)
#pragma unroll
            for (int kp = 0; kp < 2; ++kp) { const int row = 16 * t + li; const LAS unsigned char* rp = vb + row * 128; const int f = row & 14;
                const s16x4 lo = *(const LAS s16x4*)(rp + (((8 * kp + g) ^ f) * 8)), hi = *(const LAS s16x4*)(rp + (((8 * kp + 4 + g) ^ f) * 8)); vf[t][kp] = cat4(lo, hi); }
        bf16x8 ua[2][2];
#pragma unroll
        for (int d = 0; d < 2; ++d)
#pragma unroll
            for (int kp = 0; kp < 2; ++kp) { const int dkt = 2 * w + d;
                const int r0 = 32 * kp + 4 * g + (li >> 2), r1 = r0 + 16;
                const int cch = 2 * dkt + ((li >> 1) & 1), hb = (li & 1) * 8;
                const s16x4 lo = __builtin_bit_cast(s16x4, __builtin_amdgcn_ds_read_tr16_b64_v4i16((lds_s16x4*)(kb + r0 * 512 + ((cch ^ ((r0 & 7) << 1)) * 16) + hb)));
                const s16x4 hi = __builtin_bit_cast(s16x4, __builtin_amdgcn_ds_read_tr16_b64_v4i16((lds_s16x4*)(kb + r1 * 512 + ((cch ^ ((r1 & 7) << 1)) * 16) + hb)));
                ua[d][kp] = cat4(lo, hi); }
        __builtin_amdgcn_sched_barrier(0);
#pragma unroll
        for (int d = 0; d < 2; ++d)
#pragma unroll
            for (int kp = 0; kp < 2; ++kp)
#pragma unroll
                for (int t = 0; t < 4; ++t) st[d][t] = __builtin_amdgcn_mfma_f32_16x16x32_bf16(ua[d][kp], vf[t][kp], st[d][t], 0, 0, 0);
        asm volatile("s_waitcnt lgkmcnt(0)" ::: "memory"); __builtin_amdgcn_s_barrier(); asm volatile("" ::: "memory");
        if (RET_PROBE & 8) { __builtin_amdgcn_s_barrier(); asm volatile("" ::: "memory"); __builtin_amdgcn_s_barrier(); asm volatile("" ::: "memory"); }
        float ssq = 0.f;
        bf16x8 sf[2]; bool sv[2];
#pragma unroll
        for (int kp = 0; kp < 2; ++kp) { sv[kp] = (2 * kp <= qt); sf[kp] = (bf16x8){0, 0, 0, 0, 0, 0, 0, 0};
            if (sv[kp]) { const s16x4 lo = *(const LAS s16x4*)(lds + SIMG + ((qt * 4 + 2 * kp) * 64 + lane) * 8);
                s16x4 hi = (s16x4){0, 0, 0, 0}; if (2 * kp + 1 <= qt) hi = *(const LAS s16x4*)(lds + SIMG + ((qt * 4 + 2 * kp + 1) * 64 + lane) * 8);
                sf[kp] = cat4(lo, hi); } }
#pragma unroll
        for (int dd2 = 0; dd2 < ((RET_PROBE & 4) ? 4 : 2); ++dd2) { const int dd = dd2 & 1; const int t = 2 * dvh + dd; if (dd2 == 2) ssq = 0.f;
            bf16x8 sa[8];
            {   const int row = 16 * t + li; const LAS unsigned char* rp = sb + row * 512; const int sw = (row & 7) << 1;
#pragma unroll
                for (int ks = 0; ks < 8; ++ks) sa[ks] = *(const LAS bf16x8*)(rp + (((4 * ks + g) ^ sw) * 16)); }
            __builtin_amdgcn_sched_barrier(0);
            f32x4 acc = (f32x4){0.f, 0.f, 0.f, 0.f};
#pragma unroll
            for (int kp = 0; kp < 2; ++kp) if (sv[kp]) {
                const bf16x8 va = dvh ? (dd ? vf[3][kp] : vf[2][kp]) : (dd ? vf[1][kp] : vf[0][kp]);
                acc = __builtin_amdgcn_mfma_f32_16x16x32_bf16(va, sf[kp], acc, 0, 0, 0); }
#pragma unroll
            for (int ks = 0; ks < 8; ++ks) acc = __builtin_amdgcn_mfma_f32_16x16x32_bf16(sa[ks], qf[ks], acc, 0, 0, 0);
            ssq += (acc[0] * acc[0] + acc[1] * acc[1]) + (acc[2] * acc[2] + acc[3] * acc[3]);
            u32x2 pk; pk.x = pk2(acc[0], acc[1]); pk.y = pk2(acc[2], acc[3]);
            *(u32x2*)(RET + (rowb + n * 64 + 16 * qt + li) * 2048 + h * 512 + blk * 64 + 16 * t + 4 * g) = pk;
            __builtin_amdgcn_sched_barrier(0); }
        ssq += __shfl_xor(ssq, 16); ssq += __shfl_xor(ssq, 32);
        if (g == 0) SSR[((rowb + n * 64 + 16 * qt + li) * 4 + h) * 16 + blk * 2 + dvh] = ssq;
        LAS unsigned char* sn = lds + ST + nxt * 32768;
#pragma unroll
        for (int d = 0; d < 2; ++d)
#pragma unroll
            for (int t = 0; t < 4; ++t) { st[d][t] *= g64; const int row = 16 * t + li, dkt = 2 * w + d;
                u32x2 pk; pk.x = pk2(st[d][t][0], st[d][t][1]); pk.y = pk2(st[d][t][2], st[d][t][3]);
                *(LAS u32x2*)(sn + row * 512 + (((2 * dkt + (g >> 1)) ^ ((row & 7) << 1)) * 16) + (g & 1) * 8) = pk; }
        if (n + 1 < 32) *(LAS u32x4*)(lds + VB + nxt * 8192 + vw_off) = vreg;
#pragma unroll
        for (int ks = 0; ks < 8; ++ks) qf[ks] = qn[ks];
        asm volatile("s_waitcnt vmcnt(0) lgkmcnt(0)" ::: "memory"); __builtin_amdgcn_s_barrier(); asm volatile("" ::: "memory");
    }
#undef RK_DMA
}


#ifndef DSA_REP
#define DSA_REP 0
#endif
constexpr int DSA_SC = 0, DSA_KST = 131072, DSA_IDX = 147456;
__device__ __forceinline__ unsigned fkey(float f) { const unsigned u = __float_as_uint(f); return (u & 0x80000000u) ? ~u : (u | 0x80000000u); }
__device__ __forceinline__ int bcnt(bool p) { return __popcll(__ballot(p)); }
#define SUMF(a_, b_) ((a_) + (b_))
#define WAVE_RED(OP, v) do { v = OP(v, __int_as_float(__builtin_amdgcn_update_dpp(__float_as_int(v), __float_as_int(v), 0xB1, 0xf, 0xf, true))); \
        v = OP(v, __int_as_float(__builtin_amdgcn_update_dpp(__float_as_int(v), __float_as_int(v), 0x4E, 0xf, 0xf, true))); \
        v = OP(v, __int_as_float(__builtin_amdgcn_update_dpp(__float_as_int(v), __float_as_int(v), 0x141, 0xf, 0xf, true))); \
        v = OP(v, __int_as_float(__builtin_amdgcn_update_dpp(__float_as_int(v), __float_as_int(v), 0x140, 0xf, 0xf, true))); \
        v = OP(OP(__int_as_float(__builtin_amdgcn_readlane(__float_as_int(v), 0)), __int_as_float(__builtin_amdgcn_readlane(__float_as_int(v), 16))), \
               OP(__int_as_float(__builtin_amdgcn_readlane(__float_as_int(v), 32)), __int_as_float(__builtin_amdgcn_readlane(__float_as_int(v), 48)))); } while (0)

template <int NB>
__device__ __forceinline__ void dsa_topk_t(const LAS float* sc, LAS unsigned short* il, int limit, int lane) {
    const int nb = limit >> 6;
    float v[NB];
#pragma unroll
    for (int i = 0; i < NB; ++i) v[i] = (i < nb) ? sc[64 * i + lane] : -INFINITY;
    float mn = INFINITY, mx = -INFINITY;
#pragma unroll
    for (int i = 0; i < NB; ++i) { mn = fminf(mn, (i < nb) ? v[i] : INFINITY); mx = fmaxf(mx, v[i]); }
    WAVE_RED(fminf, mn); WAVE_RED(fmaxf, mx);
    float lo = mn, hi = INFINITY; int clo = limit, chi = 0;
#pragma unroll 1
    for (int it = 0; it < 64 && clo - chi > 64; ++it) {
        const float top = (hi == INFINITY) ? mx : hi; const float mid = 0.5f * lo + 0.5f * top;
        if (!(mid > lo) || !(mid < hi)) break;
        int c = 0;
#pragma unroll
        for (int i = 0; i < NB; ++i) c += (v[i] >= mid) ? 1 : 0;
        float cf = (float)c; WAVE_RED(SUMF, cf); c = (int)cf;
        if (c >= TOPK) { lo = mid; clo = c; } else { hi = mid; chi = c; }
    }
    const int r = TOPK - chi; unsigned T; int ngt, neq;
    if (clo - chi <= 64) {
        int filled = 0;
#pragma unroll
        for (int i = 0; i < NB; ++i) { const bool in = (v[i] >= lo) && (v[i] < hi);
            const unsigned long long m = __ballot(in); const int pos = filled + __builtin_amdgcn_mbcnt_hi((unsigned)(m >> 32), __builtin_amdgcn_mbcnt_lo((unsigned)m, 0));
            if (in) ((LAS unsigned*)il)[pos] = fkey(v[i]);
            filled += __popcll(m); }
        asm volatile("s_waitcnt lgkmcnt(0)" ::: "memory");
        const unsigned ck = (lane < filled) ? ((LAS unsigned*)il)[lane] : 0u;
        T = 0u;
#pragma unroll 4
        for (int bit = 31; bit >= 0; --bit) { const unsigned cand = T | (1u << bit); if (bcnt(ck >= cand) >= r) T = cand; }
        ngt = chi + bcnt(ck > T); neq = bcnt(ck == T);
    } else {
        T = 0u;
#pragma unroll 1
        for (int bit = 31; bit >= 0; --bit) { const unsigned cand = T | (1u << bit); int c = 0;
#pragma unroll
            for (int i = 0; i < NB; ++i) c += bcnt(i < nb && fkey(v[i]) >= cand);
            if (c >= TOPK) T = cand; }
        ngt = 0; neq = 0;
#pragma unroll
        for (int i = 0; i < NB; ++i) { const unsigned k = fkey(v[i]); ngt += bcnt(i < nb && k > T); neq += bcnt(i < nb && k == T); }
    }
    const int need_eq = TOPK - ngt;
    asm volatile("s_waitcnt lgkmcnt(0)" ::: "memory");
    int base = 0, tb = 0;
    const bool alleq = (neq == need_eq);
#pragma unroll
    for (int i = 0; i < NB; ++i) if (i < nb) { const unsigned k = fkey(v[i]);
        bool f = k >= T;
        if (!alleq) { const bool eq = (k == T); const unsigned long long me = __ballot(eq);
            const int er = tb + __builtin_amdgcn_mbcnt_hi((unsigned)(me >> 32), __builtin_amdgcn_mbcnt_lo((unsigned)me, 0));
            f = (k > T) || (eq && er < need_eq); tb += __popcll(me); }
        const unsigned long long mf = __ballot(f); const int pos = base + __builtin_amdgcn_mbcnt_hi((unsigned)(mf >> 32), __builtin_amdgcn_mbcnt_lo((unsigned)mf, 0));
        if (f && pos < TOPK) il[pos] = (unsigned short)(64 * i + lane);
        base += __popcll(mf); }
}
__device__ __forceinline__ void dsa_topk(const LAS float* sc, LAS unsigned short* il, int limit, int lane) {
    if (limit <= 512) dsa_topk_t<8>(sc, il, limit, lane);
    else if (limit <= 1024) dsa_topk_t<16>(sc, il, limit, lane);
    else dsa_topk_t<32>(sc, il, limit, lane);
}

struct DsaQ { bf16x8 qf[4]; f32x4 ps; };
__device__ __forceinline__ DsaQ dsa_load_q(const bf16_t* QH, const float* PS, size_t trow, int lane) {
    const int li = lane & 15, g = lane >> 4; DsaQ q;
#pragma unroll
    for (int s = 0; s < 4; ++s) { q.qf[s] = (bf16x8){0, 0, 0, 0, 0, 0, 0, 0}; if (li < 8) q.qf[s] = *(const bf16x8*)(QH + trow * 1024 + li * 128 + 32 * s + 8 * g); }
    q.ps = (f32x4){1.f, 1.f, 1.f, 1.f}; if (li < 8) q.ps = *(const f32x4*)(PS + trow * 56 + (li >> 1) * 8 + (li & 1) * 4);
    return q;
}
__device__ __forceinline__ void dsa_attend(LAS unsigned char* wl, const LAS unsigned short* il, const LAS float* rctab, LAS float* rcl, const DsaQ& Q, const bf16_t* Cb, bf16_t* AO, size_t trow, int b, int count, float bound_l2, int lane) {
    const int li = lane & 15, g = lane >> 4;
    typedef __attribute__((address_space(3))) s16x4 lds_s16x4;
    bf16x8 qf[4];
#pragma unroll
    for (int s = 0; s < 4; ++s) qf[s] = Q.qf[s];
    const float rq = (li < 8) ? rsqrtf(((Q.ps[0] + Q.ps[1]) + (Q.ps[2] + Q.ps[3])) * (1.0f / 128.0f) + EPS) * 1.4426950408889634f : 0.f;
    const bf16_t* cbase = Cb + (size_t)b * SEQ * 128; const unsigned wlb = lds_addr(wl);
#define DSA_GATHER(ci_, buf_) do { const u32x4 kw_ = *(const LAS u32x4*)(il + 32 * (ci_) + 8 * (lane >> 4)); \
        _Pragma("unroll") for (int i = 0; i < 8; ++i) { const int row = 4 * i + (lane >> 4); const unsigned kk_ = (i < 2 ? kw_.x : i < 4 ? kw_.y : i < 6 ? kw_.z : kw_.w); const int key = (i & 1) ? (int)(kk_ >> 16) : (int)(kk_ & 0xffffu); \
        const int sc_ = (lane & 15) ^ ((row & 7) << 1); \
        glds16_asm(cbase + (size_t)key * 128 + sc_ * 8, wlb + (buf_) * 8192 + i * 1024); } } while (0)
    for (int pos = lane; pos < count; pos += 64) { const int e = pos & 31; rcl[(pos & ~31) + 4 * (e & 7) + (e >> 3)] = rctab[il[pos]]; }
    asm volatile("s_waitcnt lgkmcnt(0)" ::: "memory");
    f32x4 oacc[8];
#pragma unroll
    for (int d = 0; d < 8; ++d) oacc[d] = (f32x4){0.f, 0.f, 0.f, 0.f};
    float lsum = 0.f;
    const int nch = count >> 5;
    DSA_GATHER(0, 0);
#pragma unroll 1
    for (int ci = 0; ci < nch; ++ci) {
        const int cur = ci & 1;
        if (ci + 1 < nch) { DSA_GATHER(ci + 1, cur ^ 1); if (DSA_REP & 8) { DSA_GATHER(ci + 1, cur ^ 1); asm volatile("s_waitcnt vmcnt(16)" ::: "memory"); } else asm volatile("s_waitcnt vmcnt(8)" ::: "memory"); } else { asm volatile("s_waitcnt vmcnt(0)" ::: "memory"); }
        const LAS unsigned char* ct = wl + cur * 8192;
        f32x4 lt[2];
        bf16x8 ca[2][4];
#pragma unroll
        for (int T = 0; T < 2; ++T) { const int row = 16 * T + li; const LAS unsigned char* rp = ct + row * 256; const int sw = (row & 7) << 1;
#pragma unroll
            for (int s = 0; s < 4; ++s) ca[T][s] = *(const LAS bf16x8*)(rp + (((4 * s + g) ^ sw) * 16)); }
        f32x4 rcv[2];
#pragma unroll
        for (int T = 0; T < 2; ++T) rcv[T] = *(const LAS f32x4*)(rcl + 32 * ci + 16 * T + 4 * g);
        __builtin_amdgcn_sched_barrier(0);
#pragma unroll
        for (int T = 0; T < 2; ++T) { lt[T] = (f32x4){0.f, 0.f, 0.f, 0.f};
#pragma unroll
            for (int s = 0; s < 4; ++s) lt[T] = __builtin_amdgcn_mfma_f32_16x16x32_bf16(ca[T][s], qf[s], lt[T], 0, 0, 0); }
        bf16x8 cv[8];
#pragma unroll
        for (int dt = 0; dt < 8; ++dt) {
            const int r0 = 4 * g + (li >> 2), r1 = r0 + 16; const int cch = 2 * dt + ((li >> 1) & 1), hb = (li & 1) * 8;
            const s16x4 lo = __builtin_bit_cast(s16x4, __builtin_amdgcn_ds_read_tr16_b64_v4i16((lds_s16x4*)(ct + r0 * 256 + ((cch ^ ((r0 & 7) << 1)) * 16) + hb)));
            const s16x4 hi = __builtin_bit_cast(s16x4, __builtin_amdgcn_ds_read_tr16_b64_v4i16((lds_s16x4*)(ct + r1 * 256 + ((cch ^ ((r1 & 7) << 1)) * 16) + hb)));
            cv[dt] = cat4(lo, hi); }
        __builtin_amdgcn_sched_barrier(0);
        bf16x8 pf;
#pragma unroll
        for (int T = 0; T < 2; ++T) { float pv[4];
#pragma unroll
            for (int r = 0; r < 4; ++r) { pv[r] = __builtin_amdgcn_exp2f(lt[T][r] * rq * rcv[T][r] - bound_l2); lsum += pv[r]; }
            const unsigned w0 = pk2(pv[0], pv[1]), w1 = pk2(pv[2], pv[3]);
            pf[4 * T + 0] = (short)(w0 & 0xffff); pf[4 * T + 1] = (short)(w0 >> 16); pf[4 * T + 2] = (short)(w1 & 0xffff); pf[4 * T + 3] = (short)(w1 >> 16); }
#pragma unroll
        for (int dt = 0; dt < 8; ++dt) oacc[dt] = __builtin_amdgcn_mfma_f32_16x16x32_bf16(cv[dt], pf, oacc[dt], 0, 0, 0);
    }
#undef DSA_GATHER
    lsum += __shfl_xor(lsum, 16); lsum += __shfl_xor(lsum, 32);
    const float inv = 1.0f / lsum;
    if (li < 8) {
#pragma unroll
        for (int dt = 0; dt < 8; ++dt) { u32x2 o; o.x = pk2(oacc[dt][0] * inv, oacc[dt][1] * inv); o.y = pk2(oacc[dt][2] * inv, oacc[dt][3] * inv);
            *(u32x2*)(AO + trow * 1024 + li * 128 + 16 * dt + 4 * g) = o; }
    }
}

__device__ __forceinline__ void dsa_fast_phase(LAS unsigned char* lds, const bf16_t* QH, const bf16_t* Cb, const float* PS, const bf16_t* QI, const bf16_t* KI, const float* WI, const float* CSC, bf16_t* AO, int vcu, int G) {
    int tid_ = threadIdx.x; asm volatile("" : "+v"(tid_));
    const int tid = tid_, lane0 = tid & 63, w = __builtin_amdgcn_readfirstlane(tid >> 6);
    LAS unsigned char* wl = lds + DSA_SC + w * 16384; LAS float* rctab = (LAS float*)(lds + DSA_KST);
    LAS unsigned short* il0 = (LAS unsigned short*)(lds + DSA_IDX + (2 * w) * 512); LAS unsigned short* il1 = il0 + 256;
    float mxs = 0.f;
    for (int i = lane0; i < 128; i += 64) mxs = fmaxf(mxs, fabsf(CSC[i]));
#pragma unroll
    for (int o = 1; o < 64; o <<= 1) mxs = fmaxf(mxs, __shfl_xor(mxs, o));
    const float bound_l2 = mxs * 128.0f * 1.4426950408889634f;
    for (int wg = vcu; wg < 256; wg += G) {
        const int b = wg >> 5, r = wg & 31;
        __syncthreads();
        for (int k = tid; k < SEQ; k += NWAVES * 64) { const f32x4 p = *(const f32x4*)(PS + ((size_t)b * SEQ + k) * 56 + 32); rctab[k] = rsqrtf(((p[0] + p[1]) + (p[2] + p[3])) * (1.0f / 128.0f) + EPS); }
#pragma unroll 1
        for (int it = 0; it < 4; ++it) {
            int lane = lane0; asm volatile("" : "+v"(lane));
            const int li = lane & 15, g = lane >> 4;
            const int chunk = (it & 1) ? 31 - (r & 15) : (r & 15), sub = 2 * (r >> 4) + (it >> 1);
            const int t0 = chunk * 64 + sub * 16, limit = (chunk + 1) * 64;
            const size_t trow0 = (size_t)b * SEQ + t0 + 2 * w;
            const DsaQ Q0 = dsa_load_q(QH, PS, trow0, lane), Q1 = dsa_load_q(QH, PS, trow0 + 1, lane);
            __syncthreads();
            if (limit > TOPK) {
                for (int srep = 0; srep < 1 + (DSA_REP & 1); ++srep) {
                bf16x8 af[8][2]; float wq[8][4];
                const size_t trowi = (size_t)b * SEQ + t0;
#pragma unroll
                for (int p = 0; p < 8; ++p) {
#pragma unroll
                    for (int sidx = 0; sidx < 2; ++sidx) af[p][sidx] = *(const bf16x8*)(QI + (trowi + 2 * p + (li >> 3)) * 512 + (li & 7) * 64 + 32 * sidx + 8 * g);
                    const size_t row = trowi + 2 * p + (g >> 1); const int hb = 4 * (g & 1);
                    const f32x4 wv = *(const f32x4*)(WI + row * 8 + hb); const float* ps = PS + row * 56 + 40 + (g & 1) * 8;
                    const f32x4 p0 = *(const f32x4*)ps, p1 = *(const f32x4*)(ps + 4);
                    wq[p][0] = wv[0] * rsqrtf((p0[0] + p0[1]) * (1.0f / 64.0f) + EPS); wq[p][1] = wv[1] * rsqrtf((p0[2] + p0[3]) * (1.0f / 64.0f) + EPS);
                    wq[p][2] = wv[2] * rsqrtf((p1[0] + p1[1]) * (1.0f / 64.0f) + EPS); wq[p][3] = wv[3] * rsqrtf((p1[2] + p1[3]) * (1.0f / 64.0f) + EPS);
                    asm volatile("" ::: "memory"); }
                const int nst = limit >> 4;
                const bf16_t* kp = KI + ((size_t)b * SEQ + 16 * w + li) * 64 + 8 * g; const float* pp = PS + ((size_t)b * SEQ + 16 * w + li) * 56 + 36;
                bf16x8 b0 = *(const bf16x8*)kp, b1 = *(const bf16x8*)(kp + 32); f32x2_t pk = *(const f32x2_t*)pp;
                bf16x8 d0 = b0, d1 = b1; f32x2_t pk2v = pk;
                if (w + 8 < nst) { kp += 8 * 16 * 64; pp += 8 * 16 * 56; d0 = *(const bf16x8*)kp; d1 = *(const bf16x8*)(kp + 32); pk2v = *(const f32x2_t*)pp; }
#pragma unroll 1
                for (int st = w; st < nst; st += 8) {
                    const bf16x8 c0 = b0, c1 = b1; const float rk = rsqrtf((pk[0] + pk[1]) * (1.0f / 64.0f) + EPS);
                    b0 = d0; b1 = d1; pk = pk2v;
                    if (st + 16 < nst) { kp += 8 * 16 * 64; pp += 8 * 16 * 56; d0 = *(const bf16x8*)kp; d1 = *(const bf16x8*)(kp + 32); pk2v = *(const f32x2_t*)pp; }
                    LAS float* so = (LAS float*)(lds + DSA_SC) + (g >> 1) * 2048 + 16 * st + li;
#pragma unroll
                    for (int p = 0; p < 8; ++p) {
                        f32x4 acc = (f32x4){0.f, 0.f, 0.f, 0.f};
                        acc = __builtin_amdgcn_mfma_f32_16x16x32_bf16(af[p][0], c0, acc, 0, 0, 0); acc = __builtin_amdgcn_mfma_f32_16x16x32_bf16(af[p][1], c1, acc, 0, 0, 0);
                        float part = (fmaxf(acc[0], 0.f) * wq[p][0] + fmaxf(acc[1], 0.f) * wq[p][1]) + (fmaxf(acc[2], 0.f) * wq[p][2] + fmaxf(acc[3], 0.f) * wq[p][3]);
                        {   const auto sw = __builtin_amdgcn_permlane16_swap(__float_as_uint(part), __float_as_uint(part), false, false);
                            part = __uint_as_float(sw[0]) + __uint_as_float(sw[1]); }
                        if ((g & 1) == 0) so[p * 4096] = part * rk + 0.0f;
                    }
                }
                __syncthreads();
                }
                for (int trep = 0; trep < 1 + ((DSA_REP >> 1) & 1); ++trep) {
                dsa_topk((const LAS float*)wl, il0, limit, lane);
                dsa_topk((const LAS float*)wl + 2048, il1, limit, lane); }
            } else {
                for (int j = lane; j < limit; j += 64) { il0[j] = (unsigned short)j; il1[j] = (unsigned short)j; }
            }
            const int count = limit < TOPK ? limit : TOPK;
            for (int arep = 0; arep < 1 + ((DSA_REP >> 2) & 1); ++arep) {
            dsa_attend(wl, il0, rctab, (LAS float*)(lds + DSA_KST + 8192 + w * 1024), Q0, Cb, AO, trow0, b, count, bound_l2, lane);
            dsa_attend(wl, il1, rctab, (LAS float*)(lds + DSA_KST + 8192 + w * 1024), Q1, Cb, AO, trow0 + 1, b, count, bound_l2, lane); }
        }
    }
    __syncthreads();
}

typedef const __attribute__((address_space(4))) Args* ArgsP;
__device__ __forceinline__ ArgsP fresh_args() { ArgsP p = (ArgsP)__builtin_amdgcn_kernarg_segment_ptr(); asm volatile("" : "+s"(p)); return p; }

__device__ __forceinline__ int fresh_bx() { int v = blockIdx.x; asm volatile("" : "+s"(v)); return v; }
__device__ __forceinline__ int fresh_gx() { int v = gridDim.x; asm volatile("" : "+s"(v)); return v; }
__global__ void __launch_bounds__(NWAVES * 64, 2) mega(Args args_unused) {
    extern __shared__ __attribute__((aligned(16))) unsigned char lds_raw[];
    LAS unsigned char* lds = (LAS unsigned char*)lds_raw;
    const int tid = threadIdx.x;
    for (int u = tid; u < (LDS_BYTES - LDSCTL_OFF) / 4; u += NWAVES * 64) ((LAS unsigned*)(lds + LDSCTL_OFF))[u] = 0u;
    __syncthreads();
    int lo, hi;
    {   ArgsP A = fresh_args(); lo = A->ph_lo; hi = A->ph_hi;
        if (hi - lo > 1) (void)xcd_barrier_post((unsigned*)(A->ws + WS_CTL) + CW_BAR + A->li * XCD_BAR_WORDS, (volatile LAS unsigned*)(lds + MISC_OFF) + 8); }
#ifndef PHMASK
#define PHMASK 0xffff
#endif
#define IN(k) (((PHMASK >> (k)) & 1) && lo <= (k) && (k) < hi)
#define SEAM(k) do { if (lo <= (k) && (k) + 1 < hi) { ArgsP A_ = fresh_args(); XcdBarrier b_; b_.bar = (unsigned*)(A_->ws + WS_CTL) + CW_BAR + A_->li * XCD_BAR_WORDS; b_.x = xb_xcc_id(); \
        b_.st = (volatile LAS unsigned*)(lds + MISC_OFF) + 8; xcd_barrier(b_); } } while (0)
#ifndef REPMASK
#define REPMASK 0
#endif
#define GBAR() do { ArgsP A_ = fresh_args(); XcdBarrier b_; b_.bar = (unsigned*)(A_->ws + WS_CTL) + CW_BAR + A_->li * XCD_BAR_WORDS; b_.x = xb_xcc_id(); \
        b_.st = (volatile LAS unsigned*)(lds + MISC_OFF) + 8; xcd_barrier(b_); } while (0)
#define REPEAT(k) for (int rep_ = 0; rep_ < 1 + ((REPMASK >> (k)) & 1); ++rep_)
#define REPBAR() do { if (rep_) GBAR(); } while (0)
#define GWS int t_ = threadIdx.x; asm volatile("" : "+v"(t_)); const int lane = t_ & 63, wave = __builtin_amdgcn_readfirstlane(t_ >> 6); const int G = fresh_gx(), bx = fresh_bx(); const int vcu = (G % 8 == 0) ? (bx % 8) * (G / 8) + bx / 8 : bx; \
        const int gw = vcu * NWAVES + wave, NGW = G * NWAVES; LAS float* scr = (LAS float*)(lds + wave * 16640); (void)lane; (void)gw; (void)NGW; (void)scr;
#define WCONV(Wp, K_, Nsrc_, N_, mode_, gain_, WT_) do { const int items_ = ((K_) / 64) * ((N_) / 64); \
        for (int it = gw; it < items_; it += NGW) p0_transpose_item((Wp), (K_), (Nsrc_), (N_), (mode_), (gain_), (WT_), scr, it, lane); } while (0)

    if (IN(PH_PRO)) REPEAT(PH_PRO) { REPBAR();
        GWS; ArgsP A = fresh_args(); unsigned char* ws = A->ws;
        constexpr int I0 = 16 * 28, I1 = I0 + 16 * 16, I2 = I1 + 16 * 96, I3 = I2 + 32 * 16, I4 = I3 + 16 * 88, I5 = I4 + 44 * 16, IX = I5 + M / 4;
        {   const float* x = A->in[0]; float* SS = (float*)(ws + WS_SS); bf16_t* XB = (bf16_t*)(ws + WS_XB);
#pragma unroll 1
            for (int it = gw; it < IX; it += NGW) {
                if (it < I0) p0_transpose_item(A->in[3], 1024, A_IN_COLS, A_IN_PAD, WM_AIN, A->in[1], (bf16_t*)(ws + WS_WAIN), scr, it, lane);
                else if (it < I1) p0_transpose_item(A->in[8], 1024, 1024, 1024, WM_NAT, (const float*)nullptr, (bf16_t*)(ws + WS_WAOUT), scr, it - I0, lane);
                else if (it < I2) p0_transpose_item(A->in[9], 1024, B_IN_COLS, B_IN_COLS, WM_NAT, A->in[1] + 1024, (bf16_t*)(ws + WS_WBIN), scr, it - I1, lane);
                else if (it < I3) p0_transpose_item(A->in[11], 2048, 1024, 1024, WM_NAT, A->in[10], (bf16_t*)(ws + WS_WBOUT), scr, it - I2, lane);
                else if (it < I4) p0_transpose_item(A->in[12], 1024, FF2, FF2, WM_FUP, A->in[2], (bf16_t*)(ws + WS_WFUP0), scr, it - I3, lane);
                else if (it < I5) p0_transpose_item(A->in[15], 2816, 1024, 1024, WM_NAT, (const float*)nullptr, (bf16_t*)(ws + WS_WFDN0), scr, it - I4, lane);
                else { const int row0 = (it - I5) * 4;
                    f32x4 v[4][4];
#pragma unroll
                    for (int r = 0; r < 4; ++r)
#pragma unroll
                        for (int q = 0; q < 4; ++q) v[r][q] = ((const f32x4*)(x + (size_t)(row0 + r) * DM))[q * 64 + lane];
#pragma unroll
                    for (int r = 0; r < 4; ++r)
#pragma unroll
                        for (int q = 0; q < 4; ++q) { const f32x4 w = v[r][q]; float sq = (w[0] * w[0] + w[1] * w[1]) + (w[2] * w[2] + w[3] * w[3]); sq = wave_sum(sq);
                            if (lane < 4) SS[(size_t)(row0 + r) * 16 + q * 4 + lane] = lane == 0 ? sq : 0.f;
                            u32x2 o; o.x = pk2(w[0], w[1]); o.y = pk2(w[2], w[3]); *(u32x2*)(XB + (size_t)(row0 + r) * DM + q * 256 + lane * 4) = o; } } } }
        {   float2* ROPE = (float2*)(ws + WS_ROPE);
            for (int e = gw * 64 + lane; e < 2048 * 128; e += NGW * 64) { const int t = e >> 7, i = e & 127;
                const float inv = exp2f(-(float)(2 * i) * (13.287712379549449f / 256.0f)), ang = (float)t * inv; float sn, cs; sincosf(ang, &sn, &cs); ROPE[e] = make_float2(cs, sn); } }
        {   float* CSC = (float*)(ws + WS_CSC); const float* a_q_g = A->in[4]; const float* a_k_g = A->in[5]; const float* a_iq_g = A->in[6]; const float* a_ik_g = A->in[7];
            for (int n = gw * 64 + lane; n < A_IN_PAD; n += NGW * 64) { float v;
                if (n < 1024) v = a_q_g[n & 127] * a_k_g[n & 127] * 0.08838834764831845f; else if (n < 1152) v = 1.0f; else if (n < 1216) v = a_ik_g[n - 1152];
                else if (n < 1224) v = 0.044194173824159216f; else if (n < 1280) v = 0.f; else v = a_iq_g[(n - 1280) & 63];
                CSC[n] = v; } }
    }
    SEAM(PH_PRO);
    if (IN(PH_A1)) REPEAT(PH_A1) { REPBAR();
        ArgsP A = fresh_args(); unsigned char* ws = A->ws;
        pg8::Gemm g{(const bf16_t*)(ws + WS_XB), (const bf16_t*)(ws + WS_WAIN), M, A_IN_PAD, 1024}; pg8::StaticOrder S; S.init(M, A_IN_PAD, fresh_gx(), fresh_bx());
        pg8::EpiA1 E{(const float*)(ws + WS_SS), (const float*)(ws + WS_CSC), (bf16_t*)(ws + WS_QH), (bf16_t*)(ws + WS_C), (bf16_t*)(ws + WS_KI), (bf16_t*)(ws + WS_QI), (float*)(ws + WS_WI), (float*)(ws + WS_PS)};
        pg8::gemm_phase(lds, g, S, E);
    }
    SEAM(PH_A1);
    if (IN(PH_A2)) REPEAT(PH_A2) { REPBAR();
        ArgsP A = fresh_args(); unsigned char* ws = A->ws; const int G = fresh_gx(), bx = fresh_bx(); const int vcu = (G % 8 == 0) ? (bx % 8) * (G / 8) + bx / 8 : bx;
#if defined(DSA_SLOW)
        dsa_slow_phase(lds, (const bf16_t*)(ws + WS_QH), (const bf16_t*)(ws + WS_C), (const float*)(ws + WS_PS), (const bf16_t*)(ws + WS_QI), (const bf16_t*)(ws + WS_KI), (const float*)(ws + WS_WI), (bf16_t*)(ws + WS_AO), vcu, G);
#else
        dsa_fast_phase(lds, (const bf16_t*)(ws + WS_QH), (const bf16_t*)(ws + WS_C), (const float*)(ws + WS_PS), (const bf16_t*)(ws + WS_QI), (const bf16_t*)(ws + WS_KI), (const float*)(ws + WS_WI), (const float*)(ws + WS_CSC), (bf16_t*)(ws + WS_AO), vcu, G);
#endif
    }
    SEAM(PH_A2);
    if (IN(PH_A3)) REPEAT(PH_A3) { REPBAR();
        ArgsP A = fresh_args(); unsigned char* ws = A->ws;
        pg8::Gemm g{(const bf16_t*)(ws + WS_AO), (const bf16_t*)(ws + WS_WAOUT), M, 1024, 1024}; pg8::StaticOrder S; S.init(M, 1024, fresh_gx(), fresh_bx());
        pg8::EpiRes<0> E{A->in[0], nullptr, (bf16_t*)(ws + WS_XB), (float*)(ws + WS_SS)};
        pg8::gemm_phase(lds, g, S, E);
    }
    SEAM(PH_A3);
#pragma unroll 1
    for (int layer = 0; layer < 2; ++layer) {
        const int ph1 = layer ? PH_F1B : PH_F1A, ph2 = layer ? PH_F2B : PH_F2A;
        if (layer == 1) {
            if (IN(PH_B1)) REPEAT(PH_B1) { REPBAR();
                ArgsP A = fresh_args(); unsigned char* ws = A->ws;
                pg8::Gemm g{(const bf16_t*)(ws + WS_XB), (const bf16_t*)(ws + WS_WBIN), M, 4096, 1024}; pg8::StaticOrder S; S.init(M, 4096, fresh_gx(), fresh_bx());
                pg8::EpiB1 E{(const float*)(ws + WS_SS), (const float2*)(ws + WS_ROPE), (bf16_t*)(ws + WS_QT), (bf16_t*)(ws + WS_KT), (bf16_t*)(ws + WS_VT)};
                pg8::gemm_phase(lds, g, S, E);
            }
            SEAM(PH_B1);
            if (IN(PH_B2)) REPEAT(PH_B2) { REPBAR();
                ArgsP A = fresh_args(); unsigned char* ws = A->ws;
#if defined(RET_SLOW)
                ret_slow_phase(lds, (const bf16_t*)(ws + WS_QT), (const bf16_t*)(ws + WS_KT), (const bf16_t*)(ws + WS_VT), (bf16_t*)(ws + WS_RET), (float*)(ws + WS_SSR), fresh_bx(), fresh_gx());
#else
                { const int G = fresh_gx(), bx = fresh_bx(); const int vcu = (G % 8 == 0) ? (bx % 8) * (G / 8) + bx / 8 : bx;
                  for (int u = vcu; u < 256; u += G) ret_fast_phase(lds, (const bf16_t*)(ws + WS_QT), (const bf16_t*)(ws + WS_KT), (const bf16_t*)(ws + WS_VT), (bf16_t*)(ws + WS_RET), (float*)(ws + WS_SSR), u); }
#endif
            }
            SEAM(PH_B2);
            if (IN(PH_GATE)) REPEAT(PH_GATE) { REPBAR();
                {   ArgsP A = fresh_args(); unsigned char* ws = A->ws;
                    pg8::Gemm g{(const bf16_t*)(ws + WS_XB), (const bf16_t*)(ws + WS_WBIN) + (size_t)4096 * 1024, M, 2048, 1024}; pg8::StaticOrder S; S.init(M, 2048, fresh_gx(), fresh_bx());
                    pg8::EpiGate E{(const float*)(ws + WS_SS), (const float*)(ws + WS_SSR), (bf16_t*)(ws + WS_RET)};
                    pg8::gemm_phase(lds, g, S, E); }
#if !defined(NO_WCONV2)
                {   GWS; ArgsP A = fresh_args(); unsigned char* ws = A->ws; constexpr int J0 = 16 * 88, J1 = J0 + 44 * 16;
#pragma unroll 1
                    for (int it = gw; it < J1; it += NGW) {
                        if (it < J0) p0_transpose_item(A->in[12] + (size_t)1024 * FF2, 1024, FF2, FF2, WM_FUP, A->in[2] + 1024, (bf16_t*)(ws + WS_WFUP1), scr, it, lane);
                        else p0_transpose_item(A->in[15] + (size_t)2816 * 1024, 2816, 1024, 1024, WM_NAT, (const float*)nullptr, (bf16_t*)(ws + WS_WFDN1), scr, it - J0, lane); } }
#endif
            }
            SEAM(PH_GATE);
            if (IN(PH_B3)) REPEAT(PH_B3) { REPBAR();
                ArgsP A = fresh_args(); unsigned char* ws = A->ws;
                pg8::Gemm g{(const bf16_t*)(ws + WS_RET), (const bf16_t*)(ws + WS_WBOUT), M, 1024, 2048}; pg8::StaticOrder S; S.init(M, 1024, fresh_gx(), fresh_bx());
                pg8::EpiRes<1> E{nullptr, nullptr, (bf16_t*)(ws + WS_XB), (float*)(ws + WS_SS)};
                pg8::gemm_phase(lds, g, S, E);
            }
            SEAM(PH_B3);
        }
        if (IN(ph1)) REPEAT(ph1) { REPBAR();
            ArgsP A = fresh_args(); unsigned char* ws = A->ws;
            pg8::Gemm g{(const bf16_t*)(ws + WS_XB), (const bf16_t*)(ws + (layer ? WS_WFUP1 : WS_WFUP0)), M, FF2, 1024}; pg8::StaticOrder S; S.init(M, FF2, fresh_gx(), fresh_bx());
            pg8::EpiF1 E{(const float*)(ws + WS_SS), A->in[13] + (size_t)layer * 3 * FF2, A->in[14] + (size_t)layer * FF2, (bf16_t*)(ws + (layer ? WS_H1 : WS_H0)),
                         (float*)(ws + (layer ? WS_PART1 : WS_PART0)), (float*)(ws + (layer ? WS_HALO1 : WS_HALO0))};
            pg8::gemm_phase(lds, g, S, E);
        }
        SEAM(ph1);
        if (IN(ph2)) {
            ArgsP A = fresh_args(); unsigned char* ws = A->ws; bf16_t* Hb = (bf16_t*)(ws + (layer ? WS_H1 : WS_H0));
            pg8::Gemm g{Hb, (const bf16_t*)(ws + (layer ? WS_WFDN1 : WS_WFDN0)), M, 1024, D_FF}; pg8::StaticOrder S; S.init(M, 1024, fresh_gx(), fresh_bx());
            {   pg8::Unit u0; if (S.next(0, u0)) ffn_fixup(u0.pm, A->in[13] + (size_t)layer * 3 * FF2, (const float*)(ws + (layer ? WS_PART1 : WS_PART0)), (const float*)(ws + (layer ? WS_HALO1 : WS_HALO0)), Hb);
                VM_WAIT(); __syncthreads(); }
            if (layer == 0) { pg8::EpiRes<1> E{nullptr, nullptr, (bf16_t*)(ws + WS_XB), (float*)(ws + WS_SS)}; pg8::gemm_phase(lds, g, S, E); }
            else { pg8::EpiRes<2> E{nullptr, A->out, (bf16_t*)(ws + WS_XB), nullptr}; pg8::gemm_phase(lds, g, S, E); }
        }
        SEAM(ph2);
    }
#undef IN
#undef SEAM
}

extern "C" void kernel_launch(void* const* d_in, const int* in_sizes, int n_in, void* d_out, int out_size, void* d_ws, size_t ws_size, hipStream_t stream) {
    static int grid = 0;
    constexpr int RET_LDS = 64 * 256 * 2 * 2 + 64 * 64 * 2 + 64 * 65 * 4 + 256 * 64 * 4;
    if (grid == 0) {
        int dev = 0, cus = 0, per_cu = 0;
        (void)hipGetDevice(&dev); (void)hipDeviceGetAttribute(&cus, hipDeviceAttributeMultiprocessorCount, dev);
        (void)hipFuncSetAttribute((const void*)mega, hipFuncAttributeMaxDynamicSharedMemorySize, LDS_BYTES);
        (void)hipFuncSetAttribute((const void*)k_ret_v0, hipFuncAttributeMaxDynamicSharedMemorySize, RET_LDS);
        if (hipOccupancyMaxActiveBlocksPerMultiprocessor(&per_cu, (const void*)mega, NWAVES * 64, LDS_BYTES) != hipSuccess || per_cu < 1)
            fprintf(stderr, "kernel_launch: occupancy query reports %d workgroups per CU\n", per_cu);
        (void)hipGetLastError();
        grid = cus > 0 ? cus : 256;
        if (grid != 256) fprintf(stderr, "kernel_launch: %d CUs (built for 256)\n", grid);
    }
    unsigned char* ws = (unsigned char*)d_ws;
    (void)hipMemsetAsync(ws + WS_CTL, 0, CTL_ZERO_BYTES, stream);
    Args a{};
    for (int i = 0; i < 16; ++i) a.in[i] = (const float*)d_in[i];
    a.out = (float*)d_out; a.ws = ws;
    auto launch = [&](int lo, int hi, int li) { a.ph_lo = lo; a.ph_hi = hi; a.li = li; hipLaunchKernelGGL(mega, dim3(grid), dim3(NWAVES * 64), LDS_BYTES, stream, a); };
#if MK_LAUNCH_MODE == 1
    launch(0, PH_END, 0);
#else
    launch(PH_PRO, PH_PRO + 1, 0);
    launch(PH_A1, PH_A1 + 1, 0);
    hipLaunchKernelGGL(k_dsa_v0, dim3(M), dim3(256), 0, stream, (const bf16_t*)(ws + WS_QH), (const bf16_t*)(ws + WS_C), (const float*)(ws + WS_PS), (const bf16_t*)(ws + WS_QI), (const bf16_t*)(ws + WS_KI), (const float*)(ws + WS_WI), (bf16_t*)(ws + WS_AO));
    launch(PH_A3, PH_A3 + 1, 0);
    launch(PH_F1A, PH_F1A + 1, 0);
    launch(PH_F2A, PH_F2A + 1, 0);
    launch(PH_B1, PH_B1 + 1, 0);
    hipLaunchKernelGGL(k_ret_v0, dim3(256), dim3(256), RET_LDS, stream, (const bf16_t*)(ws + WS_QT), (const bf16_t*)(ws + WS_KT), (const bf16_t*)(ws + WS_VT), (bf16_t*)(ws + WS_RET), (float*)(ws + WS_SSR));
    launch(PH_GATE, PH_GATE + 1, 0);
    launch(PH_B3, PH_B3 + 1, 0);
    launch(PH_F1B, PH_F1B + 1, 0);
    launch(PH_F2B, PH_F2B + 1, 0);
#endif
}
```

```cpp
#include <hip/hip_runtime.h>
#include <stdint.h>
#include <stdio.h>

typedef unsigned short bf16_t;
typedef short bf16x8 __attribute__((ext_vector_type(8)));
typedef float f32x4 __attribute__((ext_vector_type(4)));
typedef unsigned u32x4 __attribute__((ext_vector_type(4)));
typedef unsigned u32x2 __attribute__((ext_vector_type(2)));

#ifndef MK_LAUNCH_MODE
#define MK_LAUNCH_MODE 1
#endif

constexpr int BATCH = 8, SEQ = 2048, DM = 1024, M = BATCH * SEQ;
constexpr int TOPK = 256;
constexpr int A_IN_COLS = 1736, A_IN_PAD = 1792;
constexpr int O2 = 1152, O3 = 1664, O4 = 1728;
constexpr int B_IN_COLS = 6144;
constexpr int D_FF = 2816, FF2 = 5632;
constexpr float EPS = 1e-6f;

constexpr size_t MiB = 1u << 20;
constexpr size_t WS_CTL = 0, CTL_ZERO_BYTES = 65536;
constexpr size_t WS_SS = 1 * MiB;
constexpr size_t WS_WI = 2 * MiB;
constexpr size_t WS_CSC = 2 * MiB + 512 * 1024;
constexpr size_t WS_ROPE = 3 * MiB;
constexpr size_t WS_SSR = 249 * MiB;
constexpr size_t WS_WBIN = 8 * MiB;
constexpr size_t WS_WBOUT = 20 * MiB;
constexpr size_t WS_XB = 24 * MiB;
constexpr size_t WS_WAIN = 56 * MiB;
constexpr size_t WS_WAOUT = 60 * MiB;
constexpr size_t WS_QH = 64 * MiB;
constexpr size_t WS_AO = 96 * MiB;
constexpr size_t WS_QI = 128 * MiB;
constexpr size_t WS_C = 144 * MiB;
constexpr size_t WS_KI = 148 * MiB;
constexpr size_t WS_PS = 150 * MiB;
constexpr size_t WS_WFUP0 = 232 * MiB;
constexpr size_t WS_WFDN0 = 243 * MiB;
constexpr size_t WS_H0 = 64 * MiB;
constexpr size_t WS_PART0 = 152 * MiB;
constexpr size_t WS_HALO0 = 155 * MiB;
constexpr size_t WS_QT = 56 * MiB;
constexpr size_t WS_KT = 88 * MiB;
constexpr size_t WS_VT = 120 * MiB;
constexpr size_t WS_RET = 184 * MiB;
constexpr size_t WS_WFUP1 = 56 * MiB;
constexpr size_t WS_WFDN1 = 67 * MiB;
constexpr size_t WS_H1 = 88 * MiB;
constexpr size_t WS_PART1 = 176 * MiB;
constexpr size_t WS_HALO1 = 179 * MiB;

__device__ __forceinline__ unsigned short f2bf(float f) { unsigned u = __float_as_uint(f); return (unsigned short)((u + 0x7fffu + ((u >> 16) & 1u)) >> 16); }
__device__ __forceinline__ float bf2f(unsigned short h) { return __uint_as_float(((unsigned)h) << 16); }
__device__ __forceinline__ float bflo(unsigned w) { return __uint_as_float(w << 16); }
__device__ __forceinline__ float bfhi(unsigned w) { return __uint_as_float(w & 0xffff0000u); }
typedef __bf16 bf16x2_t __attribute__((ext_vector_type(2)));
typedef float f32x2_t __attribute__((ext_vector_type(2)));
__device__ __forceinline__ unsigned pk2(float lo, float hi) { const f32x2_t v = {lo, hi}; return __builtin_bit_cast(unsigned, __builtin_convertvector(v, bf16x2_t)); }
__device__ __forceinline__ float wave_sum(float v) {
#pragma unroll
    for (int o = 1; o < 64; o <<= 1) v += __shfl_xor(v, o);
    return v;
}
__device__ __forceinline__ float siluf(float x) { return x * __builtin_amdgcn_rcpf(1.0f + __builtin_amdgcn_exp2f(-1.4426950408889634f * x)); }
__device__ __forceinline__ float gamma_log(int h) { return h == 0 ? -0.031748698314580301f : h == 1 ? -0.015748356968139168f : h == 2 ? -0.0078431774610258787f : -0.0039138993211363287f; }

enum { WM_NAT = 0, WM_AIN = 1, WM_FUP = 2 };
__device__ __forceinline__ int wmap(int mode, int n) {
    if (mode == WM_NAT) return n;
    if (mode == WM_AIN) {
        if (n < 1152) return n;
        if (n < 1216) return O3 + (n - 1152);
        if (n < 1224) return O4 + (n - 1216);
        if (n < 1280) return -1;
        return O2 + (n - 1280);
    }
    const int p = n >> 8, bj = (n >> 7) & 1, i = n & 127;
    return bj * D_FF + 128 * p + i;
}

namespace pg8 {
#define PG8_LAS __attribute__((address_space(3)))
constexpr int BM = 256, BK = 64, HALF = 128, HTB = HALF * BK * 2, STAGE_BYTES = 8 * HTB, NXCD = 8, WGM = 8;
constexpr int XCH_OFF = 0, CWT_OFF = 2048, RT1_OFF = 6144, RT2_OFF = 14336;
__host__ __device__ __forceinline__ int lds_byte(int r, int c) { const int st = (r >> 4) * 2 + (c >> 5), rr = r & 15, cc = c & 31, ob = rr * 64 + cc * 2; return st * 1024 + (ob ^ (((ob >> 9) & 1) << 5)); }
__host__ __device__ __forceinline__ void stage_rc(int b, int& R, int& C) { const int st = b / 1024, sb = b % 1024, swz = sb ^ (((sb >> 9) & 1) << 5); R = (st >> 1) * 16 + swz / 64; C = (st & 1) * 32 + (swz % 64) / 2; }
__host__ __device__ __forceinline__ int perm32(int rho) { const int n = rho >> 4, i = rho & 15; return 8 * (i >> 2) + 4 * n + (i & 3); }
struct Unit { int pm, pn; };
struct Gemm { const bf16_t* A; const bf16_t* Bt; int M, N, K; };
struct StaticOrder {
    int nM, nN, nwg, G, c;
    __host__ __device__ __forceinline__ void init(int M_, int N_, int G_, int c_) { nM = M_ / BM; nN = N_ / BM; nwg = nM * nN; G = G_; c = c_; }
    __host__ __device__ __forceinline__ bool next(int i, Unit& u) const {
        const long L = (long)i * G + c; if (L >= nwg) return false;
        int wgid = (int)L; { const int q = nwg / NXCD, r = nwg % NXCD, xcd = wgid % NXCD, off = wgid / NXCD; wgid = (xcd < r ? xcd * (q + 1) : r * (q + 1) + (xcd - r) * q) + off; }
        const int nig = WGM * nN, gid = wgid / nig, fm = gid * WGM, gsz = (nM - fm) < WGM ? (nM - fm) : WGM;
        u.pm = fm + ((wgid % nig) % gsz); u.pn = (wgid % nig) / gsz; return true;
    }
};
__device__ __forceinline__ float rstd16(const float* ss16, int row) {
    float s = 0.f;
#pragma unroll
    for (int g = 0; g < 16; ++g) s += ss16[(size_t)g * M + row];
    return rsqrtf(s * (1.0f / DM) + EPS);
}
__device__ __forceinline__ float sel4(const float (&s)[4], int fq) { return fq == 0 ? s[0] : fq == 1 ? s[1] : fq == 2 ? s[2] : s[3]; }
__device__ __forceinline__ float ssq8(const f32x4 a, const f32x4 b) { return ((a[0] * a[0] + a[1] * a[1]) + (a[2] * a[2] + a[3] * a[3])) + ((b[0] * b[0] + b[1] * b[1]) + (b[2] * b[2] + b[3] * b[3])); }
__device__ __forceinline__ u32x4 pack8(const f32x4 a, const f32x4 b) { u32x4 w; w.x = pk2(a[0], a[1]); w.y = pk2(a[2], a[3]); w.z = pk2(b[0], b[1]); w.w = pk2(b[2], b[3]); return w; }

template <int MODE>
struct EpiRes {
    static constexpr bool AROWPERM = false;
    const float* basef; float* out; bf16_t* xb; float* ss16;
    static constexpr int NTAB = 0;
    __device__ __forceinline__ void fill(PG8_LAS unsigned char*, int, const Unit&, int) const {}
    __device__ __forceinline__ void operator()(f32x4 (&acc)[2][2][4][2], const Unit& u, int ui, int wr, int wc, int fr, int fq, PG8_LAS unsigned char*) const {
        const int row0 = u.pm * BM + wr * 64 + fr, colb = u.pn * BM + wc * 32 + 8 * fq;
#pragma unroll
        for (int ai = 0; ai < 2; ++ai) {
            f32x4 bv[4][2][2];
#pragma unroll
            for (int m = 0; m < 4; ++m)
#pragma unroll
                for (int bj = 0; bj < 2; ++bj) { const size_t o = (size_t)(row0 + ai * HALF + m * 16) * DM + colb + bj * HALF;
                    if (MODE == 0) { bv[m][bj][0] = *(const f32x4*)(basef + o); bv[m][bj][1] = *(const f32x4*)(basef + o + 4); }
                    else { const u32x4 w = *(const u32x4*)(xb + o); bv[m][bj][0] = (f32x4){bflo(w.x), bfhi(w.x), bflo(w.y), bfhi(w.y)}; bv[m][bj][1] = (f32x4){bflo(w.z), bfhi(w.z), bflo(w.w), bfhi(w.w)}; } }
            float sm[4];
#pragma unroll
            for (int m = 0; m < 4; ++m) { const int row = row0 + ai * HALF + m * 16; float s = 0.f;
#pragma unroll
                for (int bj = 0; bj < 2; ++bj) { const size_t o = (size_t)row * DM + colb + bj * HALF;
                    const f32x4 v0 = acc[ai][bj][m][0] + bv[m][bj][0], v1 = acc[ai][bj][m][1] + bv[m][bj][1];
                    if (MODE == 2) { *(f32x4*)(out + o) = v0; *(f32x4*)(out + o + 4) = v1; }
                    else { s += ssq8(v0, v1); *(u32x4*)(xb + o) = pack8(v0, v1); } }
                if (MODE != 2) { s += __shfl_xor(s, 16); s += __shfl_xor(s, 32); }
                sm[m] = s; }
            if (MODE != 2) ss16[(size_t)(u.pn * 4 + wc) * M + u.pm * BM + ai * HALF + wr * 64 + 16 * fq + fr] = sel4(sm, fq);
            asm volatile("" ::: "memory"); }
    }
};
struct EpiA1 {
    static constexpr bool AROWPERM = false;
    const float* ss16; const float* csc; bf16_t* Q; bf16_t* C; bf16_t* KI; bf16_t* QI; float* WI; float* PS;
    static constexpr int NTAB = 1;
    __device__ __forceinline__ void fill(PG8_LAS unsigned char* xl, int i, const Unit& u, int t) const { ((PG8_LAS float*)(xl + RT1_OFF))[i * 256 + t] = rstd16(ss16, u.pm * BM + t); }
    __device__ __forceinline__ void operator()(f32x4 (&acc)[2][2][4][2], const Unit& u, int ui, int wr, int wc, int fr, int fq, PG8_LAS unsigned char* xl) const {
        const int row0 = u.pm * BM + wr * 64 + fr, pn = u.pn;
        const PG8_LAS float* rt = (const PG8_LAS float*)(xl + RT1_OFF) + ui * 256 + wr * 64 + fr;
        float rs[2][4];
#pragma unroll
        for (int ai = 0; ai < 2; ++ai)
#pragma unroll
            for (int m = 0; m < 4; ++m) rs[ai][m] = rt[ai * HALF + m * 16];
#pragma unroll
        for (int bj = 0; bj < 2; ++bj) {
            const int cl = bj * HALF + wc * 32 + 8 * fq, gcol = pn * BM + cl;
            const f32x4 c0 = *(const f32x4*)(csc + gcol), c1 = *(const f32x4*)(csc + gcol + 4);
            bf16_t* dst; int ld; bool st16 = true, stwi = false;
            if (pn < 4) { dst = Q + gcol; ld = 1024; }
            else if (pn == 4) { if (bj == 0) { dst = C + cl; ld = 128; } else if (wc < 2) { dst = KI + (wc * 32 + 8 * fq); ld = 64; } else { dst = Q; ld = 0; st16 = false; stwi = (wc == 2) && (fq == 0); } }
            else { dst = QI + (pn - 5) * 256 + cl; ld = 512; }
#pragma unroll
            for (int ai = 0; ai < 2; ++ai) { float sm[4];
#pragma unroll
                for (int m = 0; m < 4; ++m) { const int row = row0 + ai * HALF + m * 16; const float r = rs[ai][m];
                    const f32x4 v0 = acc[ai][bj][m][0] * r, v1 = acc[ai][bj][m][1] * r;
                    float s = ssq8(v0, v1); s += __shfl_xor(s, 16); s += __shfl_xor(s, 32); sm[m] = s;
                    const f32x4 o0 = v0 * c0, o1 = v1 * c1;
                    if (st16) *(u32x4*)(dst + (size_t)row * ld) = pack8(o0, o1);
                    if (stwi) { *(f32x4*)(WI + (size_t)row * 8) = o0; *(f32x4*)(WI + (size_t)row * 8 + 4) = o1; }
                    if (m & 1) asm volatile("" ::: "memory"); }
                PS[(size_t)(pn * 8 + bj * 4 + wc) * M + u.pm * BM + ai * HALF + wr * 64 + 16 * fq + fr] = sel4(sm, fq); }
        }
    }
};
struct EpiF1 {
    static constexpr bool AROWPERM = true;
    static constexpr int NTAB = 1;
    const float* ss16; const float* cw; const float* cb; bf16_t* H; float* PART; float* HALO;
    __device__ __forceinline__ void fill(PG8_LAS unsigned char* xl, int i, const Unit& u, int t) const { ((PG8_LAS float*)(xl + RT1_OFF))[i * 256 + t] = rstd16(ss16, u.pm * BM + t); }
    __device__ __forceinline__ void operator()(f32x4 (&acc)[2][2][4][2], const Unit& u, int ui, int wr, int wc, int fr, int fq, PG8_LAS unsigned char* xl) const {
        const int trow0 = 8 * (16 * wr + fr), grow0 = u.pm * BM + trow0, hcol = 128 * u.pn + 32 * wc + 8 * fq, tcol = 32 * wc + 8 * fq;
        const PG8_LAS float* rt = (const PG8_LAS float*)(xl + RT1_OFF) + ui * 256 + trow0;
        {   const f32x4 r0 = *(const PG8_LAS f32x4*)rt, r1 = *(const PG8_LAS f32x4*)(rt + 4);
#pragma unroll
            for (int m = 0; m < 4; ++m)
#pragma unroll
                for (int bj = 0; bj < 2; ++bj) { acc[0][bj][m][0] *= r0[m]; acc[0][bj][m][1] *= r0[m]; acc[1][bj][m][0] *= r1[m]; acc[1][bj][m][1] *= r1[m]; } }
        {   PG8_LAS float* cwt = (PG8_LAS float*)(xl + CWT_OFF); const int tid = ((wr * 4 + wc) * 4 + fq) * 16 + fr;
#pragma unroll
            for (int r = 0; r < 2; ++r) { const int idx = tid + r * 512, k = idx >> 8, c = idx & 255, orig = (c < 128) ? 128 * u.pn + c : D_FF + 128 * u.pn + (c - 128);
                cwt[idx] = (k < 3) ? cw[(size_t)k * FF2 + orig] : cb[orig]; } }
        PG8_LAS f32x4* X = (PG8_LAS f32x4*)(xl + XCH_OFF) + (wc * 4 + fq) * 8;
        if (wr == 0 && fr == 15) {
#pragma unroll
            for (int bj = 0; bj < 2; ++bj)
#pragma unroll
                for (int e = 0; e < 2; ++e)
#pragma unroll
                    for (int n = 0; n < 2; ++n) X[(bj * 2 + e) * 2 + n] = acc[1][bj][2 + e][n];
        }
        asm volatile("s_waitcnt vmcnt(0) lgkmcnt(0)" ::: "memory"); __builtin_amdgcn_s_barrier(); asm volatile("" ::: "memory");
        const bool need_fix = (wr == 0) && (fr == 0) && ((u.pm & 7) != 0);
        const bool give_halo = (wr == 1) && (fr == 15);
        const bool take_x = (wr == 1) && (fr == 0);
        float* part = PART + (size_t)u.pm * (2 * 2 * D_FF) + hcol;
        float* halo = HALO + (size_t)u.pm * (2 * 2 * D_FF) + hcol;
        const PG8_LAS float* cwt = (const PG8_LAS float*)(xl + CWT_OFF) + tcol;
#pragma unroll
        for (int n = 0; n < 2; ++n) {
            f32x4 pa[2], pb[2];
#pragma unroll
            for (int e = 0; e < 2; ++e) {
                f32x4 ha = (f32x4){0.f, 0.f, 0.f, 0.f}, hb = (f32x4){0.f, 0.f, 0.f, 0.f};
                if (take_x) { ha = X[(0 * 2 + e) * 2 + n]; hb = X[(1 * 2 + e) * 2 + n]; }
#pragma unroll
                for (int j = 0; j < 4; ++j) {
                    pa[e][j] = __int_as_float(__builtin_amdgcn_update_dpp(__float_as_int(ha[j]), __float_as_int(acc[1][0][2 + e][n][j]), 0x111, 0xf, 0xf, false));
                    pb[e][j] = __int_as_float(__builtin_amdgcn_update_dpp(__float_as_int(hb[j]), __float_as_int(acc[1][1][2 + e][n][j]), 0x111, 0xf, 0xf, false)); } }
            const f32x4 wa0 = *(const PG8_LAS f32x4*)(cwt + 4 * n), wa1 = *(const PG8_LAS f32x4*)(cwt + 256 + 4 * n), wa2 = *(const PG8_LAS f32x4*)(cwt + 512 + 4 * n), ba = *(const PG8_LAS f32x4*)(cwt + 768 + 4 * n);
            const f32x4 wb0 = *(const PG8_LAS f32x4*)(cwt + 128 + 4 * n), wb1 = *(const PG8_LAS f32x4*)(cwt + 384 + 4 * n), wb2 = *(const PG8_LAS f32x4*)(cwt + 640 + 4 * n), bb = *(const PG8_LAS f32x4*)(cwt + 896 + 4 * n);
            if (give_halo) {
                *(f32x4*)(halo + 4 * n) = acc[1][0][2][n]; *(f32x4*)(halo + D_FF + 4 * n) = acc[1][1][2][n];
                *(f32x4*)(halo + 2 * D_FF + 4 * n) = acc[1][0][3][n]; *(f32x4*)(halo + 3 * D_FF + 4 * n) = acc[1][1][3][n]; }
#pragma unroll
            for (int e = 0; e < 8; ++e) {
                const f32x4 ua = acc[e >> 2][0][e & 3][n], ub = acc[e >> 2][1][e & 3][n];
                const f32x4 ua1 = e >= 1 ? acc[(e - 1) >> 2][0][(e - 1) & 3][n] : pa[1], ub1 = e >= 1 ? acc[(e - 1) >> 2][1][(e - 1) & 3][n] : pb[1];
                const f32x4 ua2 = e >= 2 ? acc[(e - 2) >> 2][0][(e - 2) & 3][n] : pa[e], ub2 = e >= 2 ? acc[(e - 2) >> 2][1][(e - 2) & 3][n] : pb[e];
                const f32x4 av = ba + wa2 * ua + wa1 * ua1 + wa0 * ua2, bv = bb + wb2 * ub + wb1 * ub1 + wb0 * ub2;
                if (e < 2 && need_fix) { *(f32x4*)(part + (size_t)e * 2 * D_FF + 4 * n) = av; *(f32x4*)(part + (size_t)e * 2 * D_FF + D_FF + 4 * n) = bv; }
                u32x2 w; w.x = pk2(siluf(av[0]) * bv[0], siluf(av[1]) * bv[1]); w.y = pk2(siluf(av[2]) * bv[2], siluf(av[3]) * bv[3]);
                *(u32x2*)(H + (size_t)(grow0 + e) * D_FF + hcol + 4 * n) = w;
            }
            asm volatile("" ::: "memory");
        }
    }
};
struct EpiB1 {
    static constexpr bool AROWPERM = true;
    static constexpr int NTAB = 1;
    const float* ss16; const float2* rope; bf16_t* QT; bf16_t* KT; bf16_t* VT;
    __device__ __forceinline__ void fill(PG8_LAS unsigned char* xl, int i, const Unit& u, int t) const { ((PG8_LAS float*)(xl + RT1_OFF))[i * 256 + t] = rstd16(ss16, u.pm * BM + t); }
    __device__ __forceinline__ void operator()(f32x4 (&acc)[2][2][4][2], const Unit& u, int ui, int wr, int wc, int fr, int fq, PG8_LAS unsigned char* xl) const {
        const int trow0 = 8 * (16 * wr + fr), grow0 = u.pm * BM + trow0, pn = u.pn, t0 = grow0 & (SEQ - 1);
        const PG8_LAS float* rt = (const PG8_LAS float*)(xl + RT1_OFF) + ui * 256 + trow0;
        const f32x4 r0 = *(const PG8_LAS f32x4*)rt, r1 = *(const PG8_LAS f32x4*)(rt + 4);
        if (pn < 8) {
            const int h = pn & 3; const bool isk = pn >= 4; const float lg = gamma_log(h);
            bf16_t* dst = (isk ? KT : QT) + (size_t)grow0 * 1024 + h * 256 + 32 * wc + 8 * fq;
            const int i0 = 32 * wc + 8 * fq;
#pragma unroll
            for (int eh = 0; eh < 2; ++eh) {
                f32x4 rc[4][4];
#pragma unroll
                for (int e4 = 0; e4 < 4; ++e4) { const f32x4* rp = (const f32x4*)(rope + (size_t)(t0 + 4 * eh + e4) * 128 + i0);
#pragma unroll
                    for (int q = 0; q < 4; ++q) rc[e4][q] = rp[q]; }
#pragma unroll
                for (int e4 = 0; e4 < 4; ++e4) { const int e = 4 * eh + e4;
                    const int t = t0 + e, pos = t & 63;
                    const float dsc = isk ? 0.0625f * __expf(-(float)(pos + 1) * lg) : __expf((float)(pos + 1) * lg);
                    const float sc = (eh == 0 ? r0[e4] : r1[e4]) * dsc;
                    f32x4 o1[2], o2[2];
#pragma unroll
                    for (int n = 0; n < 2; ++n) { const f32x4 c0 = rc[e4][2 * n], c1 = rc[e4][2 * n + 1];
                        const f32x4 x1 = acc[eh][0][e4][n] * sc, x2 = acc[eh][1][e4][n] * sc;
                        o1[n][0] = x1[0] * c0[0] - x2[0] * c0[1]; o2[n][0] = x1[0] * c0[1] + x2[0] * c0[0];
                        o1[n][1] = x1[1] * c0[2] - x2[1] * c0[3]; o2[n][1] = x1[1] * c0[3] + x2[1] * c0[2];
                        o1[n][2] = x1[2] * c1[0] - x2[2] * c1[1]; o2[n][2] = x1[2] * c1[1] + x2[2] * c1[0];
                        o1[n][3] = x1[3] * c1[2] - x2[3] * c1[3]; o2[n][3] = x1[3] * c1[3] + x2[3] * c1[2]; }
                    *(u32x4*)(dst + (size_t)e * 1024) = pack8(o1[0], o1[1]); *(u32x4*)(dst + (size_t)e * 1024 + 128) = pack8(o2[0], o2[1]); }
                asm volatile("" ::: "memory");
            }
        } else {
            const int b = grow0 / SEQ;
            bf16_t* dst = VT + ((size_t)b * 2048 + (pn - 8) * 256 + 32 * wc + 8 * fq) * SEQ + t0;
#pragma unroll
            for (int bj = 0; bj < 2; ++bj)
#pragma unroll
                for (int n = 0; n < 2; ++n)
#pragma unroll
                    for (int j = 0; j < 4; ++j) { u32x4 w;
                        w.x = pk2(acc[0][bj][0][n][j] * r0[0], acc[0][bj][1][n][j] * r0[1]); w.y = pk2(acc[0][bj][2][n][j] * r0[2], acc[0][bj][3][n][j] * r0[3]);
                        w.z = pk2(acc[1][bj][0][n][j] * r1[0], acc[1][bj][1][n][j] * r1[1]); w.w = pk2(acc[1][bj][2][n][j] * r1[2], acc[1][bj][3][n][j] * r1[3]);
                        *(u32x4*)(dst + (size_t)(128 * bj + 4 * n + j) * SEQ) = w; }
        }
    }
};
struct EpiGate {
    static constexpr bool AROWPERM = false;
    static constexpr int NTAB = 1;
    const float* ss16; const float* ssr; bf16_t* RET;
    __device__ __forceinline__ void fill(PG8_LAS unsigned char* xl, int i, const Unit& u, int t) const {
        const int row = u.pm * BM + t;
        ((PG8_LAS float*)(xl + RT1_OFF))[i * 256 + t] = rstd16(ss16, row);
        const f32x4* sp = (const f32x4*)(ssr + ((size_t)row * 4 + (u.pn >> 1)) * 16); const f32x4 s0 = sp[0], s1 = sp[1], s2 = sp[2], s3 = sp[3];
        ((PG8_LAS float*)(xl + RT2_OFF))[i * 256 + t] = rsqrtf(((((s0[0] + s0[1]) + (s0[2] + s0[3])) + ((s1[0] + s1[1]) + (s1[2] + s1[3]))) + (((s2[0] + s2[1]) + (s2[2] + s2[3])) + ((s3[0] + s3[1]) + (s3[2] + s3[3])))) * (1.0f / 512.0f) + EPS);
    }
    __device__ __forceinline__ void operator()(f32x4 (&acc)[2][2][4][2], const Unit& u, int ui, int wr, int wc, int fr, int fq, PG8_LAS unsigned char* xl) const {
        const int row0 = u.pm * BM + wr * 64 + fr, colb = u.pn * BM + wc * 32 + 8 * fq;
        const PG8_LAS float* rt = (const PG8_LAS float*)(xl + RT1_OFF) + ui * 256 + wr * 64 + fr;
        const PG8_LAS float* rt2 = (const PG8_LAS float*)(xl + RT2_OFF) + ui * 256 + wr * 64 + fr;
        u32x4 rvv[2][4][2];
#pragma unroll
        for (int ai = 0; ai < 2; ++ai)
#pragma unroll
            for (int m = 0; m < 4; ++m)
#pragma unroll
                for (int bj = 0; bj < 2; ++bj) rvv[ai][m][bj] = *(const u32x4*)(RET + (size_t)(row0 + ai * HALF + m * 16) * 2048 + colb + bj * HALF);
#pragma unroll
        for (int ai = 0; ai < 2; ++ai)
#pragma unroll
            for (int m = 0; m < 4; ++m) { const int row = row0 + ai * HALF + m * 16; const float r = rt[ai * HALF + m * 16], rh = rt2[ai * HALF + m * 16];
#pragma unroll
                for (int bj = 0; bj < 2; ++bj) { bf16_t* p = RET + (size_t)row * 2048 + colb + bj * HALF; const u32x4 rv = rvv[ai][m][bj];
                    const f32x4 g0 = acc[ai][bj][m][0] * r, g1 = acc[ai][bj][m][1] * r; f32x4 y0, y1;
                    y0[0] = bflo(rv.x) * rh * siluf(g0[0]); y0[1] = bfhi(rv.x) * rh * siluf(g0[1]); y0[2] = bflo(rv.y) * rh * siluf(g0[2]); y0[3] = bfhi(rv.y) * rh * siluf(g0[3]);
                    y1[0] = bflo(rv.z) * rh * siluf(g1[0]); y1[1] = bfhi(rv.z) * rh * siluf(g1[1]); y1[2] = bflo(rv.w) * rh * siluf(g1[2]); y1[3] = bfhi(rv.w) * rh * siluf(g1[3]);
                    *(u32x4*)p = pack8(y0, y1); } }
    }
};

template <class Epi, class Sched>
__device__ __forceinline__ void gemm_phase(PG8_LAS unsigned char* lds, const Gemm g, const Sched& S, const Epi& E) {
    int tid_ = threadIdx.x; asm volatile("" : "+v"(tid_));
    const int tid = tid_, wid = __builtin_amdgcn_readfirstlane(tid >> 6), lane = tid & 63, wr = wid >> 2, wc = wid & 3, fr = lane & 15, fq = lane >> 4;
    const int K = g.K, nt = K / BK;
    unsigned voffA0[2], voffA1[2], voffB[2];
#pragma unroll
    for (int i = 0; i < 2; ++i) { int R, C; stage_rc(tid * 16 + i * 8192, R, C); const int Rb = (R & ~31) + perm32(R & 31);
        int ra0, ra1;
        if (Epi::AROWPERM) { const int base = ((R >> 6) * 16 + (R & 15)) * 8 + ((R >> 4) & 3); ra0 = base; ra1 = base + 4; } else { ra0 = R; ra1 = R + HALF; }
        voffA0[i] = (unsigned)(ra0 * K + C) * 2u; voffA1[i] = (unsigned)(ra1 * K + C) * 2u; voffB[i] = (unsigned)(Rb * K + C) * 2u; }
    const size_t kstep = (size_t)(BK * 2);
    const size_t hstep = (size_t)HALF * K * 2;
    const size_t tstep = 2 * hstep;
    const unsigned ldsw = (unsigned)wid * 1024u;
    const int aoff = lds_byte(wr * 64 + fr, fq * 8), boff = lds_byte(wc * 32 + fr, fq * 8);
#define PG8_SA(b, h) (((b) * 2 + (h)) * HTB)
#define PG8_SB(b, h) ((4 + (b) * 2 + (h)) * HTB)
#define PG8_STAGE(bufoff, gbase, voff) do { _Pragma("unroll") for (int _i = 0; _i < 2; ++_i) \
        __builtin_amdgcn_global_load_lds((const unsigned*)((const char*)(gbase) + (voff)[_i]), (PG8_LAS unsigned*)(lds + (bufoff) + ldsw + _i * 8192), 16, 0, 0); } while (0)
#define PG8_LDA(dst, b, h) do { _Pragma("unroll") for (int m = 0; m < 4; ++m) _Pragma("unroll") for (int k = 0; k < 2; ++k) dst[m][k] = *(const PG8_LAS bf16x8*)(lds + PG8_SA(b, h) + aoff + m * 2048 + k * 1024); } while (0)
#define PG8_LDB(dst, b, h) do { _Pragma("unroll") for (int n = 0; n < 2; ++n) _Pragma("unroll") for (int k = 0; k < 2; ++k) dst[n][k] = *(const PG8_LAS bf16x8*)(lds + PG8_SB(b, h) + boff + n * 2048 + k * 1024); } while (0)
#define PG8_MMA(ai, bj, At, Bt) do { __builtin_amdgcn_s_setprio(1); _Pragma("unroll") for (int m = 0; m < 4; ++m) _Pragma("unroll") for (int n = 0; n < 2; ++n) _Pragma("unroll") for (int k = 0; k < 2; ++k) \
        acc[ai][bj][m][n] = __builtin_amdgcn_mfma_f32_16x16x32_bf16(Bt[n][k], At[m][k], acc[ai][bj][m][n], 0, 0, 0); __builtin_amdgcn_s_setprio(0); } while (0)
#define PG8_WAIT_V(n) asm volatile("s_waitcnt vmcnt(" #n ")" ::: "memory")
#define PG8_WAIT_L(n) asm volatile("s_waitcnt lgkmcnt(" #n ")" ::: "memory")
#define PG8_BAR __builtin_amdgcn_s_barrier()
#define PG8_SCHED __builtin_amdgcn_sched_barrier(0)
    Unit cur, nxt; int ui = 0;
    if (!S.next(0, cur)) return;
    f32x4 acc[2][2][4][2];
#pragma unroll
    for (int a = 0; a < 2; ++a)
#pragma unroll
        for (int b = 0; b < 2; ++b)
#pragma unroll
            for (int m = 0; m < 4; ++m)
#pragma unroll
                for (int n = 0; n < 2; ++n) acc[a][b][m][n] = (f32x4){0.f, 0.f, 0.f, 0.f};
    bf16x8 At[4][2], B0[2][2], B1[2][2];
    const char* cA = (const char*)g.A + (size_t)cur.pm * tstep; const char* cB = (const char*)g.Bt + (size_t)cur.pn * tstep;
    PG8_STAGE(PG8_SB(0, 0), cB, voffB); PG8_STAGE(PG8_SB(0, 1), cB + hstep, voffB); PG8_STAGE(PG8_SA(0, 0), cA, voffA0); PG8_STAGE(PG8_SA(0, 1), cA, voffA1);
    if constexpr (Epi::NTAB > 0) {
#pragma unroll 1
        for (int i = tid >> 8; i < 8; i += 2) { Unit uu; if (!S.next(i, uu)) break; E.fill(lds + STAGE_BYTES, i, uu, tid & 255); asm volatile("" ::: "memory"); }
        asm volatile("s_waitcnt lgkmcnt(0)" ::: "memory");
    }
    if (wr == 1) PG8_BAR;
    PG8_WAIT_V(2); PG8_BAR;
    PG8_STAGE(PG8_SB(1, 0), cB + kstep, voffB); PG8_STAGE(PG8_SA(1, 0), cA + kstep, voffA0); PG8_STAGE(PG8_SB(1, 1), cB + hstep + kstep, voffB);
    PG8_WAIT_V(6); PG8_BAR;
    for (;;) {
        const bool has_next = S.next(ui + 1, nxt);
        const char* nA = has_next ? (const char*)g.A + (size_t)nxt.pm * tstep : cA; const char* nB = has_next ? (const char*)g.Bt + (size_t)nxt.pn * tstep : cB;
        for (int t = 0; t < nt; t += 2) {
            const bool last = (t == nt - 2);
            const char* a1 = cA + (size_t)(t + 1) * kstep;
            const char* a2 = last ? nA : cA + (size_t)(t + 2) * kstep; const char* b2 = last ? nB : cB + (size_t)(t + 2) * kstep;
            const char* a3 = a2 + kstep; const char* b3 = b2 + kstep;
            PG8_LDB(B0, 0, 0); PG8_LDB(B1, 0, 1); PG8_SCHED; PG8_LDA(At, 0, 0); PG8_STAGE(PG8_SA(1, 1), a1, voffA1);
            PG8_WAIT_V(8); PG8_WAIT_L(0); PG8_BAR; PG8_MMA(0, 0, At, B0); PG8_MMA(0, 1, At, B1); PG8_BAR; PG8_SCHED;
            PG8_LDA(At, 0, 1); PG8_STAGE(PG8_SB(0, 0), b2, voffB); PG8_STAGE(PG8_SB(0, 1), b2 + hstep, voffB); PG8_STAGE(PG8_SA(0, 0), a2, voffA0);
            PG8_WAIT_V(8); PG8_WAIT_L(0); PG8_BAR; PG8_MMA(1, 0, At, B0); PG8_MMA(1, 1, At, B1); PG8_BAR; PG8_SCHED;
            PG8_LDB(B0, 1, 0); PG8_LDB(B1, 1, 1); PG8_SCHED; PG8_LDA(At, 1, 0); PG8_STAGE(PG8_SA(0, 1), a2, voffA1);
            PG8_WAIT_V(8); PG8_WAIT_L(0); PG8_BAR; PG8_MMA(0, 0, At, B0); PG8_MMA(0, 1, At, B1); PG8_BAR; PG8_SCHED;
            PG8_LDA(At, 1, 1); PG8_STAGE(PG8_SB(1, 0), b3, voffB); PG8_STAGE(PG8_SB(1, 1), b3 + hstep, voffB); PG8_STAGE(PG8_SA(1, 0), a3, voffA0);
            PG8_WAIT_V(8); PG8_WAIT_L(0); PG8_BAR; PG8_MMA(1, 0, At, B0); PG8_MMA(1, 1, At, B1); PG8_BAR; PG8_SCHED;
        }
        if (wr == 0) PG8_BAR;
        E(acc, cur, ui, wr, wc, fr, fq, lds + STAGE_BYTES);
        if (!has_next) break;
#pragma unroll
        for (int a = 0; a < 2; ++a)
#pragma unroll
            for (int b = 0; b < 2; ++b)
#pragma unroll
                for (int m = 0; m < 4; ++m)
#pragma unroll
                    for (int n = 0; n < 2; ++n) acc[a][b][m][n] = (f32x4){0.f, 0.f, 0.f, 0.f};
        cur = nxt; cA = nA; cB = nB; ++ui;
        if (wr == 1) PG8_BAR;
    }
    PG8_WAIT_V(0);
    PG8_BAR;
#undef PG8_SA
#undef PG8_SB
#undef PG8_STAGE
#undef PG8_LDA
#undef PG8_LDB
#undef PG8_MMA
#undef PG8_WAIT_V
#undef PG8_WAIT_L
#undef PG8_BAR
#undef PG8_SCHED
}
}

constexpr int NWAVES = 8;
constexpr int RING_BYTES = 131072, LDS_BYTES = 163840, LDSCTL_OFF = LDS_BYTES - 512, MISC_OFF = LDSCTL_OFF + 320;
#define GAS __attribute__((address_space(1)))
#define LAS __attribute__((address_space(3)))
typedef GAS unsigned gu32;
#define RLX_AGENT __ATOMIC_RELAXED, __HIP_MEMORY_SCOPE_AGENT
#define LDS_WAIT() asm volatile("s_waitcnt lgkmcnt(0)" ::: "memory")
#define VM_WAIT() asm volatile("s_waitcnt vmcnt(0)" ::: "memory")
constexpr int CW_BAR = 4096;
#define XB_TMO      128
#define XB_XCNT(j)  (256  + 64 * (j))
#define XB_XSUB(j)  (1280 + 64 * (j))
#define XB_XGEN(j)  (2304 + 64 * (j))
#define XB_TOP      3328
#define XB_TOPGEN   3392
#define XCD_BAR_WORDS 3456
#define XB_SPIN_CAP (1u << 18)
__device__ __forceinline__ unsigned xb_ld(unsigned* p)              { return __hip_atomic_load(p, __ATOMIC_RELAXED, __HIP_MEMORY_SCOPE_AGENT); }
__device__ __forceinline__ unsigned xb_add(unsigned* p, unsigned v) { return __hip_atomic_fetch_add(p, v, __ATOMIC_RELAXED, __HIP_MEMORY_SCOPE_AGENT); }
__device__ __forceinline__ unsigned xb_xcc_id() { return (unsigned)__builtin_amdgcn_s_getreg((3 << 11) | 20) & 0xFu; }
#define XB_SPIN(cond, bar) do { unsigned _sp = 0; while (cond) { __builtin_amdgcn_s_sleep(1); \
    if ((++_sp & 255u) == 0u) { if (xb_ld(&(bar)[XB_TMO])) break; if (_sp > XB_SPIN_CAP) { atomicAdd(&(bar)[XB_TMO], 1u); break; } } } } while (0)
struct XcdBarrier { unsigned* bar; unsigned x; volatile LAS unsigned* st; };
__device__ __forceinline__ XcdBarrier xcd_barrier_post(unsigned* bar, volatile LAS unsigned* st) {
    XcdBarrier b; b.bar = bar; b.x = xb_xcc_id(); b.st = st;
    if (threadIdx.x == 0) (void)xb_add(&bar[XB_XCNT(b.x)], 1u);
    return b;
}
__device__ __forceinline__ void xcd_barrier_complete(unsigned* bar, unsigned x, unsigned& nloc, unsigned& nx) {
    const unsigned G = gridDim.x * gridDim.y * gridDim.z;
    unsigned sum, cnt, mine, sp = 0u;
    for (;;) {
        sum = 0u; cnt = 0u; mine = 0u;
#pragma unroll
        for (unsigned j = 0; j < 16; ++j) { const unsigned c = xb_ld(&bar[XB_XCNT(j)]); sum += c; cnt += (c > 0u) ? 1u : 0u; mine = (j == x) ? c : mine; }
        if (sum == G) break;
        __builtin_amdgcn_s_sleep(1);
        if ((++sp & 255u) == 0u) { if (xb_ld(&bar[XB_TMO])) break; if (sp > XB_SPIN_CAP) { atomicAdd(&bar[XB_TMO], 1u); break; } }
    }
    nloc = mine > 0u ? mine : 1u; nx = cnt > 0u ? cnt : 1u;
}
__device__ __forceinline__ void xcd_barrier(const XcdBarrier& b) {
    asm volatile("s_waitcnt vmcnt(0)" ::: "memory");
    __syncthreads();
    if (threadIdx.x == 0) {
        unsigned* bar = b.bar;
        __builtin_amdgcn_s_waitcnt(0);
        unsigned nloc = b.st[0], nx = b.st[1];
        if (nloc == 0u) { xcd_barrier_complete(bar, b.x, nloc, nx); b.st[0] = nloc; b.st[1] = nx; }
        const unsigned old = xb_add(&bar[XB_XSUB(b.x)], 1u);
        const unsigned gen = old / nloc;
        if (old + 1u == (gen + 1u) * nloc) {
            __builtin_amdgcn_fence(__ATOMIC_RELEASE, "agent");
            asm volatile("s_waitcnt vmcnt(0)" ::: "memory");
            const unsigned og = xb_add(&bar[XB_TOP], 1u);
            const unsigned tg = og / nx;
            if (og + 1u == (tg + 1u) * nx) xb_add(&bar[XB_TOPGEN], 1u);
            else XB_SPIN(xb_ld(&bar[XB_TOPGEN]) == tg, bar);
            __builtin_amdgcn_fence(__ATOMIC_ACQUIRE, "agent");
            xb_add(&bar[XB_XGEN(b.x)], 1u);
            asm volatile("s_waitcnt vmcnt(0)" ::: "memory");
        } else {
            XB_SPIN(xb_ld(&bar[XB_XGEN(b.x)]) == gen, bar);
            __builtin_amdgcn_fence(__ATOMIC_ACQUIRE, "agent");
            asm volatile("s_waitcnt vmcnt(0)" ::: "memory");
        }
    }
    __syncthreads();
}

struct Args { const float* in[16]; float* out; unsigned char* ws; int ph_lo, ph_hi, li, pad; };
enum { PH_PRO = 0, PH_A1, PH_A2, PH_A3, PH_F1A, PH_F2A, PH_B1, PH_B2, PH_GATE, PH_B3, PH_F1B, PH_F2B, PH_END };

__device__ __forceinline__ void p0_transpose_item(const float* W, int K, int Nsrc, int N, int mode, const float* gain, bf16_t* WT, LAS float* scr, int item, int lane) {
    const int nblk = N / 64, kb = item / nblk, nb = item % nblk, k0 = 64 * kb, n0 = 64 * nb;
    const int src = wmap(mode, n0 + lane);
    const float* wp = W + (size_t)k0 * Nsrc + (src >= 0 ? src : 0);
#pragma unroll
    for (int h = 0; h < 2; ++h) { float v[32];
#pragma unroll
        for (int i = 0; i < 32; ++i) v[i] = wp[(size_t)(32 * h + i) * Nsrc];
#pragma unroll
        for (int i = 0; i < 32; ++i) { float x = v[i]; if (gain) x *= gain[k0 + 32 * h + i]; if (src < 0) x = 0.f; scr[(32 * h + i) * 65 + lane] = x; } }
    LDS_WAIT(); asm volatile("" ::: "memory");
    const int kq = (lane & 3) * 16;
#pragma unroll
    for (int j = 0; j < 4; ++j) { const int n = (lane >> 2) + 16 * j; const LAS float* sp = scr + kq * 65 + n;
        u32x4 o0, o1;
        o0.x = pk2(sp[0 * 65], sp[1 * 65]); o0.y = pk2(sp[2 * 65], sp[3 * 65]); o0.z = pk2(sp[4 * 65], sp[5 * 65]); o0.w = pk2(sp[6 * 65], sp[7 * 65]);
        o1.x = pk2(sp[8 * 65], sp[9 * 65]); o1.y = pk2(sp[10 * 65], sp[11 * 65]); o1.z = pk2(sp[12 * 65], sp[13 * 65]); o1.w = pk2(sp[14 * 65], sp[15 * 65]);
        bf16_t* dst = WT + (size_t)(n0 + n) * K + k0 + kq; *(u32x4*)dst = o0; *(u32x4*)(dst + 8) = o1; }
    LDS_WAIT(); asm volatile("" ::: "memory");
}
__device__ __forceinline__ void ffn_fixup(int pm, const float* cw, const float* PART, const float* HALO, bf16_t* H) {
    if ((pm & 7) == 0) return;
    int tid = threadIdx.x; asm volatile("" : "+v"(tid));
    const float* part = PART + (size_t)pm * (4 * D_FF); const float* halo = HALO + (size_t)(pm - 1) * (4 * D_FF);
#pragma unroll
    for (int idx0 = 0; idx0 < 2 * D_FF; idx0 += NWAVES * 64) { const int idx = idx0 + tid; const int e = idx / D_FF, c = idx - e * D_FF;
        float a = part[(size_t)e * 2 * D_FF + c], b = part[(size_t)e * 2 * D_FF + D_FF + c];
        const float ha0 = halo[c], hb0 = halo[D_FF + c], ha1 = halo[2 * D_FF + c], hb1 = halo[3 * D_FF + c];
        const float wa0 = cw[c], wa1 = cw[FF2 + c], wb0 = cw[D_FF + c], wb1 = cw[FF2 + D_FF + c];
        if (e == 0) { a += wa1 * ha1 + wa0 * ha0; b += wb1 * hb1 + wb0 * hb0; } else { a += wa0 * ha1; b += wb0 * hb1; }
        H[(size_t)(pm * 256 + e) * D_FF + c] = f2bf(siluf(a) * b); }
}


__device__ __forceinline__ void glds16_asm(const void* gsrc, unsigned lds_dst) {
    unsigned keep; asm volatile("s_mov_b32 %0, m0\n\ts_mov_b32 m0, %2\n\ts_nop 0\n\tglobal_load_lds_dwordx4 %1, off\n\ts_mov_b32 m0, %0" : "=&s"(keep) : "v"(gsrc), "s"(lds_dst) : "memory"); }
__device__ __forceinline__ unsigned lds_addr(LAS unsigned char* p) { return (unsigned)__builtin_amdgcn_readfirstlane((int)(unsigned)(size_t)p); }

typedef short s16x4 __attribute__((ext_vector_type(4)));
__device__ __forceinline__ bf16x8 cat4(s16x4 a, s16x4 b) { bf16x8 r; r[0] = a[0]; r[1] = a[1]; r[2] = a[2]; r[3] = a[3]; r[4] = b[0]; r[5] = b[1]; r[6] = b[2]; r[7] = b[3]; return r; }
__device__ __forceinline__ void ret_fast_phase(LAS unsigned char* lds, const bf16_t* QT, const bf16_t* KT, const bf16_t* VT, bf16_t* RET, float* SSR, int unit) {
    int tid_ = threadIdx.x; asm volatile("" : "+v"(tid_));
    const int tid = tid_, lane = tid & 63, w = __builtin_amdgcn_readfirstlane(tid >> 6), li = lane & 15, g = lane >> 4;
    const int blk = unit & 7, h = (unit >> 3) & 3, b = unit >> 5;
    const float g64 = __expf(64.0f * gamma_log(h));
    const int qt = (w < 2) ? 0 : (w < 4) ? 1 : (w < 6) ? 3 : 2, dvh = w & 1;
    const int kt0 = (w == 3) ? 1 : (w == 5 || w == 7) ? 2 : 0;
    const int kt1 = (w == 0 || w == 2) ? 1 : (w == 1) ? 0 : (w == 3) ? 2 : (w == 4 || w == 6) ? 2 : (w == 5) ? 4 : 3;
    constexpr int KB = 0, VB = 65536, ST = 81920, SIMG = 147456;
    typedef __attribute__((address_space(3))) s16x4 lds_s16x4;
    for (int e = tid; e < 2048; e += 512) *(LAS u32x4*)(lds + ST + e * 16) = (u32x4){0u, 0u, 0u, 0u};
    f32x4 st[2][4];
#pragma unroll
    for (int d = 0; d < 2; ++d)
#pragma unroll
        for (int t = 0; t < 4; ++t) st[d][t] = (f32x4){0.f, 0.f, 0.f, 0.f};
    const size_t rowb = (size_t)b * SEQ;
    const bf16_t* kbase = KT + rowb * 1024 + h * 256;
    const bf16_t* qbase = QT + (rowb + 16 * qt + li) * 1024 + h * 256 + 8 * g;
    const bf16_t* vbase = VT + ((size_t)b * 2048 + h * 512 + blk * 64 + (tid >> 3)) * SEQ + 8 * (tid & 7);
    const unsigned vw_off = (unsigned)((tid >> 3) * 128 + (((2 * (tid & 7)) ^ ((tid >> 3) & 14)) * 8));
    unsigned ksrc[4];
#pragma unroll
    for (int i = 0; i < 4; ++i) { const int row = 2 * (4 * w + i) + (lane >> 5), p = lane & 31, c = p ^ ((row & 7) << 1); ksrc[i] = (unsigned)(row * 2048 + c * 16); }
#define RK_DMA(n_, buf_) do { const char* kb_ = (const char*)(kbase + (size_t)(n_) * 64 * 1024); const unsigned ld_ = lds_addr(lds + KB + (buf_) * 32768 + (4 * w) * 1024); _Pragma("unroll") for (int i = 0; i < 4; ++i) \
        glds16_asm(kb_ + ksrc[i], ld_ + i * 1024); } while (0)
    bf16x8 qf[8], qn[8]; u32x4 vreg;
    RK_DMA(0, 0);
    vreg = *(const u32x4*)(vbase);
#pragma unroll
    for (int ks = 0; ks < 8; ++ks) { qf[ks] = *(const bf16x8*)(qbase + 32 * ks); qn[ks] = qf[ks]; }
    *(LAS u32x4*)(lds + VB + vw_off) = vreg;
    asm volatile("s_waitcnt vmcnt(0) lgkmcnt(0)" ::: "memory"); __builtin_amdgcn_s_barrier(); asm volatile("" ::: "memory");
#pragma unroll 1
    for (int n = 0; n < 32; ++n) {
        const int cur = n & 1, nxt = cur ^ 1;
        LAS unsigned char* kb = lds + KB + cur * 32768; LAS unsigned char* vb = lds + VB + cur * 8192; LAS unsigned char* sb = lds + ST + cur * 32768;
#ifndef RET_PROBE
#define RET_PROBE 0
#endif
        if (n + 1 < 32) {
            RK_DMA(n + 1, nxt);
            if (RET_PROBE & 1) { RK_DMA(n + 1, nxt); }
            vreg = *(const u32x4*)(vbase + (size_t)(n + 1) * 64);
#pragma unroll
            for (int ks = 0; ks < 8; ++ks) qn[ks] = *(const bf16x8*)(qbase + (size_t)(n + 1) * 64 * 1024 + 32 * ks);
        }
#pragma unroll 1
        for (int kt2 = 2 * kt0; kt2 < 2 * kt1; kt2 += ((RET_PROBE & 2) ? 1 : 2)) { const int kt = kt2 >> 1;
            f32x4 acc = (f32x4){0.f, 0.f, 0.f, 0.f};
            const int row = 16 * kt + li; const LAS unsigned char* rp = kb + row * 512; const int sw = (row & 7) << 1;
            bf16x8 av[8];
#pragma unroll
            for (int ks = 0; ks < 8; ++ks) av[ks] = *(const LAS bf16x8*)(rp + (((4 * ks + g) ^ sw) * 16));
            __builtin_amdgcn_sched_barrier(0);
#pragma unroll
            for (int ks = 0; ks < 8; ++ks) acc = __builtin_amdgcn_mfma_f32_16x16x32_bf16(av[ks], qf[ks], acc, 0, 0, 0);
            if (kt == qt) {
#pragma unroll
                for (int r = 0; r < 4; ++r) acc[r] = (4 * g + r <= li) ? acc[r] : 0.f; }
            u32x2 pk; pk.x = pk2(acc[0], acc[1]); pk.y = pk2(acc[2], acc[3]);
            *(LAS u32x2*)(lds + SIMG + ((qt * 4 + kt) * 64 + lane) * 8) = pk;
        }
        bf16x8 vf[4][2];
#pragma unroll
        for (int t = 0; t < 4; ++t)
#pragma unroll
            for (int kp = 0; kp < 2; ++kp) { const int row = 16 * t + li; const LAS unsigned char* rp = vb + row * 128; const int f = row & 14;
                const s16x4 lo = *(const LAS s16x4*)(rp + (((8 * kp + g) ^ f) * 8)), hi = *(const LAS s16x4*)(rp + (((8 * kp + 4 + g) ^ f) * 8)); vf[t][kp] = cat4(lo, hi); }
        bf16x8 ua[2][2];
#pragma unroll
        for (int d = 0; d < 2; ++d)
#pragma unroll
            for (int kp = 0; kp < 2; ++kp) { const int dkt = 2 * w + d;
                const int r0 = 32 * kp + 4 * g + (li >> 2), r1 = r0 + 16;
                const int cch = 2 * dkt + ((li >> 1) & 1), hb = (li & 1) * 8;
                const s16x4 lo = __builtin_bit_cast(s16x4, __builtin_amdgcn_ds_read_tr16_b64_v4i16((lds_s16x4*)(kb + r0 * 512 + ((cch ^ ((r0 & 7) << 1)) * 16) + hb)));
                const s16x4 hi = __builtin_bit_cast(s16x4, __builtin_amdgcn_ds_read_tr16_b64_v4i16((lds_s16x4*)(kb + r1 * 512 + ((cch ^ ((r1 & 7) << 1)) * 16) + hb)));
                ua[d][kp] = cat4(lo, hi); }
        __builtin_amdgcn_sched_barrier(0);
#pragma unroll
        for (int d = 0; d < 2; ++d)
#pragma unroll
            for (int kp = 0; kp < 2; ++kp)
#pragma unroll
                for (int t = 0; t < 4; ++t) st[d][t] = __builtin_amdgcn_mfma_f32_16x16x32_bf16(ua[d][kp], vf[t][kp], st[d][t], 0, 0, 0);
        asm volatile("s_waitcnt lgkmcnt(0)" ::: "memory"); __builtin_amdgcn_s_barrier(); asm volatile("" ::: "memory");
        if (RET_PROBE & 8) { __builtin_amdgcn_s_barrier(); asm volatile("" ::: "memory"); __builtin_amdgcn_s_barrier(); asm volatile("" ::: "memory"); }
        float ssq = 0.f;
        bf16x8 sf[2]; bool sv[2];
#pragma unroll
        for (int kp = 0; kp < 2; ++kp) { sv[kp] = (2 * kp <= qt); sf[kp] = (bf16x8){0, 0, 0, 0, 0, 0, 0, 0};
            if (sv[kp]) { const s16x4 lo = *(const LAS s16x4*)(lds + SIMG + ((qt * 4 + 2 * kp) * 64 + lane) * 8);
                s16x4 hi = (s16x4){0, 0, 0, 0}; if (2 * kp + 1 <= qt) hi = *(const LAS s16x4*)(lds + SIMG + ((qt * 4 + 2 * kp + 1) * 64 + lane) * 8);
                sf[kp] = cat4(lo, hi); } }
#pragma unroll
        for (int dd2 = 0; dd2 < ((RET_PROBE & 4) ? 4 : 2); ++dd2) { const int dd = dd2 & 1; const int t = 2 * dvh + dd; if (dd2 == 2) ssq = 0.f;
            bf16x8 sa[8];
            {   const int row = 16 * t + li; const LAS unsigned char* rp = sb + row * 512; const int sw = (row & 7) << 1;
#pragma unroll
                for (int ks = 0; ks < 8; ++ks) sa[ks] = *(const LAS bf16x8*)(rp + (((4 * ks + g) ^ sw) * 16)); }
            __builtin_amdgcn_sched_barrier(0);
            f32x4 acc = (f32x4){0.f, 0.f, 0.f, 0.f};
#pragma unroll
            for (int kp = 0; kp < 2; ++kp) if (sv[kp]) {
                const bf16x8 va = dvh ? (dd ? vf[3][kp] : vf[2][kp]) : (dd ? vf[1][kp] : vf[0][kp]);
                acc = __builtin_amdgcn_mfma_f32_16x16x32_bf16(va, sf[kp], acc, 0, 0, 0); }
#pragma unroll
            for (int ks = 0; ks < 8; ++ks) acc = __builtin_amdgcn_mfma_f32_16x16x32_bf16(sa[ks], qf[ks], acc, 0, 0, 0);
            ssq += (acc[0] * acc[0] + acc[1] * acc[1]) + (acc[2] * acc[2] + acc[3] * acc[3]);
            u32x2 pk; pk.x = pk2(acc[0], acc[1]); pk.y = pk2(acc[2], acc[3]);
            *(u32x2*)(RET + (rowb + n * 64 + 16 * qt + li) * 2048 + h * 512 + blk * 64 + 16 * t + 4 * g) = pk;
            __builtin_amdgcn_sched_barrier(0); }
        ssq += __shfl_xor(ssq, 16); ssq += __shfl_xor(ssq, 32);
        if (g == 0) SSR[((rowb + n * 64 + 16 * qt + li) * 4 + h) * 16 + blk * 2 + dvh] = ssq;
        LAS unsigned char* sn = lds + ST + nxt * 32768;
#pragma unroll
        for (int d = 0; d < 2; ++d)
#pragma unroll
            for (int t = 0; t < 4; ++t) { st[d][t] *= g64; const int row = 16 * t + li, dkt = 2 * w + d;
                u32x2 pk; pk.x = pk2(st[d][t][0], st[d][t][1]); pk.y = pk2(st[d][t][2], st[d][t][3]);
                *(LAS u32x2*)(sn + row * 512 + (((2 * dkt + (g >> 1)) ^ ((row & 7) << 1)) * 16) + (g & 1) * 8) = pk; }
        if (n + 1 < 32) *(LAS u32x4*)(lds + VB + nxt * 8192 + vw_off) = vreg;
#pragma unroll
        for (int ks = 0; ks < 8; ++ks) qf[ks] = qn[ks];
        asm volatile("s_waitcnt vmcnt(0) lgkmcnt(0)" ::: "memory"); __builtin_amdgcn_s_barrier(); asm volatile("" ::: "memory");
    }
#undef RK_DMA
}


#ifndef DSA_REP
#define DSA_REP 0
#endif
constexpr int DSA_SC = 0, DSA_KST = 131072, DSA_IDX = 147456, DSA_WQ = 155648;
__device__ __forceinline__ unsigned fkey(float f) { const unsigned u = __float_as_uint(f); return (u & 0x80000000u) ? ~u : (u | 0x80000000u); }
__device__ __forceinline__ int bcnt(bool p) { return __popcll(__ballot(p)); }
#define SUMF(a_, b_) ((a_) + (b_))
#define WAVE_RED(OP, v) do { v = OP(v, __int_as_float(__builtin_amdgcn_update_dpp(__float_as_int(v), __float_as_int(v), 0xB1, 0xf, 0xf, true))); \
        v = OP(v, __int_as_float(__builtin_amdgcn_update_dpp(__float_as_int(v), __float_as_int(v), 0x4E, 0xf, 0xf, true))); \
        v = OP(v, __int_as_float(__builtin_amdgcn_update_dpp(__float_as_int(v), __float_as_int(v), 0x141, 0xf, 0xf, true))); \
        v = OP(v, __int_as_float(__builtin_amdgcn_update_dpp(__float_as_int(v), __float_as_int(v), 0x140, 0xf, 0xf, true))); \
        v = OP(OP(__int_as_float(__builtin_amdgcn_readlane(__float_as_int(v), 0)), __int_as_float(__builtin_amdgcn_readlane(__float_as_int(v), 16))), \
               OP(__int_as_float(__builtin_amdgcn_readlane(__float_as_int(v), 32)), __int_as_float(__builtin_amdgcn_readlane(__float_as_int(v), 48)))); } while (0)

template <int NB>
__device__ __forceinline__ void dsa_topk_t(const LAS float* sc, LAS unsigned short* il, int limit, int lane) {
    const int nb = limit >> 6;
    float v[NB];
#pragma unroll
    for (int i = 0; i < NB; ++i) v[i] = (i < nb) ? sc[64 * i + lane] : -INFINITY;
    float mn = INFINITY, mx = -INFINITY;
#pragma unroll
    for (int i = 0; i < NB; ++i) { mn = fminf(mn, (i < nb) ? v[i] : INFINITY); mx = fmaxf(mx, v[i]); }
    WAVE_RED(fminf, mn); WAVE_RED(fmaxf, mx);
    float lo = mn, hi = INFINITY; int clo = limit, chi = 0;
#pragma unroll 1
    for (int it = 0; it < 64 && clo - chi > 64; ++it) {
        const float top = (hi == INFINITY) ? mx : hi; const float mid = 0.5f * lo + 0.5f * top;
        if (!(mid > lo) || !(mid < hi)) break;
        int c = 0;
#pragma unroll
        for (int i = 0; i < NB; ++i) c += (v[i] >= mid) ? 1 : 0;
        float cf = (float)c; WAVE_RED(SUMF, cf); c = (int)cf;
        if (c >= TOPK) { lo = mid; clo = c; } else { hi = mid; chi = c; }
    }
    const int r = TOPK - chi; unsigned T; int ngt, neq;
    if (clo - chi <= 64) {
        int filled = 0;
#pragma unroll
        for (int i = 0; i < NB; ++i) { const bool in = (v[i] >= lo) && (v[i] < hi);
            const unsigned long long m = __ballot(in); const int pos = filled + __builtin_amdgcn_mbcnt_hi((unsigned)(m >> 32), __builtin_amdgcn_mbcnt_lo((unsigned)m, 0));
            if (in) ((LAS unsigned*)il)[pos] = fkey(v[i]);
            filled += __popcll(m); }
        asm volatile("s_waitcnt lgkmcnt(0)" ::: "memory");
        const unsigned ck = (lane < filled) ? ((LAS unsigned*)il)[lane] : 0u;
        T = 0u;
#pragma unroll 4
        for (int bit = 31; bit >= 0; --bit) { const unsigned cand = T | (1u << bit); if (bcnt(ck >= cand) >= r) T = cand; }
        ngt = chi + bcnt(ck > T); neq = bcnt(ck == T);
    } else {
        T = 0u;
#pragma unroll 1
        for (int bit = 31; bit >= 0; --bit) { const unsigned cand = T | (1u << bit); int c = 0;
#pragma unroll
            for (int i = 0; i < NB; ++i) c += bcnt(i < nb && fkey(v[i]) >= cand);
            if (c >= TOPK) T = cand; }
        ngt = 0; neq = 0;
#pragma unroll
        for (int i = 0; i < NB; ++i) { const unsigned k = fkey(v[i]); ngt += bcnt(i < nb && k > T); neq += bcnt(i < nb && k == T); }
    }
    const int need_eq = TOPK - ngt;
    asm volatile("s_waitcnt lgkmcnt(0)" ::: "memory");
    int base = 0, tb = 0;
    const bool alleq = (neq == need_eq);
#pragma unroll
    for (int i = 0; i < NB; ++i) if (i < nb) { const unsigned k = fkey(v[i]);
        bool f = k >= T;
        if (!alleq) { const bool eq = (k == T); const unsigned long long me = __ballot(eq);
            const int er = tb + __builtin_amdgcn_mbcnt_hi((unsigned)(me >> 32), __builtin_amdgcn_mbcnt_lo((unsigned)me, 0));
            f = (k > T) || (eq && er < need_eq); tb += __popcll(me); }
        const unsigned long long mf = __ballot(f); const int pos = base + __builtin_amdgcn_mbcnt_hi((unsigned)(mf >> 32), __builtin_amdgcn_mbcnt_lo((unsigned)mf, 0));
        if (f && pos < TOPK) il[pos] = (unsigned short)(64 * i + lane);
        base += __popcll(mf); }
}
__device__ __forceinline__ void dsa_topk(const LAS float* sc, LAS unsigned short* il, int limit, int lane) {
    if (limit <= 512) dsa_topk_t<8>(sc, il, limit, lane);
    else if (limit <= 1024) dsa_topk_t<16>(sc, il, limit, lane);
    else dsa_topk_t<32>(sc, il, limit, lane);
}

struct DsaQ { bf16x8 qf[4]; f32x4 ps; };
__device__ __forceinline__ DsaQ dsa_load_q(const bf16_t* QH, const float* PS, size_t trow, int lane) {
    const int li = lane & 15, g = lane >> 4; DsaQ q;
#pragma unroll
    for (int s = 0; s < 4; ++s) { q.qf[s] = (bf16x8){0, 0, 0, 0, 0, 0, 0, 0}; if (li < 8) q.qf[s] = *(const bf16x8*)(QH + trow * 1024 + li * 128 + 32 * s + 8 * g); }
    q.ps = (f32x4){1.f, 1.f, 1.f, 1.f};
    if (li < 8) { const float* pp = PS + (size_t)((li >> 1) * 8 + (li & 1) * 4) * M + trow; q.ps = (f32x4){pp[0], pp[(size_t)M], pp[(size_t)2 * M], pp[(size_t)3 * M]}; }
    return q;
}
__device__ __forceinline__ void dsa_attend(LAS unsigned char* wl, const LAS unsigned short* il, const LAS float* rctab, LAS float* rcl, const DsaQ& Q, const bf16_t* Cb, bf16_t* AO, size_t trow, int b, int count, float bound_l2, int lane) {
    const int li = lane & 15, g = lane >> 4;
    typedef __attribute__((address_space(3))) s16x4 lds_s16x4;
    bf16x8 qf[4];
#pragma unroll
    for (int s = 0; s < 4; ++s) qf[s] = Q.qf[s];
    const float rq = (li < 8) ? rsqrtf(((Q.ps[0] + Q.ps[1]) + (Q.ps[2] + Q.ps[3])) * (1.0f / 128.0f) + EPS) * 1.4426950408889634f : 0.f;
    const bf16_t* cbase = Cb + (size_t)b * SEQ * 128; const unsigned wlb = lds_addr(wl);
#define DSA_GATHER(ci_, buf_) do { const u32x4 kw_ = *(const LAS u32x4*)(il + 32 * (ci_) + 8 * (lane >> 4)); \
        _Pragma("unroll") for (int i = 0; i < 8; ++i) { const int row = 4 * i + (lane >> 4); const unsigned kk_ = (i < 2 ? kw_.x : i < 4 ? kw_.y : i < 6 ? kw_.z : kw_.w); const int key = (i & 1) ? (int)(kk_ >> 16) : (int)(kk_ & 0xffffu); \
        const int sc_ = (lane & 15) ^ ((row & 7) << 1); \
        glds16_asm(cbase + (size_t)key * 128 + sc_ * 8, wlb + (buf_) * 8192 + i * 1024); } } while (0)
    for (int pos = lane; pos < count; pos += 64) { const int e = pos & 31; rcl[(pos & ~31) + 4 * (e & 7) + (e >> 3)] = rctab[il[pos]]; }
    asm volatile("s_waitcnt lgkmcnt(0)" ::: "memory");
    f32x4 oacc[8];
#pragma unroll
    for (int d = 0; d < 8; ++d) oacc[d] = (f32x4){0.f, 0.f, 0.f, 0.f};
    float lsum = 0.f;
    const int nch = count >> 5;
    DSA_GATHER(0, 0);
#pragma unroll 1
    for (int ci = 0; ci < nch; ++ci) {
        const int cur = ci & 1;
        if (ci + 1 < nch) { DSA_GATHER(ci + 1, cur ^ 1); if (DSA_REP & 8) { DSA_GATHER(ci + 1, cur ^ 1); asm volatile("s_waitcnt vmcnt(16)" ::: "memory"); } else asm volatile("s_waitcnt vmcnt(8)" ::: "memory"); } else { asm volatile("s_waitcnt vmcnt(0)" ::: "memory"); }
        const LAS unsigned char* ct = wl + cur * 8192;
        f32x4 lt[2];
        bf16x8 ca[2][4];
#pragma unroll
        for (int T = 0; T < 2; ++T) { const int row = 16 * T + li; const LAS unsigned char* rp = ct + row * 256; const int sw = (row & 7) << 1;
#pragma unroll
            for (int s = 0; s < 4; ++s) ca[T][s] = *(const LAS bf16x8*)(rp + (((4 * s + g) ^ sw) * 16)); }
        f32x4 rcv[2];
#pragma unroll
        for (int T = 0; T < 2; ++T) rcv[T] = *(const LAS f32x4*)(rcl + 32 * ci + 16 * T + 4 * g);
        __builtin_amdgcn_sched_barrier(0);
#pragma unroll
        for (int T = 0; T < 2; ++T) { lt[T] = (f32x4){0.f, 0.f, 0.f, 0.f};
#pragma unroll
            for (int s = 0; s < 4; ++s) lt[T] = __builtin_amdgcn_mfma_f32_16x16x32_bf16(ca[T][s], qf[s], lt[T], 0, 0, 0); }
        bf16x8 cv[8];
#pragma unroll
        for (int dt = 0; dt < 8; ++dt) {
            const int r0 = 4 * g + (li >> 2), r1 = r0 + 16; const int cch = 2 * dt + ((li >> 1) & 1), hb = (li & 1) * 8;
            const s16x4 lo = __builtin_bit_cast(s16x4, __builtin_amdgcn_ds_read_tr16_b64_v4i16((lds_s16x4*)(ct + r0 * 256 + ((cch ^ ((r0 & 7) << 1)) * 16) + hb)));
            const s16x4 hi = __builtin_bit_cast(s16x4, __builtin_amdgcn_ds_read_tr16_b64_v4i16((lds_s16x4*)(ct + r1 * 256 + ((cch ^ ((r1 & 7) << 1)) * 16) + hb)));
            cv[dt] = cat4(lo, hi); }
        __builtin_amdgcn_sched_barrier(0);
        bf16x8 pf;
#pragma unroll
        for (int T = 0; T < 2; ++T) { float pv[4];
#pragma unroll
            for (int r = 0; r < 4; ++r) { pv[r] = __builtin_amdgcn_exp2f(lt[T][r] * rq * rcv[T][r] - bound_l2); lsum += pv[r]; }
            const unsigned w0 = pk2(pv[0], pv[1]), w1 = pk2(pv[2], pv[3]);
            pf[4 * T + 0] = (short)(w0 & 0xffff); pf[4 * T + 1] = (short)(w0 >> 16); pf[4 * T + 2] = (short)(w1 & 0xffff); pf[4 * T + 3] = (short)(w1 >> 16); }
#pragma unroll
        for (int dt = 0; dt < 8; ++dt) oacc[dt] = __builtin_amdgcn_mfma_f32_16x16x32_bf16(cv[dt], pf, oacc[dt], 0, 0, 0);
    }
#undef DSA_GATHER
    lsum += __shfl_xor(lsum, 16); lsum += __shfl_xor(lsum, 32);
    const float inv = 1.0f / lsum;
    if (li < 8) {
#pragma unroll
        for (int dt = 0; dt < 8; ++dt) { u32x2 o; o.x = pk2(oacc[dt][0] * inv, oacc[dt][1] * inv); o.y = pk2(oacc[dt][2] * inv, oacc[dt][3] * inv);
            *(u32x2*)(AO + trow * 1024 + li * 128 + 16 * dt + 4 * g) = o; }
    }
}

__device__ __forceinline__ void dsa_fast_phase(LAS unsigned char* lds, const bf16_t* QH, const bf16_t* Cb, const float* PS, const bf16_t* QI, const bf16_t* KI, const float* WI, const float* CSC, bf16_t* AO, int vcu, int G) {
    int tid_ = threadIdx.x; asm volatile("" : "+v"(tid_));
    const int tid = tid_, lane0 = tid & 63, w = __builtin_amdgcn_readfirstlane(tid >> 6);
    LAS unsigned char* wl = lds + DSA_SC + w * 16384; LAS float* rctab = (LAS float*)(lds + DSA_KST);
    LAS unsigned short* il0 = (LAS unsigned short*)(lds + DSA_IDX + (2 * w) * 512); LAS unsigned short* il1 = il0 + 256;
    float mxs = 0.f;
    for (int i = lane0; i < 128; i += 64) mxs = fmaxf(mxs, fabsf(CSC[i]));
#pragma unroll
    for (int o = 1; o < 64; o <<= 1) mxs = fmaxf(mxs, __shfl_xor(mxs, o));
    const float bound_l2 = mxs * 128.0f * 1.4426950408889634f;
    for (int wg = vcu; wg < 256; wg += G) {
        const int b = wg >> 5, r = wg & 31;
        __syncthreads();
        for (int k = tid; k < SEQ; k += NWAVES * 64) { const float* pp = PS + (size_t)32 * M + (size_t)b * SEQ + k;
            rctab[k] = rsqrtf(((pp[0] + pp[(size_t)M]) + (pp[(size_t)2 * M] + pp[(size_t)3 * M])) * (1.0f / 128.0f) + EPS); }
#pragma unroll 1
        for (int it = 0; it < 4; ++it) {
            int lane = lane0; asm volatile("" : "+v"(lane));
            const int li = lane & 15, g = lane >> 4;
            const int chunk = (it & 1) ? 31 - (r & 15) : (r & 15), sub = 2 * (r >> 4) + (it >> 1);
            const int t0 = chunk * 64 + sub * 16, limit = (chunk + 1) * 64;
            const size_t trow0 = (size_t)b * SEQ + t0 + 2 * w;
            const DsaQ Q0 = dsa_load_q(QH, PS, trow0, lane), Q1 = dsa_load_q(QH, PS, trow0 + 1, lane);
            LAS float* wqt = (LAS float*)(lds + DSA_WQ);
            if (limit > TOPK && tid < 128) { const int qq = tid >> 3, hh = tid & 7; const size_t row = (size_t)b * SEQ + t0 + qq;
                const float* ps = PS + (size_t)(40 + (hh >> 2) * 8 + ((hh >> 1) & 1) * 4 + 2 * (hh & 1)) * M + row;
                wqt[tid] = WI[row * 8 + hh] * rsqrtf((ps[0] + ps[(size_t)M]) * (1.0f / 64.0f) + EPS); }
            __syncthreads();
            if (limit > TOPK) {
                for (int srep = 0; srep < 1 + (DSA_REP & 1); ++srep) {
                bf16x8 af[8][2]; float wq[8][4];
                const size_t trowi = (size_t)b * SEQ + t0;
#pragma unroll
                for (int p = 0; p < 8; ++p) {
#pragma unroll
                    for (int sidx = 0; sidx < 2; ++sidx) af[p][sidx] = *(const bf16x8*)(QI + (trowi + 2 * p + (li >> 3)) * 512 + (li & 7) * 64 + 32 * sidx + 8 * g);
                    const f32x4 wv = *(const LAS f32x4*)(wqt + (2 * p + (g >> 1)) * 8 + 4 * (g & 1));
                    wq[p][0] = wv[0]; wq[p][1] = wv[1]; wq[p][2] = wv[2]; wq[p][3] = wv[3];
                    asm volatile("" ::: "memory"); }
                const int nst = limit >> 4;
                const bf16_t* kp = KI + ((size_t)b * SEQ + 16 * w + li) * 64 + 8 * g; const float* pp = PS + (size_t)36 * M + (size_t)b * SEQ + 16 * w + li;
                bf16x8 b0 = *(const bf16x8*)kp, b1 = *(const bf16x8*)(kp + 32); f32x2_t pk = (f32x2_t){pp[0], pp[(size_t)M]};
                bf16x8 d0 = b0, d1 = b1; f32x2_t pk2v = pk;
                if (w + 8 < nst) { kp += 8 * 16 * 64; pp += 8 * 16; d0 = *(const bf16x8*)kp; d1 = *(const bf16x8*)(kp + 32); pk2v = (f32x2_t){pp[0], pp[(size_t)M]}; }
#pragma unroll 1
                for (int st = w; st < nst; st += 8) {
                    const bf16x8 c0 = b0, c1 = b1; const float rk = rsqrtf((pk[0] + pk[1]) * (1.0f / 64.0f) + EPS);
                    b0 = d0; b1 = d1; pk = pk2v;
                    if (st + 16 < nst) { kp += 8 * 16 * 64; pp += 8 * 16; d0 = *(const bf16x8*)kp; d1 = *(const bf16x8*)(kp + 32); pk2v = (f32x2_t){pp[0], pp[(size_t)M]}; }
                    LAS float* so = (LAS float*)(lds + DSA_SC) + (g >> 1) * 2048 + 16 * st + li;
#pragma unroll
                    for (int p = 0; p < 8; ++p) {
                        f32x4 acc = (f32x4){0.f, 0.f, 0.f, 0.f};
                        acc = __builtin_amdgcn_mfma_f32_16x16x32_bf16(af[p][0], c0, acc, 0, 0, 0); acc = __builtin_amdgcn_mfma_f32_16x16x32_bf16(af[p][1], c1, acc, 0, 0, 0);
                        float part = (fmaxf(acc[0], 0.f) * wq[p][0] + fmaxf(acc[1], 0.f) * wq[p][1]) + (fmaxf(acc[2], 0.f) * wq[p][2] + fmaxf(acc[3], 0.f) * wq[p][3]);
                        {   const auto sw = __builtin_amdgcn_permlane16_swap(__float_as_uint(part), __float_as_uint(part), false, false);
                            part = __uint_as_float(sw[0]) + __uint_as_float(sw[1]); }
                        if ((g & 1) == 0) so[p * 4096] = part * rk + 0.0f;
                    }
                }
                __syncthreads();
                }
                for (int trep = 0; trep < 1 + ((DSA_REP >> 1) & 1); ++trep) {
                dsa_topk((const LAS float*)wl, il0, limit, lane);
                dsa_topk((const LAS float*)wl + 2048, il1, limit, lane); }
            } else {
                for (int j = lane; j < limit; j += 64) { il0[j] = (unsigned short)j; il1[j] = (unsigned short)j; }
            }
            const int count = limit < TOPK ? limit : TOPK;
            for (int arep = 0; arep < 1 + ((DSA_REP >> 2) & 1); ++arep) {
            dsa_attend(wl, il0, rctab, (LAS float*)(lds + DSA_KST + 8192 + w * 1024), Q0, Cb, AO, trow0, b, count, bound_l2, lane);
            dsa_attend(wl, il1, rctab, (LAS float*)(lds + DSA_KST + 8192 + w * 1024), Q1, Cb, AO, trow0 + 1, b, count, bound_l2, lane); }
        }
    }
    __syncthreads();
}

typedef const __attribute__((address_space(4))) Args* ArgsP;
__device__ __forceinline__ ArgsP fresh_args() { ArgsP p = (ArgsP)__builtin_amdgcn_kernarg_segment_ptr(); asm volatile("" : "+s"(p)); return p; }

__device__ __forceinline__ int fresh_bx() { int v = blockIdx.x; asm volatile("" : "+s"(v)); return v; }
__device__ __forceinline__ int fresh_gx() { int v = gridDim.x; asm volatile("" : "+s"(v)); return v; }
__global__ void __launch_bounds__(NWAVES * 64, 2) mega(Args args_unused) {
    extern __shared__ __attribute__((aligned(16))) unsigned char lds_raw[];
    LAS unsigned char* lds = (LAS unsigned char*)lds_raw;
    const int tid = threadIdx.x;
    for (int u = tid; u < (LDS_BYTES - LDSCTL_OFF) / 4; u += NWAVES * 64) ((LAS unsigned*)(lds + LDSCTL_OFF))[u] = 0u;
    __syncthreads();
    int lo, hi;
    {   ArgsP A = fresh_args(); lo = A->ph_lo; hi = A->ph_hi;
        if (hi - lo > 1) (void)xcd_barrier_post((unsigned*)(A->ws + WS_CTL) + CW_BAR + A->li * XCD_BAR_WORDS, (volatile LAS unsigned*)(lds + MISC_OFF) + 8); }
#ifndef PHMASK
#define PHMASK 0xffff
#endif
#define IN(k) (((PHMASK >> (k)) & 1) && lo <= (k) && (k) < hi)
#define SEAM(k) do { if (lo <= (k) && (k) + 1 < hi) { ArgsP A_ = fresh_args(); XcdBarrier b_; b_.bar = (unsigned*)(A_->ws + WS_CTL) + CW_BAR + A_->li * XCD_BAR_WORDS; b_.x = xb_xcc_id(); \
        b_.st = (volatile LAS unsigned*)(lds + MISC_OFF) + 8; xcd_barrier(b_); } } while (0)
#ifndef REPMASK
#define REPMASK 0
#endif
#define GBAR() do { ArgsP A_ = fresh_args(); XcdBarrier b_; b_.bar = (unsigned*)(A_->ws + WS_CTL) + CW_BAR + A_->li * XCD_BAR_WORDS; b_.x = xb_xcc_id(); \
        b_.st = (volatile LAS unsigned*)(lds + MISC_OFF) + 8; xcd_barrier(b_); } while (0)
#define REPEAT(k) for (int rep_ = 0; rep_ < 1 + ((REPMASK >> (k)) & 1); ++rep_)
#define REPBAR() do { if (rep_) GBAR(); } while (0)
#define GWS int t_ = threadIdx.x; asm volatile("" : "+v"(t_)); const int lane = t_ & 63, wave = __builtin_amdgcn_readfirstlane(t_ >> 6); const int G = fresh_gx(), bx = fresh_bx(); const int vcu = (G % 8 == 0) ? (bx % 8) * (G / 8) + bx / 8 : bx; \
        const int gw = vcu * NWAVES + wave, NGW = G * NWAVES; LAS float* scr = (LAS float*)(lds + wave * 16640); (void)lane; (void)gw; (void)NGW; (void)scr;
#define WCONV(Wp, K_, Nsrc_, N_, mode_, gain_, WT_) do { const int items_ = ((K_) / 64) * ((N_) / 64); \
        for (int it = gw; it < items_; it += NGW) p0_transpose_item((Wp), (K_), (Nsrc_), (N_), (mode_), (gain_), (WT_), scr, it, lane); } while (0)

    if (IN(PH_PRO)) REPEAT(PH_PRO) { REPBAR();
        GWS; ArgsP A = fresh_args(); unsigned char* ws = A->ws;
        constexpr int I0 = 16 * 28, I1 = I0 + 16 * 16, I2 = I1 + 16 * 96, I3 = I2 + 32 * 16, I4 = I3 + 16 * 88, I5 = I4 + 44 * 16, IX = I5 + M / 4;
        {   const float* x = A->in[0]; float* SS = (float*)(ws + WS_SS); bf16_t* XB = (bf16_t*)(ws + WS_XB);
#pragma unroll 1
            for (int it = gw; it < IX; it += NGW) {
                if (it < I0) p0_transpose_item(A->in[3], 1024, A_IN_COLS, A_IN_PAD, WM_AIN, A->in[1], (bf16_t*)(ws + WS_WAIN), scr, it, lane);
                else if (it < I1) p0_transpose_item(A->in[8], 1024, 1024, 1024, WM_NAT, (const float*)nullptr, (bf16_t*)(ws + WS_WAOUT), scr, it - I0, lane);
                else if (it < I2) p0_transpose_item(A->in[9], 1024, B_IN_COLS, B_IN_COLS, WM_NAT, A->in[1] + 1024, (bf16_t*)(ws + WS_WBIN), scr, it - I1, lane);
                else if (it < I3) p0_transpose_item(A->in[11], 2048, 1024, 1024, WM_NAT, A->in[10], (bf16_t*)(ws + WS_WBOUT), scr, it - I2, lane);
                else if (it < I4) p0_transpose_item(A->in[12], 1024, FF2, FF2, WM_FUP, A->in[2], (bf16_t*)(ws + WS_WFUP0), scr, it - I3, lane);
                else if (it < I5) p0_transpose_item(A->in[15], 2816, 1024, 1024, WM_NAT, (const float*)nullptr, (bf16_t*)(ws + WS_WFDN0), scr, it - I4, lane);
                else { const int row0 = (it - I5) * 4;
                    f32x4 v[4][4];
#pragma unroll
                    for (int r = 0; r < 4; ++r)
#pragma unroll
                        for (int q = 0; q < 4; ++q) v[r][q] = ((const f32x4*)(x + (size_t)(row0 + r) * DM))[q * 64 + lane];
#pragma unroll
                    for (int r = 0; r < 4; ++r)
#pragma unroll
                        for (int q = 0; q < 4; ++q) { const f32x4 w = v[r][q]; float sq = (w[0] * w[0] + w[1] * w[1]) + (w[2] * w[2] + w[3] * w[3]); sq = wave_sum(sq);
                            if (lane < 4) SS[(size_t)(q * 4 + lane) * M + row0 + r] = lane == 0 ? sq : 0.f;
                            u32x2 o; o.x = pk2(w[0], w[1]); o.y = pk2(w[2], w[3]); *(u32x2*)(XB + (size_t)(row0 + r) * DM + q * 256 + lane * 4) = o; } } } }
        {   float2* ROPE = (float2*)(ws + WS_ROPE);
            for (int e = gw * 64 + lane; e < 2048 * 128; e += NGW * 64) { const int t = e >> 7, i = e & 127;
                const float inv = exp2f(-(float)(2 * i) * (13.287712379549449f / 256.0f)), ang = (float)t * inv; float sn, cs; sincosf(ang, &sn, &cs); ROPE[e] = make_float2(cs, sn); } }
        {   float* CSC = (float*)(ws + WS_CSC); const float* a_q_g = A->in[4]; const float* a_k_g = A->in[5]; const float* a_iq_g = A->in[6]; const float* a_ik_g = A->in[7];
            for (int n = gw * 64 + lane; n < A_IN_PAD; n += NGW * 64) { float v;
                if (n < 1024) v = a_q_g[n & 127] * a_k_g[n & 127] * 0.08838834764831845f; else if (n < 1152) v = 1.0f; else if (n < 1216) v = a_ik_g[n - 1152];
                else if (n < 1224) v = 0.044194173824159216f; else if (n < 1280) v = 0.f; else v = a_iq_g[(n - 1280) & 63];
                CSC[n] = v; } }
    }
    SEAM(PH_PRO);
    if (IN(PH_A1)) REPEAT(PH_A1) { REPBAR();
        ArgsP A = fresh_args(); unsigned char* ws = A->ws;
        pg8::Gemm g{(const bf16_t*)(ws + WS_XB), (const bf16_t*)(ws + WS_WAIN), M, A_IN_PAD, 1024}; pg8::StaticOrder S; S.init(M, A_IN_PAD, fresh_gx(), fresh_bx());
        pg8::EpiA1 E{(const float*)(ws + WS_SS), (const float*)(ws + WS_CSC), (bf16_t*)(ws + WS_QH), (bf16_t*)(ws + WS_C), (bf16_t*)(ws + WS_KI), (bf16_t*)(ws + WS_QI), (float*)(ws + WS_WI), (float*)(ws + WS_PS)};
        pg8::gemm_phase(lds, g, S, E);
    }
    SEAM(PH_A1);
    if (IN(PH_A2)) REPEAT(PH_A2) { REPBAR();
        ArgsP A = fresh_args(); unsigned char* ws = A->ws; const int G = fresh_gx(), bx = fresh_bx(); const int vcu = (G % 8 == 0) ? (bx % 8) * (G / 8) + bx / 8 : bx;
        dsa_fast_phase(lds, (const bf16_t*)(ws + WS_QH), (const bf16_t*)(ws + WS_C), (const float*)(ws + WS_PS), (const bf16_t*)(ws + WS_QI), (const bf16_t*)(ws + WS_KI), (const float*)(ws + WS_WI), (const float*)(ws + WS_CSC), (bf16_t*)(ws + WS_AO), vcu, G);
    }
    SEAM(PH_A2);
    if (IN(PH_A3)) REPEAT(PH_A3) { REPBAR();
        ArgsP A = fresh_args(); unsigned char* ws = A->ws;
        pg8::Gemm g{(const bf16_t*)(ws + WS_AO), (const bf16_t*)(ws + WS_WAOUT), M, 1024, 1024}; pg8::StaticOrder S; S.init(M, 1024, fresh_gx(), fresh_bx());
        pg8::EpiRes<0> E{A->in[0], nullptr, (bf16_t*)(ws + WS_XB), (float*)(ws + WS_SS)};
        pg8::gemm_phase(lds, g, S, E);
    }
    SEAM(PH_A3);
#define FFN_PHASES(LAYER, PH1, PH2) do { \
        if (IN(PH1)) REPEAT(PH1) { REPBAR(); \
            ArgsP A = fresh_args(); unsigned char* ws = A->ws; \
            pg8::Gemm g{(const bf16_t*)(ws + WS_XB), (const bf16_t*)(ws + ((LAYER) ? WS_WFUP1 : WS_WFUP0)), M, FF2, 1024}; pg8::StaticOrder S; S.init(M, FF2, fresh_gx(), fresh_bx()); \
            pg8::EpiF1 E{(const float*)(ws + WS_SS), A->in[13] + (size_t)(LAYER) * 3 * FF2, A->in[14] + (size_t)(LAYER) * FF2, (bf16_t*)(ws + ((LAYER) ? WS_H1 : WS_H0)), \
                         (float*)(ws + ((LAYER) ? WS_PART1 : WS_PART0)), (float*)(ws + ((LAYER) ? WS_HALO1 : WS_HALO0))}; \
            pg8::gemm_phase(lds, g, S, E); \
        } \
        SEAM(PH1); \
        if (IN(PH2)) { \
            ArgsP A = fresh_args(); unsigned char* ws = A->ws; bf16_t* Hb = (bf16_t*)(ws + ((LAYER) ? WS_H1 : WS_H0)); \
            pg8::Gemm g{Hb, (const bf16_t*)(ws + ((LAYER) ? WS_WFDN1 : WS_WFDN0)), M, 1024, D_FF}; pg8::StaticOrder S; S.init(M, 1024, fresh_gx(), fresh_bx()); \
            {   pg8::Unit u0; if (S.next(0, u0)) ffn_fixup(u0.pm, A->in[13] + (size_t)(LAYER) * 3 * FF2, (const float*)(ws + ((LAYER) ? WS_PART1 : WS_PART0)), (const float*)(ws + ((LAYER) ? WS_HALO1 : WS_HALO0)), Hb); \
                VM_WAIT(); __syncthreads(); } \
            if ((LAYER) == 0) { pg8::EpiRes<1> E{nullptr, nullptr, (bf16_t*)(ws + WS_XB), (float*)(ws + WS_SS)}; pg8::gemm_phase(lds, g, S, E); } \
            else { pg8::EpiRes<2> E{nullptr, A->out, (bf16_t*)(ws + WS_XB), nullptr}; pg8::gemm_phase(lds, g, S, E); } \
        } \
        SEAM(PH2); } while (0)
    FFN_PHASES(0, PH_F1A, PH_F2A);
    if (IN(PH_B1)) REPEAT(PH_B1) { REPBAR();
        ArgsP A = fresh_args(); unsigned char* ws = A->ws;
        pg8::Gemm g{(const bf16_t*)(ws + WS_XB), (const bf16_t*)(ws + WS_WBIN), M, 4096, 1024}; pg8::StaticOrder S; S.init(M, 4096, fresh_gx(), fresh_bx());
        pg8::EpiB1 E{(const float*)(ws + WS_SS), (const float2*)(ws + WS_ROPE), (bf16_t*)(ws + WS_QT), (bf16_t*)(ws + WS_KT), (bf16_t*)(ws + WS_VT)};
        pg8::gemm_phase(lds, g, S, E);
    }
    SEAM(PH_B1);
    if (IN(PH_B2)) REPEAT(PH_B2) { REPBAR();
        ArgsP A = fresh_args(); unsigned char* ws = A->ws;
        { const int G = fresh_gx(), bx = fresh_bx(); const int vcu = (G % 8 == 0) ? (bx % 8) * (G / 8) + bx / 8 : bx;
          for (int u = vcu; u < 256; u += G) ret_fast_phase(lds, (const bf16_t*)(ws + WS_QT), (const bf16_t*)(ws + WS_KT), (const bf16_t*)(ws + WS_VT), (bf16_t*)(ws + WS_RET), (float*)(ws + WS_SSR), u); }
    }
    SEAM(PH_B2);
    if (IN(PH_GATE)) REPEAT(PH_GATE) { REPBAR();
        {   ArgsP A = fresh_args(); unsigned char* ws = A->ws;
            pg8::Gemm g{(const bf16_t*)(ws + WS_XB), (const bf16_t*)(ws + WS_WBIN) + (size_t)4096 * 1024, M, 2048, 1024}; pg8::StaticOrder S; S.init(M, 2048, fresh_gx(), fresh_bx());
            pg8::EpiGate E{(const float*)(ws + WS_SS), (const float*)(ws + WS_SSR), (bf16_t*)(ws + WS_RET)};
            pg8::gemm_phase(lds, g, S, E); }
#if !defined(NO_WCONV2)
        {   GWS; ArgsP A = fresh_args(); unsigned char* ws = A->ws; constexpr int J0 = 16 * 88, J1 = J0 + 44 * 16;
#pragma unroll 1
            for (int it = gw; it < J1; it += NGW) {
                if (it < J0) p0_transpose_item(A->in[12] + (size_t)1024 * FF2, 1024, FF2, FF2, WM_FUP, A->in[2] + 1024, (bf16_t*)(ws + WS_WFUP1), scr, it, lane);
                else p0_transpose_item(A->in[15] + (size_t)2816 * 1024, 2816, 1024, 1024, WM_NAT, (const float*)nullptr, (bf16_t*)(ws + WS_WFDN1), scr, it - J0, lane); } }
#endif
    }
    SEAM(PH_GATE);
    if (IN(PH_B3)) REPEAT(PH_B3) { REPBAR();
        ArgsP A = fresh_args(); unsigned char* ws = A->ws;
        pg8::Gemm g{(const bf16_t*)(ws + WS_RET), (const bf16_t*)(ws + WS_WBOUT), M, 1024, 2048}; pg8::StaticOrder S; S.init(M, 1024, fresh_gx(), fresh_bx());
        pg8::EpiRes<1> E{nullptr, nullptr, (bf16_t*)(ws + WS_XB), (float*)(ws + WS_SS)};
        pg8::gemm_phase(lds, g, S, E);
    }
    SEAM(PH_B3);
    FFN_PHASES(1, PH_F1B, PH_F2B);
#undef FFN_PHASES
#undef IN
#undef SEAM
}

extern "C" void kernel_launch(void* const* d_in, const int* in_sizes, int n_in, void* d_out, int out_size, void* d_ws, size_t ws_size, hipStream_t stream) {
    static int grid = 0;
    if (grid == 0) {
        int dev = 0, cus = 0, per_cu = 0;
        (void)hipGetDevice(&dev); (void)hipDeviceGetAttribute(&cus, hipDeviceAttributeMultiprocessorCount, dev);
        (void)hipFuncSetAttribute((const void*)mega, hipFuncAttributeMaxDynamicSharedMemorySize, LDS_BYTES);
        if (hipOccupancyMaxActiveBlocksPerMultiprocessor(&per_cu, (const void*)mega, NWAVES * 64, LDS_BYTES) != hipSuccess || per_cu < 1)
            fprintf(stderr, "kernel_launch: occupancy query reports %d workgroups per CU\n", per_cu);
        (void)hipGetLastError();
        grid = cus > 0 ? cus : 256;
        if (grid != 256) fprintf(stderr, "kernel_launch: %d CUs (built for 256)\n", grid);
    }
    unsigned char* ws = (unsigned char*)d_ws;
    (void)hipMemsetAsync(ws + WS_CTL, 0, CTL_ZERO_BYTES, stream);
    Args a{};
    for (int i = 0; i < 16; ++i) a.in[i] = (const float*)d_in[i];
    a.out = (float*)d_out; a.ws = ws;
    auto launch = [&](int lo, int hi, int li) { a.ph_lo = lo; a.ph_hi = hi; a.li = li; hipLaunchKernelGGL(mega, dim3(grid), dim3(NWAVES * 64), LDS_BYTES, stream, a); };
    launch(0, PH_END, 0);
}
```

```cpp
#include <hip/hip_runtime.h>
#include <stdint.h>
#include <stdio.h>

typedef unsigned short bf16_t;
typedef short bf16x8 __attribute__((ext_vector_type(8)));
typedef float f32x4 __attribute__((ext_vector_type(4)));
typedef unsigned u32x4 __attribute__((ext_vector_type(4)));
typedef unsigned u32x2 __attribute__((ext_vector_type(2)));

#ifndef MK_LAUNCH_MODE
#define MK_LAUNCH_MODE 1
#endif

constexpr int BATCH = 8, SEQ = 2048, DM = 1024, M = BATCH * SEQ;
constexpr int TOPK = 256;
constexpr int A_IN_COLS = 1736, A_IN_PAD = 1792;
constexpr int O2 = 1152, O3 = 1664, O4 = 1728;
constexpr int B_IN_COLS = 6144;
constexpr int D_FF = 2816, FF2 = 5632;
constexpr float EPS = 1e-6f;

constexpr size_t MiB = 1u << 20;
constexpr size_t WS_CTL = 0, CTL_ZERO_BYTES = 65536;
constexpr size_t WS_SS = 1 * MiB;
constexpr size_t WS_WI = 2 * MiB;
constexpr size_t WS_CSC = 2 * MiB + 512 * 1024;
constexpr size_t WS_ROPE = 3 * MiB;
constexpr size_t WS_SSR = 249 * MiB;
constexpr size_t WS_WBIN = 8 * MiB;
constexpr size_t WS_WBOUT = 20 * MiB;
constexpr size_t WS_XB = 24 * MiB;
constexpr size_t WS_WAIN = 56 * MiB;
constexpr size_t WS_WAOUT = 60 * MiB;
constexpr size_t WS_QH = 64 * MiB;
constexpr size_t WS_AO = 96 * MiB;
constexpr size_t WS_QI = 128 * MiB;
constexpr size_t WS_C = 144 * MiB;
constexpr size_t WS_KI = 148 * MiB;
constexpr size_t WS_PS = 150 * MiB;
constexpr size_t WS_WFUP0 = 232 * MiB;
constexpr size_t WS_WFDN0 = 243 * MiB;
constexpr size_t WS_H0 = 64 * MiB;
constexpr size_t WS_PART0 = 152 * MiB;
constexpr size_t WS_HALO0 = 155 * MiB;
constexpr size_t WS_QT = 56 * MiB;
constexpr size_t WS_KT = 88 * MiB;
constexpr size_t WS_VT = 120 * MiB;
constexpr size_t WS_RET = 184 * MiB;
constexpr size_t WS_WFUP1 = 56 * MiB;
constexpr size_t WS_WFDN1 = 67 * MiB;
constexpr size_t WS_H1 = 88 * MiB;
constexpr size_t WS_PART1 = 176 * MiB;
constexpr size_t WS_HALO1 = 179 * MiB;

__device__ __forceinline__ unsigned short f2bf(float f) { unsigned u = __float_as_uint(f); return (unsigned short)((u + 0x7fffu + ((u >> 16) & 1u)) >> 16); }
__device__ __forceinline__ float bf2f(unsigned short h) { return __uint_as_float(((unsigned)h) << 16); }
__device__ __forceinline__ float bflo(unsigned w) { return __uint_as_float(w << 16); }
__device__ __forceinline__ float bfhi(unsigned w) { return __uint_as_float(w & 0xffff0000u); }
typedef __bf16 bf16x2_t __attribute__((ext_vector_type(2)));
typedef float f32x2_t __attribute__((ext_vector_type(2)));
__device__ __forceinline__ unsigned pk2(float lo, float hi) { const f32x2_t v = {lo, hi}; return __builtin_bit_cast(unsigned, __builtin_convertvector(v, bf16x2_t)); }
__device__ __forceinline__ float wave_sum(float v) {
#pragma unroll
    for (int o = 1; o < 64; o <<= 1) v += __shfl_xor(v, o);
    return v;
}
__device__ __forceinline__ float siluf(float x) { return x * __builtin_amdgcn_rcpf(1.0f + __builtin_amdgcn_exp2f(-1.4426950408889634f * x)); }
__device__ __forceinline__ float gamma_log(int h) { return h == 0 ? -0.031748698314580301f : h == 1 ? -0.015748356968139168f : h == 2 ? -0.0078431774610258787f : -0.0039138993211363287f; }

enum { WM_NAT = 0, WM_AIN = 1, WM_FUP = 2 };
__device__ __forceinline__ int wmap(int mode, int n) {
    if (mode == WM_NAT) return n;
    if (mode == WM_AIN) {
        if (n < 1152) return n;
        if (n < 1216) return O3 + (n - 1152);
        if (n < 1224) return O4 + (n - 1216);
        if (n < 1280) return -1;
        return O2 + (n - 1280);
    }
    const int p = n >> 8, bj = (n >> 7) & 1, i = n & 127;
    return bj * D_FF + 128 * p + i;
}

namespace pg8 {
#define PG8_LAS __attribute__((address_space(3)))
constexpr int BM = 256, BK = 64, HALF = 128, HTB = HALF * BK * 2, STAGE_BYTES = 8 * HTB, NXCD = 8, WGM = 8;
constexpr int XCH_OFF = 0, CWT_OFF = 2048, RT1_OFF = 6144, RT2_OFF = 14336;
__host__ __device__ __forceinline__ int lds_byte(int r, int c) { const int st = (r >> 4) * 2 + (c >> 5), rr = r & 15, cc = c & 31, ob = rr * 64 + cc * 2; return st * 1024 + (ob ^ (((ob >> 9) & 1) << 5)); }
__host__ __device__ __forceinline__ void stage_rc(int b, int& R, int& C) { const int st = b / 1024, sb = b % 1024, swz = sb ^ (((sb >> 9) & 1) << 5); R = (st >> 1) * 16 + swz / 64; C = (st & 1) * 32 + (swz % 64) / 2; }
__host__ __device__ __forceinline__ int perm32(int rho) { const int n = rho >> 4, i = rho & 15; return 8 * (i >> 2) + 4 * n + (i & 3); }
struct Unit { int pm, pn; };
struct Gemm { const bf16_t* A; const bf16_t* Bt; int M, N, K; };
struct StaticOrder {
    int nM, nN, nwg, G, c;
    __host__ __device__ __forceinline__ void init(int M_, int N_, int G_, int c_) { nM = M_ / BM; nN = N_ / BM; nwg = nM * nN; G = G_; c = c_; }
    __host__ __device__ __forceinline__ bool next(int i, Unit& u) const {
        const long L = (long)i * G + c; if (L >= nwg) return false;
        int wgid = (int)L; { const int q = nwg / NXCD, r = nwg % NXCD, xcd = wgid % NXCD, off = wgid / NXCD; wgid = (xcd < r ? xcd * (q + 1) : r * (q + 1) + (xcd - r) * q) + off; }
        const int nig = WGM * nN, gid = wgid / nig, fm = gid * WGM, gsz = (nM - fm) < WGM ? (nM - fm) : WGM;
        u.pm = fm + ((wgid % nig) % gsz); u.pn = (wgid % nig) / gsz; return true;
    }
};
__device__ __forceinline__ float rstd16(const float* ss16, int row) {
    float s = 0.f;
#pragma unroll
    for (int g = 0; g < 16; ++g) s += ss16[(size_t)g * M + row];
    return rsqrtf(s * (1.0f / DM) + EPS);
}
__device__ __forceinline__ float sel4(const float (&s)[4], int fq) { return fq == 0 ? s[0] : fq == 1 ? s[1] : fq == 2 ? s[2] : s[3]; }
__device__ __forceinline__ float ssq8(const f32x4 a, const f32x4 b) { return ((a[0] * a[0] + a[1] * a[1]) + (a[2] * a[2] + a[3] * a[3])) + ((b[0] * b[0] + b[1] * b[1]) + (b[2] * b[2] + b[3] * b[3])); }
__device__ __forceinline__ u32x4 pack8(const f32x4 a, const f32x4 b) { u32x4 w; w.x = pk2(a[0], a[1]); w.y = pk2(a[2], a[3]); w.z = pk2(b[0], b[1]); w.w = pk2(b[2], b[3]); return w; }

template <int MODE>
struct EpiRes {
    static constexpr bool PERM = true;
    static constexpr bool AROWPERM = false;
    const float* basef; float* out; bf16_t* xb; float* ss16;
    static constexpr int NTAB = 0;
    __device__ __forceinline__ void fill(PG8_LAS unsigned char*, int, const Unit&, int) const {}
    __device__ __forceinline__ void operator()(f32x4 (&acc)[2][2][4][2], const Unit& u, int ui, int wr, int wc, int fr, int fq, PG8_LAS unsigned char*) const {
        const int row0 = u.pm * BM + wr * 64 + fr, colb = u.pn * BM + wc * 32 + 8 * fq;
#pragma unroll
        for (int ai = 0; ai < 2; ++ai) {
            f32x4 bv[4][2][2];
#pragma unroll
            for (int m = 0; m < 4; ++m)
#pragma unroll
                for (int bj = 0; bj < 2; ++bj) { const size_t o = (size_t)(row0 + ai * HALF + m * 16) * DM + colb + bj * HALF;
                    if (MODE == 0) { bv[m][bj][0] = *(const f32x4*)(basef + o); bv[m][bj][1] = *(const f32x4*)(basef + o + 4); }
                    else { const u32x4 w = *(const u32x4*)(xb + o); bv[m][bj][0] = (f32x4){bflo(w.x), bfhi(w.x), bflo(w.y), bfhi(w.y)}; bv[m][bj][1] = (f32x4){bflo(w.z), bfhi(w.z), bflo(w.w), bfhi(w.w)}; } }
            float sm[4];
#pragma unroll
            for (int m = 0; m < 4; ++m) { const int row = row0 + ai * HALF + m * 16; float s = 0.f;
#pragma unroll
                for (int bj = 0; bj < 2; ++bj) { const size_t o = (size_t)row * DM + colb + bj * HALF;
                    const f32x4 v0 = acc[ai][bj][m][0] + bv[m][bj][0], v1 = acc[ai][bj][m][1] + bv[m][bj][1];
                    if (MODE == 2) { *(f32x4*)(out + o) = v0; *(f32x4*)(out + o + 4) = v1; }
                    else { s += ssq8(v0, v1); *(u32x4*)(xb + o) = pack8(v0, v1); } }
                if (MODE != 2) { s += __shfl_xor(s, 16); s += __shfl_xor(s, 32); }
                sm[m] = s; }
            if (MODE != 2) ss16[(size_t)(u.pn * 4 + wc) * M + u.pm * BM + ai * HALF + wr * 64 + 16 * fq + fr] = sel4(sm, fq);
            asm volatile("" ::: "memory"); }
    }
};
struct EpiA1 {
    static constexpr bool PERM = true;
    static constexpr bool AROWPERM = false;
    const float* ss16; const float* csc; bf16_t* Q; bf16_t* C; bf16_t* KI; bf16_t* QI; float* WI; float* PS;
    static constexpr int NTAB = 1;
    __device__ __forceinline__ void fill(PG8_LAS unsigned char* xl, int i, const Unit& u, int t) const { ((PG8_LAS float*)(xl + RT1_OFF))[i * 256 + t] = rstd16(ss16, u.pm * BM + t); }
    __device__ __forceinline__ void operator()(f32x4 (&acc)[2][2][4][2], const Unit& u, int ui, int wr, int wc, int fr, int fq, PG8_LAS unsigned char* xl) const {
        const int row0 = u.pm * BM + wr * 64 + fr, pn = u.pn;
        const PG8_LAS float* rt = (const PG8_LAS float*)(xl + RT1_OFF) + ui * 256 + wr * 64 + fr;
        float rs[2][4];
#pragma unroll
        for (int ai = 0; ai < 2; ++ai)
#pragma unroll
            for (int m = 0; m < 4; ++m) rs[ai][m] = rt[ai * HALF + m * 16];
#pragma unroll
        for (int bj = 0; bj < 2; ++bj) {
            const int cl = bj * HALF + wc * 32 + 8 * fq, gcol = pn * BM + cl;
            const f32x4 c0 = *(const f32x4*)(csc + gcol), c1 = *(const f32x4*)(csc + gcol + 4);
            bf16_t* dst; int ld; bool st16 = true, stwi = false;
            if (pn < 4) { dst = Q + gcol; ld = 1024; }
            else if (pn == 4) { if (bj == 0) { dst = C + cl; ld = 128; } else if (wc < 2) { dst = KI + (wc * 32 + 8 * fq); ld = 64; } else { dst = Q; ld = 0; st16 = false; stwi = (wc == 2) && (fq == 0); } }
            else { dst = QI + (pn - 5) * 256 + cl; ld = 512; }
#pragma unroll
            for (int ai = 0; ai < 2; ++ai) { float sm[4];
#pragma unroll
                for (int m = 0; m < 4; ++m) { const int row = row0 + ai * HALF + m * 16; const float r = rs[ai][m];
                    const f32x4 v0 = acc[ai][bj][m][0] * r, v1 = acc[ai][bj][m][1] * r;
                    float s = ssq8(v0, v1); s += __shfl_xor(s, 16); s += __shfl_xor(s, 32); sm[m] = s;
                    const f32x4 o0 = v0 * c0, o1 = v1 * c1;
                    if (st16) *(u32x4*)(dst + (size_t)row * ld) = pack8(o0, o1);
                    if (stwi) { *(f32x4*)(WI + (size_t)row * 8) = o0; *(f32x4*)(WI + (size_t)row * 8 + 4) = o1; }
                    if (m & 1) asm volatile("" ::: "memory"); }
                PS[(size_t)(pn * 8 + bj * 4 + wc) * M + u.pm * BM + ai * HALF + wr * 64 + 16 * fq + fr] = sel4(sm, fq); }
        }
    }
};
struct EpiF1 {
    static constexpr bool PERM = false;
    static constexpr bool AROWPERM = true;
    static constexpr int NTAB = 1;
    const float* ss16; const float* cw; const float* cb; bf16_t* H; float* PART; float* HALO;
    __device__ __forceinline__ void fill(PG8_LAS unsigned char* xl, int i, const Unit& u, int t) const { ((PG8_LAS float*)(xl + RT1_OFF))[i * 256 + t] = rstd16(ss16, u.pm * BM + t); }
    __device__ __forceinline__ void operator()(f32x4 (&acc)[2][2][4][2], const Unit& u, int ui, int wr, int wc, int fr, int fq, PG8_LAS unsigned char* xl) const {
        const int trow0 = 8 * (16 * wr + fr), grow0 = u.pm * BM + trow0, hcol = 128 * u.pn + 32 * wc + 4 * fq, tcol = 32 * wc + 4 * fq;
        const PG8_LAS float* rt = (const PG8_LAS float*)(xl + RT1_OFF) + ui * 256 + trow0;
        {   const f32x4 r0 = *(const PG8_LAS f32x4*)rt, r1 = *(const PG8_LAS f32x4*)(rt + 4);
#pragma unroll
            for (int m = 0; m < 4; ++m)
#pragma unroll
                for (int bj = 0; bj < 2; ++bj) { acc[0][bj][m][0] *= r0[m]; acc[0][bj][m][1] *= r0[m]; acc[1][bj][m][0] *= r1[m]; acc[1][bj][m][1] *= r1[m]; } }
        {   PG8_LAS float* cwt = (PG8_LAS float*)(xl + CWT_OFF); const int tid = ((wr * 4 + wc) * 4 + fq) * 16 + fr;
#pragma unroll
            for (int r = 0; r < 2; ++r) { const int idx = tid + r * 512, k = idx >> 8, c = idx & 255, orig = (c < 128) ? 128 * u.pn + c : D_FF + 128 * u.pn + (c - 128);
                cwt[idx] = (k < 3) ? cw[(size_t)k * FF2 + orig] : cb[orig]; } }
        PG8_LAS f32x4* X = (PG8_LAS f32x4*)(xl + XCH_OFF) + (wc * 4 + fq) * 8;
        if (wr == 0 && fr == 15) {
#pragma unroll
            for (int bj = 0; bj < 2; ++bj)
#pragma unroll
                for (int e = 0; e < 2; ++e)
#pragma unroll
                    for (int n = 0; n < 2; ++n) X[(bj * 2 + e) * 2 + n] = acc[1][bj][2 + e][n];
        }
        asm volatile("s_waitcnt vmcnt(0) lgkmcnt(0)" ::: "memory"); __builtin_amdgcn_s_barrier(); asm volatile("" ::: "memory");
        const bool need_fix = (wr == 0) && (fr == 0) && ((u.pm & 7) != 0);
        const bool give_halo = (wr == 1) && (fr == 15);
        const bool take_x = (wr == 1) && (fr == 0);
        float* part = PART + (size_t)u.pm * (2 * 2 * D_FF) + hcol;
        float* halo = HALO + (size_t)u.pm * (2 * 2 * D_FF) + hcol;
        const PG8_LAS float* cwt = (const PG8_LAS float*)(xl + CWT_OFF) + tcol;
#pragma unroll
        for (int n = 0; n < 2; ++n) {
            f32x4 pa[2], pb[2];
#pragma unroll
            for (int e = 0; e < 2; ++e) {
                f32x4 ha = (f32x4){0.f, 0.f, 0.f, 0.f}, hb = (f32x4){0.f, 0.f, 0.f, 0.f};
                if (take_x) { ha = X[(0 * 2 + e) * 2 + n]; hb = X[(1 * 2 + e) * 2 + n]; }
#pragma unroll
                for (int j = 0; j < 4; ++j) {
                    pa[e][j] = __int_as_float(__builtin_amdgcn_update_dpp(__float_as_int(ha[j]), __float_as_int(acc[1][0][2 + e][n][j]), 0x111, 0xf, 0xf, false));
                    pb[e][j] = __int_as_float(__builtin_amdgcn_update_dpp(__float_as_int(hb[j]), __float_as_int(acc[1][1][2 + e][n][j]), 0x111, 0xf, 0xf, false)); } }
            const f32x4 wa0 = *(const PG8_LAS f32x4*)(cwt + 16 * n), wa1 = *(const PG8_LAS f32x4*)(cwt + 256 + 16 * n), wa2 = *(const PG8_LAS f32x4*)(cwt + 512 + 16 * n), ba = *(const PG8_LAS f32x4*)(cwt + 768 + 16 * n);
            const f32x4 wb0 = *(const PG8_LAS f32x4*)(cwt + 128 + 16 * n), wb1 = *(const PG8_LAS f32x4*)(cwt + 384 + 16 * n), wb2 = *(const PG8_LAS f32x4*)(cwt + 640 + 16 * n), bb = *(const PG8_LAS f32x4*)(cwt + 896 + 16 * n);
            if (give_halo) {
                *(f32x4*)(halo + 16 * n) = acc[1][0][2][n]; *(f32x4*)(halo + D_FF + 16 * n) = acc[1][1][2][n];
                *(f32x4*)(halo + 2 * D_FF + 16 * n) = acc[1][0][3][n]; *(f32x4*)(halo + 3 * D_FF + 16 * n) = acc[1][1][3][n]; }
            u32x2 wprev = (u32x2){0u, 0u};
#pragma unroll
            for (int e = 0; e < 8; ++e) {
                const f32x4 ua = acc[e >> 2][0][e & 3][n], ub = acc[e >> 2][1][e & 3][n];
                const f32x4 ua1 = e >= 1 ? acc[(e - 1) >> 2][0][(e - 1) & 3][n] : pa[1], ub1 = e >= 1 ? acc[(e - 1) >> 2][1][(e - 1) & 3][n] : pb[1];
                const f32x4 ua2 = e >= 2 ? acc[(e - 2) >> 2][0][(e - 2) & 3][n] : pa[e], ub2 = e >= 2 ? acc[(e - 2) >> 2][1][(e - 2) & 3][n] : pb[e];
                const f32x4 av = ba + wa2 * ua + wa1 * ua1 + wa0 * ua2, bv = bb + wb2 * ub + wb1 * ub1 + wb0 * ub2;
                if (e < 2 && need_fix) { *(f32x4*)(part + (size_t)e * 2 * D_FF + 16 * n) = av; *(f32x4*)(part + (size_t)e * 2 * D_FF + D_FF + 16 * n) = bv; }
                u32x2 w; w.x = pk2(siluf(av[0]) * bv[0], siluf(av[1]) * bv[1]); w.y = pk2(siluf(av[2]) * bv[2], siluf(av[3]) * bv[3]);
                if ((e & 1) == 0) wprev = w;
                else {
                    const auto sx = __builtin_amdgcn_permlane16_swap(wprev.x, w.x, false, false), sy = __builtin_amdgcn_permlane16_swap(wprev.y, w.y, false, false);
                    u32x4 w4; w4.x = sx[0]; w4.y = sy[0]; w4.z = sx[1]; w4.w = sy[1];
                    *(u32x4*)(H + (size_t)(grow0 + e - 1 + (fq & 1)) * D_FF + 128 * u.pn + 32 * wc + 16 * n + 4 * (fq & 2)) = w4; }
            }
            asm volatile("" ::: "memory");
        }
    }
};
struct EpiB1 {
    static constexpr bool PERM = false;
    static constexpr bool AROWPERM = true;
    static constexpr int NTAB = 1;
    const float* ss16; const float2* rope; bf16_t* QT; bf16_t* KT; bf16_t* VT;
    __device__ __forceinline__ void fill(PG8_LAS unsigned char* xl, int i, const Unit& u, int t) const { ((PG8_LAS float*)(xl + RT1_OFF))[i * 256 + t] = rstd16(ss16, u.pm * BM + t); }
    __device__ __forceinline__ void operator()(f32x4 (&acc)[2][2][4][2], const Unit& u, int ui, int wr, int wc, int fr, int fq, PG8_LAS unsigned char* xl) const {
        const int trow0 = 8 * (16 * wr + fr), grow0 = u.pm * BM + trow0, pn = u.pn, t0 = grow0 & (SEQ - 1);
        const PG8_LAS float* rt = (const PG8_LAS float*)(xl + RT1_OFF) + ui * 256 + trow0;
        const f32x4 r0 = *(const PG8_LAS f32x4*)rt, r1 = *(const PG8_LAS f32x4*)(rt + 4);
        if (pn < 8) {
            const int h = pn & 3; const bool isk = pn >= 4; const float lg = gamma_log(h);
            bf16_t* dbase = (isk ? KT : QT) + (size_t)grow0 * 1024 + h * 256 + 32 * wc + 4 * (fq & 2);
            float sc[8];
#pragma unroll
            for (int e = 0; e < 8; ++e) { const int pos = (t0 + e) & 63; sc[e] = (e < 4 ? r0[e & 3] : r1[e & 3]) * (isk ? 0.0625f * __expf(-(float)(pos + 1) * lg) : __expf((float)(pos + 1) * lg)); }
#pragma unroll
            for (int n = 0; n < 2; ++n) {
                const int i0 = 32 * wc + 16 * n + 4 * fq;
                f32x4 cur[2], dw[2];
                {   const f32x4* rp = (const f32x4*)(rope + (size_t)t0 * 128 + i0); const f32x4* rw = (const f32x4*)(rope + (size_t)128 + i0); cur[0] = rp[0]; cur[1] = rp[1]; dw[0] = rw[0]; dw[1] = rw[1]; }
                u32x2 p1 = (u32x2){0u, 0u}, p2 = (u32x2){0u, 0u};
#pragma unroll
                for (int e = 0; e < 8; ++e) {
                    const f32x4 c0 = cur[0], c1 = cur[1];
                    const f32x4 x1 = acc[e >> 2][0][e & 3][n] * sc[e], x2 = acc[e >> 2][1][e & 3][n] * sc[e];
                    f32x4 o1, o2;
                    o1[0] = x1[0] * c0[0] - x2[0] * c0[1]; o2[0] = x1[0] * c0[1] + x2[0] * c0[0];
                    o1[1] = x1[1] * c0[2] - x2[1] * c0[3]; o2[1] = x1[1] * c0[3] + x2[1] * c0[2];
                    o1[2] = x1[2] * c1[0] - x2[2] * c1[1]; o2[2] = x1[2] * c1[1] + x2[2] * c1[0];
                    o1[3] = x1[3] * c1[2] - x2[3] * c1[3]; o2[3] = x1[3] * c1[3] + x2[3] * c1[2];
                    u32x2 w1, w2; w1.x = pk2(o1[0], o1[1]); w1.y = pk2(o1[2], o1[3]); w2.x = pk2(o2[0], o2[1]); w2.y = pk2(o2[2], o2[3]);
                    if ((e & 1) == 0) { p1 = w1; p2 = w2; }
                    else {
                        const auto ax = __builtin_amdgcn_permlane16_swap(p1.x, w1.x, false, false), ay = __builtin_amdgcn_permlane16_swap(p1.y, w1.y, false, false);
                        const auto bx = __builtin_amdgcn_permlane16_swap(p2.x, w2.x, false, false), by = __builtin_amdgcn_permlane16_swap(p2.y, w2.y, false, false);
                        bf16_t* d = dbase + (size_t)(e - 1 + (fq & 1)) * 1024 + 16 * n;
                        u32x4 v1; v1.x = ax[0]; v1.y = ay[0]; v1.z = ax[1]; v1.w = ay[1]; *(u32x4*)d = v1;
                        u32x4 v2; v2.x = bx[0]; v2.y = by[0]; v2.z = bx[1]; v2.w = by[1]; *(u32x4*)(d + 128) = v2; }
                    if (e < 7) {
#pragma unroll
                        for (int q = 0; q < 2; ++q) { const f32x4 c = cur[q], dd = dw[q]; f32x4 nx;
                            nx[0] = c[0] * dd[0] - c[1] * dd[1]; nx[1] = c[1] * dd[0] + c[0] * dd[1]; nx[2] = c[2] * dd[2] - c[3] * dd[3]; nx[3] = c[3] * dd[2] + c[2] * dd[3]; cur[q] = nx; } }
                }
                asm volatile("" ::: "memory");
            }
        } else {
            const int b = grow0 / SEQ;
            bf16_t* dst = VT + ((size_t)b * 2048 + (pn - 8) * 256 + 32 * wc + 4 * fq) * SEQ + t0;
#pragma unroll
            for (int bj = 0; bj < 2; ++bj)
#pragma unroll
                for (int n = 0; n < 2; ++n)
#pragma unroll
                    for (int j = 0; j < 4; ++j) { u32x4 w;
                        w.x = pk2(acc[0][bj][0][n][j] * r0[0], acc[0][bj][1][n][j] * r0[1]); w.y = pk2(acc[0][bj][2][n][j] * r0[2], acc[0][bj][3][n][j] * r0[3]);
                        w.z = pk2(acc[1][bj][0][n][j] * r1[0], acc[1][bj][1][n][j] * r1[1]); w.w = pk2(acc[1][bj][2][n][j] * r1[2], acc[1][bj][3][n][j] * r1[3]);
                        *(u32x4*)(dst + (size_t)(128 * bj + 16 * n + j) * SEQ) = w; }
        }
    }
};
struct EpiGate {
    static constexpr bool PERM = true;
    static constexpr bool AROWPERM = false;
    static constexpr int NTAB = 1;
    const float* ss16; const float* ssr; bf16_t* RET;
    __device__ __forceinline__ void fill(PG8_LAS unsigned char* xl, int i, const Unit& u, int t) const {
        const int row = u.pm * BM + t;
        ((PG8_LAS float*)(xl + RT1_OFF))[i * 256 + t] = rstd16(ss16, row);
        const f32x4* sp = (const f32x4*)(ssr + ((size_t)row * 4 + (u.pn >> 1)) * 16); const f32x4 s0 = sp[0], s1 = sp[1], s2 = sp[2], s3 = sp[3];
        ((PG8_LAS float*)(xl + RT2_OFF))[i * 256 + t] = rsqrtf(((((s0[0] + s0[1]) + (s0[2] + s0[3])) + ((s1[0] + s1[1]) + (s1[2] + s1[3]))) + (((s2[0] + s2[1]) + (s2[2] + s2[3])) + ((s3[0] + s3[1]) + (s3[2] + s3[3])))) * (1.0f / 512.0f) + EPS);
    }
    __device__ __forceinline__ void operator()(f32x4 (&acc)[2][2][4][2], const Unit& u, int ui, int wr, int wc, int fr, int fq, PG8_LAS unsigned char* xl) const {
        const int row0 = u.pm * BM + wr * 64 + fr, colb = u.pn * BM + wc * 32 + 8 * fq;
        const PG8_LAS float* rt = (const PG8_LAS float*)(xl + RT1_OFF) + ui * 256 + wr * 64 + fr;
        const PG8_LAS float* rt2 = (const PG8_LAS float*)(xl + RT2_OFF) + ui * 256 + wr * 64 + fr;
        u32x4 rvv[2][4][2];
#pragma unroll
        for (int ai = 0; ai < 2; ++ai)
#pragma unroll
            for (int m = 0; m < 4; ++m)
#pragma unroll
                for (int bj = 0; bj < 2; ++bj) rvv[ai][m][bj] = *(const u32x4*)(RET + (size_t)(row0 + ai * HALF + m * 16) * 2048 + colb + bj * HALF);
#pragma unroll
        for (int ai = 0; ai < 2; ++ai)
#pragma unroll
            for (int m = 0; m < 4; ++m) { const int row = row0 + ai * HALF + m * 16; const float r = rt[ai * HALF + m * 16], rh = rt2[ai * HALF + m * 16];
#pragma unroll
                for (int bj = 0; bj < 2; ++bj) { bf16_t* p = RET + (size_t)row * 2048 + colb + bj * HALF; const u32x4 rv = rvv[ai][m][bj];
                    const f32x4 g0 = acc[ai][bj][m][0] * r, g1 = acc[ai][bj][m][1] * r; f32x4 y0, y1;
                    y0[0] = bflo(rv.x) * rh * siluf(g0[0]); y0[1] = bfhi(rv.x) * rh * siluf(g0[1]); y0[2] = bflo(rv.y) * rh * siluf(g0[2]); y0[3] = bfhi(rv.y) * rh * siluf(g0[3]);
                    y1[0] = bflo(rv.z) * rh * siluf(g1[0]); y1[1] = bfhi(rv.z) * rh * siluf(g1[1]); y1[2] = bflo(rv.w) * rh * siluf(g1[2]); y1[3] = bfhi(rv.w) * rh * siluf(g1[3]);
                    *(u32x4*)p = pack8(y0, y1); } }
    }
};

template <class Epi, class Sched>
__device__ __forceinline__ void gemm_phase(PG8_LAS unsigned char* lds, const Gemm g, const Sched& S, const Epi& E) {
    int tid_ = threadIdx.x; asm volatile("" : "+v"(tid_));
    const int tid = tid_, wid = __builtin_amdgcn_readfirstlane(tid >> 6), lane = tid & 63, wr = wid >> 2, wc = wid & 3, fr = lane & 15, fq = lane >> 4;
    const int K = g.K, nt = K / BK;
    unsigned voffA0[2], voffA1[2], voffB[2];
#pragma unroll
    for (int i = 0; i < 2; ++i) { int R, C; stage_rc(tid * 16 + i * 8192, R, C); const int Rb = Epi::PERM ? (R & ~31) + perm32(R & 31) : R;
        int ra0, ra1;
        if (Epi::AROWPERM) { const int base = ((R >> 6) * 16 + (R & 15)) * 8 + ((R >> 4) & 3); ra0 = base; ra1 = base + 4; } else { ra0 = R; ra1 = R + HALF; }
        voffA0[i] = (unsigned)(ra0 * K + C) * 2u; voffA1[i] = (unsigned)(ra1 * K + C) * 2u; voffB[i] = (unsigned)(Rb * K + C) * 2u; }
    const size_t kstep = (size_t)(BK * 2);
    const size_t hstep = (size_t)HALF * K * 2;
    const size_t tstep = 2 * hstep;
    const unsigned ldsw = (unsigned)wid * 1024u;
    const int aoff = lds_byte(wr * 64 + fr, fq * 8), boff = lds_byte(wc * 32 + fr, fq * 8);
#define PG8_SA(b, h) (((b) * 2 + (h)) * HTB)
#define PG8_SB(b, h) ((4 + (b) * 2 + (h)) * HTB)
#define PG8_STAGE(bufoff, gbase, voff) do { _Pragma("unroll") for (int _i = 0; _i < 2; ++_i) \
        __builtin_amdgcn_global_load_lds((const unsigned*)((const char*)(gbase) + (voff)[_i]), (PG8_LAS unsigned*)(lds + (bufoff) + ldsw + _i * 8192), 16, 0, 0); } while (0)
#define PG8_LDA(dst, b, h) do { _Pragma("unroll") for (int m = 0; m < 4; ++m) _Pragma("unroll") for (int k = 0; k < 2; ++k) dst[m][k] = *(const PG8_LAS bf16x8*)(lds + PG8_SA(b, h) + aoff + m * 2048 + k * 1024); } while (0)
#define PG8_LDB(dst, b, h) do { _Pragma("unroll") for (int n = 0; n < 2; ++n) _Pragma("unroll") for (int k = 0; k < 2; ++k) dst[n][k] = *(const PG8_LAS bf16x8*)(lds + PG8_SB(b, h) + boff + n * 2048 + k * 1024); } while (0)
#define PG8_MMA(ai, bj, At, Bt) do { __builtin_amdgcn_s_setprio(1); _Pragma("unroll") for (int m = 0; m < 4; ++m) _Pragma("unroll") for (int n = 0; n < 2; ++n) _Pragma("unroll") for (int k = 0; k < 2; ++k) \
        acc[ai][bj][m][n] = __builtin_amdgcn_mfma_f32_16x16x32_bf16(Bt[n][k], At[m][k], acc[ai][bj][m][n], 0, 0, 0); __builtin_amdgcn_s_setprio(0); } while (0)
#define PG8_WAIT_V(n) asm volatile("s_waitcnt vmcnt(" #n ")" ::: "memory")
#define PG8_WAIT_L(n) asm volatile("s_waitcnt lgkmcnt(" #n ")" ::: "memory")
#define PG8_BAR __builtin_amdgcn_s_barrier()
#define PG8_SCHED __builtin_amdgcn_sched_barrier(0)
    Unit cur, nxt; int ui = 0;
    if (!S.next(0, cur)) return;
    f32x4 acc[2][2][4][2];
#pragma unroll
    for (int a = 0; a < 2; ++a)
#pragma unroll
        for (int b = 0; b < 2; ++b)
#pragma unroll
            for (int m = 0; m < 4; ++m)
#pragma unroll
                for (int n = 0; n < 2; ++n) acc[a][b][m][n] = (f32x4){0.f, 0.f, 0.f, 0.f};
    bf16x8 At[4][2], B0[2][2], B1[2][2];
    const char* cA = (const char*)g.A + (size_t)cur.pm * tstep; const char* cB = (const char*)g.Bt + (size_t)cur.pn * tstep;
    PG8_STAGE(PG8_SB(0, 0), cB, voffB); PG8_STAGE(PG8_SB(0, 1), cB + hstep, voffB); PG8_STAGE(PG8_SA(0, 0), cA, voffA0); PG8_STAGE(PG8_SA(0, 1), cA, voffA1);
    if constexpr (Epi::NTAB > 0) {
#pragma unroll 1
        for (int i = tid >> 8; i < 8; i += 2) { Unit uu; if (!S.next(i, uu)) break; E.fill(lds + STAGE_BYTES, i, uu, tid & 255); asm volatile("" ::: "memory"); }
        asm volatile("s_waitcnt lgkmcnt(0)" ::: "memory");
    }
    if (wr == 1) PG8_BAR;
    PG8_WAIT_V(2); PG8_BAR;
    PG8_STAGE(PG8_SB(1, 0), cB + kstep, voffB); PG8_STAGE(PG8_SA(1, 0), cA + kstep, voffA0); PG8_STAGE(PG8_SB(1, 1), cB + hstep + kstep, voffB);
    PG8_WAIT_V(6); PG8_BAR;
    for (;;) {
        const bool has_next = S.next(ui + 1, nxt);
        const char* nA = has_next ? (const char*)g.A + (size_t)nxt.pm * tstep : cA; const char* nB = has_next ? (const char*)g.Bt + (size_t)nxt.pn * tstep : cB;
        for (int t = 0; t < nt; t += 2) {
            const bool last = (t == nt - 2);
            const char* a1 = cA + (size_t)(t + 1) * kstep;
            const char* a2 = last ? nA : cA + (size_t)(t + 2) * kstep; const char* b2 = last ? nB : cB + (size_t)(t + 2) * kstep;
            const char* a3 = a2 + kstep; const char* b3 = b2 + kstep;
            PG8_LDB(B0, 0, 0); PG8_LDB(B1, 0, 1); PG8_SCHED; PG8_LDA(At, 0, 0); PG8_STAGE(PG8_SA(1, 1), a1, voffA1);
            PG8_WAIT_V(8); PG8_WAIT_L(0); PG8_BAR; PG8_MMA(0, 0, At, B0); PG8_MMA(0, 1, At, B1); PG8_BAR; PG8_SCHED;
            PG8_LDA(At, 0, 1); PG8_STAGE(PG8_SB(0, 0), b2, voffB); PG8_STAGE(PG8_SB(0, 1), b2 + hstep, voffB); PG8_STAGE(PG8_SA(0, 0), a2, voffA0);
            PG8_WAIT_V(8); PG8_WAIT_L(0); PG8_BAR; PG8_MMA(1, 0, At, B0); PG8_MMA(1, 1, At, B1); PG8_BAR; PG8_SCHED;
            PG8_LDB(B0, 1, 0); PG8_LDB(B1, 1, 1); PG8_SCHED; PG8_LDA(At, 1, 0); PG8_STAGE(PG8_SA(0, 1), a2, voffA1);
            PG8_WAIT_V(8); PG8_WAIT_L(0); PG8_BAR; PG8_MMA(0, 0, At, B0); PG8_MMA(0, 1, At, B1); PG8_BAR; PG8_SCHED;
            PG8_LDA(At, 1, 1); PG8_STAGE(PG8_SB(1, 0), b3, voffB); PG8_STAGE(PG8_SB(1, 1), b3 + hstep, voffB); PG8_STAGE(PG8_SA(1, 0), a3, voffA0);
            PG8_WAIT_V(8); PG8_WAIT_L(0); PG8_BAR; PG8_MMA(1, 0, At, B0); PG8_MMA(1, 1, At, B1); PG8_BAR; PG8_SCHED;
        }
        if (wr == 0) PG8_BAR;
        E(acc, cur, ui, wr, wc, fr, fq, lds + STAGE_BYTES);
        if (!has_next) break;
#pragma unroll
        for (int a = 0; a < 2; ++a)
#pragma unroll
            for (int b = 0; b < 2; ++b)
#pragma unroll
                for (int m = 0; m < 4; ++m)
#pragma unroll
                    for (int n = 0; n < 2; ++n) acc[a][b][m][n] = (f32x4){0.f, 0.f, 0.f, 0.f};
        cur = nxt; cA = nA; cB = nB; ++ui;
        if (wr == 1) PG8_BAR;
    }
    PG8_WAIT_V(0);
    PG8_BAR;
#undef PG8_SA
#undef PG8_SB
#undef PG8_STAGE
#undef PG8_LDA
#undef PG8_LDB
#undef PG8_MMA
#undef PG8_WAIT_V
#undef PG8_WAIT_L
#undef PG8_BAR
#undef PG8_SCHED
}
}

constexpr int NWAVES = 8;
constexpr int RING_BYTES = 131072, LDS_BYTES = 163840, LDSCTL_OFF = LDS_BYTES - 512, MISC_OFF = LDSCTL_OFF + 320;
#define GAS __attribute__((address_space(1)))
#define LAS __attribute__((address_space(3)))
typedef GAS unsigned gu32;
#define RLX_AGENT __ATOMIC_RELAXED, __HIP_MEMORY_SCOPE_AGENT
#define LDS_WAIT() asm volatile("s_waitcnt lgkmcnt(0)" ::: "memory")
#define VM_WAIT() asm volatile("s_waitcnt vmcnt(0)" ::: "memory")
constexpr int CW_BAR = 4096;
#define XB_TMO      128
#define XB_XCNT(j)  (256  + 64 * (j))
#define XB_XSUB(j)  (1280 + 64 * (j))
#define XB_XGEN(j)  (2304 + 64 * (j))
#define XB_TOP      3328
#define XB_TOPGEN   3392
#define XCD_BAR_WORDS 3456
#define XB_SPIN_CAP (1u << 18)
__device__ __forceinline__ unsigned xb_ld(unsigned* p)              { return __hip_atomic_load(p, __ATOMIC_RELAXED, __HIP_MEMORY_SCOPE_AGENT); }
__device__ __forceinline__ unsigned xb_add(unsigned* p, unsigned v) { return __hip_atomic_fetch_add(p, v, __ATOMIC_RELAXED, __HIP_MEMORY_SCOPE_AGENT); }
__device__ __forceinline__ unsigned xb_xcc_id() { return (unsigned)__builtin_amdgcn_s_getreg((3 << 11) | 20) & 0xFu; }
#define XB_SPIN(cond, bar) do { unsigned _sp = 0; while (cond) { __builtin_amdgcn_s_sleep(1); \
    if ((++_sp & 255u) == 0u) { if (xb_ld(&(bar)[XB_TMO])) break; if (_sp > XB_SPIN_CAP) { atomicAdd(&(bar)[XB_TMO], 1u); break; } } } } while (0)
struct XcdBarrier { unsigned* bar; unsigned x; volatile LAS unsigned* st; };
__device__ __forceinline__ XcdBarrier xcd_barrier_post(unsigned* bar, volatile LAS unsigned* st) {
    XcdBarrier b; b.bar = bar; b.x = xb_xcc_id(); b.st = st;
    if (threadIdx.x == 0) (void)xb_add(&bar[XB_XCNT(b.x)], 1u);
    return b;
}
__device__ __forceinline__ void xcd_barrier_complete(unsigned* bar, unsigned x, unsigned& nloc, unsigned& nx) {
    const unsigned G = gridDim.x * gridDim.y * gridDim.z;
    unsigned sum, cnt, mine, sp = 0u;
    for (;;) {
        sum = 0u; cnt = 0u; mine = 0u;
#pragma unroll
        for (unsigned j = 0; j < 16; ++j) { const unsigned c = xb_ld(&bar[XB_XCNT(j)]); sum += c; cnt += (c > 0u) ? 1u : 0u; mine = (j == x) ? c : mine; }
        if (sum == G) break;
        __builtin_amdgcn_s_sleep(1);
        if ((++sp & 255u) == 0u) { if (xb_ld(&bar[XB_TMO])) break; if (sp > XB_SPIN_CAP) { atomicAdd(&bar[XB_TMO], 1u); break; } }
    }
    nloc = mine > 0u ? mine : 1u; nx = cnt > 0u ? cnt : 1u;
}
__device__ __forceinline__ void xcd_barrier(const XcdBarrier& b) {
    asm volatile("s_waitcnt vmcnt(0)" ::: "memory");
    __syncthreads();
    if (threadIdx.x == 0) {
        unsigned* bar = b.bar;
        __builtin_amdgcn_s_waitcnt(0);
        unsigned nloc = b.st[0], nx = b.st[1];
        if (nloc == 0u) { xcd_barrier_complete(bar, b.x, nloc, nx); b.st[0] = nloc; b.st[1] = nx; }
        const unsigned old = xb_add(&bar[XB_XSUB(b.x)], 1u);
        const unsigned gen = old / nloc;
        if (old + 1u == (gen + 1u) * nloc) {
            __builtin_amdgcn_fence(__ATOMIC_RELEASE, "agent");
            asm volatile("s_waitcnt vmcnt(0)" ::: "memory");
            const unsigned og = xb_add(&bar[XB_TOP], 1u);
            const unsigned tg = og / nx;
            if (og + 1u == (tg + 1u) * nx) xb_add(&bar[XB_TOPGEN], 1u);
            else XB_SPIN(xb_ld(&bar[XB_TOPGEN]) == tg, bar);
            __builtin_amdgcn_fence(__ATOMIC_ACQUIRE, "agent");
            xb_add(&bar[XB_XGEN(b.x)], 1u);
            asm volatile("s_waitcnt vmcnt(0)" ::: "memory");
        } else {
            XB_SPIN(xb_ld(&bar[XB_XGEN(b.x)]) == gen, bar);
            __builtin_amdgcn_fence(__ATOMIC_ACQUIRE, "agent");
            asm volatile("s_waitcnt vmcnt(0)" ::: "memory");
        }
    }
    __syncthreads();
}

struct Args { const float* in[16]; float* out; unsigned char* ws; int ph_lo, ph_hi, li, pad; };
enum { PH_PRO = 0, PH_A1, PH_A2, PH_A3, PH_F1A, PH_F2A, PH_B1, PH_B2, PH_GATE, PH_B3, PH_F1B, PH_F2B, PH_END };

__device__ __forceinline__ void p0_transpose_item(const float* W, int K, int Nsrc, int N, int mode, const float* gain, bf16_t* WT, LAS float* scr, int item, int lane) {
    const int nblk = N / 64, kb = item / nblk, nb = item % nblk, k0 = 64 * kb, n0 = 64 * nb;
    const int src = wmap(mode, n0 + lane);
    const float* wp = W + (size_t)k0 * Nsrc + (src >= 0 ? src : 0);
#pragma unroll
    for (int h = 0; h < 2; ++h) { float v[32];
#pragma unroll
        for (int i = 0; i < 32; ++i) v[i] = wp[(size_t)(32 * h + i) * Nsrc];
#pragma unroll
        for (int i = 0; i < 32; ++i) { float x = v[i]; if (gain) x *= gain[k0 + 32 * h + i]; if (src < 0) x = 0.f; scr[(32 * h + i) * 65 + lane] = x; } }
    LDS_WAIT(); asm volatile("" ::: "memory");
    const int kq = (lane & 3) * 16;
#pragma unroll
    for (int j = 0; j < 4; ++j) { const int n = (lane >> 2) + 16 * j; const LAS float* sp = scr + kq * 65 + n;
        u32x4 o0, o1;
        o0.x = pk2(sp[0 * 65], sp[1 * 65]); o0.y = pk2(sp[2 * 65], sp[3 * 65]); o0.z = pk2(sp[4 * 65], sp[5 * 65]); o0.w = pk2(sp[6 * 65], sp[7 * 65]);
        o1.x = pk2(sp[8 * 65], sp[9 * 65]); o1.y = pk2(sp[10 * 65], sp[11 * 65]); o1.z = pk2(sp[12 * 65], sp[13 * 65]); o1.w = pk2(sp[14 * 65], sp[15 * 65]);
        bf16_t* dst = WT + (size_t)(n0 + n) * K + k0 + kq; *(u32x4*)dst = o0; *(u32x4*)(dst + 8) = o1; }
    LDS_WAIT(); asm volatile("" ::: "memory");
}
__device__ __forceinline__ void ffn_fixup(int pm, const float* cw, const float* PART, const float* HALO, bf16_t* H) {
    if ((pm & 7) == 0) return;
    int tid = threadIdx.x; asm volatile("" : "+v"(tid));
    const float* part = PART + (size_t)pm * (4 * D_FF); const float* halo = HALO + (size_t)(pm - 1) * (4 * D_FF);
#pragma unroll
    for (int idx0 = 0; idx0 < 2 * D_FF; idx0 += NWAVES * 64) { const int idx = idx0 + tid; const int e = idx / D_FF, c = idx - e * D_FF;
        float a = part[(size_t)e * 2 * D_FF + c], b = part[(size_t)e * 2 * D_FF + D_FF + c];
        const float ha0 = halo[c], hb0 = halo[D_FF + c], ha1 = halo[2 * D_FF + c], hb1 = halo[3 * D_FF + c];
        const float wa0 = cw[c], wa1 = cw[FF2 + c], wb0 = cw[D_FF + c], wb1 = cw[FF2 + D_FF + c];
        if (e == 0) { a += wa1 * ha1 + wa0 * ha0; b += wb1 * hb1 + wb0 * hb0; } else { a += wa0 * ha1; b += wb0 * hb1; }
        H[(size_t)(pm * 256 + e) * D_FF + c] = f2bf(siluf(a) * b); }
}


__device__ __forceinline__ void glds16_asm(const void* gsrc, unsigned lds_dst) {
    unsigned keep; asm volatile("s_mov_b32 %0, m0\n\ts_mov_b32 m0, %2\n\ts_nop 0\n\tglobal_load_lds_dwordx4 %1, off\n\ts_mov_b32 m0, %0" : "=&s"(keep) : "v"(gsrc), "s"(lds_dst) : "memory"); }
__device__ __forceinline__ unsigned lds_addr(LAS unsigned char* p) { return (unsigned)__builtin_amdgcn_readfirstlane((int)(unsigned)(size_t)p); }

typedef short s16x4 __attribute__((ext_vector_type(4)));
__device__ __forceinline__ bf16x8 cat4(s16x4 a, s16x4 b) { bf16x8 r; r[0] = a[0]; r[1] = a[1]; r[2] = a[2]; r[3] = a[3]; r[4] = b[0]; r[5] = b[1]; r[6] = b[2]; r[7] = b[3]; return r; }
__device__ __forceinline__ void ret_fast_phase(LAS unsigned char* lds, const bf16_t* QT, const bf16_t* KT, const bf16_t* VT, bf16_t* RET, float* SSR, int unit) {
    int tid_ = threadIdx.x; asm volatile("" : "+v"(tid_));
    const int tid = tid_, lane = tid & 63, w = __builtin_amdgcn_readfirstlane(tid >> 6), li = lane & 15, g = lane >> 4;
    const int blk = unit & 7, h = (unit >> 3) & 3, b = unit >> 5;
    const float g64 = __expf(64.0f * gamma_log(h));
    const int qt = (w < 2) ? 0 : (w < 4) ? 1 : (w < 6) ? 3 : 2, dvh = w & 1;
    const int kt0 = (w == 3) ? 1 : (w == 5 || w == 7) ? 2 : 0;
    const int kt1 = (w == 0 || w == 2) ? 1 : (w == 1) ? 0 : (w == 3) ? 2 : (w == 4 || w == 6) ? 2 : (w == 5) ? 4 : 3;
    constexpr int KB = 0, VB = 65536, ST = 81920, SIMG = 147456;
    typedef __attribute__((address_space(3))) s16x4 lds_s16x4;
    for (int e = tid; e < 2048; e += 512) *(LAS u32x4*)(lds + ST + e * 16) = (u32x4){0u, 0u, 0u, 0u};
    f32x4 st[2][4];
#pragma unroll
    for (int d = 0; d < 2; ++d)
#pragma unroll
        for (int t = 0; t < 4; ++t) st[d][t] = (f32x4){0.f, 0.f, 0.f, 0.f};
    const size_t rowb = (size_t)b * SEQ;
    const bf16_t* kbase = KT + rowb * 1024 + h * 256;
    const bf16_t* qbase = QT + (rowb + 16 * qt + li) * 1024 + h * 256 + 8 * g;
    const bf16_t* vbase = VT + ((size_t)b * 2048 + h * 512 + blk * 64 + (tid >> 3)) * SEQ + 8 * (tid & 7);
    const unsigned vw_off = (unsigned)((tid >> 3) * 128 + (((2 * (tid & 7)) ^ ((tid >> 3) & 14)) * 8));
    unsigned ksrc[4];
#pragma unroll
    for (int i = 0; i < 4; ++i) { const int row = 2 * (4 * w + i) + (lane >> 5), p = lane & 31, c = p ^ ((row & 7) << 1); ksrc[i] = (unsigned)(row * 2048 + c * 16); }
#define RK_DMA(n_, buf_) do { const char* kb_ = (const char*)(kbase + (size_t)(n_) * 64 * 1024); const unsigned ld_ = lds_addr(lds + KB + (buf_) * 32768 + (4 * w) * 1024); _Pragma("unroll") for (int i = 0; i < 4; ++i) \
        glds16_asm(kb_ + ksrc[i], ld_ + i * 1024); } while (0)
    bf16x8 qf[8], qn[8]; u32x4 vreg;
    RK_DMA(0, 0);
    vreg = *(const u32x4*)(vbase);
#pragma unroll
    for (int ks = 0; ks < 8; ++ks) { qf[ks] = *(const bf16x8*)(qbase + 32 * ks); qn[ks] = qf[ks]; }
    *(LAS u32x4*)(lds + VB + vw_off) = vreg;
    asm volatile("s_waitcnt vmcnt(0) lgkmcnt(0)" ::: "memory"); __builtin_amdgcn_s_barrier(); asm volatile("" ::: "memory");
#pragma unroll 1
    for (int n = 0; n < 32; ++n) {
        const int cur = n & 1, nxt = cur ^ 1;
        LAS unsigned char* kb = lds + KB + cur * 32768; LAS unsigned char* vb = lds + VB + cur * 8192; LAS unsigned char* sb = lds + ST + cur * 32768;
#ifndef RET_PROBE
#define RET_PROBE 0
#endif
        if (n + 1 < 32) {
            RK_DMA(n + 1, nxt);
            if (RET_PROBE & 1) { RK_DMA(n + 1, nxt); }
            vreg = *(const u32x4*)(vbase + (size_t)(n + 1) * 64);
#pragma unroll
            for (int ks = 0; ks < 8; ++ks) qn[ks] = *(const bf16x8*)(qbase + (size_t)(n + 1) * 64 * 1024 + 32 * ks);
        }
#pragma unroll 1
        for (int kt2 = 2 * kt0; kt2 < 2 * kt1; kt2 += ((RET_PROBE & 2) ? 1 : 2)) { const int kt = kt2 >> 1;
            f32x4 acc = (f32x4){0.f, 0.f, 0.f, 0.f};
            const int row = 16 * kt + li; const LAS unsigned char* rp = kb + row * 512; const int sw = (row & 7) << 1;
            bf16x8 av[8];
#pragma unroll
            for (int ks = 0; ks < 8; ++ks) av[ks] = *(const LAS bf16x8*)(rp + (((4 * ks + g) ^ sw) * 16));
            __builtin_amdgcn_sched_barrier(0);
#pragma unroll
            for (int ks = 0; ks < 8; ++ks) acc = __builtin_amdgcn_mfma_f32_16x16x32_bf16(av[ks], qf[ks], acc, 0, 0, 0);
            if (kt == qt) {
#pragma unroll
                for (int r = 0; r < 4; ++r) acc[r] = (4 * g + r <= li) ? acc[r] : 0.f; }
            u32x2 pk; pk.x = pk2(acc[0], acc[1]); pk.y = pk2(acc[2], acc[3]);
            *(LAS u32x2*)(lds + SIMG + ((qt * 4 + kt) * 64 + lane) * 8) = pk;
        }
        bf16x8 vf[4][2];
#pragma unroll
        for (int t = 0; t < 4; ++t)
#pragma unroll
            for (int kp = 0; kp < 2; ++kp) { const int row = 16 * t + li; const LAS unsigned char* rp = vb + row * 128; const int f = row & 14;
                const s16x4 lo = *(const LAS s16x4*)(rp + (((8 * kp + g) ^ f) * 8)), hi = *(const LAS s16x4*)(rp + (((8 * kp + 4 + g) ^ f) * 8)); vf[t][kp] = cat4(lo, hi); }
        bf16x8 ua[2][2];
#pragma unroll
        for (int d = 0; d < 2; ++d)
#pragma unroll
            for (int kp = 0; kp < 2; ++kp) { const int dkt = 2 * w + d;
                const int r0 = 32 * kp + 4 * g + (li >> 2), r1 = r0 + 16;
                const int cch = 2 * dkt + ((li >> 1) & 1), hb = (li & 1) * 8;
                const s16x4 lo = __builtin_bit_cast(s16x4, __builtin_amdgcn_ds_read_tr16_b64_v4i16((lds_s16x4*)(kb + r0 * 512 + ((cch ^ ((r0 & 7) << 1)) * 16) + hb)));
                const s16x4 hi = __builtin_bit_cast(s16x4, __builtin_amdgcn_ds_read_tr16_b64_v4i16((lds_s16x4*)(kb + r1 * 512 + ((cch ^ ((r1 & 7) << 1)) * 16) + hb)));
                ua[d][kp] = cat4(lo, hi); }
        __builtin_amdgcn_sched_barrier(0);
#pragma unroll
        for (int d = 0; d < 2; ++d)
#pragma unroll
            for (int kp = 0; kp < 2; ++kp)
#pragma unroll
                for (int t = 0; t < 4; ++t) st[d][t] = __builtin_amdgcn_mfma_f32_16x16x32_bf16(ua[d][kp], vf[t][kp], st[d][t], 0, 0, 0);
        asm volatile("s_waitcnt lgkmcnt(0)" ::: "memory"); __builtin_amdgcn_s_barrier(); asm volatile("" ::: "memory");
        if (RET_PROBE & 8) { __builtin_amdgcn_s_barrier(); asm volatile("" ::: "memory"); __builtin_amdgcn_s_barrier(); asm volatile("" ::: "memory"); }
        float ssq = 0.f;
        bf16x8 sf[2]; bool sv[2];
#pragma unroll
        for (int kp = 0; kp < 2; ++kp) { sv[kp] = (2 * kp <= qt); sf[kp] = (bf16x8){0, 0, 0, 0, 0, 0, 0, 0};
            if (sv[kp]) { const s16x4 lo = *(const LAS s16x4*)(lds + SIMG + ((qt * 4 + 2 * kp) * 64 + lane) * 8);
                s16x4 hi = (s16x4){0, 0, 0, 0}; if (2 * kp + 1 <= qt) hi = *(const LAS s16x4*)(lds + SIMG + ((qt * 4 + 2 * kp + 1) * 64 + lane) * 8);
                sf[kp] = cat4(lo, hi); } }
#pragma unroll
        for (int dd2 = 0; dd2 < ((RET_PROBE & 4) ? 4 : 2); ++dd2) { const int dd = dd2 & 1; const int t = 2 * dvh + dd; if (dd2 == 2) ssq = 0.f;
            bf16x8 sa[8];
            {   const int row = 16 * t + li; const LAS unsigned char* rp = sb + row * 512; const int sw = (row & 7) << 1;
#pragma unroll
                for (int ks = 0; ks < 8; ++ks) sa[ks] = *(const LAS bf16x8*)(rp + (((4 * ks + g) ^ sw) * 16)); }
            __builtin_amdgcn_sched_barrier(0);
            f32x4 acc = (f32x4){0.f, 0.f, 0.f, 0.f};
#pragma unroll
            for (int kp = 0; kp < 2; ++kp) if (sv[kp]) {
                const bf16x8 va = dvh ? (dd ? vf[3][kp] : vf[2][kp]) : (dd ? vf[1][kp] : vf[0][kp]);
                acc = __builtin_amdgcn_mfma_f32_16x16x32_bf16(va, sf[kp], acc, 0, 0, 0); }
#pragma unroll
            for (int ks = 0; ks < 8; ++ks) acc = __builtin_amdgcn_mfma_f32_16x16x32_bf16(sa[ks], qf[ks], acc, 0, 0, 0);
            ssq += (acc[0] * acc[0] + acc[1] * acc[1]) + (acc[2] * acc[2] + acc[3] * acc[3]);
            u32x2 pk; pk.x = pk2(acc[0], acc[1]); pk.y = pk2(acc[2], acc[3]);
            *(u32x2*)(RET + (rowb + n * 64 + 16 * qt + li) * 2048 + h * 512 + blk * 64 + 16 * t + 4 * g) = pk;
            __builtin_amdgcn_sched_barrier(0); }
        ssq += __shfl_xor(ssq, 16); ssq += __shfl_xor(ssq, 32);
        if (g == 0) SSR[((rowb + n * 64 + 16 * qt + li) * 4 + h) * 16 + blk * 2 + dvh] = ssq;
        LAS unsigned char* sn = lds + ST + nxt * 32768;
#pragma unroll
        for (int d = 0; d < 2; ++d)
#pragma unroll
            for (int t = 0; t < 4; ++t) { st[d][t] *= g64; const int row = 16 * t + li, dkt = 2 * w + d;
                u32x2 pk; pk.x = pk2(st[d][t][0], st[d][t][1]); pk.y = pk2(st[d][t][2], st[d][t][3]);
                *(LAS u32x2*)(sn + row * 512 + (((2 * dkt + (g >> 1)) ^ ((row & 7) << 1)) * 16) + (g & 1) * 8) = pk; }
        if (n + 1 < 32) *(LAS u32x4*)(lds + VB + nxt * 8192 + vw_off) = vreg;
#pragma unroll
        for (int ks = 0; ks < 8; ++ks) qf[ks] = qn[ks];
        asm volatile("s_waitcnt vmcnt(0) lgkmcnt(0)" ::: "memory"); __builtin_amdgcn_s_barrier(); asm volatile("" ::: "memory");
    }
#undef RK_DMA
}


#ifndef DSA_REP
#define DSA_REP 0
#endif
constexpr int DSA_SC = 0, DSA_KST = 131072, DSA_IDX = 147456, DSA_WQ = 155648;
__device__ __forceinline__ unsigned fkey(float f) { const unsigned u = __float_as_uint(f); return (u & 0x80000000u) ? ~u : (u | 0x80000000u); }
__device__ __forceinline__ int bcnt(bool p) { return __popcll(__ballot(p)); }
#define SUMF(a_, b_) ((a_) + (b_))
#define WAVE_RED(OP, v) do { v = OP(v, __int_as_float(__builtin_amdgcn_update_dpp(__float_as_int(v), __float_as_int(v), 0xB1, 0xf, 0xf, true))); \
        v = OP(v, __int_as_float(__builtin_amdgcn_update_dpp(__float_as_int(v), __float_as_int(v), 0x4E, 0xf, 0xf, true))); \
        v = OP(v, __int_as_float(__builtin_amdgcn_update_dpp(__float_as_int(v), __float_as_int(v), 0x141, 0xf, 0xf, true))); \
        v = OP(v, __int_as_float(__builtin_amdgcn_update_dpp(__float_as_int(v), __float_as_int(v), 0x140, 0xf, 0xf, true))); \
        v = OP(OP(__int_as_float(__builtin_amdgcn_readlane(__float_as_int(v), 0)), __int_as_float(__builtin_amdgcn_readlane(__float_as_int(v), 16))), \
               OP(__int_as_float(__builtin_amdgcn_readlane(__float_as_int(v), 32)), __int_as_float(__builtin_amdgcn_readlane(__float_as_int(v), 48)))); } while (0)

template <int NB>
__device__ __forceinline__ void dsa_topk_t(const LAS float* sc, LAS unsigned short* il, int limit, int lane) {
    const int nb = limit >> 6;
    float v[NB];
#pragma unroll
    for (int i = 0; i < NB; ++i) v[i] = (i < nb) ? sc[64 * i + lane] : -INFINITY;
    float mn = INFINITY, mx = -INFINITY;
#pragma unroll
    for (int i = 0; i < NB; ++i) { mn = fminf(mn, (i < nb) ? v[i] : INFINITY); mx = fmaxf(mx, v[i]); }
    WAVE_RED(fminf, mn); WAVE_RED(fmaxf, mx);
    float lo = mn, hi = INFINITY; int clo = limit, chi = 0;
#pragma unroll 1
    for (int it = 0; it < 64 && clo - chi > 64; ++it) {
        const float top = (hi == INFINITY) ? mx : hi; const float mid = 0.5f * lo + 0.5f * top;
        if (!(mid > lo) || !(mid < hi)) break;
        int c = 0;
#pragma unroll
        for (int i = 0; i < NB; ++i) c += (v[i] >= mid) ? 1 : 0;
        float cf = (float)c; WAVE_RED(SUMF, cf); c = (int)cf;
        if (c >= TOPK) { lo = mid; clo = c; } else { hi = mid; chi = c; }
    }
    const int r = TOPK - chi; unsigned T; int ngt, neq;
    if (clo - chi <= 64) {
        int filled = 0;
#pragma unroll
        for (int i = 0; i < NB; ++i) { const bool in = (v[i] >= lo) && (v[i] < hi);
            const unsigned long long m = __ballot(in); const int pos = filled + __builtin_amdgcn_mbcnt_hi((unsigned)(m >> 32), __builtin_amdgcn_mbcnt_lo((unsigned)m, 0));
            if (in) ((LAS unsigned*)il)[pos] = fkey(v[i]);
            filled += __popcll(m); }
        asm volatile("s_waitcnt lgkmcnt(0)" ::: "memory");
        const unsigned ck = (lane < filled) ? ((LAS unsigned*)il)[lane] : 0u;
        T = 0u;
#pragma unroll 4
        for (int bit = 31; bit >= 0; --bit) { const unsigned cand = T | (1u << bit); if (bcnt(ck >= cand) >= r) T = cand; }
        ngt = chi + bcnt(ck > T); neq = bcnt(ck == T);
    } else {
        T = 0u;
#pragma unroll 1
        for (int bit = 31; bit >= 0; --bit) { const unsigned cand = T | (1u << bit); int c = 0;
#pragma unroll
            for (int i = 0; i < NB; ++i) c += bcnt(i < nb && fkey(v[i]) >= cand);
            if (c >= TOPK) T = cand; }
        ngt = 0; neq = 0;
#pragma unroll
        for (int i = 0; i < NB; ++i) { const unsigned k = fkey(v[i]); ngt += bcnt(i < nb && k > T); neq += bcnt(i < nb && k == T); }
    }
    const int need_eq = TOPK - ngt;
    asm volatile("s_waitcnt lgkmcnt(0)" ::: "memory");
    int base = 0, tb = 0;
    const bool alleq = (neq == need_eq);
#pragma unroll
    for (int i = 0; i < NB; ++i) if (i < nb) { const unsigned k = fkey(v[i]);
        bool f = k >= T;
        if (!alleq) { const bool eq = (k == T); const unsigned long long me = __ballot(eq);
            const int er = tb + __builtin_amdgcn_mbcnt_hi((unsigned)(me >> 32), __builtin_amdgcn_mbcnt_lo((unsigned)me, 0));
            f = (k > T) || (eq && er < need_eq); tb += __popcll(me); }
        const unsigned long long mf = __ballot(f); const int pos = base + __builtin_amdgcn_mbcnt_hi((unsigned)(mf >> 32), __builtin_amdgcn_mbcnt_lo((unsigned)mf, 0));
        if (f && pos < TOPK) il[pos] = (unsigned short)(64 * i + lane);
        base += __popcll(mf); }
}
__device__ __forceinline__ void dsa_topk(const LAS float* sc, LAS unsigned short* il, int limit, int lane) {
    if (limit <= 512) dsa_topk_t<8>(sc, il, limit, lane);
    else if (limit <= 1024) dsa_topk_t<16>(sc, il, limit, lane);
    else dsa_topk_t<32>(sc, il, limit, lane);
}

struct DsaQ { bf16x8 qf[4]; f32x4 ps; };
__device__ __forceinline__ DsaQ dsa_load_q(const bf16_t* QH, const float* PS, size_t trow, int lane) {
    const int li = lane & 15, g = lane >> 4; DsaQ q;
#pragma unroll
    for (int s = 0; s < 4; ++s) { q.qf[s] = (bf16x8){0, 0, 0, 0, 0, 0, 0, 0}; if (li < 8) q.qf[s] = *(const bf16x8*)(QH + trow * 1024 + li * 128 + 32 * s + 8 * g); }
    q.ps = (f32x4){1.f, 1.f, 1.f, 1.f};
    if (li < 8) { const float* pp = PS + (size_t)((li >> 1) * 8 + (li & 1) * 4) * M + trow; q.ps = (f32x4){pp[0], pp[(size_t)M], pp[(size_t)2 * M], pp[(size_t)3 * M]}; }
    return q;
}
__device__ __forceinline__ void dsa_attend(LAS unsigned char* wl, const LAS unsigned short* il, const LAS float* rctab, LAS float* rcl, const DsaQ& Q, const bf16_t* Cb, bf16_t* AO, size_t trow, int b, int count, float bound_l2, int lane) {
    const int li = lane & 15, g = lane >> 4;
    typedef __attribute__((address_space(3))) s16x4 lds_s16x4;
    bf16x8 qf[4];
#pragma unroll
    for (int s = 0; s < 4; ++s) qf[s] = Q.qf[s];
    const float rq = (li < 8) ? rsqrtf(((Q.ps[0] + Q.ps[1]) + (Q.ps[2] + Q.ps[3])) * (1.0f / 128.0f) + EPS) * 1.4426950408889634f : 0.f;
    const bf16_t* cbase = Cb + (size_t)b * SEQ * 128; const unsigned wlb = lds_addr(wl);
#define DSA_GATHER(ci_, buf_) do { const u32x4 kw_ = *(const LAS u32x4*)(il + 32 * (ci_) + 8 * (lane >> 4)); \
        _Pragma("unroll") for (int i = 0; i < 8; ++i) { const int row = 4 * i + (lane >> 4); const unsigned kk_ = (i < 2 ? kw_.x : i < 4 ? kw_.y : i < 6 ? kw_.z : kw_.w); const int key = (i & 1) ? (int)(kk_ >> 16) : (int)(kk_ & 0xffffu); \
        const int sc_ = (lane & 15) ^ ((row & 7) << 1); \
        glds16_asm(cbase + (size_t)key * 128 + sc_ * 8, wlb + (buf_) * 8192 + i * 1024); } } while (0)
    for (int pos = lane; pos < count; pos += 64) { const int e = pos & 31; rcl[(pos & ~31) + 4 * (e & 7) + (e >> 3)] = rctab[il[pos]]; }
    asm volatile("s_waitcnt lgkmcnt(0)" ::: "memory");
    f32x4 oacc[8];
#pragma unroll
    for (int d = 0; d < 8; ++d) oacc[d] = (f32x4){0.f, 0.f, 0.f, 0.f};
    float lsum = 0.f;
    const int nch = count >> 5;
    DSA_GATHER(0, 0);
#pragma unroll 1
    for (int ci = 0; ci < nch; ++ci) {
        const int cur = ci & 1;
        if (ci + 1 < nch) { DSA_GATHER(ci + 1, cur ^ 1); if (DSA_REP & 8) { DSA_GATHER(ci + 1, cur ^ 1); asm volatile("s_waitcnt vmcnt(16)" ::: "memory"); } else asm volatile("s_waitcnt vmcnt(8)" ::: "memory"); } else { asm volatile("s_waitcnt vmcnt(0)" ::: "memory"); }
        const LAS unsigned char* ct = wl + cur * 8192;
        f32x4 lt[2];
        bf16x8 ca[2][4];
#pragma unroll
        for (int T = 0; T < 2; ++T) { const int row = 16 * T + li; const LAS unsigned char* rp = ct + row * 256; const int sw = (row & 7) << 1;
#pragma unroll
            for (int s = 0; s < 4; ++s) ca[T][s] = *(const LAS bf16x8*)(rp + (((4 * s + g) ^ sw) * 16)); }
        f32x4 rcv[2];
#pragma unroll
        for (int T = 0; T < 2; ++T) rcv[T] = *(const LAS f32x4*)(rcl + 32 * ci + 16 * T + 4 * g);
        __builtin_amdgcn_sched_barrier(0);
#pragma unroll
        for (int T = 0; T < 2; ++T) { lt[T] = (f32x4){0.f, 0.f, 0.f, 0.f};
#pragma unroll
            for (int s = 0; s < 4; ++s) lt[T] = __builtin_amdgcn_mfma_f32_16x16x32_bf16(ca[T][s], qf[s], lt[T], 0, 0, 0); }
        bf16x8 cv[8];
#pragma unroll
        for (int dt = 0; dt < 8; ++dt) {
            const int r0 = 4 * g + (li >> 2), r1 = r0 + 16; const int cch = 2 * dt + ((li >> 1) & 1), hb = (li & 1) * 8;
            const s16x4 lo = __builtin_bit_cast(s16x4, __builtin_amdgcn_ds_read_tr16_b64_v4i16((lds_s16x4*)(ct + r0 * 256 + ((cch ^ ((r0 & 7) << 1)) * 16) + hb)));
            const s16x4 hi = __builtin_bit_cast(s16x4, __builtin_amdgcn_ds_read_tr16_b64_v4i16((lds_s16x4*)(ct + r1 * 256 + ((cch ^ ((r1 & 7) << 1)) * 16) + hb)));
            cv[dt] = cat4(lo, hi); }
        __builtin_amdgcn_sched_barrier(0);
        bf16x8 pf;
#pragma unroll
        for (int T = 0; T < 2; ++T) { float pv[4];
#pragma unroll
            for (int r = 0; r < 4; ++r) { pv[r] = __builtin_amdgcn_exp2f(lt[T][r] * rq * rcv[T][r] - bound_l2); lsum += pv[r]; }
            const unsigned w0 = pk2(pv[0], pv[1]), w1 = pk2(pv[2], pv[3]);
            pf[4 * T + 0] = (short)(w0 & 0xffff); pf[4 * T + 1] = (short)(w0 >> 16); pf[4 * T + 2] = (short)(w1 & 0xffff); pf[4 * T + 3] = (short)(w1 >> 16); }
#pragma unroll
        for (int dt = 0; dt < 8; ++dt) oacc[dt] = __builtin_amdgcn_mfma_f32_16x16x32_bf16(cv[dt], pf, oacc[dt], 0, 0, 0);
    }
#undef DSA_GATHER
    lsum += __shfl_xor(lsum, 16); lsum += __shfl_xor(lsum, 32);
    const float inv = 1.0f / lsum;
    if (li < 8) {
#pragma unroll
        for (int dt = 0; dt < 8; ++dt) { u32x2 o; o.x = pk2(oacc[dt][0] * inv, oacc[dt][1] * inv); o.y = pk2(oacc[dt][2] * inv, oacc[dt][3] * inv);
            *(u32x2*)(AO + trow * 1024 + li * 128 + 16 * dt + 4 * g) = o; }
    }
}

__device__ __forceinline__ void dsa_fast_phase(LAS unsigned char* lds, const bf16_t* QH, const bf16_t* Cb, const float* PS, const bf16_t* QI, const bf16_t* KI, const float* WI, const float* CSC, bf16_t* AO, int vcu, int G) {
    int tid_ = threadIdx.x; asm volatile("" : "+v"(tid_));
    const int tid = tid_, lane0 = tid & 63, w = __builtin_amdgcn_readfirstlane(tid >> 6);
    LAS unsigned char* wl = lds + DSA_SC + w * 16384; LAS float* rctab = (LAS float*)(lds + DSA_KST);
    LAS unsigned short* il0 = (LAS unsigned short*)(lds + DSA_IDX + (2 * w) * 512); LAS unsigned short* il1 = il0 + 256;
    float mxs = 0.f;
    for (int i = lane0; i < 128; i += 64) mxs = fmaxf(mxs, fabsf(CSC[i]));
#pragma unroll
    for (int o = 1; o < 64; o <<= 1) mxs = fmaxf(mxs, __shfl_xor(mxs, o));
    const float bound_l2 = mxs * 128.0f * 1.4426950408889634f;
    for (int wg = vcu; wg < 256; wg += G) {
        const int b = wg >> 5, r = wg & 31;
        __syncthreads();
        for (int k = tid; k < SEQ; k += NWAVES * 64) { const float* pp = PS + (size_t)32 * M + (size_t)b * SEQ + k;
            rctab[k] = rsqrtf(((pp[0] + pp[(size_t)M]) + (pp[(size_t)2 * M] + pp[(size_t)3 * M])) * (1.0f / 128.0f) + EPS); }
#pragma unroll 1
        for (int it = 0; it < 4; ++it) {
            int lane = lane0; asm volatile("" : "+v"(lane));
            const int li = lane & 15, g = lane >> 4;
            const int chunk = (it & 1) ? 31 - (r & 15) : (r & 15), sub = 2 * (r >> 4) + (it >> 1);
            const int t0 = chunk * 64 + sub * 16, limit = (chunk + 1) * 64;
            const size_t trow0 = (size_t)b * SEQ + t0 + 2 * w;
            const DsaQ Q0 = dsa_load_q(QH, PS, trow0, lane), Q1 = dsa_load_q(QH, PS, trow0 + 1, lane);
            LAS float* wqt = (LAS float*)(lds + DSA_WQ);
            if (limit > TOPK && tid < 128) { const int qq = tid >> 3, hh = tid & 7; const size_t row = (size_t)b * SEQ + t0 + qq;
                const float* ps = PS + (size_t)(40 + (hh >> 2) * 8 + ((hh >> 1) & 1) * 4 + 2 * (hh & 1)) * M + row;
                wqt[tid] = WI[row * 8 + hh] * rsqrtf((ps[0] + ps[(size_t)M]) * (1.0f / 64.0f) + EPS); }
            __syncthreads();
            if (limit > TOPK) {
                for (int srep = 0; srep < 1 + (DSA_REP & 1); ++srep) {
                bf16x8 af[8][2]; float wq[8][4];
                const size_t trowi = (size_t)b * SEQ + t0;
#pragma unroll
                for (int p = 0; p < 8; ++p) {
#pragma unroll
                    for (int sidx = 0; sidx < 2; ++sidx) af[p][sidx] = *(const bf16x8*)(QI + (trowi + 2 * p + (li >> 3)) * 512 + (li & 7) * 64 + 32 * sidx + 8 * g);
                    const f32x4 wv = *(const LAS f32x4*)(wqt + (2 * p + (g >> 1)) * 8 + 4 * (g & 1));
                    wq[p][0] = wv[0]; wq[p][1] = wv[1]; wq[p][2] = wv[2]; wq[p][3] = wv[3];
                    asm volatile("" ::: "memory"); }
                const int nst = limit >> 4;
                const bf16_t* kp = KI + ((size_t)b * SEQ + 16 * w + li) * 64 + 8 * g; const float* pp = PS + (size_t)36 * M + (size_t)b * SEQ + 16 * w + li;
                bf16x8 b0 = *(const bf16x8*)kp, b1 = *(const bf16x8*)(kp + 32); f32x2_t pk = (f32x2_t){pp[0], pp[(size_t)M]};
                bf16x8 d0 = b0, d1 = b1; f32x2_t pk2v = pk;
                if (w + 8 < nst) { kp += 8 * 16 * 64; pp += 8 * 16; d0 = *(const bf16x8*)kp; d1 = *(const bf16x8*)(kp + 32); pk2v = (f32x2_t){pp[0], pp[(size_t)M]}; }
#pragma unroll 1
                for (int st = w; st < nst; st += 8) {
                    const bf16x8 c0 = b0, c1 = b1; const float rk = rsqrtf((pk[0] + pk[1]) * (1.0f / 64.0f) + EPS);
                    b0 = d0; b1 = d1; pk = pk2v;
                    if (st + 16 < nst) { kp += 8 * 16 * 64; pp += 8 * 16; d0 = *(const bf16x8*)kp; d1 = *(const bf16x8*)(kp + 32); pk2v = (f32x2_t){pp[0], pp[(size_t)M]}; }
                    LAS float* so = (LAS float*)(lds + DSA_SC) + (g >> 1) * 2048 + 16 * st + li;
#pragma unroll
                    for (int p = 0; p < 8; ++p) {
                        f32x4 acc = (f32x4){0.f, 0.f, 0.f, 0.f};
                        acc = __builtin_amdgcn_mfma_f32_16x16x32_bf16(af[p][0], c0, acc, 0, 0, 0); acc = __builtin_amdgcn_mfma_f32_16x16x32_bf16(af[p][1], c1, acc, 0, 0, 0);
                        float part = (fmaxf(acc[0], 0.f) * wq[p][0] + fmaxf(acc[1], 0.f) * wq[p][1]) + (fmaxf(acc[2], 0.f) * wq[p][2] + fmaxf(acc[3], 0.f) * wq[p][3]);
                        {   const auto sw = __builtin_amdgcn_permlane16_swap(__float_as_uint(part), __float_as_uint(part), false, false);
                            part = __uint_as_float(sw[0]) + __uint_as_float(sw[1]); }
                        if ((g & 1) == 0) so[p * 4096] = part * rk + 0.0f;
                    }
                }
                __syncthreads();
                }
                for (int trep = 0; trep < 1 + ((DSA_REP >> 1) & 1); ++trep) {
                dsa_topk((const LAS float*)wl, il0, limit, lane);
                dsa_topk((const LAS float*)wl + 2048, il1, limit, lane); }
            } else {
                for (int j = lane; j < limit; j += 64) { il0[j] = (unsigned short)j; il1[j] = (unsigned short)j; }
            }
            const int count = limit < TOPK ? limit : TOPK;
            for (int arep = 0; arep < 1 + ((DSA_REP >> 2) & 1); ++arep) {
            dsa_attend(wl, il0, rctab, (LAS float*)(lds + DSA_KST + 8192 + w * 1024), Q0, Cb, AO, trow0, b, count, bound_l2, lane);
            dsa_attend(wl, il1, rctab, (LAS float*)(lds + DSA_KST + 8192 + w * 1024), Q1, Cb, AO, trow0 + 1, b, count, bound_l2, lane); }
        }
    }
    __syncthreads();
}

typedef const __attribute__((address_space(4))) Args* ArgsP;
__device__ __forceinline__ ArgsP fresh_args() { ArgsP p = (ArgsP)__builtin_amdgcn_kernarg_segment_ptr(); asm volatile("" : "+s"(p)); return p; }

__device__ __forceinline__ int fresh_bx() { int v = blockIdx.x; asm volatile("" : "+s"(v)); return v; }
__device__ __forceinline__ int fresh_gx() { int v = gridDim.x; asm volatile("" : "+s"(v)); return v; }
__global__ void __launch_bounds__(NWAVES * 64, 2) mega(Args args_unused) {
    extern __shared__ __attribute__((aligned(16))) unsigned char lds_raw[];
    LAS unsigned char* lds = (LAS unsigned char*)lds_raw;
    const int tid = threadIdx.x;
    for (int u = tid; u < (LDS_BYTES - LDSCTL_OFF) / 4; u += NWAVES * 64) ((LAS unsigned*)(lds + LDSCTL_OFF))[u] = 0u;
    __syncthreads();
    int lo, hi;
    {   ArgsP A = fresh_args(); lo = A->ph_lo; hi = A->ph_hi;
        if (hi - lo > 1) (void)xcd_barrier_post((unsigned*)(A->ws + WS_CTL) + CW_BAR + A->li * XCD_BAR_WORDS, (volatile LAS unsigned*)(lds + MISC_OFF) + 8); }
#ifndef PHMASK
#define PHMASK 0xffff
#endif
#define IN(k) (((PHMASK >> (k)) & 1) && lo <= (k) && (k) < hi)
#define SEAM(k) do { if (lo <= (k) && (k) + 1 < hi) { ArgsP A_ = fresh_args(); XcdBarrier b_; b_.bar = (unsigned*)(A_->ws + WS_CTL) + CW_BAR + A_->li * XCD_BAR_WORDS; b_.x = xb_xcc_id(); \
        b_.st = (volatile LAS unsigned*)(lds + MISC_OFF) + 8; xcd_barrier(b_); } } while (0)
#ifndef REPMASK
#define REPMASK 0
#endif
#define GBAR() do { ArgsP A_ = fresh_args(); XcdBarrier b_; b_.bar = (unsigned*)(A_->ws + WS_CTL) + CW_BAR + A_->li * XCD_BAR_WORDS; b_.x = xb_xcc_id(); \
        b_.st = (volatile LAS unsigned*)(lds + MISC_OFF) + 8; xcd_barrier(b_); } while (0)
#define REPEAT(k) for (int rep_ = 0; rep_ < 1 + ((REPMASK >> (k)) & 1); ++rep_)
#define REPBAR() do { if (rep_) GBAR(); } while (0)
#define GWS int t_ = threadIdx.x; asm volatile("" : "+v"(t_)); const int lane = t_ & 63, wave = __builtin_amdgcn_readfirstlane(t_ >> 6); const int G = fresh_gx(), bx = fresh_bx(); const int vcu = (G % 8 == 0) ? (bx % 8) * (G / 8) + bx / 8 : bx; \
        const int gw = vcu * NWAVES + wave, NGW = G * NWAVES; LAS float* scr = (LAS float*)(lds + wave * 16640); (void)lane; (void)gw; (void)NGW; (void)scr;
#define WCONV(Wp, K_, Nsrc_, N_, mode_, gain_, WT_) do { const int items_ = ((K_) / 64) * ((N_) / 64); \
        for (int it = gw; it < items_; it += NGW) p0_transpose_item((Wp), (K_), (Nsrc_), (N_), (mode_), (gain_), (WT_), scr, it, lane); } while (0)

    if (IN(PH_PRO)) REPEAT(PH_PRO) { REPBAR();
        GWS; ArgsP A = fresh_args(); unsigned char* ws = A->ws;
        constexpr int I0 = 16 * 28, I1 = I0 + 16 * 16, I2 = I1 + 16 * 96, I3 = I2 + 32 * 16, I4 = I3 + 16 * 88, I5 = I4 + 44 * 16, IX = I5 + M / 4;
        {   const float* x = A->in[0]; float* SS = (float*)(ws + WS_SS); bf16_t* XB = (bf16_t*)(ws + WS_XB);
#pragma unroll 1
            for (int it = gw; it < IX; it += NGW) {
                if (it < I0) p0_transpose_item(A->in[3], 1024, A_IN_COLS, A_IN_PAD, WM_AIN, A->in[1], (bf16_t*)(ws + WS_WAIN), scr, it, lane);
                else if (it < I1) p0_transpose_item(A->in[8], 1024, 1024, 1024, WM_NAT, (const float*)nullptr, (bf16_t*)(ws + WS_WAOUT), scr, it - I0, lane);
                else if (it < I2) p0_transpose_item(A->in[9], 1024, B_IN_COLS, B_IN_COLS, WM_NAT, A->in[1] + 1024, (bf16_t*)(ws + WS_WBIN), scr, it - I1, lane);
                else if (it < I3) p0_transpose_item(A->in[11], 2048, 1024, 1024, WM_NAT, A->in[10], (bf16_t*)(ws + WS_WBOUT), scr, it - I2, lane);
                else if (it < I4) p0_transpose_item(A->in[12], 1024, FF2, FF2, WM_FUP, A->in[2], (bf16_t*)(ws + WS_WFUP0), scr, it - I3, lane);
                else if (it < I5) p0_transpose_item(A->in[15], 2816, 1024, 1024, WM_NAT, (const float*)nullptr, (bf16_t*)(ws + WS_WFDN0), scr, it - I4, lane);
                else { const int row0 = (it - I5) * 4;
                    f32x4 v[4][4];
#pragma unroll
                    for (int r = 0; r < 4; ++r)
#pragma unroll
                        for (int q = 0; q < 4; ++q) v[r][q] = ((const f32x4*)(x + (size_t)(row0 + r) * DM))[q * 64 + lane];
#pragma unroll
                    for (int r = 0; r < 4; ++r)
#pragma unroll
                        for (int q = 0; q < 4; ++q) { const f32x4 w = v[r][q]; float sq = (w[0] * w[0] + w[1] * w[1]) + (w[2] * w[2] + w[3] * w[3]); sq = wave_sum(sq);
                            if (lane < 4) SS[(size_t)(q * 4 + lane) * M + row0 + r] = lane == 0 ? sq : 0.f;
                            u32x2 o; o.x = pk2(w[0], w[1]); o.y = pk2(w[2], w[3]); *(u32x2*)(XB + (size_t)(row0 + r) * DM + q * 256 + lane * 4) = o; } } } }
        {   float2* ROPE = (float2*)(ws + WS_ROPE);
            for (int e = gw * 64 + lane; e < 2048 * 128; e += NGW * 64) { const int t = e >> 7, i = e & 127;
                const float inv = exp2f(-(float)(2 * i) * (13.287712379549449f / 256.0f)), ang = (float)t * inv; float sn, cs; sincosf(ang, &sn, &cs); ROPE[e] = make_float2(cs, sn); } }
        {   float* CSC = (float*)(ws + WS_CSC); const float* a_q_g = A->in[4]; const float* a_k_g = A->in[5]; const float* a_iq_g = A->in[6]; const float* a_ik_g = A->in[7];
            for (int n = gw * 64 + lane; n < A_IN_PAD; n += NGW * 64) { float v;
                if (n < 1024) v = a_q_g[n & 127] * a_k_g[n & 127] * 0.08838834764831845f; else if (n < 1152) v = 1.0f; else if (n < 1216) v = a_ik_g[n - 1152];
                else if (n < 1224) v = 0.044194173824159216f; else if (n < 1280) v = 0.f; else v = a_iq_g[(n - 1280) & 63];
                CSC[n] = v; } }
    }
    SEAM(PH_PRO);
    if (IN(PH_A1)) REPEAT(PH_A1) { REPBAR();
        ArgsP A = fresh_args(); unsigned char* ws = A->ws;
        pg8::Gemm g{(const bf16_t*)(ws + WS_XB), (const bf16_t*)(ws + WS_WAIN), M, A_IN_PAD, 1024}; pg8::StaticOrder S; S.init(M, A_IN_PAD, fresh_gx(), fresh_bx());
        pg8::EpiA1 E{(const float*)(ws + WS_SS), (const float*)(ws + WS_CSC), (bf16_t*)(ws + WS_QH), (bf16_t*)(ws + WS_C), (bf16_t*)(ws + WS_KI), (bf16_t*)(ws + WS_QI), (float*)(ws + WS_WI), (float*)(ws + WS_PS)};
        pg8::gemm_phase(lds, g, S, E);
    }
    SEAM(PH_A1);
    if (IN(PH_A2)) REPEAT(PH_A2) { REPBAR();
        ArgsP A = fresh_args(); unsigned char* ws = A->ws; const int G = fresh_gx(), bx = fresh_bx(); const int vcu = (G % 8 == 0) ? (bx % 8) * (G / 8) + bx / 8 : bx;
        dsa_fast_phase(lds, (const bf16_t*)(ws + WS_QH), (const bf16_t*)(ws + WS_C), (const float*)(ws + WS_PS), (const bf16_t*)(ws + WS_QI), (const bf16_t*)(ws + WS_KI), (const float*)(ws + WS_WI), (const float*)(ws + WS_CSC), (bf16_t*)(ws + WS_AO), vcu, G);
    }
    SEAM(PH_A2);
    if (IN(PH_A3)) REPEAT(PH_A3) { REPBAR();
        ArgsP A = fresh_args(); unsigned char* ws = A->ws;
        pg8::Gemm g{(const bf16_t*)(ws + WS_AO), (const bf16_t*)(ws + WS_WAOUT), M, 1024, 1024}; pg8::StaticOrder S; S.init(M, 1024, fresh_gx(), fresh_bx());
        pg8::EpiRes<1> E{nullptr, nullptr, (bf16_t*)(ws + WS_XB), (float*)(ws + WS_SS)};
        pg8::gemm_phase(lds, g, S, E);
    }
    SEAM(PH_A3);
#define FFN_PHASES(LAYER, PH1, PH2) do { \
        if (IN(PH1)) REPEAT(PH1) { REPBAR(); \
            ArgsP A = fresh_args(); unsigned char* ws = A->ws; \
            pg8::Gemm g{(const bf16_t*)(ws + WS_XB), (const bf16_t*)(ws + ((LAYER) ? WS_WFUP1 : WS_WFUP0)), M, FF2, 1024}; pg8::StaticOrder S; S.init(M, FF2, fresh_gx(), fresh_bx()); \
            pg8::EpiF1 E{(const float*)(ws + WS_SS), A->in[13] + (size_t)(LAYER) * 3 * FF2, A->in[14] + (size_t)(LAYER) * FF2, (bf16_t*)(ws + ((LAYER) ? WS_H1 : WS_H0)), \
                         (float*)(ws + ((LAYER) ? WS_PART1 : WS_PART0)), (float*)(ws + ((LAYER) ? WS_HALO1 : WS_HALO0))}; \
            pg8::gemm_phase(lds, g, S, E); \
        } \
        SEAM(PH1); \
        if (IN(PH2)) { \
            ArgsP A = fresh_args(); unsigned char* ws = A->ws; bf16_t* Hb = (bf16_t*)(ws + ((LAYER) ? WS_H1 : WS_H0)); \
            pg8::Gemm g{Hb, (const bf16_t*)(ws + ((LAYER) ? WS_WFDN1 : WS_WFDN0)), M, 1024, D_FF}; pg8::StaticOrder S; S.init(M, 1024, fresh_gx(), fresh_bx()); \
            {   pg8::Unit u0; if (S.next(0, u0)) ffn_fixup(u0.pm, A->in[13] + (size_t)(LAYER) * 3 * FF2, (const float*)(ws + ((LAYER) ? WS_PART1 : WS_PART0)), (const float*)(ws + ((LAYER) ? WS_HALO1 : WS_HALO0)), Hb); \
                VM_WAIT(); __syncthreads(); } \
            if ((LAYER) == 0) { pg8::EpiRes<1> E{nullptr, nullptr, (bf16_t*)(ws + WS_XB), (float*)(ws + WS_SS)}; pg8::gemm_phase(lds, g, S, E); } \
            else { pg8::EpiRes<2> E{nullptr, A->out, (bf16_t*)(ws + WS_XB), nullptr}; pg8::gemm_phase(lds, g, S, E); } \
        } \
        SEAM(PH2); } while (0)
    FFN_PHASES(0, PH_F1A, PH_F2A);
    if (IN(PH_B1)) REPEAT(PH_B1) { REPBAR();
        ArgsP A = fresh_args(); unsigned char* ws = A->ws;
        pg8::Gemm g{(const bf16_t*)(ws + WS_XB), (const bf16_t*)(ws + WS_WBIN), M, 4096, 1024}; pg8::StaticOrder S; S.init(M, 4096, fresh_gx(), fresh_bx());
        pg8::EpiB1 E{(const float*)(ws + WS_SS), (const float2*)(ws + WS_ROPE), (bf16_t*)(ws + WS_QT), (bf16_t*)(ws + WS_KT), (bf16_t*)(ws + WS_VT)};
        pg8::gemm_phase(lds, g, S, E);
    }
    SEAM(PH_B1);
    if (IN(PH_B2)) REPEAT(PH_B2) { REPBAR();
        ArgsP A = fresh_args(); unsigned char* ws = A->ws;
        { const int G = fresh_gx(), bx = fresh_bx(); const int vcu = (G % 8 == 0) ? (bx % 8) * (G / 8) + bx / 8 : bx;
          for (int u = vcu; u < 256; u += G) ret_fast_phase(lds, (const bf16_t*)(ws + WS_QT), (const bf16_t*)(ws + WS_KT), (const bf16_t*)(ws + WS_VT), (bf16_t*)(ws + WS_RET), (float*)(ws + WS_SSR), u); }
    }
    SEAM(PH_B2);
    if (IN(PH_GATE)) REPEAT(PH_GATE) { REPBAR();
        {   ArgsP A = fresh_args(); unsigned char* ws = A->ws;
            pg8::Gemm g{(const bf16_t*)(ws + WS_XB), (const bf16_t*)(ws + WS_WBIN) + (size_t)4096 * 1024, M, 2048, 1024}; pg8::StaticOrder S; S.init(M, 2048, fresh_gx(), fresh_bx());
            pg8::EpiGate E{(const float*)(ws + WS_SS), (const float*)(ws + WS_SSR), (bf16_t*)(ws + WS_RET)};
            pg8::gemm_phase(lds, g, S, E); }
#if !defined(NO_WCONV2)
        {   GWS; ArgsP A = fresh_args(); unsigned char* ws = A->ws; constexpr int J0 = 16 * 88, J1 = J0 + 44 * 16;
#pragma unroll 1
            for (int it = gw; it < J1; it += NGW) {
                if (it < J0) p0_transpose_item(A->in[12] + (size_t)1024 * FF2, 1024, FF2, FF2, WM_FUP, A->in[2] + 1024, (bf16_t*)(ws + WS_WFUP1), scr, it, lane);
                else p0_transpose_item(A->in[15] + (size_t)2816 * 1024, 2816, 1024, 1024, WM_NAT, (const float*)nullptr, (bf16_t*)(ws + WS_WFDN1), scr, it - J0, lane); } }
#endif
    }
    SEAM(PH_GATE);
    if (IN(PH_B3)) REPEAT(PH_B3) { REPBAR();
        ArgsP A = fresh_args(); unsigned char* ws = A->ws;
        pg8::Gemm g{(const bf16_t*)(ws + WS_RET), (const bf16_t*)(ws + WS_WBOUT), M, 1024, 2048}; pg8::StaticOrder S; S.init(M, 1024, fresh_gx(), fresh_bx());
        pg8::EpiRes<1> E{nullptr, nullptr, (bf16_t*)(ws + WS_XB), (float*)(ws + WS_SS)};
        pg8::gemm_phase(lds, g, S, E);
    }
    SEAM(PH_B3);
    FFN_PHASES(1, PH_F1B, PH_F2B);
#undef FFN_PHASES
#undef IN
#undef SEAM
}

extern "C" void kernel_launch(void* const* d_in, const int* in_sizes, int n_in, void* d_out, int out_size, void* d_ws, size_t ws_size, hipStream_t stream) {
    static int grid = 0;
    if (grid == 0) {
        int dev = 0, cus = 0, per_cu = 0;
        (void)hipGetDevice(&dev); (void)hipDeviceGetAttribute(&cus, hipDeviceAttributeMultiprocessorCount, dev);
        (void)hipFuncSetAttribute((const void*)mega, hipFuncAttributeMaxDynamicSharedMemorySize, LDS_BYTES);
        if (hipOccupancyMaxActiveBlocksPerMultiprocessor(&per_cu, (const void*)mega, NWAVES * 64, LDS_BYTES) != hipSuccess || per_cu < 1)
            fprintf(stderr, "kernel_launch: occupancy query reports %d workgroups per CU\n", per_cu);
        (void)hipGetLastError();
        grid = cus > 0 ? cus : 256;
        if (grid != 256) fprintf(stderr, "kernel_launch: %d CUs (built for 256)\n", grid);
    }
    unsigned char* ws = (unsigned char*)d_ws;
    (void)hipMemsetAsync(ws + WS_CTL, 0, CTL_ZERO_BYTES, stream);
    Args a{};
    for (int i = 0; i < 16; ++i) a.in[i] = (const float*)d_in[i];
    a.out = (float*)d_out; a.ws = ws;
    auto launch = [&](int lo, int hi, int li) { a.ph_lo = lo; a.ph_hi = hi; a.li = li; hipLaunchKernelGGL(mega, dim3(grid), dim3(NWAVES * 64), LDS_BYTES, stream, a); };
    launch(0, PH_END, 0);
}
```

```cpp
#include <hip/hip_runtime.h>
#include <stdint.h>
#include <stdio.h>

typedef unsigned short bf16_t;
typedef short bf16x8 __attribute__((ext_vector_type(8)));
typedef float f32x4 __attribute__((ext_vector_type(4)));
typedef unsigned u32x4 __attribute__((ext_vector_type(4)));
typedef unsigned u32x2 __attribute__((ext_vector_type(2)));

#ifndef MK_LAUNCH_MODE
#define MK_LAUNCH_MODE 1
#endif

constexpr int BATCH = 8, SEQ = 2048, DM = 1024, M = BATCH * SEQ;
constexpr int TOPK = 256;
constexpr int A_IN_COLS = 1736, A_IN_PAD = 1792;
constexpr int O2 = 1152, O3 = 1664, O4 = 1728;
constexpr int B_IN_COLS = 6144;
constexpr int D_FF = 2816, FF2 = 5632;
constexpr float EPS = 1e-6f;

constexpr size_t MiB = 1u << 20;
constexpr size_t WS_CTL = 0, CTL_ZERO_BYTES = 65536;
constexpr size_t WS_SS = 1 * MiB;
constexpr size_t WS_WI = 2 * MiB;
constexpr size_t WS_CSC = 2 * MiB + 512 * 1024;
constexpr size_t WS_ROPE = 3 * MiB;
constexpr size_t WS_SSR = 249 * MiB;
constexpr size_t WS_WBIN = 8 * MiB;
constexpr size_t WS_WBOUT = 20 * MiB;
constexpr size_t WS_XB = 24 * MiB;
constexpr size_t WS_WAIN = 56 * MiB;
constexpr size_t WS_WAOUT = 60 * MiB;
constexpr size_t WS_QH = 64 * MiB;
constexpr size_t WS_AO = 96 * MiB;
constexpr size_t WS_QI = 128 * MiB;
constexpr size_t WS_C = 144 * MiB;
constexpr size_t WS_KI = 148 * MiB;
constexpr size_t WS_PS = 150 * MiB;
constexpr size_t WS_WFUP0 = 232 * MiB;
constexpr size_t WS_WFDN0 = 243 * MiB;
constexpr size_t WS_H0 = 64 * MiB;
constexpr size_t WS_PART0 = 152 * MiB;
constexpr size_t WS_HALO0 = 155 * MiB;
constexpr size_t WS_QT = 56 * MiB;
constexpr size_t WS_KT = 88 * MiB;
constexpr size_t WS_VT = 120 * MiB;
constexpr size_t WS_RET = 184 * MiB;
constexpr size_t WS_WFUP1 = 56 * MiB;
constexpr size_t WS_WFDN1 = 67 * MiB;
constexpr size_t WS_H1 = 88 * MiB;
constexpr size_t WS_PART1 = 176 * MiB;
constexpr size_t WS_HALO1 = 179 * MiB;

__device__ __forceinline__ unsigned short f2bf(float f) { unsigned u = __float_as_uint(f); return (unsigned short)((u + 0x7fffu + ((u >> 16) & 1u)) >> 16); }
__device__ __forceinline__ float bf2f(unsigned short h) { return __uint_as_float(((unsigned)h) << 16); }
__device__ __forceinline__ float bflo(unsigned w) { return __uint_as_float(w << 16); }
__device__ __forceinline__ float bfhi(unsigned w) { return __uint_as_float(w & 0xffff0000u); }
typedef __bf16 bf16x2_t __attribute__((ext_vector_type(2)));
typedef float f32x2_t __attribute__((ext_vector_type(2)));
__device__ __forceinline__ unsigned pk2(float lo, float hi) { const f32x2_t v = {lo, hi}; return __builtin_bit_cast(unsigned, __builtin_convertvector(v, bf16x2_t)); }
__device__ __forceinline__ float wave_sum(float v) {
#pragma unroll
    for (int o = 1; o < 64; o <<= 1) v += __shfl_xor(v, o);
    return v;
}
__device__ __forceinline__ float siluf(float x) { return x * __builtin_amdgcn_rcpf(1.0f + __builtin_amdgcn_exp2f(-1.4426950408889634f * x)); }
__device__ __forceinline__ float gamma_log(int h) { return h == 0 ? -0.031748698314580301f : h == 1 ? -0.015748356968139168f : h == 2 ? -0.0078431774610258787f : -0.0039138993211363287f; }

enum { WM_NAT = 0, WM_AIN = 1, WM_FUP = 2 };
__device__ __forceinline__ int wmap(int mode, int n) {
    if (mode == WM_NAT) return n;
    if (mode == WM_AIN) {
        if (n < 1152) return n;
        if (n < 1216) return O3 + (n - 1152);
        if (n < 1224) return O4 + (n - 1216);
        if (n < 1280) return -1;
        return O2 + (n - 1280);
    }
    const int p = n >> 8, bj = (n >> 7) & 1, i = n & 127;
    return bj * D_FF + 128 * p + i;
}

namespace pg8 {
#define PG8_LAS __attribute__((address_space(3)))
constexpr int BM = 256, BK = 64, HALF = 128, HTB = HALF * BK * 2, STAGE_BYTES = 8 * HTB, NXCD = 8, WGM = 8;
constexpr int XCH_OFF = 0, CWT_OFF = 2048, RT1_OFF = 6144, RT2_OFF = 14336;
__host__ __device__ __forceinline__ int lds_byte(int r, int c) { const int st = (r >> 4) * 2 + (c >> 5), rr = r & 15, cc = c & 31, ob = rr * 64 + cc * 2; return st * 1024 + (ob ^ (((ob >> 9) & 1) << 5)); }
__host__ __device__ __forceinline__ void stage_rc(int b, int& R, int& C) { const int st = b / 1024, sb = b % 1024, swz = sb ^ (((sb >> 9) & 1) << 5); R = (st >> 1) * 16 + swz / 64; C = (st & 1) * 32 + (swz % 64) / 2; }
__host__ __device__ __forceinline__ int perm32(int rho) { const int n = rho >> 4, i = rho & 15; return 8 * (i >> 2) + 4 * n + (i & 3); }
struct Unit { int pm, pn; };
struct Gemm { const bf16_t* A; const bf16_t* Bt; int M, N, K; };
struct StaticOrder {
    int nM, nN, nwg, G, c;
    __host__ __device__ __forceinline__ void init(int M_, int N_, int G_, int c_) { nM = M_ / BM; nN = N_ / BM; nwg = nM * nN; G = G_; c = c_; }
    __host__ __device__ __forceinline__ bool next(int i, Unit& u) const {
        const long L = (long)i * G + c; if (L >= nwg) return false;
        int wgid = (int)L; { const int q = nwg / NXCD, r = nwg % NXCD, xcd = wgid % NXCD, off = wgid / NXCD; wgid = (xcd < r ? xcd * (q + 1) : r * (q + 1) + (xcd - r) * q) + off; }
        const int nig = WGM * nN, gid = wgid / nig, fm = gid * WGM, gsz = (nM - fm) < WGM ? (nM - fm) : WGM;
        u.pm = fm + ((wgid % nig) % gsz); u.pn = (wgid % nig) / gsz; return true;
    }
};
__device__ __forceinline__ float rstd16(const float* ss16, int row) {
    float s = 0.f;
#pragma unroll
    for (int g = 0; g < 16; ++g) s += ss16[(size_t)g * M + row];
    return rsqrtf(s * (1.0f / DM) + EPS);
}
__device__ __forceinline__ float sel4(const float (&s)[4], int fq) { return fq == 0 ? s[0] : fq == 1 ? s[1] : fq == 2 ? s[2] : s[3]; }
__device__ __forceinline__ float ssq8(const f32x4 a, const f32x4 b) { return ((a[0] * a[0] + a[1] * a[1]) + (a[2] * a[2] + a[3] * a[3])) + ((b[0] * b[0] + b[1] * b[1]) + (b[2] * b[2] + b[3] * b[3])); }
__device__ __forceinline__ u32x4 pack8(const f32x4 a, const f32x4 b) { u32x4 w; w.x = pk2(a[0], a[1]); w.y = pk2(a[2], a[3]); w.z = pk2(b[0], b[1]); w.w = pk2(b[2], b[3]); return w; }

template <int MODE>
struct EpiRes {
    static constexpr bool PERM = true;
    static constexpr bool AROWPERM = false;
    const float* basef; float* out; bf16_t* xb; float* ss16;
    static constexpr int NTAB = 0;
    __device__ __forceinline__ void fill(PG8_LAS unsigned char*, int, const Unit&, int) const {}
    __device__ __forceinline__ void operator()(f32x4 (&acc)[2][2][4][2], const Unit& u, int ui, int wr, int wc, int fr, int fq, PG8_LAS unsigned char*) const {
        const int row0 = u.pm * BM + wr * 64 + fr, colb = u.pn * BM + wc * 32 + 8 * fq;
#pragma unroll
        for (int ai = 0; ai < 2; ++ai) {
            f32x4 bv[4][2][2];
#pragma unroll
            for (int m = 0; m < 4; ++m)
#pragma unroll
                for (int bj = 0; bj < 2; ++bj) { const size_t o = (size_t)(row0 + ai * HALF + m * 16) * DM + colb + bj * HALF;
                    if (MODE == 0) { bv[m][bj][0] = *(const f32x4*)(basef + o); bv[m][bj][1] = *(const f32x4*)(basef + o + 4); }
                    else { const u32x4 w = *(const u32x4*)(xb + o); bv[m][bj][0] = (f32x4){bflo(w.x), bfhi(w.x), bflo(w.y), bfhi(w.y)}; bv[m][bj][1] = (f32x4){bflo(w.z), bfhi(w.z), bflo(w.w), bfhi(w.w)}; } }
            float sm[4];
#pragma unroll
            for (int m = 0; m < 4; ++m) { const int row = row0 + ai * HALF + m * 16; float s = 0.f;
#pragma unroll
                for (int bj = 0; bj < 2; ++bj) { const size_t o = (size_t)row * DM + colb + bj * HALF;
                    const f32x4 v0 = acc[ai][bj][m][0] + bv[m][bj][0], v1 = acc[ai][bj][m][1] + bv[m][bj][1];
                    if (MODE == 2) { *(f32x4*)(out + o) = v0; *(f32x4*)(out + o + 4) = v1; }
                    else { s += ssq8(v0, v1); *(u32x4*)(xb + o) = pack8(v0, v1); } }
                if (MODE != 2) { s += __shfl_xor(s, 16); s += __shfl_xor(s, 32); }
                sm[m] = s; }
            if (MODE != 2) ss16[(size_t)(u.pn * 4 + wc) * M + u.pm * BM + ai * HALF + wr * 64 + 16 * fq + fr] = sel4(sm, fq);
            asm volatile("" ::: "memory"); }
    }
};
struct EpiA1 {
    static constexpr bool PERM = true;
    static constexpr bool AROWPERM = false;
    const float* ss16; const float* csc; bf16_t* Q; bf16_t* C; bf16_t* KI; bf16_t* QI; float* WI; float* PS;
    static constexpr int NTAB = 1;
    __device__ __forceinline__ void fill(PG8_LAS unsigned char* xl, int i, const Unit& u, int t) const { ((PG8_LAS float*)(xl + RT1_OFF))[i * 256 + t] = rstd16(ss16, u.pm * BM + t); }
    __device__ __forceinline__ void operator()(f32x4 (&acc)[2][2][4][2], const Unit& u, int ui, int wr, int wc, int fr, int fq, PG8_LAS unsigned char* xl) const {
        const int row0 = u.pm * BM + wr * 64 + fr, pn = u.pn;
        const PG8_LAS float* rt = (const PG8_LAS float*)(xl + RT1_OFF) + ui * 256 + wr * 64 + fr;
        float rs[2][4];
#pragma unroll
        for (int ai = 0; ai < 2; ++ai)
#pragma unroll
            for (int m = 0; m < 4; ++m) rs[ai][m] = rt[ai * HALF + m * 16];
#pragma unroll
        for (int bj = 0; bj < 2; ++bj) {
            const int cl = bj * HALF + wc * 32 + 8 * fq, gcol = pn * BM + cl;
            const f32x4 c0 = *(const f32x4*)(csc + gcol), c1 = *(const f32x4*)(csc + gcol + 4);
            bf16_t* dst; int ld; bool st16 = true, stwi = false;
            if (pn < 4) { dst = Q + gcol; ld = 1024; }
            else if (pn == 4) { if (bj == 0) { dst = C + cl; ld = 128; } else if (wc < 2) { dst = KI + (wc * 32 + 8 * fq); ld = 64; } else { dst = Q; ld = 0; st16 = false; stwi = (wc == 2) && (fq == 0); } }
            else { dst = QI + (pn - 5) * 256 + cl; ld = 512; }
#pragma unroll
            for (int ai = 0; ai < 2; ++ai) { float sm[4];
#pragma unroll
                for (int m = 0; m < 4; ++m) { const int row = row0 + ai * HALF + m * 16; const float r = rs[ai][m];
                    const f32x4 v0 = acc[ai][bj][m][0] * r, v1 = acc[ai][bj][m][1] * r;
                    float s = ssq8(v0, v1); s += __shfl_xor(s, 16); s += __shfl_xor(s, 32); sm[m] = s;
                    const f32x4 o0 = v0 * c0, o1 = v1 * c1;
                    if (st16) *(u32x4*)(dst + (size_t)row * ld) = pack8(o0, o1);
                    if (stwi) { *(f32x4*)(WI + (size_t)row * 8) = o0; *(f32x4*)(WI + (size_t)row * 8 + 4) = o1; }
                    if (m & 1) asm volatile("" ::: "memory"); }
                PS[(size_t)(pn * 8 + bj * 4 + wc) * M + u.pm * BM + ai * HALF + wr * 64 + 16 * fq + fr] = sel4(sm, fq); }
        }
    }
};
struct EpiF1 {
    static constexpr bool PERM = false;
    static constexpr bool AROWPERM = true;
    static constexpr int NTAB = 1;
    const float* ss16; const float* cw; const float* cb; bf16_t* H; float* PART; float* HALO;
    __device__ __forceinline__ void fill(PG8_LAS unsigned char* xl, int i, const Unit& u, int t) const { ((PG8_LAS float*)(xl + RT1_OFF))[i * 256 + t] = rstd16(ss16, u.pm * BM + t); }
    __device__ __forceinline__ void operator()(f32x4 (&acc)[2][2][4][2], const Unit& u, int ui, int wr, int wc, int fr, int fq, PG8_LAS unsigned char* xl) const {
        const int trow0 = 8 * (16 * wr + fr), grow0 = u.pm * BM + trow0, hcol = 128 * u.pn + 32 * wc + 4 * fq, tcol = 32 * wc + 4 * fq;
        const PG8_LAS float* rt = (const PG8_LAS float*)(xl + RT1_OFF) + ui * 256 + trow0;
        {   const f32x4 r0 = *(const PG8_LAS f32x4*)rt, r1 = *(const PG8_LAS f32x4*)(rt + 4);
#pragma unroll
            for (int m = 0; m < 4; ++m)
#pragma unroll
                for (int bj = 0; bj < 2; ++bj) { acc[0][bj][m][0] *= r0[m]; acc[0][bj][m][1] *= r0[m]; acc[1][bj][m][0] *= r1[m]; acc[1][bj][m][1] *= r1[m]; } }
        {   PG8_LAS float* cwt = (PG8_LAS float*)(xl + CWT_OFF); const int tid = ((wr * 4 + wc) * 4 + fq) * 16 + fr;
#pragma unroll
            for (int r = 0; r < 2; ++r) { const int idx = tid + r * 512, k = idx >> 8, c = idx & 255, orig = (c < 128) ? 128 * u.pn + c : D_FF + 128 * u.pn + (c - 128);
                cwt[idx] = (k < 3) ? cw[(size_t)k * FF2 + orig] : cb[orig]; } }
        PG8_LAS f32x4* X = (PG8_LAS f32x4*)(xl + XCH_OFF) + (wc * 4 + fq) * 8;
        if (wr == 0 && fr == 15) {
#pragma unroll
            for (int bj = 0; bj < 2; ++bj)
#pragma unroll
                for (int e = 0; e < 2; ++e)
#pragma unroll
                    for (int n = 0; n < 2; ++n) X[(bj * 2 + e) * 2 + n] = acc[1][bj][2 + e][n];
        }
        asm volatile("s_waitcnt vmcnt(0) lgkmcnt(0)" ::: "memory"); __builtin_amdgcn_s_barrier(); asm volatile("" ::: "memory");
        const bool need_fix = (wr == 0) && (fr == 0) && ((u.pm & 7) != 0);
        const bool give_halo = (wr == 1) && (fr == 15);
        const bool take_x = (wr == 1) && (fr == 0);
        float* part = PART + (size_t)u.pm * (2 * 2 * D_FF) + hcol;
        float* halo = HALO + (size_t)u.pm * (2 * 2 * D_FF) + hcol;
        const PG8_LAS float* cwt = (const PG8_LAS float*)(xl + CWT_OFF) + tcol;
#pragma unroll
        for (int n = 0; n < 2; ++n) {
            f32x4 pa[2], pb[2];
#pragma unroll
            for (int e = 0; e < 2; ++e) {
                f32x4 ha = (f32x4){0.f, 0.f, 0.f, 0.f}, hb = (f32x4){0.f, 0.f, 0.f, 0.f};
                if (take_x) { ha = X[(0 * 2 + e) * 2 + n]; hb = X[(1 * 2 + e) * 2 + n]; }
#pragma unroll
                for (int j = 0; j < 4; ++j) {
                    pa[e][j] = __int_as_float(__builtin_amdgcn_update_dpp(__float_as_int(ha[j]), __float_as_int(acc[1][0][2 + e][n][j]), 0x111, 0xf, 0xf, false));
                    pb[e][j] = __int_as_float(__builtin_amdgcn_update_dpp(__float_as_int(hb[j]), __float_as_int(acc[1][1][2 + e][n][j]), 0x111, 0xf, 0xf, false)); } }
            const f32x4 wa0 = *(const PG8_LAS f32x4*)(cwt + 16 * n), wa1 = *(const PG8_LAS f32x4*)(cwt + 256 + 16 * n), wa2 = *(const PG8_LAS f32x4*)(cwt + 512 + 16 * n), ba = *(const PG8_LAS f32x4*)(cwt + 768 + 16 * n);
            const f32x4 wb0 = *(const PG8_LAS f32x4*)(cwt + 128 + 16 * n), wb1 = *(const PG8_LAS f32x4*)(cwt + 384 + 16 * n), wb2 = *(const PG8_LAS f32x4*)(cwt + 640 + 16 * n), bb = *(const PG8_LAS f32x4*)(cwt + 896 + 16 * n);
            if (give_halo) {
                *(f32x4*)(halo + 16 * n) = acc[1][0][2][n]; *(f32x4*)(halo + D_FF + 16 * n) = acc[1][1][2][n];
                *(f32x4*)(halo + 2 * D_FF + 16 * n) = acc[1][0][3][n]; *(f32x4*)(halo + 3 * D_FF + 16 * n) = acc[1][1][3][n]; }
            u32x2 wprev = (u32x2){0u, 0u};
#pragma unroll
            for (int e = 0; e < 8; ++e) {
                const f32x4 ua = acc[e >> 2][0][e & 3][n], ub = acc[e >> 2][1][e & 3][n];
                const f32x4 ua1 = e >= 1 ? acc[(e - 1) >> 2][0][(e - 1) & 3][n] : pa[1], ub1 = e >= 1 ? acc[(e - 1) >> 2][1][(e - 1) & 3][n] : pb[1];
                const f32x4 ua2 = e >= 2 ? acc[(e - 2) >> 2][0][(e - 2) & 3][n] : pa[e], ub2 = e >= 2 ? acc[(e - 2) >> 2][1][(e - 2) & 3][n] : pb[e];
                const f32x4 av = ba + wa2 * ua + wa1 * ua1 + wa0 * ua2, bv = bb + wb2 * ub + wb1 * ub1 + wb0 * ub2;
                if (e < 2 && need_fix) { *(f32x4*)(part + (size_t)e * 2 * D_FF + 16 * n) = av; *(f32x4*)(part + (size_t)e * 2 * D_FF + D_FF + 16 * n) = bv; }
                u32x2 w; w.x = pk2(siluf(av[0]) * bv[0], siluf(av[1]) * bv[1]); w.y = pk2(siluf(av[2]) * bv[2], siluf(av[3]) * bv[3]);
                if ((e & 1) == 0) wprev = w;
                else {
                    const auto sx = __builtin_amdgcn_permlane16_swap(wprev.x, w.x, false, false), sy = __builtin_amdgcn_permlane16_swap(wprev.y, w.y, false, false);
                    u32x4 w4; w4.x = sx[0]; w4.y = sy[0]; w4.z = sx[1]; w4.w = sy[1];
                    *(u32x4*)(H + (size_t)(grow0 + e - 1 + (fq & 1)) * D_FF + 128 * u.pn + 32 * wc + 16 * n + 4 * (fq & 2)) = w4; }
            }
            asm volatile("" ::: "memory");
        }
    }
};
struct EpiB1 {
    static constexpr bool PERM = false;
    static constexpr bool AROWPERM = true;
    static constexpr int NTAB = 1;
    const float* ss16; const float2* rope; bf16_t* QT; bf16_t* KT; bf16_t* VT;
    __device__ __forceinline__ void fill(PG8_LAS unsigned char* xl, int i, const Unit& u, int t) const { ((PG8_LAS float*)(xl + RT1_OFF))[i * 256 + t] = rstd16(ss16, u.pm * BM + t); }
    __device__ __forceinline__ void operator()(f32x4 (&acc)[2][2][4][2], const Unit& u, int ui, int wr, int wc, int fr, int fq, PG8_LAS unsigned char* xl) const {
        const int trow0 = 8 * (16 * wr + fr), grow0 = u.pm * BM + trow0, pn = u.pn, t0 = grow0 & (SEQ - 1);
        const PG8_LAS float* rt = (const PG8_LAS float*)(xl + RT1_OFF) + ui * 256 + trow0;
        const f32x4 r0 = *(const PG8_LAS f32x4*)rt, r1 = *(const PG8_LAS f32x4*)(rt + 4);
        if (pn < 8) {
            const int h = pn & 3; const bool isk = pn >= 4; const float lg = gamma_log(h);
            bf16_t* dbase = (isk ? KT : QT) + (size_t)grow0 * 1024 + h * 256 + 32 * wc + 4 * (fq & 2);
            float sc[8];
#pragma unroll
            for (int e = 0; e < 8; ++e) { const int pos = (t0 + e) & 63; sc[e] = (e < 4 ? r0[e & 3] : r1[e & 3]) * (isk ? 0.0625f * __expf(-(float)(pos + 1) * lg) : __expf((float)(pos + 1) * lg)); }
#pragma unroll
            for (int n = 0; n < 2; ++n) {
                const int i0 = 32 * wc + 16 * n + 4 * fq;
                f32x4 cur[2], dw[2];
                {   const f32x4* rp = (const f32x4*)(rope + (size_t)t0 * 128 + i0); const f32x4* rw = (const f32x4*)(rope + (size_t)128 + i0); cur[0] = rp[0]; cur[1] = rp[1]; dw[0] = rw[0]; dw[1] = rw[1]; }
                u32x2 p1 = (u32x2){0u, 0u}, p2 = (u32x2){0u, 0u};
#pragma unroll
                for (int e = 0; e < 8; ++e) {
                    const f32x4 c0 = cur[0], c1 = cur[1];
                    const f32x4 x1 = acc[e >> 2][0][e & 3][n] * sc[e], x2 = acc[e >> 2][1][e & 3][n] * sc[e];
                    f32x4 o1, o2;
                    o1[0] = x1[0] * c0[0] - x2[0] * c0[1]; o2[0] = x1[0] * c0[1] + x2[0] * c0[0];
                    o1[1] = x1[1] * c0[2] - x2[1] * c0[3]; o2[1] = x1[1] * c0[3] + x2[1] * c0[2];
                    o1[2] = x1[2] * c1[0] - x2[2] * c1[1]; o2[2] = x1[2] * c1[1] + x2[2] * c1[0];
                    o1[3] = x1[3] * c1[2] - x2[3] * c1[3]; o2[3] = x1[3] * c1[3] + x2[3] * c1[2];
                    u32x2 w1, w2; w1.x = pk2(o1[0], o1[1]); w1.y = pk2(o1[2], o1[3]); w2.x = pk2(o2[0], o2[1]); w2.y = pk2(o2[2], o2[3]);
                    if ((e & 1) == 0) { p1 = w1; p2 = w2; }
                    else {
                        const auto ax = __builtin_amdgcn_permlane16_swap(p1.x, w1.x, false, false), ay = __builtin_amdgcn_permlane16_swap(p1.y, w1.y, false, false);
                        const auto bx = __builtin_amdgcn_permlane16_swap(p2.x, w2.x, false, false), by = __builtin_amdgcn_permlane16_swap(p2.y, w2.y, false, false);
                        bf16_t* d = dbase + (size_t)(e - 1 + (fq & 1)) * 1024 + 16 * n;
                        u32x4 v1; v1.x = ax[0]; v1.y = ay[0]; v1.z = ax[1]; v1.w = ay[1]; *(u32x4*)d = v1;
                        u32x4 v2; v2.x = bx[0]; v2.y = by[0]; v2.z = bx[1]; v2.w = by[1]; *(u32x4*)(d + 128) = v2; }
                    if (e < 7) {
#pragma unroll
                        for (int q = 0; q < 2; ++q) { const f32x4 c = cur[q], dd = dw[q]; f32x4 nx;
                            nx[0] = c[0] * dd[0] - c[1] * dd[1]; nx[1] = c[1] * dd[0] + c[0] * dd[1]; nx[2] = c[2] * dd[2] - c[3] * dd[3]; nx[3] = c[3] * dd[2] + c[2] * dd[3]; cur[q] = nx; } }
                }
                asm volatile("" ::: "memory");
            }
        } else {
            const int b = grow0 / SEQ;
            bf16_t* dst = VT + ((size_t)b * 2048 + (pn - 8) * 256 + 32 * wc + 4 * fq) * SEQ + t0;
#pragma unroll
            for (int bj = 0; bj < 2; ++bj)
#pragma unroll
                for (int n = 0; n < 2; ++n)
#pragma unroll
                    for (int j = 0; j < 4; ++j) { u32x4 w;
                        w.x = pk2(acc[0][bj][0][n][j] * r0[0], acc[0][bj][1][n][j] * r0[1]); w.y = pk2(acc[0][bj][2][n][j] * r0[2], acc[0][bj][3][n][j] * r0[3]);
                        w.z = pk2(acc[1][bj][0][n][j] * r1[0], acc[1][bj][1][n][j] * r1[1]); w.w = pk2(acc[1][bj][2][n][j] * r1[2], acc[1][bj][3][n][j] * r1[3]);
                        *(u32x4*)(dst + (size_t)(128 * bj + 16 * n + j) * SEQ) = w; }
        }
    }
};
struct EpiGate {
    static constexpr bool PERM = true;
    static constexpr bool AROWPERM = false;
    static constexpr int NTAB = 1;
    const float* ss16; const float* ssr; bf16_t* RET;
    __device__ __forceinline__ void fill(PG8_LAS unsigned char* xl, int i, const Unit& u, int t) const {
        const int row = u.pm * BM + t;
        ((PG8_LAS float*)(xl + RT1_OFF))[i * 256 + t] = rstd16(ss16, row);
        const f32x4* sp = (const f32x4*)(ssr + ((size_t)row * 4 + (u.pn >> 1)) * 16); const f32x4 s0 = sp[0], s1 = sp[1], s2 = sp[2], s3 = sp[3];
        ((PG8_LAS float*)(xl + RT2_OFF))[i * 256 + t] = rsqrtf(((((s0[0] + s0[1]) + (s0[2] + s0[3])) + ((s1[0] + s1[1]) + (s1[2] + s1[3]))) + (((s2[0] + s2[1]) + (s2[2] + s2[3])) + ((s3[0] + s3[1]) + (s3[2] + s3[3])))) * (1.0f / 512.0f) + EPS);
    }
    __device__ __forceinline__ void operator()(f32x4 (&acc)[2][2][4][2], const Unit& u, int ui, int wr, int wc, int fr, int fq, PG8_LAS unsigned char* xl) const {
        const int row0 = u.pm * BM + wr * 64 + fr, colb = u.pn * BM + wc * 32 + 8 * fq;
        const PG8_LAS float* rt = (const PG8_LAS float*)(xl + RT1_OFF) + ui * 256 + wr * 64 + fr;
        const PG8_LAS float* rt2 = (const PG8_LAS float*)(xl + RT2_OFF) + ui * 256 + wr * 64 + fr;
        u32x4 rvv[2][4][2];
#pragma unroll
        for (int ai = 0; ai < 2; ++ai)
#pragma unroll
            for (int m = 0; m < 4; ++m)
#pragma unroll
                for (int bj = 0; bj < 2; ++bj) rvv[ai][m][bj] = *(const u32x4*)(RET + (size_t)(row0 + ai * HALF + m * 16) * 2048 + colb + bj * HALF);
#pragma unroll
        for (int ai = 0; ai < 2; ++ai)
#pragma unroll
            for (int m = 0; m < 4; ++m) { const int row = row0 + ai * HALF + m * 16; const float r = rt[ai * HALF + m * 16], rh = rt2[ai * HALF + m * 16];
#pragma unroll
                for (int bj = 0; bj < 2; ++bj) { bf16_t* p = RET + (size_t)row * 2048 + colb + bj * HALF; const u32x4 rv = rvv[ai][m][bj];
                    const f32x4 g0 = acc[ai][bj][m][0] * r, g1 = acc[ai][bj][m][1] * r; f32x4 y0, y1;
                    y0[0] = bflo(rv.x) * rh * siluf(g0[0]); y0[1] = bfhi(rv.x) * rh * siluf(g0[1]); y0[2] = bflo(rv.y) * rh * siluf(g0[2]); y0[3] = bfhi(rv.y) * rh * siluf(g0[3]);
                    y1[0] = bflo(rv.z) * rh * siluf(g1[0]); y1[1] = bfhi(rv.z) * rh * siluf(g1[1]); y1[2] = bflo(rv.w) * rh * siluf(g1[2]); y1[3] = bfhi(rv.w) * rh * siluf(g1[3]);
                    *(u32x4*)p = pack8(y0, y1); } }
    }
};

template <class Epi, class Sched>
__device__ __forceinline__ void gemm_phase(PG8_LAS unsigned char* lds, const Gemm g, const Sched& S, const Epi& E) {
    int tid_ = threadIdx.x; asm volatile("" : "+v"(tid_));
    const int tid = tid_, wid = __builtin_amdgcn_readfirstlane(tid >> 6), lane = tid & 63, wr = wid >> 2, wc = wid & 3, fr = lane & 15, fq = lane >> 4;
    const int K = g.K, nt = K / BK;
    unsigned voffA0[2], voffA1[2], voffB[2];
#pragma unroll
    for (int i = 0; i < 2; ++i) { int R, C; stage_rc(tid * 16 + i * 8192, R, C); const int Rb = Epi::PERM ? (R & ~31) + perm32(R & 31) : R;
        int ra0, ra1;
        if (Epi::AROWPERM) { const int base = ((R >> 6) * 16 + (R & 15)) * 8 + ((R >> 4) & 3); ra0 = base; ra1 = base + 4; } else { ra0 = R; ra1 = R + HALF; }
        voffA0[i] = (unsigned)(ra0 * K + C) * 2u; voffA1[i] = (unsigned)(ra1 * K + C) * 2u; voffB[i] = (unsigned)(Rb * K + C) * 2u; }
    const size_t kstep = (size_t)(BK * 2);
    const size_t hstep = (size_t)HALF * K * 2;
    const size_t tstep = 2 * hstep;
    const unsigned ldsw = (unsigned)wid * 1024u;
    const int aoff = lds_byte(wr * 64 + fr, fq * 8), boff = lds_byte(wc * 32 + fr, fq * 8);
#define PG8_SA(b, h) (((b) * 2 + (h)) * HTB)
#define PG8_SB(b, h) ((4 + (b) * 2 + (h)) * HTB)
#define PG8_STAGE(bufoff, gbase, voff) do { _Pragma("unroll") for (int _i = 0; _i < 2; ++_i) \
        __builtin_amdgcn_global_load_lds((const unsigned*)((const char*)(gbase) + (voff)[_i]), (PG8_LAS unsigned*)(lds + (bufoff) + ldsw + _i * 8192), 16, 0, 0); } while (0)
#define PG8_LDA(dst, b, h) do { _Pragma("unroll") for (int m = 0; m < 4; ++m) _Pragma("unroll") for (int k = 0; k < 2; ++k) dst[m][k] = *(const PG8_LAS bf16x8*)(lds + PG8_SA(b, h) + aoff + m * 2048 + k * 1024); } while (0)
#define PG8_LDB(dst, b, h) do { _Pragma("unroll") for (int n = 0; n < 2; ++n) _Pragma("unroll") for (int k = 0; k < 2; ++k) dst[n][k] = *(const PG8_LAS bf16x8*)(lds + PG8_SB(b, h) + boff + n * 2048 + k * 1024); } while (0)
#define PG8_MMA(ai, bj, At, Bt) do { __builtin_amdgcn_s_setprio(1); _Pragma("unroll") for (int m = 0; m < 4; ++m) _Pragma("unroll") for (int n = 0; n < 2; ++n) _Pragma("unroll") for (int k = 0; k < 2; ++k) \
        acc[ai][bj][m][n] = __builtin_amdgcn_mfma_f32_16x16x32_bf16(Bt[n][k], At[m][k], acc[ai][bj][m][n], 0, 0, 0); __builtin_amdgcn_s_setprio(0); } while (0)
#define PG8_WAIT_V(n) asm volatile("s_waitcnt vmcnt(" #n ")" ::: "memory")
#define PG8_WAIT_L(n) asm volatile("s_waitcnt lgkmcnt(" #n ")" ::: "memory")
#define PG8_BAR __builtin_amdgcn_s_barrier()
#define PG8_SCHED __builtin_amdgcn_sched_barrier(0)
    Unit cur, nxt; int ui = 0;
    if (!S.next(0, cur)) return;
    f32x4 acc[2][2][4][2];
#pragma unroll
    for (int a = 0; a < 2; ++a)
#pragma unroll
        for (int b = 0; b < 2; ++b)
#pragma unroll
            for (int m = 0; m < 4; ++m)
#pragma unroll
                for (int n = 0; n < 2; ++n) acc[a][b][m][n] = (f32x4){0.f, 0.f, 0.f, 0.f};
    bf16x8 At[4][2], B0[2][2], B1[2][2];
    const char* cA = (const char*)g.A + (size_t)cur.pm * tstep; const char* cB = (const char*)g.Bt + (size_t)cur.pn * tstep;
    PG8_STAGE(PG8_SB(0, 0), cB, voffB); PG8_STAGE(PG8_SB(0, 1), cB + hstep, voffB); PG8_STAGE(PG8_SA(0, 0), cA, voffA0); PG8_STAGE(PG8_SA(0, 1), cA, voffA1);
    if constexpr (Epi::NTAB > 0) {
#pragma unroll 1
        for (int i = tid >> 8; i < 8; i += 2) { Unit uu; if (!S.next(i, uu)) break; E.fill(lds + STAGE_BYTES, i, uu, tid & 255); asm volatile("" ::: "memory"); }
        asm volatile("s_waitcnt lgkmcnt(0)" ::: "memory");
    }
    if (wr == 1) PG8_BAR;
    PG8_WAIT_V(2); PG8_BAR;
    PG8_STAGE(PG8_SB(1, 0), cB + kstep, voffB); PG8_STAGE(PG8_SA(1, 0), cA + kstep, voffA0); PG8_STAGE(PG8_SB(1, 1), cB + hstep + kstep, voffB);
    PG8_WAIT_V(6); PG8_BAR;
    for (;;) {
        const bool has_next = S.next(ui + 1, nxt);
        const char* nA = has_next ? (const char*)g.A + (size_t)nxt.pm * tstep : cA; const char* nB = has_next ? (const char*)g.Bt + (size_t)nxt.pn * tstep : cB;
        for (int t = 0; t < nt; t += 2) {
            const bool last = (t == nt - 2);
            const char* a1 = cA + (size_t)(t + 1) * kstep;
            const char* a2 = last ? nA : cA + (size_t)(t + 2) * kstep; const char* b2 = last ? nB : cB + (size_t)(t + 2) * kstep;
            const char* a3 = a2 + kstep; const char* b3 = b2 + kstep;
            PG8_LDB(B0, 0, 0); PG8_LDB(B1, 0, 1); PG8_SCHED; PG8_LDA(At, 0, 0); PG8_STAGE(PG8_SA(1, 1), a1, voffA1);
            PG8_WAIT_V(8); PG8_WAIT_L(0); PG8_BAR; PG8_MMA(0, 0, At, B0); PG8_MMA(0, 1, At, B1); PG8_BAR; PG8_SCHED;
            PG8_LDA(At, 0, 1); PG8_STAGE(PG8_SB(0, 0), b2, voffB); PG8_STAGE(PG8_SB(0, 1), b2 + hstep, voffB); PG8_STAGE(PG8_SA(0, 0), a2, voffA0);
            PG8_WAIT_V(8); PG8_WAIT_L(0); PG8_BAR; PG8_MMA(1, 0, At, B0); PG8_MMA(1, 1, At, B1); PG8_BAR; PG8_SCHED;
            PG8_LDB(B0, 1, 0); PG8_LDB(B1, 1, 1); PG8_SCHED; PG8_LDA(At, 1, 0); PG8_STAGE(PG8_SA(0, 1), a2, voffA1);
            PG8_WAIT_V(8); PG8_WAIT_L(0); PG8_BAR; PG8_MMA(0, 0, At, B0); PG8_MMA(0, 1, At, B1); PG8_BAR; PG8_SCHED;
            PG8_LDA(At, 1, 1); PG8_STAGE(PG8_SB(1, 0), b3, voffB); PG8_STAGE(PG8_SB(1, 1), b3 + hstep, voffB); PG8_STAGE(PG8_SA(1, 0), a3, voffA0);
            PG8_WAIT_V(8); PG8_WAIT_L(0); PG8_BAR; PG8_MMA(1, 0, At, B0); PG8_MMA(1, 1, At, B1); PG8_BAR; PG8_SCHED;
        }
        if (wr == 0) PG8_BAR;
        E(acc, cur, ui, wr, wc, fr, fq, lds + STAGE_BYTES);
        if (!has_next) break;
#pragma unroll
        for (int a = 0; a < 2; ++a)
#pragma unroll
            for (int b = 0; b < 2; ++b)
#pragma unroll
                for (int m = 0; m < 4; ++m)
#pragma unroll
                    for (int n = 0; n < 2; ++n) acc[a][b][m][n] = (f32x4){0.f, 0.f, 0.f, 0.f};
        cur = nxt; cA = nA; cB = nB; ++ui;
        if (wr == 1) PG8_BAR;
    }
    PG8_WAIT_V(0);
    PG8_BAR;
#undef PG8_SA
#undef PG8_SB
#undef PG8_STAGE
#undef PG8_LDA
#undef PG8_LDB
#undef PG8_MMA
#undef PG8_WAIT_V
#undef PG8_WAIT_L
#undef PG8_BAR
#undef PG8_SCHED
}
}

constexpr int NWAVES = 8;
constexpr int RING_BYTES = 131072, LDS_BYTES = 163840, LDSCTL_OFF = LDS_BYTES - 512, MISC_OFF = LDSCTL_OFF + 320;
#define GAS __attribute__((address_space(1)))
#define LAS __attribute__((address_space(3)))
typedef GAS unsigned gu32;
#define RLX_AGENT __ATOMIC_RELAXED, __HIP_MEMORY_SCOPE_AGENT
#define LDS_WAIT() asm volatile("s_waitcnt lgkmcnt(0)" ::: "memory")
#define VM_WAIT() asm volatile("s_waitcnt vmcnt(0)" ::: "memory")
constexpr int CW_BAR = 4096;
#define XB_TMO      128
#define XB_XCNT(j)  (256  + 64 * (j))
#define XB_XSUB(j)  (1280 + 64 * (j))
#define XB_XGEN(j)  (2304 + 64 * (j))
#define XB_TOP      3328
#define XB_TOPGEN   3392
#define XCD_BAR_WORDS 3456
#define XB_SPIN_CAP (1u << 18)
__device__ __forceinline__ unsigned xb_ld(unsigned* p)              { return __hip_atomic_load(p, __ATOMIC_RELAXED, __HIP_MEMORY_SCOPE_AGENT); }
__device__ __forceinline__ unsigned xb_add(unsigned* p, unsigned v) { return __hip_atomic_fetch_add(p, v, __ATOMIC_RELAXED, __HIP_MEMORY_SCOPE_AGENT); }
__device__ __forceinline__ unsigned xb_xcc_id() { return (unsigned)__builtin_amdgcn_s_getreg((3 << 11) | 20) & 0xFu; }
#define XB_SPIN(cond, bar) do { unsigned _sp = 0; while (cond) { __builtin_amdgcn_s_sleep(1); \
    if ((++_sp & 255u) == 0u) { if (xb_ld(&(bar)[XB_TMO])) break; if (_sp > XB_SPIN_CAP) { atomicAdd(&(bar)[XB_TMO], 1u); break; } } } } while (0)
struct XcdBarrier { unsigned* bar; unsigned x; volatile LAS unsigned* st; };
__device__ __forceinline__ XcdBarrier xcd_barrier_post(unsigned* bar, volatile LAS unsigned* st) {
    XcdBarrier b; b.bar = bar; b.x = xb_xcc_id(); b.st = st;
    if (threadIdx.x == 0) (void)xb_add(&bar[XB_XCNT(b.x)], 1u);
    return b;
}
__device__ __forceinline__ void xcd_barrier_complete(unsigned* bar, unsigned x, unsigned& nloc, unsigned& nx) {
    const unsigned G = gridDim.x * gridDim.y * gridDim.z;
    unsigned sum, cnt, mine, sp = 0u;
    for (;;) {
        sum = 0u; cnt = 0u; mine = 0u;
#pragma unroll
        for (unsigned j = 0; j < 16; ++j) { const unsigned c = xb_ld(&bar[XB_XCNT(j)]); sum += c; cnt += (c > 0u) ? 1u : 0u; mine = (j == x) ? c : mine; }
        if (sum == G) break;
        __builtin_amdgcn_s_sleep(1);
        if ((++sp & 255u) == 0u) { if (xb_ld(&bar[XB_TMO])) break; if (sp > XB_SPIN_CAP) { atomicAdd(&bar[XB_TMO], 1u); break; } }
    }
    nloc = mine > 0u ? mine : 1u; nx = cnt > 0u ? cnt : 1u;
}
__device__ __forceinline__ void xcd_barrier(const XcdBarrier& b) {
    asm volatile("s_waitcnt vmcnt(0)" ::: "memory");
    __syncthreads();
    if (threadIdx.x == 0) {
        unsigned* bar = b.bar;
        __builtin_amdgcn_s_waitcnt(0);
        unsigned nloc = b.st[0], nx = b.st[1];
        if (nloc == 0u) { xcd_barrier_complete(bar, b.x, nloc, nx); b.st[0] = nloc; b.st[1] = nx; }
        const unsigned old = xb_add(&bar[XB_XSUB(b.x)], 1u);
        const unsigned gen = old / nloc;
        if (old + 1u == (gen + 1u) * nloc) {
            __builtin_amdgcn_fence(__ATOMIC_RELEASE, "agent");
            asm volatile("s_waitcnt vmcnt(0)" ::: "memory");
            const unsigned og = xb_add(&bar[XB_TOP], 1u);
            const unsigned tg = og / nx;
            if (og + 1u == (tg + 1u) * nx) xb_add(&bar[XB_TOPGEN], 1u);
            else XB_SPIN(xb_ld(&bar[XB_TOPGEN]) == tg, bar);
            __builtin_amdgcn_fence(__ATOMIC_ACQUIRE, "agent");
            xb_add(&bar[XB_XGEN(b.x)], 1u);
            asm volatile("s_waitcnt vmcnt(0)" ::: "memory");
        } else {
            XB_SPIN(xb_ld(&bar[XB_XGEN(b.x)]) == gen, bar);
            __builtin_amdgcn_fence(__ATOMIC_ACQUIRE, "agent");
            asm volatile("s_waitcnt vmcnt(0)" ::: "memory");
        }
    }
    __syncthreads();
}

struct Args { const float* in[16]; float* out; unsigned char* ws; int ph_lo, ph_hi, li, pad; };
enum { PH_PRO = 0, PH_A1, PH_A2, PH_A3, PH_F1A, PH_F2A, PH_B1, PH_B2, PH_GATE, PH_B3, PH_F1B, PH_F2B, PH_END };

__device__ __forceinline__ void p0_transpose_item(const float* W, int K, int Nsrc, int N, int mode, const float* gain, bf16_t* WT, LAS float* scr, int item, int lane) {
    const int nblk = N / 64, kb = item / nblk, nb = item % nblk, k0 = 64 * kb, n0 = 64 * nb;
    const int src = wmap(mode, n0 + lane);
    const float* wp = W + (size_t)k0 * Nsrc + (src >= 0 ? src : 0);
#pragma unroll
    for (int h = 0; h < 2; ++h) { float v[32];
#pragma unroll
        for (int i = 0; i < 32; ++i) v[i] = wp[(size_t)(32 * h + i) * Nsrc];
#pragma unroll
        for (int i = 0; i < 32; ++i) { float x = v[i]; if (gain) x *= gain[k0 + 32 * h + i]; if (src < 0) x = 0.f; scr[(32 * h + i) * 65 + lane] = x; } }
    LDS_WAIT(); asm volatile("" ::: "memory");
    const int kq = (lane & 3) * 16;
#pragma unroll
    for (int j = 0; j < 4; ++j) { const int n = (lane >> 2) + 16 * j; const LAS float* sp = scr + kq * 65 + n;
        u32x4 o0, o1;
        o0.x = pk2(sp[0 * 65], sp[1 * 65]); o0.y = pk2(sp[2 * 65], sp[3 * 65]); o0.z = pk2(sp[4 * 65], sp[5 * 65]); o0.w = pk2(sp[6 * 65], sp[7 * 65]);
        o1.x = pk2(sp[8 * 65], sp[9 * 65]); o1.y = pk2(sp[10 * 65], sp[11 * 65]); o1.z = pk2(sp[12 * 65], sp[13 * 65]); o1.w = pk2(sp[14 * 65], sp[15 * 65]);
        bf16_t* dst = WT + (size_t)(n0 + n) * K + k0 + kq; *(u32x4*)dst = o0; *(u32x4*)(dst + 8) = o1; }
    LDS_WAIT(); asm volatile("" ::: "memory");
}
__device__ __forceinline__ void ffn_fixup(int pm, const float* cw, const float* PART, const float* HALO, bf16_t* H) {
    if ((pm & 7) == 0) return;
    int tid = threadIdx.x; asm volatile("" : "+v"(tid));
    const float* part = PART + (size_t)pm * (4 * D_FF); const float* halo = HALO + (size_t)(pm - 1) * (4 * D_FF);
#pragma unroll
    for (int idx0 = 0; idx0 < 2 * D_FF; idx0 += NWAVES * 64) { const int idx = idx0 + tid; const int e = idx / D_FF, c = idx - e * D_FF;
        float a = part[(size_t)e * 2 * D_FF + c], b = part[(size_t)e * 2 * D_FF + D_FF + c];
        const float ha0 = halo[c], hb0 = halo[D_FF + c], ha1 = halo[2 * D_FF + c], hb1 = halo[3 * D_FF + c];
        const float wa0 = cw[c], wa1 = cw[FF2 + c], wb0 = cw[D_FF + c], wb1 = cw[FF2 + D_FF + c];
        if (e == 0) { a += wa1 * ha1 + wa0 * ha0; b += wb1 * hb1 + wb0 * hb0; } else { a += wa0 * ha1; b += wb0 * hb1; }
        H[(size_t)(pm * 256 + e) * D_FF + c] = f2bf(siluf(a) * b); }
}


__device__ __forceinline__ void glds16_asm(const void* gsrc, unsigned lds_dst) {
    unsigned keep; asm volatile("s_mov_b32 %0, m0\n\ts_mov_b32 m0, %2\n\ts_nop 0\n\tglobal_load_lds_dwordx4 %1, off\n\ts_mov_b32 m0, %0" : "=&s"(keep) : "v"(gsrc), "s"(lds_dst) : "memory"); }
__device__ __forceinline__ unsigned lds_addr(LAS unsigned char* p) { return (unsigned)__builtin_amdgcn_readfirstlane((int)(unsigned)(size_t)p); }

typedef short s16x4 __attribute__((ext_vector_type(4)));
__device__ __forceinline__ bf16x8 cat4(s16x4 a, s16x4 b) { bf16x8 r; r[0] = a[0]; r[1] = a[1]; r[2] = a[2]; r[3] = a[3]; r[4] = b[0]; r[5] = b[1]; r[6] = b[2]; r[7] = b[3]; return r; }
__device__ __forceinline__ void ret_fast_phase(LAS unsigned char* lds, const bf16_t* QT, const bf16_t* KT, const bf16_t* VT, bf16_t* RET, float* SSR, int unit) {
    int tid_ = threadIdx.x; asm volatile("" : "+v"(tid_));
    const int tid = tid_, lane = tid & 63, w = __builtin_amdgcn_readfirstlane(tid >> 6), li = lane & 15, g = lane >> 4;
    const int blk = unit & 7, h = (unit >> 3) & 3, b = unit >> 5;
    const float g64 = __expf(64.0f * gamma_log(h));
    const bool isR = w < 4; const int qt = w & 3, u = w & 3;
    constexpr int KB = 0, VB = 65536, ST = 81920;
    typedef __attribute__((address_space(3))) s16x4 lds_s16x4;
    for (int e = tid; e < 2048; e += 512) *(LAS u32x4*)(lds + ST + e * 16) = (u32x4){0u, 0u, 0u, 0u};
    f32x4 rg[16];
#pragma unroll
    for (int i = 0; i < 16; ++i) rg[i] = (f32x4){0.f, 0.f, 0.f, 0.f};
    const size_t rowb = (size_t)b * SEQ;
    const bf16_t* kbase = KT + rowb * 1024 + h * 256;
    const bf16_t* qbase = QT + (rowb + 16 * qt + li) * 1024 + h * 256 + 8 * g;
    const bf16_t* vbase = VT + ((size_t)b * 2048 + h * 512 + blk * 64 + (tid >> 3)) * SEQ + 8 * (tid & 7);
    const unsigned vw_off = (unsigned)((tid >> 3) * 128 + (((2 * (tid & 7)) ^ ((tid >> 3) & 14)) * 8));
    unsigned ksrc[8];
#pragma unroll
    for (int i = 0; i < 8; ++i) { const int row = 2 * (8 * u + i) + (lane >> 5), p = lane & 31, c = p ^ ((row & 7) << 1); ksrc[i] = (unsigned)(row * 2048 + c * 16); }
#define RK_DMA(n_, buf_) do { const char* kb_ = (const char*)(kbase + (size_t)(n_) * 64 * 1024); const unsigned ld_ = lds_addr(lds + KB + (buf_) * 32768 + (8 * u) * 1024); _Pragma("unroll") for (int i = 0; i < 8; ++i) \
        glds16_asm(kb_ + ksrc[i], ld_ + i * 1024); } while (0)
    u32x4 vreg;
    if (!isR) { RK_DMA(0, 0); }
    vreg = *(const u32x4*)(vbase);
    if (isR) {
#pragma unroll
        for (int ks = 0; ks < 8; ++ks) rg[ks] = *(const f32x4*)(qbase + 32 * ks); }
    *(LAS u32x4*)(lds + VB + vw_off) = vreg;
    asm volatile("s_waitcnt vmcnt(0) lgkmcnt(0)" ::: "memory"); __builtin_amdgcn_s_barrier(); asm volatile("" ::: "memory");
#pragma unroll 1
    for (int n = 0; n < 32; ++n) {
        const int cur = n & 1, nxt = cur ^ 1;
        LAS unsigned char* kb = lds + KB + cur * 32768; LAS unsigned char* vb = lds + VB + cur * 8192; LAS unsigned char* sb = lds + ST + cur * 32768;
        if (n + 1 < 32) vreg = *(const u32x4*)(vbase + (size_t)(n + 1) * 64);
        if (isR) {
            if (n + 1 < 32) {
#pragma unroll
                for (int ks = 0; ks < 8; ++ks) rg[8 + ks] = *(const f32x4*)(qbase + (size_t)(n + 1) * 64 * 1024 + 32 * ks); }
            s16x4 sfr[4];
#pragma unroll
            for (int kt = 0; kt < 4; ++kt) { sfr[kt] = (s16x4){0, 0, 0, 0};
                if (kt <= qt) {
                    f32x4 acc = (f32x4){0.f, 0.f, 0.f, 0.f};
                    const int row = 16 * kt + li; const LAS unsigned char* rp = kb + row * 512; const int sw = (row & 7) << 1;
                    bf16x8 av[8];
#pragma unroll
                    for (int ks = 0; ks < 8; ++ks) av[ks] = *(const LAS bf16x8*)(rp + (((4 * ks + g) ^ sw) * 16));
                    __builtin_amdgcn_sched_barrier(0);
#pragma unroll
                    for (int ks = 0; ks < 8; ++ks) acc = __builtin_amdgcn_mfma_f32_16x16x32_bf16(av[ks], __builtin_bit_cast(bf16x8, rg[ks]), acc, 0, 0, 0);
                    if (kt == qt) {
#pragma unroll
                        for (int r = 0; r < 4; ++r) acc[r] = (4 * g + r <= li) ? acc[r] : 0.f; }
                    u32x2 pk; pk.x = pk2(acc[0], acc[1]); pk.y = pk2(acc[2], acc[3]);
                    sfr[kt] = __builtin_bit_cast(s16x4, pk); } }
            const bf16x8 sf0 = cat4(sfr[0], sfr[1]), sf1 = cat4(sfr[2], sfr[3]);
            float ssq = 0.f; u32x2 pkt[4];
#pragma unroll
            for (int t = 0; t < 4; ++t) {
                bf16x8 sa[8]; bf16x8 vf0, vf1;
                {   const int row = 16 * t + li; const LAS unsigned char* rp = sb + row * 512; const int sw = (row & 7) << 1;
#pragma unroll
                    for (int ks = 0; ks < 8; ++ks) sa[ks] = *(const LAS bf16x8*)(rp + (((4 * ks + g) ^ sw) * 16));
                    const LAS unsigned char* vp = vb + row * 128; const int f = row & 14;
                    vf0 = cat4(*(const LAS s16x4*)(vp + (((g) ^ f) * 8)), *(const LAS s16x4*)(vp + (((4 + g) ^ f) * 8)));
                    vf1 = cat4(*(const LAS s16x4*)(vp + (((8 + g) ^ f) * 8)), *(const LAS s16x4*)(vp + (((12 + g) ^ f) * 8))); }
                __builtin_amdgcn_sched_barrier(0);
                f32x4 acc = (f32x4){0.f, 0.f, 0.f, 0.f};
                acc = __builtin_amdgcn_mfma_f32_16x16x32_bf16(vf0, sf0, acc, 0, 0, 0);
                if (qt >= 2) acc = __builtin_amdgcn_mfma_f32_16x16x32_bf16(vf1, sf1, acc, 0, 0, 0);
#pragma unroll
                for (int ks = 0; ks < 8; ++ks) acc = __builtin_amdgcn_mfma_f32_16x16x32_bf16(sa[ks], __builtin_bit_cast(bf16x8, rg[ks]), acc, 0, 0, 0);
                ssq += (acc[0] * acc[0] + acc[1] * acc[1]) + (acc[2] * acc[2] + acc[3] * acc[3]);
                pkt[t].x = pk2(acc[0], acc[1]); pkt[t].y = pk2(acc[2], acc[3]);
                __builtin_amdgcn_sched_barrier(0); }
            bf16_t* rrow = RET + (rowb + n * 64 + 16 * qt + li) * 2048 + h * 512 + blk * 64 + 16 * (g & 1) + 4 * (g & 2);
#pragma unroll
            for (int pp = 0; pp < 2; ++pp) {
                const auto sx = __builtin_amdgcn_permlane16_swap(pkt[2 * pp].x, pkt[2 * pp + 1].x, false, false), sy = __builtin_amdgcn_permlane16_swap(pkt[2 * pp].y, pkt[2 * pp + 1].y, false, false);
                u32x4 w4; w4.x = sx[0]; w4.y = sy[0]; w4.z = sx[1]; w4.w = sy[1];
                *(u32x4*)(rrow + 32 * pp) = w4; }
            ssq += __shfl_xor(ssq, 16); ssq += __shfl_xor(ssq, 32);
            if (g < 2) SSR[((rowb + n * 64 + 16 * qt + li) * 4 + h) * 16 + blk * 2 + g] = g ? 0.f : ssq;
#pragma unroll
            for (int ks = 0; ks < 8; ++ks) rg[ks] = rg[8 + ks];
        } else {
            if (n + 1 < 32) { RK_DMA(n + 1, nxt); }
            bf16x8 vf[4][2];
#pragma unroll
            for (int t = 0; t < 4; ++t)
#pragma unroll
                for (int kp = 0; kp < 2; ++kp) { const int row = 16 * t + li; const LAS unsigned char* rp = vb + row * 128; const int f = row & 14;
                    const s16x4 lo = *(const LAS s16x4*)(rp + (((8 * kp + g) ^ f) * 8)), hi = *(const LAS s16x4*)(rp + (((8 * kp + 4 + g) ^ f) * 8)); vf[t][kp] = cat4(lo, hi); }
#pragma unroll
            for (int dh = 0; dh < 2; ++dh) {
                bf16x8 ua[2][2];
#pragma unroll
                for (int d2 = 0; d2 < 2; ++d2)
#pragma unroll
                    for (int kp = 0; kp < 2; ++kp) { const int dkt = 4 * u + 2 * dh + d2;
                        const int r0 = 32 * kp + 4 * g + (li >> 2), r1 = r0 + 16;
                        const int cch = 2 * dkt + ((li >> 1) & 1), hb = (li & 1) * 8;
                        const s16x4 lo = __builtin_bit_cast(s16x4, __builtin_amdgcn_ds_read_tr16_b64_v4i16((lds_s16x4*)(kb + r0 * 512 + ((cch ^ ((r0 & 7) << 1)) * 16) + hb)));
                        const s16x4 hi = __builtin_bit_cast(s16x4, __builtin_amdgcn_ds_read_tr16_b64_v4i16((lds_s16x4*)(kb + r1 * 512 + ((cch ^ ((r1 & 7) << 1)) * 16) + hb)));
                        ua[d2][kp] = cat4(lo, hi); }
                __builtin_amdgcn_sched_barrier(0);
#pragma unroll
                for (int d2 = 0; d2 < 2; ++d2)
#pragma unroll
                    for (int kp = 0; kp < 2; ++kp)
#pragma unroll
                        for (int t = 0; t < 4; ++t) rg[4 * (2 * dh + d2) + t] = __builtin_amdgcn_mfma_f32_16x16x32_bf16(ua[d2][kp], vf[t][kp], rg[4 * (2 * dh + d2) + t], 0, 0, 0);
            }
            LAS unsigned char* sn = lds + ST + nxt * 32768;
#pragma unroll
            for (int d = 0; d < 4; ++d)
#pragma unroll
                for (int t = 0; t < 4; ++t) { rg[4 * d + t] *= g64; const int row = 16 * t + li, dkt = 4 * u + d;
                    u32x2 pk; pk.x = pk2(rg[4 * d + t][0], rg[4 * d + t][1]); pk.y = pk2(rg[4 * d + t][2], rg[4 * d + t][3]);
                    *(LAS u32x2*)(sn + row * 512 + (((2 * dkt + (g >> 1)) ^ ((row & 7) << 1)) * 16) + (g & 1) * 8) = pk; }
        }
        if (n + 1 < 32) *(LAS u32x4*)(lds + VB + nxt * 8192 + vw_off) = vreg;
        asm volatile("s_waitcnt vmcnt(0) lgkmcnt(0)" ::: "memory"); __builtin_amdgcn_s_barrier(); asm volatile("" ::: "memory");
    }
#undef RK_DMA
}


#ifndef DSA_REP
#define DSA_REP 0
#endif
constexpr int DSA_SC = 0, DSA_KST = 131072, DSA_IDX = 147456, DSA_WQ = 155648;
__device__ __forceinline__ unsigned fkey(float f) { const unsigned u = __float_as_uint(f); return (u & 0x80000000u) ? ~u : (u | 0x80000000u); }
__device__ __forceinline__ int bcnt(bool p) { return __popcll(__ballot(p)); }
#define SUMF(a_, b_) ((a_) + (b_))
#define WAVE_RED(OP, v) do { v = OP(v, __int_as_float(__builtin_amdgcn_update_dpp(__float_as_int(v), __float_as_int(v), 0xB1, 0xf, 0xf, true))); \
        v = OP(v, __int_as_float(__builtin_amdgcn_update_dpp(__float_as_int(v), __float_as_int(v), 0x4E, 0xf, 0xf, true))); \
        v = OP(v, __int_as_float(__builtin_amdgcn_update_dpp(__float_as_int(v), __float_as_int(v), 0x141, 0xf, 0xf, true))); \
        v = OP(v, __int_as_float(__builtin_amdgcn_update_dpp(__float_as_int(v), __float_as_int(v), 0x140, 0xf, 0xf, true))); \
        v = OP(OP(__int_as_float(__builtin_amdgcn_readlane(__float_as_int(v), 0)), __int_as_float(__builtin_amdgcn_readlane(__float_as_int(v), 16))), \
               OP(__int_as_float(__builtin_amdgcn_readlane(__float_as_int(v), 32)), __int_as_float(__builtin_amdgcn_readlane(__float_as_int(v), 48)))); } while (0)

template <int NB>
__device__ __forceinline__ void dsa_topk_t(const LAS float* sc, LAS unsigned short* il, int limit, int lane) {
    const int nb = limit >> 6;
    float v[NB];
#pragma unroll
    for (int i = 0; i < NB; ++i) v[i] = (i < nb) ? sc[64 * i + lane] : -INFINITY;
    float mn = INFINITY, mx = -INFINITY;
#pragma unroll
    for (int i = 0; i < NB; ++i) { mn = fminf(mn, (i < nb) ? v[i] : INFINITY); mx = fmaxf(mx, v[i]); }
    WAVE_RED(fminf, mn); WAVE_RED(fmaxf, mx);
    float lo = mn, hi = INFINITY; int clo = limit, chi = 0;
#pragma unroll 1
    for (int it = 0; it < 64 && clo - chi > 64; ++it) {
        const float top = (hi == INFINITY) ? mx : hi; const float mid = 0.5f * lo + 0.5f * top;
        if (!(mid > lo) || !(mid < hi)) break;
        int c = 0;
#pragma unroll
        for (int i = 0; i < NB; ++i) c += (v[i] >= mid) ? 1 : 0;
        float cf = (float)c; WAVE_RED(SUMF, cf); c = (int)cf;
        if (c >= TOPK) { lo = mid; clo = c; } else { hi = mid; chi = c; }
    }
    const int r = TOPK - chi; unsigned T; int ngt, neq;
    if (clo - chi <= 64) {
        int filled = 0;
#pragma unroll
        for (int i = 0; i < NB; ++i) { const bool in = (v[i] >= lo) && (v[i] < hi);
            const unsigned long long m = __ballot(in); const int pos = filled + __builtin_amdgcn_mbcnt_hi((unsigned)(m >> 32), __builtin_amdgcn_mbcnt_lo((unsigned)m, 0));
            if (in) ((LAS unsigned*)il)[pos] = fkey(v[i]);
            filled += __popcll(m); }
        asm volatile("s_waitcnt lgkmcnt(0)" ::: "memory");
        const unsigned ck = (lane < filled) ? ((LAS unsigned*)il)[lane] : 0u;
        T = 0u;
#pragma unroll 4
        for (int bit = 31; bit >= 0; --bit) { const unsigned cand = T | (1u << bit); if (bcnt(ck >= cand) >= r) T = cand; }
        ngt = chi + bcnt(ck > T); neq = bcnt(ck == T);
    } else {
        T = 0u;
#pragma unroll 1
        for (int bit = 31; bit >= 0; --bit) { const unsigned cand = T | (1u << bit); int c = 0;
#pragma unroll
            for (int i = 0; i < NB; ++i) c += bcnt(i < nb && fkey(v[i]) >= cand);
            if (c >= TOPK) T = cand; }
        ngt = 0; neq = 0;
#pragma unroll
        for (int i = 0; i < NB; ++i) { const unsigned k = fkey(v[i]); ngt += bcnt(i < nb && k > T); neq += bcnt(i < nb && k == T); }
    }
    const int need_eq = TOPK - ngt;
    asm volatile("s_waitcnt lgkmcnt(0)" ::: "memory");
    int base = 0, tb = 0;
    const bool alleq = (neq == need_eq);
#pragma unroll
    for (int i = 0; i < NB; ++i) if (i < nb) { const unsigned k = fkey(v[i]);
        bool f = k >= T;
        if (!alleq) { const bool eq = (k == T); const unsigned long long me = __ballot(eq);
            const int er = tb + __builtin_amdgcn_mbcnt_hi((unsigned)(me >> 32), __builtin_amdgcn_mbcnt_lo((unsigned)me, 0));
            f = (k > T) || (eq && er < need_eq); tb += __popcll(me); }
        const unsigned long long mf = __ballot(f); const int pos = base + __builtin_amdgcn_mbcnt_hi((unsigned)(mf >> 32), __builtin_amdgcn_mbcnt_lo((unsigned)mf, 0));
        if (f && pos < TOPK) il[pos] = (unsigned short)(64 * i + lane);
        base += __popcll(mf); }
}
__device__ __forceinline__ void dsa_topk(const LAS float* sc, LAS unsigned short* il, int limit, int lane) {
    if (limit <= 512) dsa_topk_t<8>(sc, il, limit, lane);
    else if (limit <= 1024) dsa_topk_t<16>(sc, il, limit, lane);
    else dsa_topk_t<32>(sc, il, limit, lane);
}

struct DsaQ { bf16x8 qf[4]; f32x4 ps; };
__device__ __forceinline__ DsaQ dsa_load_q(const bf16_t* QH, const float* PS, size_t trow, int lane) {
    const int li = lane & 15, g = lane >> 4; DsaQ q;
#pragma unroll
    for (int s = 0; s < 4; ++s) { q.qf[s] = (bf16x8){0, 0, 0, 0, 0, 0, 0, 0}; if (li < 8) q.qf[s] = *(const bf16x8*)(QH + trow * 1024 + li * 128 + 32 * s + 8 * g); }
    q.ps = (f32x4){1.f, 1.f, 1.f, 1.f};
    if (li < 8) { const float* pp = PS + (size_t)((li >> 1) * 8 + (li & 1) * 4) * M + trow; q.ps = (f32x4){pp[0], pp[(size_t)M], pp[(size_t)2 * M], pp[(size_t)3 * M]}; }
    return q;
}
__device__ __forceinline__ void dsa_attend(LAS unsigned char* wl, const LAS unsigned short* il, const LAS float* rctab, LAS float* rcl, const DsaQ& Q, const bf16_t* Cb, bf16_t* AO, size_t trow, int b, int count, float bound_l2, int lane) {
    const int li = lane & 15, g = lane >> 4;
    typedef __attribute__((address_space(3))) s16x4 lds_s16x4;
    bf16x8 qf[4];
#pragma unroll
    for (int s = 0; s < 4; ++s) qf[s] = Q.qf[s];
    const float rq = (li < 8) ? rsqrtf(((Q.ps[0] + Q.ps[1]) + (Q.ps[2] + Q.ps[3])) * (1.0f / 128.0f) + EPS) * 1.4426950408889634f : 0.f;
    const bf16_t* cbase = Cb + (size_t)b * SEQ * 128; const unsigned wlb = lds_addr(wl);
#define DSA_GATHER(ci_, buf_) do { const u32x4 kw_ = *(const LAS u32x4*)(il + 32 * (ci_) + 8 * (lane >> 4)); \
        _Pragma("unroll") for (int i = 0; i < 8; ++i) { const int row = 4 * i + (lane >> 4); const unsigned kk_ = (i < 2 ? kw_.x : i < 4 ? kw_.y : i < 6 ? kw_.z : kw_.w); const int key = (i & 1) ? (int)(kk_ >> 16) : (int)(kk_ & 0xffffu); \
        const int sc_ = (lane & 15) ^ ((row & 7) << 1); \
        glds16_asm(cbase + (size_t)key * 128 + sc_ * 8, wlb + (buf_) * 8192 + i * 1024); } } while (0)
    for (int pos = lane; pos < count; pos += 64) { const int e = pos & 31; rcl[(pos & ~31) + 4 * (e & 7) + (e >> 3)] = rctab[il[pos]]; }
    asm volatile("s_waitcnt lgkmcnt(0)" ::: "memory");
    f32x4 oacc[8];
#pragma unroll
    for (int d = 0; d < 8; ++d) oacc[d] = (f32x4){0.f, 0.f, 0.f, 0.f};
    float lsum = 0.f;
    const int nch = count >> 5;
    DSA_GATHER(0, 0);
#pragma unroll 1
    for (int ci = 0; ci < nch; ++ci) {
        const int cur = ci & 1;
        if (ci + 1 < nch) { DSA_GATHER(ci + 1, cur ^ 1); if (DSA_REP & 8) { DSA_GATHER(ci + 1, cur ^ 1); asm volatile("s_waitcnt vmcnt(16)" ::: "memory"); } else asm volatile("s_waitcnt vmcnt(8)" ::: "memory"); } else { asm volatile("s_waitcnt vmcnt(0)" ::: "memory"); }
        const LAS unsigned char* ct = wl + cur * 8192;
        f32x4 lt[2];
        bf16x8 ca[2][4];
#pragma unroll
        for (int T = 0; T < 2; ++T) { const int row = 16 * T + li; const LAS unsigned char* rp = ct + row * 256; const int sw = (row & 7) << 1;
#pragma unroll
            for (int s = 0; s < 4; ++s) ca[T][s] = *(const LAS bf16x8*)(rp + (((4 * s + g) ^ sw) * 16)); }
        f32x4 rcv[2];
#pragma unroll
        for (int T = 0; T < 2; ++T) rcv[T] = *(const LAS f32x4*)(rcl + 32 * ci + 16 * T + 4 * g);
        __builtin_amdgcn_sched_barrier(0);
#pragma unroll
        for (int T = 0; T < 2; ++T) { lt[T] = (f32x4){0.f, 0.f, 0.f, 0.f};
#pragma unroll
            for (int s = 0; s < 4; ++s) lt[T] = __builtin_amdgcn_mfma_f32_16x16x32_bf16(ca[T][s], qf[s], lt[T], 0, 0, 0); }
        bf16x8 cv[8];
#pragma unroll
        for (int dt = 0; dt < 8; ++dt) {
            const int r0 = 4 * g + (li >> 2), r1 = r0 + 16; const int cch = 2 * dt + ((li >> 1) & 1), hb = (li & 1) * 8;
            const s16x4 lo = __builtin_bit_cast(s16x4, __builtin_amdgcn_ds_read_tr16_b64_v4i16((lds_s16x4*)(ct + r0 * 256 + ((cch ^ ((r0 & 7) << 1)) * 16) + hb)));
            const s16x4 hi = __builtin_bit_cast(s16x4, __builtin_amdgcn_ds_read_tr16_b64_v4i16((lds_s16x4*)(ct + r1 * 256 + ((cch ^ ((r1 & 7) << 1)) * 16) + hb)));
            cv[dt] = cat4(lo, hi); }
        __builtin_amdgcn_sched_barrier(0);
        bf16x8 pf;
#pragma unroll
        for (int T = 0; T < 2; ++T) { float pv[4];
#pragma unroll
            for (int r = 0; r < 4; ++r) { pv[r] = __builtin_amdgcn_exp2f(lt[T][r] * rq * rcv[T][r] - bound_l2); lsum += pv[r]; }
            const unsigned w0 = pk2(pv[0], pv[1]), w1 = pk2(pv[2], pv[3]);
            pf[4 * T + 0] = (short)(w0 & 0xffff); pf[4 * T + 1] = (short)(w0 >> 16); pf[4 * T + 2] = (short)(w1 & 0xffff); pf[4 * T + 3] = (short)(w1 >> 16); }
#pragma unroll
        for (int dt = 0; dt < 8; ++dt) oacc[dt] = __builtin_amdgcn_mfma_f32_16x16x32_bf16(cv[dt], pf, oacc[dt], 0, 0, 0);
    }
#undef DSA_GATHER
    lsum += __shfl_xor(lsum, 16); lsum += __shfl_xor(lsum, 32);
    const float inv = 1.0f / lsum;
    if (li < 8) {
#pragma unroll
        for (int dt = 0; dt < 8; ++dt) { u32x2 o; o.x = pk2(oacc[dt][0] * inv, oacc[dt][1] * inv); o.y = pk2(oacc[dt][2] * inv, oacc[dt][3] * inv);
            *(u32x2*)(AO + trow * 1024 + li * 128 + 16 * dt + 4 * g) = o; }
    }
}

__device__ __forceinline__ void dsa_fast_phase(LAS unsigned char* lds, const bf16_t* QH, const bf16_t* Cb, const float* PS, const bf16_t* QI, const bf16_t* KI, const float* WI, const float* CSC, bf16_t* AO, int vcu, int G) {
    int tid_ = threadIdx.x; asm volatile("" : "+v"(tid_));
    const int tid = tid_, lane0 = tid & 63, w = __builtin_amdgcn_readfirstlane(tid >> 6);
    LAS unsigned char* wl = lds + DSA_SC + w * 16384; LAS float* rctab = (LAS float*)(lds + DSA_KST);
    LAS unsigned short* il0 = (LAS unsigned short*)(lds + DSA_IDX + (2 * w) * 512); LAS unsigned short* il1 = il0 + 256;
    float mxs = 0.f;
    for (int i = lane0; i < 128; i += 64) mxs = fmaxf(mxs, fabsf(CSC[i]));
#pragma unroll
    for (int o = 1; o < 64; o <<= 1) mxs = fmaxf(mxs, __shfl_xor(mxs, o));
    const float bound_l2 = mxs * 128.0f * 1.4426950408889634f;
    for (int wg = vcu; wg < 256; wg += G) {
        const int b = wg >> 5, r = wg & 31;
        __syncthreads();
        for (int k = tid; k < SEQ; k += NWAVES * 64) { const float* pp = PS + (size_t)32 * M + (size_t)b * SEQ + k;
            rctab[k] = rsqrtf(((pp[0] + pp[(size_t)M]) + (pp[(size_t)2 * M] + pp[(size_t)3 * M])) * (1.0f / 128.0f) + EPS); }
#pragma unroll 1
        for (int it = 0; it < 4; ++it) {
            int lane = lane0; asm volatile("" : "+v"(lane));
            const int li = lane & 15, g = lane >> 4;
            const int chunk = (it & 1) ? 31 - (r & 15) : (r & 15), sub = 2 * (r >> 4) + (it >> 1);
            const int t0 = chunk * 64 + sub * 16, limit = (chunk + 1) * 64;
            const size_t trow0 = (size_t)b * SEQ + t0 + 2 * w;
            const DsaQ Q0 = dsa_load_q(QH, PS, trow0, lane), Q1 = dsa_load_q(QH, PS, trow0 + 1, lane);
            LAS float* wqt = (LAS float*)(lds + DSA_WQ);
            if (limit > TOPK && tid < 128) { const int qq = tid >> 3, hh = tid & 7; const size_t row = (size_t)b * SEQ + t0 + qq;
                const float* ps = PS + (size_t)(40 + (hh >> 2) * 8 + ((hh >> 1) & 1) * 4 + 2 * (hh & 1)) * M + row;
                wqt[tid] = WI[row * 8 + hh] * rsqrtf((ps[0] + ps[(size_t)M]) * (1.0f / 64.0f) + EPS); }
            __syncthreads();
            if (limit > TOPK) {
                for (int srep = 0; srep < 1 + (DSA_REP & 1); ++srep) {
                bf16x8 af[8][2]; float wq[8][4];
                const size_t trowi = (size_t)b * SEQ + t0;
#pragma unroll
                for (int p = 0; p < 8; ++p) {
#pragma unroll
                    for (int sidx = 0; sidx < 2; ++sidx) af[p][sidx] = *(const bf16x8*)(QI + (trowi + 2 * p + (li >> 3)) * 512 + (li & 7) * 64 + 32 * sidx + 8 * g);
                    const f32x4 wv = *(const LAS f32x4*)(wqt + (2 * p + (g >> 1)) * 8 + 4 * (g & 1));
                    wq[p][0] = wv[0]; wq[p][1] = wv[1]; wq[p][2] = wv[2]; wq[p][3] = wv[3];
                    asm volatile("" ::: "memory"); }
                const int nst = limit >> 4;
                const bf16_t* kp = KI + ((size_t)b * SEQ + 16 * w + li) * 64 + 8 * g; const float* pp = PS + (size_t)36 * M + (size_t)b * SEQ + 16 * w + li;
                bf16x8 b0 = *(const bf16x8*)kp, b1 = *(const bf16x8*)(kp + 32); f32x2_t pk = (f32x2_t){pp[0], pp[(size_t)M]};
                bf16x8 d0 = b0, d1 = b1; f32x2_t pk2v = pk;
                if (w + 8 < nst) { kp += 8 * 16 * 64; pp += 8 * 16; d0 = *(const bf16x8*)kp; d1 = *(const bf16x8*)(kp + 32); pk2v = (f32x2_t){pp[0], pp[(size_t)M]}; }
#pragma unroll 1
                for (int st = w; st < nst; st += 8) {
                    const bf16x8 c0 = b0, c1 = b1; const float rk = rsqrtf((pk[0] + pk[1]) * (1.0f / 64.0f) + EPS);
                    b0 = d0; b1 = d1; pk = pk2v;
                    if (st + 16 < nst) { kp += 8 * 16 * 64; pp += 8 * 16; d0 = *(const bf16x8*)kp; d1 = *(const bf16x8*)(kp + 32); pk2v = (f32x2_t){pp[0], pp[(size_t)M]}; }
                    LAS float* so = (LAS float*)(lds + DSA_SC) + (g >> 1) * 2048 + 16 * st + li;
#pragma unroll
                    for (int p = 0; p < 8; ++p) {
                        f32x4 acc = (f32x4){0.f, 0.f, 0.f, 0.f};
                        acc = __builtin_amdgcn_mfma_f32_16x16x32_bf16(af[p][0], c0, acc, 0, 0, 0); acc = __builtin_amdgcn_mfma_f32_16x16x32_bf16(af[p][1], c1, acc, 0, 0, 0);
                        float part = (fmaxf(acc[0], 0.f) * wq[p][0] + fmaxf(acc[1], 0.f) * wq[p][1]) + (fmaxf(acc[2], 0.f) * wq[p][2] + fmaxf(acc[3], 0.f) * wq[p][3]);
                        {   const auto sw = __builtin_amdgcn_permlane16_swap(__float_as_uint(part), __float_as_uint(part), false, false);
                            part = __uint_as_float(sw[0]) + __uint_as_float(sw[1]); }
                        if ((g & 1) == 0) so[p * 4096] = part * rk + 0.0f;
                    }
                }
                __syncthreads();
                }
                for (int trep = 0; trep < 1 + ((DSA_REP >> 1) & 1); ++trep) {
                dsa_topk((const LAS float*)wl, il0, limit, lane);
                dsa_topk((const LAS float*)wl + 2048, il1, limit, lane); }
            } else {
                for (int j = lane; j < limit; j += 64) { il0[j] = (unsigned short)j; il1[j] = (unsigned short)j; }
            }
            const int count = limit < TOPK ? limit : TOPK;
            for (int arep = 0; arep < 1 + ((DSA_REP >> 2) & 1); ++arep) {
            dsa_attend(wl, il0, rctab, (LAS float*)(lds + DSA_KST + 8192 + w * 1024), Q0, Cb, AO, trow0, b, count, bound_l2, lane);
            dsa_attend(wl, il1, rctab, (LAS float*)(lds + DSA_KST + 8192 + w * 1024), Q1, Cb, AO, trow0 + 1, b, count, bound_l2, lane); }
        }
    }
    __syncthreads();
}

typedef const __attribute__((address_space(4))) Args* ArgsP;
__device__ __forceinline__ ArgsP fresh_args() { ArgsP p = (ArgsP)__builtin_amdgcn_kernarg_segment_ptr(); asm volatile("" : "+s"(p)); return p; }

__device__ __forceinline__ int fresh_bx() { int v = blockIdx.x; asm volatile("" : "+s"(v)); return v; }
__device__ __forceinline__ int fresh_gx() { int v = gridDim.x; asm volatile("" : "+s"(v)); return v; }
__global__ void __launch_bounds__(NWAVES * 64, 2) mega(Args args_unused) {
    extern __shared__ __attribute__((aligned(16))) unsigned char lds_raw[];
    LAS unsigned char* lds = (LAS unsigned char*)lds_raw;
    const int tid = threadIdx.x;
    for (int u = tid; u < (LDS_BYTES - LDSCTL_OFF) / 4; u += NWAVES * 64) ((LAS unsigned*)(lds + LDSCTL_OFF))[u] = 0u;
    __syncthreads();
    int lo, hi;
    {   ArgsP A = fresh_args(); lo = A->ph_lo; hi = A->ph_hi;
        if (hi - lo > 1) (void)xcd_barrier_post((unsigned*)(A->ws + WS_CTL) + CW_BAR + A->li * XCD_BAR_WORDS, (volatile LAS unsigned*)(lds + MISC_OFF) + 8); }
#ifndef PHMASK
#define PHMASK 0xffff
#endif
#define IN(k) (((PHMASK >> (k)) & 1) && lo <= (k) && (k) < hi)
#define SEAM(k) do { if (lo <= (k) && (k) + 1 < hi) { ArgsP A_ = fresh_args(); XcdBarrier b_; b_.bar = (unsigned*)(A_->ws + WS_CTL) + CW_BAR + A_->li * XCD_BAR_WORDS; b_.x = xb_xcc_id(); \
        b_.st = (volatile LAS unsigned*)(lds + MISC_OFF) + 8; xcd_barrier(b_); } } while (0)
#ifndef REPMASK
#define REPMASK 0
#endif
#define GBAR() do { ArgsP A_ = fresh_args(); XcdBarrier b_; b_.bar = (unsigned*)(A_->ws + WS_CTL) + CW_BAR + A_->li * XCD_BAR_WORDS; b_.x = xb_xcc_id(); \
        b_.st = (volatile LAS unsigned*)(lds + MISC_OFF) + 8; xcd_barrier(b_); } while (0)
#define REPEAT(k) for (int rep_ = 0; rep_ < 1 + ((REPMASK >> (k)) & 1); ++rep_)
#define REPBAR() do { if (rep_) GBAR(); } while (0)
#define GWS int t_ = threadIdx.x; asm volatile("" : "+v"(t_)); const int lane = t_ & 63, wave = __builtin_amdgcn_readfirstlane(t_ >> 6); const int G = fresh_gx(), bx = fresh_bx(); const int vcu = (G % 8 == 0) ? (bx % 8) * (G / 8) + bx / 8 : bx; \
        const int gw = vcu * NWAVES + wave, NGW = G * NWAVES; LAS float* scr = (LAS float*)(lds + wave * 16640); (void)lane; (void)gw; (void)NGW; (void)scr;
#define WCONV(Wp, K_, Nsrc_, N_, mode_, gain_, WT_) do { const int items_ = ((K_) / 64) * ((N_) / 64); \
        for (int it = gw; it < items_; it += NGW) p0_transpose_item((Wp), (K_), (Nsrc_), (N_), (mode_), (gain_), (WT_), scr, it, lane); } while (0)

    if (IN(PH_PRO)) REPEAT(PH_PRO) { REPBAR();
        GWS; ArgsP A = fresh_args(); unsigned char* ws = A->ws;
        constexpr int I0 = 16 * 28, I1 = I0 + 16 * 16, I2 = I1 + 16 * 96, I3 = I2 + 32 * 16, I4 = I3 + 16 * 88, I5 = I4 + 44 * 16, IX = I5 + M / 4;
        {   const float* x = A->in[0]; float* SS = (float*)(ws + WS_SS); bf16_t* XB = (bf16_t*)(ws + WS_XB);
#pragma unroll 1
            for (int it = gw; it < IX; it += NGW) {
                if (it < I0) p0_transpose_item(A->in[3], 1024, A_IN_COLS, A_IN_PAD, WM_AIN, A->in[1], (bf16_t*)(ws + WS_WAIN), scr, it, lane);
                else if (it < I1) p0_transpose_item(A->in[8], 1024, 1024, 1024, WM_NAT, (const float*)nullptr, (bf16_t*)(ws + WS_WAOUT), scr, it - I0, lane);
                else if (it < I2) p0_transpose_item(A->in[9], 1024, B_IN_COLS, B_IN_COLS, WM_NAT, A->in[1] + 1024, (bf16_t*)(ws + WS_WBIN), scr, it - I1, lane);
                else if (it < I3) p0_transpose_item(A->in[11], 2048, 1024, 1024, WM_NAT, A->in[10], (bf16_t*)(ws + WS_WBOUT), scr, it - I2, lane);
                else if (it < I4) p0_transpose_item(A->in[12], 1024, FF2, FF2, WM_FUP, A->in[2], (bf16_t*)(ws + WS_WFUP0), scr, it - I3, lane);
                else if (it < I5) p0_transpose_item(A->in[15], 2816, 1024, 1024, WM_NAT, (const float*)nullptr, (bf16_t*)(ws + WS_WFDN0), scr, it - I4, lane);
                else { const int row0 = (it - I5) * 4;
                    f32x4 v[4][4];
#pragma unroll
                    for (int r = 0; r < 4; ++r)
#pragma unroll
                        for (int q = 0; q < 4; ++q) v[r][q] = ((const f32x4*)(x + (size_t)(row0 + r) * DM))[q * 64 + lane];
#pragma unroll
                    for (int r = 0; r < 4; ++r)
#pragma unroll
                        for (int q = 0; q < 4; ++q) { const f32x4 w = v[r][q]; float sq = (w[0] * w[0] + w[1] * w[1]) + (w[2] * w[2] + w[3] * w[3]); sq = wave_sum(sq);
                            if (lane < 4) SS[(size_t)(q * 4 + lane) * M + row0 + r] = lane == 0 ? sq : 0.f;
                            u32x2 o; o.x = pk2(w[0], w[1]); o.y = pk2(w[2], w[3]); *(u32x2*)(XB + (size_t)(row0 + r) * DM + q * 256 + lane * 4) = o; } } } }
        {   float2* ROPE = (float2*)(ws + WS_ROPE);
            for (int e = gw * 64 + lane; e < 2048 * 128; e += NGW * 64) { const int t = e >> 7, i = e & 127;
                const float inv = exp2f(-(float)(2 * i) * (13.287712379549449f / 256.0f)), ang = (float)t * inv; float sn, cs; sincosf(ang, &sn, &cs); ROPE[e] = make_float2(cs, sn); } }
        {   float* CSC = (float*)(ws + WS_CSC); const float* a_q_g = A->in[4]; const float* a_k_g = A->in[5]; const float* a_iq_g = A->in[6]; const float* a_ik_g = A->in[7];
            for (int n = gw * 64 + lane; n < A_IN_PAD; n += NGW * 64) { float v;
                if (n < 1024) v = a_q_g[n & 127] * a_k_g[n & 127] * 0.08838834764831845f; else if (n < 1152) v = 1.0f; else if (n < 1216) v = a_ik_g[n - 1152];
                else if (n < 1224) v = 0.044194173824159216f; else if (n < 1280) v = 0.f; else v = a_iq_g[(n - 1280) & 63];
                CSC[n] = v; } }
    }
    SEAM(PH_PRO);
    if (IN(PH_A1)) REPEAT(PH_A1) { REPBAR();
        ArgsP A = fresh_args(); unsigned char* ws = A->ws;
        pg8::Gemm g{(const bf16_t*)(ws + WS_XB), (const bf16_t*)(ws + WS_WAIN), M, A_IN_PAD, 1024}; pg8::StaticOrder S; S.init(M, A_IN_PAD, fresh_gx(), fresh_bx());
        pg8::EpiA1 E{(const float*)(ws + WS_SS), (const float*)(ws + WS_CSC), (bf16_t*)(ws + WS_QH), (bf16_t*)(ws + WS_C), (bf16_t*)(ws + WS_KI), (bf16_t*)(ws + WS_QI), (float*)(ws + WS_WI), (float*)(ws + WS_PS)};
        pg8::gemm_phase(lds, g, S, E);
    }
    SEAM(PH_A1);
    if (IN(PH_A2)) REPEAT(PH_A2) { REPBAR();
        ArgsP A = fresh_args(); unsigned char* ws = A->ws; const int G = fresh_gx(), bx = fresh_bx(); const int vcu = (G % 8 == 0) ? (bx % 8) * (G / 8) + bx / 8 : bx;
        dsa_fast_phase(lds, (const bf16_t*)(ws + WS_QH), (const bf16_t*)(ws + WS_C), (const float*)(ws + WS_PS), (const bf16_t*)(ws + WS_QI), (const bf16_t*)(ws + WS_KI), (const float*)(ws + WS_WI), (const float*)(ws + WS_CSC), (bf16_t*)(ws + WS_AO), vcu, G);
    }
    SEAM(PH_A2);
    if (IN(PH_A3)) REPEAT(PH_A3) { REPBAR();
        ArgsP A = fresh_args(); unsigned char* ws = A->ws;
        pg8::Gemm g{(const bf16_t*)(ws + WS_AO), (const bf16_t*)(ws + WS_WAOUT), M, 1024, 1024}; pg8::StaticOrder S; S.init(M, 1024, fresh_gx(), fresh_bx());
        pg8::EpiRes<1> E{nullptr, nullptr, (bf16_t*)(ws + WS_XB), (float*)(ws + WS_SS)};
        pg8::gemm_phase(lds, g, S, E);
    }
    SEAM(PH_A3);
#define FFN_PHASES(LAYER, PH1, PH2) do { \
        if (IN(PH1)) REPEAT(PH1) { REPBAR(); \
            ArgsP A = fresh_args(); unsigned char* ws = A->ws; \
            pg8::Gemm g{(const bf16_t*)(ws + WS_XB), (const bf16_t*)(ws + ((LAYER) ? WS_WFUP1 : WS_WFUP0)), M, FF2, 1024}; pg8::StaticOrder S; S.init(M, FF2, fresh_gx(), fresh_bx()); \
            pg8::EpiF1 E{(const float*)(ws + WS_SS), A->in[13] + (size_t)(LAYER) * 3 * FF2, A->in[14] + (size_t)(LAYER) * FF2, (bf16_t*)(ws + ((LAYER) ? WS_H1 : WS_H0)), \
                         (float*)(ws + ((LAYER) ? WS_PART1 : WS_PART0)), (float*)(ws + ((LAYER) ? WS_HALO1 : WS_HALO0))}; \
            pg8::gemm_phase(lds, g, S, E); \
        } \
        SEAM(PH1); \
        if (IN(PH2)) { \
            ArgsP A = fresh_args(); unsigned char* ws = A->ws; bf16_t* Hb = (bf16_t*)(ws + ((LAYER) ? WS_H1 : WS_H0)); \
            pg8::Gemm g{Hb, (const bf16_t*)(ws + ((LAYER) ? WS_WFDN1 : WS_WFDN0)), M, 1024, D_FF}; pg8::StaticOrder S; S.init(M, 1024, fresh_gx(), fresh_bx()); \
            {   pg8::Unit u0; if (S.next(0, u0)) ffn_fixup(u0.pm, A->in[13] + (size_t)(LAYER) * 3 * FF2, (const float*)(ws + ((LAYER) ? WS_PART1 : WS_PART0)), (const float*)(ws + ((LAYER) ? WS_HALO1 : WS_HALO0)), Hb); \
                VM_WAIT(); __syncthreads(); } \
            if ((LAYER) == 0) { pg8::EpiRes<1> E{nullptr, nullptr, (bf16_t*)(ws + WS_XB), (float*)(ws + WS_SS)}; pg8::gemm_phase(lds, g, S, E); } \
            else { pg8::EpiRes<2> E{nullptr, A->out, (bf16_t*)(ws + WS_XB), nullptr}; pg8::gemm_phase(lds, g, S, E); } \
        } \
        SEAM(PH2); } while (0)
    FFN_PHASES(0, PH_F1A, PH_F2A);
    if (IN(PH_B1)) REPEAT(PH_B1) { REPBAR();
        ArgsP A = fresh_args(); unsigned char* ws = A->ws;
        pg8::Gemm g{(const bf16_t*)(ws + WS_XB), (const bf16_t*)(ws + WS_WBIN), M, 4096, 1024}; pg8::StaticOrder S; S.init(M, 4096, fresh_gx(), fresh_bx());
        pg8::EpiB1 E{(const float*)(ws + WS_SS), (const float2*)(ws + WS_ROPE), (bf16_t*)(ws + WS_QT), (bf16_t*)(ws + WS_KT), (bf16_t*)(ws + WS_VT)};
        pg8::gemm_phase(lds, g, S, E);
    }
    SEAM(PH_B1);
    if (IN(PH_B2)) REPEAT(PH_B2) { REPBAR();
        ArgsP A = fresh_args(); unsigned char* ws = A->ws;
        { const int G = fresh_gx(), bx = fresh_bx(); const int vcu = (G % 8 == 0) ? (bx % 8) * (G / 8) + bx / 8 : bx;
          for (int u = vcu; u < 256; u += G) ret_fast_phase(lds, (const bf16_t*)(ws + WS_QT), (const bf16_t*)(ws + WS_KT), (const bf16_t*)(ws + WS_VT), (bf16_t*)(ws + WS_RET), (float*)(ws + WS_SSR), u); }
    }
    SEAM(PH_B2);
    if (IN(PH_GATE)) REPEAT(PH_GATE) { REPBAR();
        {   ArgsP A = fresh_args(); unsigned char* ws = A->ws;
            pg8::Gemm g{(const bf16_t*)(ws + WS_XB), (const bf16_t*)(ws + WS_WBIN) + (size_t)4096 * 1024, M, 2048, 1024}; pg8::StaticOrder S; S.init(M, 2048, fresh_gx(), fresh_bx());
            pg8::EpiGate E{(const float*)(ws + WS_SS), (const float*)(ws + WS_SSR), (bf16_t*)(ws + WS_RET)};
            pg8::gemm_phase(lds, g, S, E); }
#if !defined(NO_WCONV2)
        {   GWS; ArgsP A = fresh_args(); unsigned char* ws = A->ws; constexpr int J0 = 16 * 88, J1 = J0 + 44 * 16;
#pragma unroll 1
            for (int it = gw; it < J1; it += NGW) {
                if (it < J0) p0_transpose_item(A->in[12] + (size_t)1024 * FF2, 1024, FF2, FF2, WM_FUP, A->in[2] + 1024, (bf16_t*)(ws + WS_WFUP1), scr, it, lane);
                else p0_transpose_item(A->in[15] + (size_t)2816 * 1024, 2816, 1024, 1024, WM_NAT, (const float*)nullptr, (bf16_t*)(ws + WS_WFDN1), scr, it - J0, lane); } }
#endif
    }
    SEAM(PH_GATE);
    if (IN(PH_B3)) REPEAT(PH_B3) { REPBAR();
        ArgsP A = fresh_args(); unsigned char* ws = A->ws;
        pg8::Gemm g{(const bf16_t*)(ws + WS_RET), (const bf16_t*)(ws + WS_WBOUT), M, 1024, 2048}; pg8::StaticOrder S; S.init(M, 1024, fresh_gx(), fresh_bx());
        pg8::EpiRes<1> E{nullptr, nullptr, (bf16_t*)(ws + WS_XB), (float*)(ws + WS_SS)};
        pg8::gemm_phase(lds, g, S, E);
    }
    SEAM(PH_B3);
    FFN_PHASES(1, PH_F1B, PH_F2B);
#undef FFN_PHASES
#undef IN
#undef SEAM
}

extern "C" void kernel_launch(void* const* d_in, const int* in_sizes, int n_in, void* d_out, int out_size, void* d_ws, size_t ws_size, hipStream_t stream) {
    static int grid = 0;
    if (grid == 0) {
        int dev = 0, cus = 0, per_cu = 0;
        (void)hipGetDevice(&dev); (void)hipDeviceGetAttribute(&cus, hipDeviceAttributeMultiprocessorCount, dev);
        (void)hipFuncSetAttribute((const void*)mega, hipFuncAttributeMaxDynamicSharedMemorySize, LDS_BYTES);
        if (hipOccupancyMaxActiveBlocksPerMultiprocessor(&per_cu, (const void*)mega, NWAVES * 64, LDS_BYTES) != hipSuccess || per_cu < 1)
            fprintf(stderr, "kernel_launch: occupancy query reports %d workgroups per CU\n", per_cu);
        (void)hipGetLastError();
        grid = cus > 0 ? cus : 256;
        if (grid != 256) fprintf(stderr, "kernel_launch: %d CUs (built for 256)\n", grid);
    }
    unsigned char* ws = (unsigned char*)d_ws;
    (void)hipMemsetAsync(ws + WS_CTL, 0, CTL_ZERO_BYTES, stream);
    Args a{};
    for (int i = 0; i < 16; ++i) a.in[i] = (const float*)d_in[i];
    a.out = (float*)d_out; a.ws = ws;
    auto launch = [&](int lo, int hi, int li) { a.ph_lo = lo; a.ph_hi = hi; a.li = li; hipLaunchKernelGGL(mega, dim3(grid), dim3(NWAVES * 64), LDS_BYTES, stream, a); };
    launch(0, PH_END, 0);
}
```

```cpp
#include <hip/hip_runtime.h>
#include <stdint.h>
#include <stdio.h>

typedef unsigned short bf16_t;
typedef short bf16x8 __attribute__((ext_vector_type(8)));
typedef float f32x4 __attribute__((ext_vector_type(4)));
typedef unsigned u32x4 __attribute__((ext_vector_type(4)));
typedef unsigned u32x2 __attribute__((ext_vector_type(2)));

#ifndef MK_LAUNCH_MODE
#define MK_LAUNCH_MODE 1
#endif

constexpr int BATCH = 8, SEQ = 2048, DM = 1024, M = BATCH * SEQ;
constexpr int TOPK = 256;
constexpr int A_IN_COLS = 1736, A_IN_PAD = 1792;
constexpr int O2 = 1152, O3 = 1664, O4 = 1728;
constexpr int B_IN_COLS = 6144;
constexpr int D_FF = 2816, FF2 = 5632;
constexpr float EPS = 1e-6f;

constexpr size_t MiB = 1u << 20;
constexpr size_t WS_CTL = 0, CTL_ZERO_BYTES = 65536;
constexpr size_t WS_SS = 1 * MiB;
constexpr size_t WS_WI = 2 * MiB;
constexpr size_t WS_CSC = 2 * MiB + 512 * 1024;
constexpr size_t WS_ROPE = 3 * MiB;
constexpr size_t WS_SSR = 249 * MiB;
constexpr size_t WS_WBIN = 8 * MiB;
constexpr size_t WS_WBOUT = 20 * MiB;
constexpr size_t WS_XB = 24 * MiB;
constexpr size_t WS_WAIN = 56 * MiB;
constexpr size_t WS_WAOUT = 60 * MiB;
constexpr size_t WS_QH = 64 * MiB;
constexpr size_t WS_AO = 96 * MiB;
constexpr size_t WS_QI = 128 * MiB;
constexpr size_t WS_C = 144 * MiB;
constexpr size_t WS_KI = 148 * MiB;
constexpr size_t WS_PS = 150 * MiB;
constexpr size_t WS_WFUP0 = 232 * MiB;
constexpr size_t WS_WFDN0 = 243 * MiB;
constexpr size_t WS_H0 = 64 * MiB;
constexpr size_t WS_PART0 = 152 * MiB;
constexpr size_t WS_HALO0 = 155 * MiB;
constexpr size_t WS_QT = 56 * MiB;
constexpr size_t WS_KT = 88 * MiB;
constexpr size_t WS_VT = 120 * MiB;
constexpr size_t WS_RET = 184 * MiB;
constexpr size_t WS_WFUP1 = 56 * MiB;
constexpr size_t WS_WFDN1 = 67 * MiB;
constexpr size_t WS_H1 = 88 * MiB;
constexpr size_t WS_PART1 = 176 * MiB;
constexpr size_t WS_HALO1 = 179 * MiB;

__device__ __forceinline__ unsigned short f2bf(float f) { unsigned u = __float_as_uint(f); return (unsigned short)((u + 0x7fffu + ((u >> 16) & 1u)) >> 16); }
__device__ __forceinline__ float bf2f(unsigned short h) { return __uint_as_float(((unsigned)h) << 16); }
__device__ __forceinline__ float bflo(unsigned w) { return __uint_as_float(w << 16); }
__device__ __forceinline__ float bfhi(unsigned w) { return __uint_as_float(w & 0xffff0000u); }
typedef __bf16 bf16x2_t __attribute__((ext_vector_type(2)));
typedef float f32x2_t __attribute__((ext_vector_type(2)));
__device__ __forceinline__ unsigned pk2(float lo, float hi) { const f32x2_t v = {lo, hi}; return __builtin_bit_cast(unsigned, __builtin_convertvector(v, bf16x2_t)); }
__device__ __forceinline__ float wave_sum(float v) {
#pragma unroll
    for (int o = 1; o < 64; o <<= 1) v += __shfl_xor(v, o);
    return v;
}
__device__ __forceinline__ float siluf(float x) { return x * __builtin_amdgcn_rcpf(1.0f + __builtin_amdgcn_exp2f(-1.4426950408889634f * x)); }
__device__ __forceinline__ float gamma_log(int h) { return h == 0 ? -0.031748698314580301f : h == 1 ? -0.015748356968139168f : h == 2 ? -0.0078431774610258787f : -0.0039138993211363287f; }

enum { WM_NAT = 0, WM_AIN = 1, WM_FUP = 2 };
__device__ __forceinline__ int wmap(int mode, int n) {
    if (mode == WM_NAT) return n;
    if (mode == WM_AIN) {
        if (n < 1152) return n;
        if (n < 1216) return O3 + (n - 1152);
        if (n < 1224) return O4 + (n - 1216);
        if (n < 1280) return -1;
        return O2 + (n - 1280);
    }
    const int p = n >> 8, bj = (n >> 7) & 1, i = n & 127;
    return bj * D_FF + 128 * p + i;
}

namespace pg8 {
#define PG8_LAS __attribute__((address_space(3)))
constexpr int BM = 256, BK = 64, HALF = 128, HTB = HALF * BK * 2, STAGE_BYTES = 8 * HTB, NXCD = 8, WGM = 8;
constexpr int XCH_OFF = 0, CWT_OFF = 2048, RT1_OFF = 6144, RT2_OFF = 14336;
__host__ __device__ __forceinline__ int lds_byte(int r, int c) { const int st = (r >> 4) * 2 + (c >> 5), rr = r & 15, cc = c & 31, ob = rr * 64 + cc * 2; return st * 1024 + (ob ^ (((ob >> 9) & 1) << 5)); }
__host__ __device__ __forceinline__ void stage_rc(int b, int& R, int& C) { const int st = b / 1024, sb = b % 1024, swz = sb ^ (((sb >> 9) & 1) << 5); R = (st >> 1) * 16 + swz / 64; C = (st & 1) * 32 + (swz % 64) / 2; }
__host__ __device__ __forceinline__ int perm32(int rho) { const int n = rho >> 4, i = rho & 15; return 8 * (i >> 2) + 4 * n + (i & 3); }
struct Unit { int pm, pn; };
struct Gemm { const bf16_t* A; const bf16_t* Bt; int M, N, K; };
struct StaticOrder {
    int nM, nN, nwg, G, c;
    __host__ __device__ __forceinline__ void init(int M_, int N_, int G_, int c_) { nM = M_ / BM; nN = N_ / BM; nwg = nM * nN; G = G_; c = c_; }
    __host__ __device__ __forceinline__ bool next(int i, Unit& u) const {
        const long L = (long)i * G + c; if (L >= nwg) return false;
        int wgid = (int)L; { const int q = nwg / NXCD, r = nwg % NXCD, xcd = wgid % NXCD, off = wgid / NXCD; wgid = (xcd < r ? xcd * (q + 1) : r * (q + 1) + (xcd - r) * q) + off; }
        const int nig = WGM * nN, gid = wgid / nig, fm = gid * WGM, gsz = (nM - fm) < WGM ? (nM - fm) : WGM;
        u.pm = fm + ((wgid % nig) % gsz); u.pn = (wgid % nig) / gsz; return true;
    }
};
__device__ __forceinline__ float rstd16(const float* ss16, int row) {
    float s = 0.f;
#pragma unroll
    for (int g = 0; g < 16; ++g) s += ss16[(size_t)g * M + row];
    return rsqrtf(s * (1.0f / DM) + EPS);
}
__device__ __forceinline__ float sel4(const float (&s)[4], int fq) { return fq == 0 ? s[0] : fq == 1 ? s[1] : fq == 2 ? s[2] : s[3]; }
__device__ __forceinline__ float ssq8(const f32x4 a, const f32x4 b) { return ((a[0] * a[0] + a[1] * a[1]) + (a[2] * a[2] + a[3] * a[3])) + ((b[0] * b[0] + b[1] * b[1]) + (b[2] * b[2] + b[3] * b[3])); }
__device__ __forceinline__ u32x4 pack8(const f32x4 a, const f32x4 b) { u32x4 w; w.x = pk2(a[0], a[1]); w.y = pk2(a[2], a[3]); w.z = pk2(b[0], b[1]); w.w = pk2(b[2], b[3]); return w; }

template <int MODE>
struct EpiRes {
    static constexpr bool PERM = true;
    static constexpr bool AROWPERM = false;
    const float* basef; float* out; bf16_t* xb; float* ss16;
    static constexpr int NTAB = 0;
    __device__ __forceinline__ void fill(PG8_LAS unsigned char*, int, const Unit&, int) const {}
    __device__ __forceinline__ void operator()(f32x4 (&acc)[2][2][4][2], const Unit& u, int ui, int wr, int wc, int fr, int fq, PG8_LAS unsigned char*) const {
        const int row0 = u.pm * BM + wr * 64 + fr, colb = u.pn * BM + wc * 32 + 8 * fq;
#pragma unroll
        for (int ai = 0; ai < 2; ++ai) {
            f32x4 bv[4][2][2];
#pragma unroll
            for (int m = 0; m < 4; ++m)
#pragma unroll
                for (int bj = 0; bj < 2; ++bj) { const size_t o = (size_t)(row0 + ai * HALF + m * 16) * DM + colb + bj * HALF;
                    if (MODE == 0) { bv[m][bj][0] = *(const f32x4*)(basef + o); bv[m][bj][1] = *(const f32x4*)(basef + o + 4); }
                    else { const u32x4 w = *(const u32x4*)(xb + o); bv[m][bj][0] = (f32x4){bflo(w.x), bfhi(w.x), bflo(w.y), bfhi(w.y)}; bv[m][bj][1] = (f32x4){bflo(w.z), bfhi(w.z), bflo(w.w), bfhi(w.w)}; } }
            float sm[4];
#pragma unroll
            for (int m = 0; m < 4; ++m) { const int row = row0 + ai * HALF + m * 16; float s = 0.f;
#pragma unroll
                for (int bj = 0; bj < 2; ++bj) { const size_t o = (size_t)row * DM + colb + bj * HALF;
                    const f32x4 v0 = acc[ai][bj][m][0] + bv[m][bj][0], v1 = acc[ai][bj][m][1] + bv[m][bj][1];
                    if (MODE == 2) { *(f32x4*)(out + o) = v0; *(f32x4*)(out + o + 4) = v1; }
                    else { s += ssq8(v0, v1); *(u32x4*)(xb + o) = pack8(v0, v1); } }
                if (MODE != 2) { s += __shfl_xor(s, 16); s += __shfl_xor(s, 32); }
                sm[m] = s; }
            if (MODE != 2) ss16[(size_t)(u.pn * 4 + wc) * M + u.pm * BM + ai * HALF + wr * 64 + 16 * fq + fr] = sel4(sm, fq);
            asm volatile("" ::: "memory"); }
    }
};
struct EpiA1 {
    static constexpr bool PERM = true;
    static constexpr bool AROWPERM = false;
    const float* ss16; const float* csc; bf16_t* Q; bf16_t* C; bf16_t* KI; bf16_t* QI; float* WI; float* PS;
    static constexpr int NTAB = 1;
    __device__ __forceinline__ void fill(PG8_LAS unsigned char* xl, int i, const Unit& u, int t) const { ((PG8_LAS float*)(xl + RT1_OFF))[i * 256 + t] = rstd16(ss16, u.pm * BM + t); }
    __device__ __forceinline__ void operator()(f32x4 (&acc)[2][2][4][2], const Unit& u, int ui, int wr, int wc, int fr, int fq, PG8_LAS unsigned char* xl) const {
        const int row0 = u.pm * BM + wr * 64 + fr, pn = u.pn;
        const PG8_LAS float* rt = (const PG8_LAS float*)(xl + RT1_OFF) + ui * 256 + wr * 64 + fr;
        float rs[2][4];
#pragma unroll
        for (int ai = 0; ai < 2; ++ai)
#pragma unroll
            for (int m = 0; m < 4; ++m) rs[ai][m] = rt[ai * HALF + m * 16];
#pragma unroll
        for (int bj = 0; bj < 2; ++bj) {
            const int cl = bj * HALF + wc * 32 + 8 * fq, gcol = pn * BM + cl;
            const f32x4 c0 = *(const f32x4*)(csc + gcol), c1 = *(const f32x4*)(csc + gcol + 4);
            bf16_t* dst; int ld; bool st16 = true, stwi = false;
            if (pn < 4) { dst = Q + gcol; ld = 1024; }
            else if (pn == 4) { if (bj == 0) { dst = C + cl; ld = 128; } else if (wc < 2) { dst = KI + (wc * 32 + 8 * fq); ld = 64; } else { dst = Q; ld = 0; st16 = false; stwi = (wc == 2) && (fq == 0); } }
            else { dst = QI + (pn - 5) * 256 + cl; ld = 512; }
#pragma unroll
            for (int ai = 0; ai < 2; ++ai) { float sm[4];
#pragma unroll
                for (int m = 0; m < 4; ++m) { const int row = row0 + ai * HALF + m * 16; const float r = rs[ai][m];
                    const f32x4 v0 = acc[ai][bj][m][0] * r, v1 = acc[ai][bj][m][1] * r;
                    float s = ssq8(v0, v1); s += __shfl_xor(s, 16); s += __shfl_xor(s, 32); sm[m] = s;
                    const f32x4 o0 = v0 * c0, o1 = v1 * c1;
                    if (st16) *(u32x4*)(dst + (size_t)row * ld) = pack8(o0, o1);
                    if (stwi) { *(f32x4*)(WI + (size_t)row * 8) = o0; *(f32x4*)(WI + (size_t)row * 8 + 4) = o1; }
                    if (m & 1) asm volatile("" ::: "memory"); }
                PS[(size_t)(pn * 8 + bj * 4 + wc) * M + u.pm * BM + ai * HALF + wr * 64 + 16 * fq + fr] = sel4(sm, fq); }
        }
    }
};
struct EpiF1 {
    static constexpr bool PERM = false;
    static constexpr bool AROWPERM = true;
    static constexpr int NTAB = 1;
    const float* ss16; const float* cw; const float* cb; bf16_t* H; float* PART; float* HALO;
    __device__ __forceinline__ void fill(PG8_LAS unsigned char* xl, int i, const Unit& u, int t) const { ((PG8_LAS float*)(xl + RT1_OFF))[i * 256 + t] = rstd16(ss16, u.pm * BM + t); }
    __device__ __forceinline__ void operator()(f32x4 (&acc)[2][2][4][2], const Unit& u, int ui, int wr, int wc, int fr, int fq, PG8_LAS unsigned char* xl) const {
        const int trow0 = 8 * (16 * wr + fr), grow0 = u.pm * BM + trow0, hcol = 128 * u.pn + 32 * wc + 4 * fq, tcol = 32 * wc + 4 * fq;
        const PG8_LAS float* rt = (const PG8_LAS float*)(xl + RT1_OFF) + ui * 256 + trow0;
        {   const f32x4 r0 = *(const PG8_LAS f32x4*)rt, r1 = *(const PG8_LAS f32x4*)(rt + 4);
#pragma unroll
            for (int m = 0; m < 4; ++m)
#pragma unroll
                for (int bj = 0; bj < 2; ++bj) { acc[0][bj][m][0] *= r0[m]; acc[0][bj][m][1] *= r0[m]; acc[1][bj][m][0] *= r1[m]; acc[1][bj][m][1] *= r1[m]; } }
        {   PG8_LAS float* cwt = (PG8_LAS float*)(xl + CWT_OFF); const int tid = ((wr * 4 + wc) * 4 + fq) * 16 + fr;
#pragma unroll
            for (int r = 0; r < 2; ++r) { const int idx = tid + r * 512, k = idx >> 8, c = idx & 255, orig = (c < 128) ? 128 * u.pn + c : D_FF + 128 * u.pn + (c - 128);
                cwt[idx] = (k < 3) ? cw[(size_t)k * FF2 + orig] : cb[orig]; } }
        PG8_LAS f32x4* X = (PG8_LAS f32x4*)(xl + XCH_OFF) + (wc * 4 + fq) * 8;
        if (wr == 0 && fr == 15) {
#pragma unroll
            for (int bj = 0; bj < 2; ++bj)
#pragma unroll
                for (int e = 0; e < 2; ++e)
#pragma unroll
                    for (int n = 0; n < 2; ++n) X[(bj * 2 + e) * 2 + n] = acc[1][bj][2 + e][n];
        }
        asm volatile("s_waitcnt vmcnt(0) lgkmcnt(0)" ::: "memory"); __builtin_amdgcn_s_barrier(); asm volatile("" ::: "memory");
        const bool need_fix = (wr == 0) && (fr == 0) && ((u.pm & 7) != 0);
        const bool give_halo = (wr == 1) && (fr == 15);
        const bool take_x = (wr == 1) && (fr == 0);
        float* part = PART + (size_t)u.pm * (2 * 2 * D_FF) + hcol;
        float* halo = HALO + (size_t)u.pm * (2 * 2 * D_FF) + hcol;
        const PG8_LAS float* cwt = (const PG8_LAS float*)(xl + CWT_OFF) + tcol;
#pragma unroll
        for (int n = 0; n < 2; ++n) {
            f32x4 pa[2], pb[2];
#pragma unroll
            for (int e = 0; e < 2; ++e) {
                f32x4 ha = (f32x4){0.f, 0.f, 0.f, 0.f}, hb = (f32x4){0.f, 0.f, 0.f, 0.f};
                if (take_x) { ha = X[(0 * 2 + e) * 2 + n]; hb = X[(1 * 2 + e) * 2 + n]; }
#pragma unroll
                for (int j = 0; j < 4; ++j) {
                    pa[e][j] = __int_as_float(__builtin_amdgcn_update_dpp(__float_as_int(ha[j]), __float_as_int(acc[1][0][2 + e][n][j]), 0x111, 0xf, 0xf, false));
                    pb[e][j] = __int_as_float(__builtin_amdgcn_update_dpp(__float_as_int(hb[j]), __float_as_int(acc[1][1][2 + e][n][j]), 0x111, 0xf, 0xf, false)); } }
            const f32x4 wa0 = *(const PG8_LAS f32x4*)(cwt + 16 * n), wa1 = *(const PG8_LAS f32x4*)(cwt + 256 + 16 * n), wa2 = *(const PG8_LAS f32x4*)(cwt + 512 + 16 * n), ba = *(const PG8_LAS f32x4*)(cwt + 768 + 16 * n);
            const f32x4 wb0 = *(const PG8_LAS f32x4*)(cwt + 128 + 16 * n), wb1 = *(const PG8_LAS f32x4*)(cwt + 384 + 16 * n), wb2 = *(const PG8_LAS f32x4*)(cwt + 640 + 16 * n), bb = *(const PG8_LAS f32x4*)(cwt + 896 + 16 * n);
            if (give_halo) {
                *(f32x4*)(halo + 16 * n) = acc[1][0][2][n]; *(f32x4*)(halo + D_FF + 16 * n) = acc[1][1][2][n];
                *(f32x4*)(halo + 2 * D_FF + 16 * n) = acc[1][0][3][n]; *(f32x4*)(halo + 3 * D_FF + 16 * n) = acc[1][1][3][n]; }
            u32x2 wprev = (u32x2){0u, 0u};
#pragma unroll
            for (int e = 0; e < 8; ++e) {
                const f32x4 ua = acc[e >> 2][0][e & 3][n], ub = acc[e >> 2][1][e & 3][n];
                const f32x4 ua1 = e >= 1 ? acc[(e - 1) >> 2][0][(e - 1) & 3][n] : pa[1], ub1 = e >= 1 ? acc[(e - 1) >> 2][1][(e - 1) & 3][n] : pb[1];
                const f32x4 ua2 = e >= 2 ? acc[(e - 2) >> 2][0][(e - 2) & 3][n] : pa[e], ub2 = e >= 2 ? acc[(e - 2) >> 2][1][(e - 2) & 3][n] : pb[e];
                const f32x4 av = ba + wa2 * ua + wa1 * ua1 + wa0 * ua2, bv = bb + wb2 * ub + wb1 * ub1 + wb0 * ub2;
                if (e < 2 && need_fix) { *(f32x4*)(part + (size_t)e * 2 * D_FF + 16 * n) = av; *(f32x4*)(part + (size_t)e * 2 * D_FF + D_FF + 16 * n) = bv; }
                u32x2 w; w.x = pk2(siluf(av[0]) * bv[0], siluf(av[1]) * bv[1]); w.y = pk2(siluf(av[2]) * bv[2], siluf(av[3]) * bv[3]);
                if ((e & 1) == 0) wprev = w;
                else {
                    const auto sx = __builtin_amdgcn_permlane16_swap(wprev.x, w.x, false, false), sy = __builtin_amdgcn_permlane16_swap(wprev.y, w.y, false, false);
                    u32x4 w4; w4.x = sx[0]; w4.y = sy[0]; w4.z = sx[1]; w4.w = sy[1];
                    *(u32x4*)(H + (size_t)(grow0 + e - 1 + (fq & 1)) * D_FF + 128 * u.pn + 32 * wc + 16 * n + 4 * (fq & 2)) = w4; }
            }
            asm volatile("" ::: "memory");
        }
    }
};
struct EpiB1 {
    static constexpr bool PERM = false;
    static constexpr bool AROWPERM = true;
    static constexpr int NTAB = 1;
    const float* ss16; const float2* rope; bf16_t* QT; bf16_t* KT; bf16_t* VT;
    __device__ __forceinline__ void fill(PG8_LAS unsigned char* xl, int i, const Unit& u, int t) const { ((PG8_LAS float*)(xl + RT1_OFF))[i * 256 + t] = rstd16(ss16, u.pm * BM + t); }
    __device__ __forceinline__ void operator()(f32x4 (&acc)[2][2][4][2], const Unit& u, int ui, int wr, int wc, int fr, int fq, PG8_LAS unsigned char* xl) const {
        const int trow0 = 8 * (16 * wr + fr), grow0 = u.pm * BM + trow0, pn = u.pn, t0 = grow0 & (SEQ - 1);
        const PG8_LAS float* rt = (const PG8_LAS float*)(xl + RT1_OFF) + ui * 256 + trow0;
        const f32x4 r0 = *(const PG8_LAS f32x4*)rt, r1 = *(const PG8_LAS f32x4*)(rt + 4);
        if (pn < 8) {
            const int h = pn & 3; const bool isk = pn >= 4; const float lg = gamma_log(h);
            bf16_t* dbase = (isk ? KT : QT) + (size_t)grow0 * 1024 + h * 256 + 32 * wc + 4 * (fq & 2);
            float sc[8];
#pragma unroll
            for (int e = 0; e < 8; ++e) { const int pos = (t0 + e) & 63; sc[e] = (e < 4 ? r0[e & 3] : r1[e & 3]) * (isk ? 0.0625f * __expf(-(float)(pos + 1) * lg) : __expf((float)(pos + 1) * lg)); }
#pragma unroll
            for (int n = 0; n < 2; ++n) {
                const int i0 = 32 * wc + 16 * n + 4 * fq;
                f32x4 cur[2], dw[2];
                {   const f32x4* rp = (const f32x4*)(rope + (size_t)t0 * 128 + i0); const f32x4* rw = (const f32x4*)(rope + (size_t)128 + i0); cur[0] = rp[0]; cur[1] = rp[1]; dw[0] = rw[0]; dw[1] = rw[1]; }
                u32x2 p1 = (u32x2){0u, 0u}, p2 = (u32x2){0u, 0u};
#pragma unroll
                for (int e = 0; e < 8; ++e) {
                    const f32x4 c0 = cur[0], c1 = cur[1];
                    const f32x4 x1 = acc[e >> 2][0][e & 3][n] * sc[e], x2 = acc[e >> 2][1][e & 3][n] * sc[e];
                    f32x4 o1, o2;
                    o1[0] = x1[0] * c0[0] - x2[0] * c0[1]; o2[0] = x1[0] * c0[1] + x2[0] * c0[0];
                    o1[1] = x1[1] * c0[2] - x2[1] * c0[3]; o2[1] = x1[1] * c0[3] + x2[1] * c0[2];
                    o1[2] = x1[2] * c1[0] - x2[2] * c1[1]; o2[2] = x1[2] * c1[1] + x2[2] * c1[0];
                    o1[3] = x1[3] * c1[2] - x2[3] * c1[3]; o2[3] = x1[3] * c1[3] + x2[3] * c1[2];
                    u32x2 w1, w2; w1.x = pk2(o1[0], o1[1]); w1.y = pk2(o1[2], o1[3]); w2.x = pk2(o2[0], o2[1]); w2.y = pk2(o2[2], o2[3]);
                    if ((e & 1) == 0) { p1 = w1; p2 = w2; }
                    else {
                        const auto ax = __builtin_amdgcn_permlane16_swap(p1.x, w1.x, false, false), ay = __builtin_amdgcn_permlane16_swap(p1.y, w1.y, false, false);
                        const auto bx = __builtin_amdgcn_permlane16_swap(p2.x, w2.x, false, false), by = __builtin_amdgcn_permlane16_swap(p2.y, w2.y, false, false);
                        bf16_t* d = dbase + (size_t)(e - 1 + (fq & 1)) * 1024 + 16 * n;
                        u32x4 v1; v1.x = ax[0]; v1.y = ay[0]; v1.z = ax[1]; v1.w = ay[1]; *(u32x4*)d = v1;
                        u32x4 v2; v2.x = bx[0]; v2.y = by[0]; v2.z = bx[1]; v2.w = by[1]; *(u32x4*)(d + 128) = v2; }
                    if (e < 7) {
#pragma unroll
                        for (int q = 0; q < 2; ++q) { const f32x4 c = cur[q], dd = dw[q]; f32x4 nx;
                            nx[0] = c[0] * dd[0] - c[1] * dd[1]; nx[1] = c[1] * dd[0] + c[0] * dd[1]; nx[2] = c[2] * dd[2] - c[3] * dd[3]; nx[3] = c[3] * dd[2] + c[2] * dd[3]; cur[q] = nx; } }
                }
                asm volatile("" ::: "memory");
            }
        } else {
            const int b = grow0 / SEQ;
            bf16_t* dst = VT + ((size_t)b * 2048 + (pn - 8) * 256 + 32 * wc + 4 * fq) * SEQ + t0;
#pragma unroll
            for (int bj = 0; bj < 2; ++bj)
#pragma unroll
                for (int n = 0; n < 2; ++n)
#pragma unroll
                    for (int j = 0; j < 4; ++j) { u32x4 w;
                        w.x = pk2(acc[0][bj][0][n][j] * r0[0], acc[0][bj][1][n][j] * r0[1]); w.y = pk2(acc[0][bj][2][n][j] * r0[2], acc[0][bj][3][n][j] * r0[3]);
                        w.z = pk2(acc[1][bj][0][n][j] * r1[0], acc[1][bj][1][n][j] * r1[1]); w.w = pk2(acc[1][bj][2][n][j] * r1[2], acc[1][bj][3][n][j] * r1[3]);
                        *(u32x4*)(dst + (size_t)(128 * bj + 16 * n + j) * SEQ) = w; }
        }
    }
};
struct EpiGate {
    static constexpr bool PERM = true;
    static constexpr bool AROWPERM = false;
    static constexpr int NTAB = 1;
    const float* ss16; const float* ssr; bf16_t* RET;
    __device__ __forceinline__ void fill(PG8_LAS unsigned char* xl, int i, const Unit& u, int t) const {
        const int row = u.pm * BM + t;
        ((PG8_LAS float*)(xl + RT1_OFF))[i * 256 + t] = rstd16(ss16, row);
        const f32x4* sp = (const f32x4*)(ssr + ((size_t)row * 4 + (u.pn >> 1)) * 16); const f32x4 s0 = sp[0], s1 = sp[1], s2 = sp[2], s3 = sp[3];
        ((PG8_LAS float*)(xl + RT2_OFF))[i * 256 + t] = rsqrtf(((((s0[0] + s0[1]) + (s0[2] + s0[3])) + ((s1[0] + s1[1]) + (s1[2] + s1[3]))) + (((s2[0] + s2[1]) + (s2[2] + s2[3])) + ((s3[0] + s3[1]) + (s3[2] + s3[3])))) * (1.0f / 512.0f) + EPS);
    }
    __device__ __forceinline__ void operator()(f32x4 (&acc)[2][2][4][2], const Unit& u, int ui, int wr, int wc, int fr, int fq, PG8_LAS unsigned char* xl) const {
        const int row0 = u.pm * BM + wr * 64 + fr, colb = u.pn * BM + wc * 32 + 8 * fq;
        const PG8_LAS float* rt = (const PG8_LAS float*)(xl + RT1_OFF) + ui * 256 + wr * 64 + fr;
        const PG8_LAS float* rt2 = (const PG8_LAS float*)(xl + RT2_OFF) + ui * 256 + wr * 64 + fr;
        u32x4 rvv[2][4][2];
#pragma unroll
        for (int ai = 0; ai < 2; ++ai)
#pragma unroll
            for (int m = 0; m < 4; ++m)
#pragma unroll
                for (int bj = 0; bj < 2; ++bj) rvv[ai][m][bj] = *(const u32x4*)(RET + (size_t)(row0 + ai * HALF + m * 16) * 2048 + colb + bj * HALF);
#pragma unroll
        for (int ai = 0; ai < 2; ++ai)
#pragma unroll
            for (int m = 0; m < 4; ++m) { const int row = row0 + ai * HALF + m * 16; const float r = rt[ai * HALF + m * 16], rh = rt2[ai * HALF + m * 16];
#pragma unroll
                for (int bj = 0; bj < 2; ++bj) { bf16_t* p = RET + (size_t)row * 2048 + colb + bj * HALF; const u32x4 rv = rvv[ai][m][bj];
                    const f32x4 g0 = acc[ai][bj][m][0] * r, g1 = acc[ai][bj][m][1] * r; f32x4 y0, y1;
                    y0[0] = bflo(rv.x) * rh * siluf(g0[0]); y0[1] = bfhi(rv.x) * rh * siluf(g0[1]); y0[2] = bflo(rv.y) * rh * siluf(g0[2]); y0[3] = bfhi(rv.y) * rh * siluf(g0[3]);
                    y1[0] = bflo(rv.z) * rh * siluf(g1[0]); y1[1] = bfhi(rv.z) * rh * siluf(g1[1]); y1[2] = bflo(rv.w) * rh * siluf(g1[2]); y1[3] = bfhi(rv.w) * rh * siluf(g1[3]);
                    *(u32x4*)p = pack8(y0, y1); } }
    }
};

template <class Epi, class Sched>
__device__ __forceinline__ void gemm_phase(PG8_LAS unsigned char* lds, const Gemm g, const Sched& S, const Epi& E) {
    int tid_ = threadIdx.x; asm volatile("" : "+v"(tid_));
    const int tid = tid_, wid = __builtin_amdgcn_readfirstlane(tid >> 6), lane = tid & 63, wr = wid >> 2, wc = wid & 3, fr = lane & 15, fq = lane >> 4;
    const int K = g.K, nt = K / BK;
    unsigned voffA0[2], voffA1[2], voffB[2];
#pragma unroll
    for (int i = 0; i < 2; ++i) { int R, C; stage_rc(tid * 16 + i * 8192, R, C); const int Rb = Epi::PERM ? (R & ~31) + perm32(R & 31) : R;
        int ra0, ra1;
        if (Epi::AROWPERM) { const int base = ((R >> 6) * 16 + (R & 15)) * 8 + ((R >> 4) & 3); ra0 = base; ra1 = base + 4; } else { ra0 = R; ra1 = R + HALF; }
        voffA0[i] = (unsigned)(ra0 * K + C) * 2u; voffA1[i] = (unsigned)(ra1 * K + C) * 2u; voffB[i] = (unsigned)(Rb * K + C) * 2u; }
    const size_t kstep = (size_t)(BK * 2);
    const size_t hstep = (size_t)HALF * K * 2;
    const size_t tstep = 2 * hstep;
    const unsigned ldsw = (unsigned)wid * 1024u;
    const int aoff = lds_byte(wr * 64 + fr, fq * 8), boff = lds_byte(wc * 32 + fr, fq * 8);
#define PG8_SA(b, h) (((b) * 2 + (h)) * HTB)
#define PG8_SB(b, h) ((4 + (b) * 2 + (h)) * HTB)
#define PG8_STAGE(bufoff, gbase, voff) do { _Pragma("unroll") for (int _i = 0; _i < 2; ++_i) \
        __builtin_amdgcn_global_load_lds((const unsigned*)((const char*)(gbase) + (voff)[_i]), (PG8_LAS unsigned*)(lds + (bufoff) + ldsw + _i * 8192), 16, 0, 0); } while (0)
#define PG8_LDA(dst, b, h) do { _Pragma("unroll") for (int m = 0; m < 4; ++m) _Pragma("unroll") for (int k = 0; k < 2; ++k) dst[m][k] = *(const PG8_LAS bf16x8*)(lds + PG8_SA(b, h) + aoff + m * 2048 + k * 1024); } while (0)
#define PG8_LDB(dst, b, h) do { _Pragma("unroll") for (int n = 0; n < 2; ++n) _Pragma("unroll") for (int k = 0; k < 2; ++k) dst[n][k] = *(const PG8_LAS bf16x8*)(lds + PG8_SB(b, h) + boff + n * 2048 + k * 1024); } while (0)
#define PG8_MMA(ai, bj, At, Bt) do { __builtin_amdgcn_s_setprio(1); _Pragma("unroll") for (int m = 0; m < 4; ++m) _Pragma("unroll") for (int n = 0; n < 2; ++n) _Pragma("unroll") for (int k = 0; k < 2; ++k) \
        acc[ai][bj][m][n] = __builtin_amdgcn_mfma_f32_16x16x32_bf16(Bt[n][k], At[m][k], acc[ai][bj][m][n], 0, 0, 0); __builtin_amdgcn_s_setprio(0); } while (0)
#define PG8_WAIT_V(n) asm volatile("s_waitcnt vmcnt(" #n ")" ::: "memory")
#define PG8_WAIT_L(n) asm volatile("s_waitcnt lgkmcnt(" #n ")" ::: "memory")
#define PG8_BAR __builtin_amdgcn_s_barrier()
#define PG8_SCHED __builtin_amdgcn_sched_barrier(0)
    Unit cur, nxt; int ui = 0;
    if (!S.next(0, cur)) return;
    f32x4 acc[2][2][4][2];
#pragma unroll
    for (int a = 0; a < 2; ++a)
#pragma unroll
        for (int b = 0; b < 2; ++b)
#pragma unroll
            for (int m = 0; m < 4; ++m)
#pragma unroll
                for (int n = 0; n < 2; ++n) acc[a][b][m][n] = (f32x4){0.f, 0.f, 0.f, 0.f};
    bf16x8 At[4][2], B0[2][2], B1[2][2];
    const char* cA = (const char*)g.A + (size_t)cur.pm * tstep; const char* cB = (const char*)g.Bt + (size_t)cur.pn * tstep;
    PG8_STAGE(PG8_SB(0, 0), cB, voffB); PG8_STAGE(PG8_SB(0, 1), cB + hstep, voffB); PG8_STAGE(PG8_SA(0, 0), cA, voffA0); PG8_STAGE(PG8_SA(0, 1), cA, voffA1);
    if constexpr (Epi::NTAB > 0) {
#pragma unroll 1
        for (int i = tid >> 8; i < 8; i += 2) { Unit uu; if (!S.next(i, uu)) break; E.fill(lds + STAGE_BYTES, i, uu, tid & 255); asm volatile("" ::: "memory"); }
        asm volatile("s_waitcnt lgkmcnt(0)" ::: "memory");
    }
    if (wr == 1) PG8_BAR;
    PG8_WAIT_V(2); PG8_BAR;
    PG8_STAGE(PG8_SB(1, 0), cB + kstep, voffB); PG8_STAGE(PG8_SA(1, 0), cA + kstep, voffA0); PG8_STAGE(PG8_SB(1, 1), cB + hstep + kstep, voffB);
    PG8_WAIT_V(6); PG8_BAR;
    for (;;) {
        const bool has_next = S.next(ui + 1, nxt);
        const char* nA = has_next ? (const char*)g.A + (size_t)nxt.pm * tstep : cA; const char* nB = has_next ? (const char*)g.Bt + (size_t)nxt.pn * tstep : cB;
        for (int t = 0; t < nt; t += 2) {
            const bool last = (t == nt - 2);
            const char* a1 = cA + (size_t)(t + 1) * kstep;
            const char* a2 = last ? nA : cA + (size_t)(t + 2) * kstep; const char* b2 = last ? nB : cB + (size_t)(t + 2) * kstep;
            const char* a3 = a2 + kstep; const char* b3 = b2 + kstep;
            PG8_LDB(B0, 0, 0); PG8_LDB(B1, 0, 1); PG8_SCHED; PG8_LDA(At, 0, 0); PG8_STAGE(PG8_SA(1, 1), a1, voffA1);
            PG8_WAIT_V(8); PG8_WAIT_L(0); PG8_BAR; PG8_MMA(0, 0, At, B0); PG8_MMA(0, 1, At, B1); PG8_BAR; PG8_SCHED;
            PG8_LDA(At, 0, 1); PG8_STAGE(PG8_SB(0, 0), b2, voffB); PG8_STAGE(PG8_SB(0, 1), b2 + hstep, voffB); PG8_STAGE(PG8_SA(0, 0), a2, voffA0);
            PG8_WAIT_V(8); PG8_WAIT_L(0); PG8_BAR; PG8_MMA(1, 0, At, B0); PG8_MMA(1, 1, At, B1); PG8_BAR; PG8_SCHED;
            PG8_LDB(B0, 1, 0); PG8_LDB(B1, 1, 1); PG8_SCHED; PG8_LDA(At, 1, 0); PG8_STAGE(PG8_SA(0, 1), a2, voffA1);
            PG8_WAIT_V(8); PG8_WAIT_L(0); PG8_BAR; PG8_MMA(0, 0, At, B0); PG8_MMA(0, 1, At, B1); PG8_BAR; PG8_SCHED;
            PG8_LDA(At, 1, 1); PG8_STAGE(PG8_SB(1, 0), b3, voffB); PG8_STAGE(PG8_SB(1, 1), b3 + hstep, voffB); PG8_STAGE(PG8_SA(1, 0), a3, voffA0);
            PG8_WAIT_V(8); PG8_WAIT_L(0); PG8_BAR; PG8_MMA(1, 0, At, B0); PG8_MMA(1, 1, At, B1); PG8_BAR; PG8_SCHED;
        }
        if (wr == 0) PG8_BAR;
        E(acc, cur, ui, wr, wc, fr, fq, lds + STAGE_BYTES);
        if (!has_next) break;
#pragma unroll
        for (int a = 0; a < 2; ++a)
#pragma unroll
            for (int b = 0; b < 2; ++b)
#pragma unroll
                for (int m = 0; m < 4; ++m)
#pragma unroll
                    for (int n = 0; n < 2; ++n) acc[a][b][m][n] = (f32x4){0.f, 0.f, 0.f, 0.f};
        cur = nxt; cA = nA; cB = nB; ++ui;
        if (wr == 1) PG8_BAR;
    }
    PG8_WAIT_V(0);
    PG8_BAR;
#undef PG8_SA
#undef PG8_SB
#undef PG8_STAGE
#undef PG8_LDA
#undef PG8_LDB
#undef PG8_MMA
#undef PG8_WAIT_V
#undef PG8_WAIT_L
#undef PG8_BAR
#undef PG8_SCHED
}
}

constexpr int NWAVES = 8;
constexpr int RING_BYTES = 131072, LDS_BYTES = 163840, LDSCTL_OFF = LDS_BYTES - 512, MISC_OFF = LDSCTL_OFF + 320;
#define GAS __attribute__((address_space(1)))
#define LAS __attribute__((address_space(3)))
typedef GAS unsigned gu32;
#define RLX_AGENT __ATOMIC_RELAXED, __HIP_MEMORY_SCOPE_AGENT
#define LDS_WAIT() asm volatile("s_waitcnt lgkmcnt(0)" ::: "memory")
#define VM_WAIT() asm volatile("s_waitcnt vmcnt(0)" ::: "memory")
constexpr int CW_BAR = 4096;
#define XB_TMO      128
#define XB_XCNT(j)  (256  + 64 * (j))
#define XB_XSUB(j)  (1280 + 64 * (j))
#define XB_XGEN(j)  (2304 + 64 * (j))
#define XB_TOP      3328
#define XB_TOPGEN   3392
#define XCD_BAR_WORDS 3456
#define XB_SPIN_CAP (1u << 18)
__device__ __forceinline__ unsigned xb_ld(unsigned* p)              { return __hip_atomic_load(p, __ATOMIC_RELAXED, __HIP_MEMORY_SCOPE_AGENT); }
__device__ __forceinline__ unsigned xb_add(unsigned* p, unsigned v) { return __hip_atomic_fetch_add(p, v, __ATOMIC_RELAXED, __HIP_MEMORY_SCOPE_AGENT); }
__device__ __forceinline__ unsigned xb_xcc_id() { return (unsigned)__builtin_amdgcn_s_getreg((3 << 11) | 20) & 0xFu; }
#define XB_SPIN(cond, bar) do { unsigned _sp = 0; while (cond) { __builtin_amdgcn_s_sleep(1); \
    if ((++_sp & 255u) == 0u) { if (xb_ld(&(bar)[XB_TMO])) break; if (_sp > XB_SPIN_CAP) { atomicAdd(&(bar)[XB_TMO], 1u); break; } } } } while (0)
struct XcdBarrier { unsigned* bar; unsigned x; volatile LAS unsigned* st; };
__device__ __forceinline__ XcdBarrier xcd_barrier_post(unsigned* bar, volatile LAS unsigned* st) {
    XcdBarrier b; b.bar = bar; b.x = xb_xcc_id(); b.st = st;
    if (threadIdx.x == 0) (void)xb_add(&bar[XB_XCNT(b.x)], 1u);
    return b;
}
__device__ __forceinline__ void xcd_barrier_complete(unsigned* bar, unsigned x, unsigned& nloc, unsigned& nx) {
    const unsigned G = gridDim.x * gridDim.y * gridDim.z;
    unsigned sum, cnt, mine, sp = 0u;
    for (;;) {
        sum = 0u; cnt = 0u; mine = 0u;
#pragma unroll
        for (unsigned j = 0; j < 16; ++j) { const unsigned c = xb_ld(&bar[XB_XCNT(j)]); sum += c; cnt += (c > 0u) ? 1u : 0u; mine = (j == x) ? c : mine; }
        if (sum == G) break;
        __builtin_amdgcn_s_sleep(1);
        if ((++sp & 255u) == 0u) { if (xb_ld(&bar[XB_TMO])) break; if (sp > XB_SPIN_CAP) { atomicAdd(&bar[XB_TMO], 1u); break; } }
    }
    nloc = mine > 0u ? mine : 1u; nx = cnt > 0u ? cnt : 1u;
}
__device__ __forceinline__ void xcd_barrier(const XcdBarrier& b) {
    asm volatile("s_waitcnt vmcnt(0)" ::: "memory");
    __syncthreads();
    if (threadIdx.x == 0) {
        unsigned* bar = b.bar;
        __builtin_amdgcn_s_waitcnt(0);
        unsigned nloc = b.st[0], nx = b.st[1];
        if (nloc == 0u) { xcd_barrier_complete(bar, b.x, nloc, nx); b.st[0] = nloc; b.st[1] = nx; }
        const unsigned old = xb_add(&bar[XB_XSUB(b.x)], 1u);
        const unsigned gen = old / nloc;
        if (old + 1u == (gen + 1u) * nloc) {
            __builtin_amdgcn_fence(__ATOMIC_RELEASE, "agent");
            asm volatile("s_waitcnt vmcnt(0)" ::: "memory");
            const unsigned og = xb_add(&bar[XB_TOP], 1u);
            const unsigned tg = og / nx;
            if (og + 1u == (tg + 1u) * nx) xb_add(&bar[XB_TOPGEN], 1u);
            else XB_SPIN(xb_ld(&bar[XB_TOPGEN]) == tg, bar);
            __builtin_amdgcn_fence(__ATOMIC_ACQUIRE, "agent");
            xb_add(&bar[XB_XGEN(b.x)], 1u);
            asm volatile("s_waitcnt vmcnt(0)" ::: "memory");
        } else {
            XB_SPIN(xb_ld(&bar[XB_XGEN(b.x)]) == gen, bar);
            __builtin_amdgcn_fence(__ATOMIC_ACQUIRE, "agent");
            asm volatile("s_waitcnt vmcnt(0)" ::: "memory");
        }
    }
    __syncthreads();
}

struct Args { const float* in[16]; float* out; unsigned char* ws; int ph_lo, ph_hi, li, pad; };
enum { PH_PRO = 0, PH_A1, PH_A2, PH_A3, PH_F1A, PH_F2A, PH_B1, PH_B2, PH_GATE, PH_B3, PH_F1B, PH_F2B, PH_END };

__device__ __forceinline__ void p0_transpose_item(const float* W, int K, int Nsrc, int N, int mode, const float* gain, bf16_t* WT, LAS float* scr, int item, int lane) {
    const int nblk = N / 64, kb = item / nblk, nb = item % nblk, k0 = 64 * kb, n0 = 64 * nb;
    const int src = wmap(mode, n0 + lane);
    const float* wp = W + (size_t)k0 * Nsrc + (src >= 0 ? src : 0);
#pragma unroll
    for (int h = 0; h < 2; ++h) { float v[32];
#pragma unroll
        for (int i = 0; i < 32; ++i) v[i] = wp[(size_t)(32 * h + i) * Nsrc];
#pragma unroll
        for (int i = 0; i < 32; ++i) { float x = v[i]; if (gain) x *= gain[k0 + 32 * h + i]; if (src < 0) x = 0.f; scr[(32 * h + i) * 65 + lane] = x; } }
    LDS_WAIT(); asm volatile("" ::: "memory");
    const int kq = (lane & 3) * 16;
#pragma unroll
    for (int j = 0; j < 4; ++j) { const int n = (lane >> 2) + 16 * j; const LAS float* sp = scr + kq * 65 + n;
        u32x4 o0, o1;
        o0.x = pk2(sp[0 * 65], sp[1 * 65]); o0.y = pk2(sp[2 * 65], sp[3 * 65]); o0.z = pk2(sp[4 * 65], sp[5 * 65]); o0.w = pk2(sp[6 * 65], sp[7 * 65]);
        o1.x = pk2(sp[8 * 65], sp[9 * 65]); o1.y = pk2(sp[10 * 65], sp[11 * 65]); o1.z = pk2(sp[12 * 65], sp[13 * 65]); o1.w = pk2(sp[14 * 65], sp[15 * 65]);
        bf16_t* dst = WT + (size_t)(n0 + n) * K + k0 + kq; *(u32x4*)dst = o0; *(u32x4*)(dst + 8) = o1; }
    LDS_WAIT(); asm volatile("" ::: "memory");
}
__device__ __forceinline__ void ffn_fixup(int pm, const float* cw, const float* PART, const float* HALO, bf16_t* H) {
    if ((pm & 7) == 0) return;
    int tid = threadIdx.x; asm volatile("" : "+v"(tid));
    const float* part = PART + (size_t)pm * (4 * D_FF); const float* halo = HALO + (size_t)(pm - 1) * (4 * D_FF);
#pragma unroll
    for (int idx0 = 0; idx0 < 2 * D_FF; idx0 += NWAVES * 64) { const int idx = idx0 + tid; const int e = idx / D_FF, c = idx - e * D_FF;
        float a = part[(size_t)e * 2 * D_FF + c], b = part[(size_t)e * 2 * D_FF + D_FF + c];
        const float ha0 = halo[c], hb0 = halo[D_FF + c], ha1 = halo[2 * D_FF + c], hb1 = halo[3 * D_FF + c];
        const float wa0 = cw[c], wa1 = cw[FF2 + c], wb0 = cw[D_FF + c], wb1 = cw[FF2 + D_FF + c];
        if (e == 0) { a += wa1 * ha1 + wa0 * ha0; b += wb1 * hb1 + wb0 * hb0; } else { a += wa0 * ha1; b += wb0 * hb1; }
        H[(size_t)(pm * 256 + e) * D_FF + c] = f2bf(siluf(a) * b); }
}


__device__ __forceinline__ void glds16_asm(const void* gsrc, unsigned lds_dst) {
    unsigned keep; asm volatile("s_mov_b32 %0, m0\n\ts_mov_b32 m0, %2\n\ts_nop 0\n\tglobal_load_lds_dwordx4 %1, off\n\ts_mov_b32 m0, %0" : "=&s"(keep) : "v"(gsrc), "s"(lds_dst) : "memory"); }
__device__ __forceinline__ unsigned lds_addr(LAS unsigned char* p) { return (unsigned)__builtin_amdgcn_readfirstlane((int)(unsigned)(size_t)p); }

typedef short s16x4 __attribute__((ext_vector_type(4)));
__device__ __forceinline__ bf16x8 cat4(s16x4 a, s16x4 b) { bf16x8 r; r[0] = a[0]; r[1] = a[1]; r[2] = a[2]; r[3] = a[3]; r[4] = b[0]; r[5] = b[1]; r[6] = b[2]; r[7] = b[3]; return r; }
__device__ __forceinline__ void ret_fast_phase(LAS unsigned char* lds, const bf16_t* QT, const bf16_t* KT, const bf16_t* VT, bf16_t* RET, float* SSR, int unit) {
    int tid_ = threadIdx.x; asm volatile("" : "+v"(tid_));
    const int tid = tid_, lane = tid & 63, w = __builtin_amdgcn_readfirstlane(tid >> 6), li = lane & 15, g = lane >> 4;
    const int blk = unit & 7, h = (unit >> 3) & 3, b = unit >> 5;
    const float g64 = __expf(64.0f * gamma_log(h));
    const bool isR = w < 4; const int qt = w & 3, u = w & 3;
    constexpr int KB = 0, VB = 65536, ST = 81920;
    typedef __attribute__((address_space(3))) s16x4 lds_s16x4;
    for (int e = tid; e < 2048; e += 512) *(LAS u32x4*)(lds + ST + e * 16) = (u32x4){0u, 0u, 0u, 0u};
    f32x4 rg[16];
#pragma unroll
    for (int i = 0; i < 16; ++i) rg[i] = (f32x4){0.f, 0.f, 0.f, 0.f};
    const size_t rowb = (size_t)b * SEQ;
    const bf16_t* kbase = KT + rowb * 1024 + h * 256;
    const bf16_t* qbase = QT + (rowb + 16 * qt + li) * 1024 + h * 256 + 8 * g;
    const bf16_t* vbase = VT + ((size_t)b * 2048 + h * 512 + blk * 64 + (tid >> 3)) * SEQ + 8 * (tid & 7);
    const unsigned vw_off = (unsigned)((tid >> 3) * 128 + (((2 * (tid & 7)) ^ ((tid >> 3) & 14)) * 8));
    unsigned ksrc[8];
#pragma unroll
    for (int i = 0; i < 8; ++i) { const int row = 2 * (8 * u + i) + (lane >> 5), p = lane & 31, c = p ^ ((row & 7) << 1); ksrc[i] = (unsigned)(row * 2048 + c * 16); }
#define RK_DMA(n_, buf_) do { const char* kb_ = (const char*)(kbase + (size_t)(n_) * 64 * 1024); const unsigned ld_ = lds_addr(lds + KB + (buf_) * 32768 + (8 * u) * 1024); _Pragma("unroll") for (int i = 0; i < 8; ++i) \
        glds16_asm(kb_ + ksrc[i], ld_ + i * 1024); } while (0)
    u32x4 vreg;
    if (!isR) { RK_DMA(0, 0); }
    vreg = *(const u32x4*)(vbase);
    if (isR) {
#pragma unroll
        for (int ks = 0; ks < 8; ++ks) rg[ks] = *(const f32x4*)(qbase + 32 * ks); }
    *(LAS u32x4*)(lds + VB + vw_off) = vreg;
    asm volatile("s_waitcnt vmcnt(0) lgkmcnt(0)" ::: "memory"); __builtin_amdgcn_s_barrier(); asm volatile("" ::: "memory");
#pragma unroll 1
    for (int n = 0; n < 32; ++n) {
        const int cur = n & 1, nxt = cur ^ 1;
        LAS unsigned char* kb = lds + KB + cur * 32768; LAS unsigned char* vb = lds + VB + cur * 8192; LAS unsigned char* sb = lds + ST + cur * 32768;
        if (n + 1 < 32) vreg = *(const u32x4*)(vbase + (size_t)(n + 1) * 64);
        if (isR) {
            if (n + 1 < 32) {
#pragma unroll
                for (int ks = 0; ks < 8; ++ks) rg[8 + ks] = *(const f32x4*)(qbase + (size_t)(n + 1) * 64 * 1024 + 32 * ks); }
            const int sw = (li & 7) << 1;
#define LDROWS(dst, base, tile) do { const LAS unsigned char* rp_ = (base) + (16 * (tile) + li) * 512; _Pragma("unroll") for (int ks = 0; ks < 8; ++ks) dst[ks] = *(const LAS bf16x8*)(rp_ + (((4 * ks + g) ^ sw) * 16)); } while (0)
#define MMA8(acc_, fr_) do { _Pragma("unroll") for (int ks = 0; ks < 8; ++ks) acc_ = __builtin_amdgcn_mfma_f32_16x16x32_bf16(fr_[ks], __builtin_bit_cast(bf16x8, rg[ks]), acc_, 0, 0, 0); } while (0)
#define SFIN(k_, a_) do { if (qt == (k_)) { _Pragma("unroll") for (int r = 0; r < 4; ++r) a_[r] = (4 * g + r <= li) ? a_[r] : 0.f; } u32x2 pk_; pk_.x = pk2(a_[0], a_[1]); pk_.y = pk2(a_[2], a_[3]); sfr[k_] = __builtin_bit_cast(s16x4, pk_); } while (0)
#define SB_ __builtin_amdgcn_sched_barrier(0)
            bf16x8 fa[8], fb[8]; f32x4 racc[4]; s16x4 sfr[4];
#pragma unroll
            for (int t = 0; t < 4; ++t) { racc[t] = (f32x4){0.f, 0.f, 0.f, 0.f}; sfr[t] = (s16x4){0, 0, 0, 0}; }
            LDROWS(fa, sb, 0); SB_;
            LDROWS(fb, sb, 1); SB_; MMA8(racc[0], fa); SB_;
            LDROWS(fa, sb, 2); SB_; MMA8(racc[1], fb); SB_;
            LDROWS(fb, sb, 3); SB_; MMA8(racc[2], fa); SB_;
            LDROWS(fa, kb, 0); SB_; MMA8(racc[3], fb); SB_;
            if (qt >= 1) { LDROWS(fb, kb, 1); }
            SB_;
            { f32x4 a = (f32x4){0.f, 0.f, 0.f, 0.f}; MMA8(a, fa); SFIN(0, a); }
            SB_;
            if (qt >= 1) { if (qt >= 2) { LDROWS(fa, kb, 2); } SB_; f32x4 a = (f32x4){0.f, 0.f, 0.f, 0.f}; MMA8(a, fb); SFIN(1, a); }
            SB_;
            if (qt >= 2) { if (qt >= 3) { LDROWS(fb, kb, 3); } SB_; f32x4 a = (f32x4){0.f, 0.f, 0.f, 0.f}; MMA8(a, fa); SFIN(2, a); }
            SB_;
            bf16x8 vf0[4], vf1[4];
#pragma unroll
            for (int t = 0; t < 4; ++t) { const int row = 16 * t + li; const LAS unsigned char* vp = vb + row * 128; const int f = row & 14;
                vf0[t] = cat4(*(const LAS s16x4*)(vp + (((g) ^ f) * 8)), *(const LAS s16x4*)(vp + (((4 + g) ^ f) * 8)));
                vf1[t] = cat4(*(const LAS s16x4*)(vp + (((8 + g) ^ f) * 8)), *(const LAS s16x4*)(vp + (((12 + g) ^ f) * 8))); }
            SB_;
            if (qt >= 3) { f32x4 a = (f32x4){0.f, 0.f, 0.f, 0.f}; MMA8(a, fb); SFIN(3, a); }
            SB_;
            const bf16x8 sf0 = cat4(sfr[0], sfr[1]), sf1 = cat4(sfr[2], sfr[3]);
            float ssq = 0.f; u32x2 pkt[4];
#pragma unroll
            for (int t = 0; t < 4; ++t) {
                f32x4 acc = __builtin_amdgcn_mfma_f32_16x16x32_bf16(vf0[t], sf0, racc[t], 0, 0, 0);
                if (qt >= 2) acc = __builtin_amdgcn_mfma_f32_16x16x32_bf16(vf1[t], sf1, acc, 0, 0, 0);
                ssq += (acc[0] * acc[0] + acc[1] * acc[1]) + (acc[2] * acc[2] + acc[3] * acc[3]);
                pkt[t].x = pk2(acc[0], acc[1]); pkt[t].y = pk2(acc[2], acc[3]); }
#undef LDROWS
#undef MMA8
#undef SFIN
            bf16_t* rrow = RET + (rowb + n * 64 + 16 * qt + li) * 2048 + h * 512 + blk * 64 + 16 * (g & 1) + 4 * (g & 2);
#pragma unroll
            for (int pp = 0; pp < 2; ++pp) {
                const auto sx = __builtin_amdgcn_permlane16_swap(pkt[2 * pp].x, pkt[2 * pp + 1].x, false, false), sy = __builtin_amdgcn_permlane16_swap(pkt[2 * pp].y, pkt[2 * pp + 1].y, false, false);
                u32x4 w4; w4.x = sx[0]; w4.y = sy[0]; w4.z = sx[1]; w4.w = sy[1];
                *(u32x4*)(rrow + 32 * pp) = w4; }
            ssq += __shfl_xor(ssq, 16); ssq += __shfl_xor(ssq, 32);
            if (g < 2) SSR[((rowb + n * 64 + 16 * qt + li) * 4 + h) * 16 + blk * 2 + g] = g ? 0.f : ssq;
#pragma unroll
            for (int ks = 0; ks < 8; ++ks) rg[ks] = rg[8 + ks];
        } else {
            if (n + 1 < 32) { RK_DMA(n + 1, nxt); }
            bf16x8 vf[4][2];
#pragma unroll
            for (int t = 0; t < 4; ++t)
#pragma unroll
                for (int kp = 0; kp < 2; ++kp) { const int row = 16 * t + li; const LAS unsigned char* rp = vb + row * 128; const int f = row & 14;
                    const s16x4 lo = *(const LAS s16x4*)(rp + (((8 * kp + g) ^ f) * 8)), hi = *(const LAS s16x4*)(rp + (((8 * kp + 4 + g) ^ f) * 8)); vf[t][kp] = cat4(lo, hi); }
            bf16x8 ua[4][2];
#pragma unroll
            for (int d = 0; d < 4; ++d) {
#pragma unroll
                for (int kp = 0; kp < 2; ++kp) { const int dkt = 4 * u + d;
                    const int r0 = 32 * kp + 4 * g + (li >> 2), r1 = r0 + 16;
                    const int cch = 2 * dkt + ((li >> 1) & 1), hb = (li & 1) * 8;
                    const s16x4 lo = __builtin_bit_cast(s16x4, __builtin_amdgcn_ds_read_tr16_b64_v4i16((lds_s16x4*)(kb + r0 * 512 + ((cch ^ ((r0 & 7) << 1)) * 16) + hb)));
                    const s16x4 hi = __builtin_bit_cast(s16x4, __builtin_amdgcn_ds_read_tr16_b64_v4i16((lds_s16x4*)(kb + r1 * 512 + ((cch ^ ((r1 & 7) << 1)) * 16) + hb)));
                    ua[d][kp] = cat4(lo, hi); }
                if (d == 1) __builtin_amdgcn_sched_barrier(0); }
            __builtin_amdgcn_sched_barrier(0);
#pragma unroll
            for (int d = 0; d < 4; ++d)
#pragma unroll
                for (int kp = 0; kp < 2; ++kp)
#pragma unroll
                    for (int t = 0; t < 4; ++t) rg[4 * d + t] = __builtin_amdgcn_mfma_f32_16x16x32_bf16(ua[d][kp], vf[t][kp], rg[4 * d + t], 0, 0, 0);
            LAS unsigned char* sn = lds + ST + nxt * 32768;
#pragma unroll
            for (int d = 0; d < 4; ++d)
#pragma unroll
                for (int t = 0; t < 4; ++t) { rg[4 * d + t] *= g64; const int row = 16 * t + li, dkt = 4 * u + d;
                    u32x2 pk; pk.x = pk2(rg[4 * d + t][0], rg[4 * d + t][1]); pk.y = pk2(rg[4 * d + t][2], rg[4 * d + t][3]);
                    *(LAS u32x2*)(sn + row * 512 + (((2 * dkt + (g >> 1)) ^ ((row & 7) << 1)) * 16) + (g & 1) * 8) = pk; }
        }
        if (n + 1 < 32) *(LAS u32x4*)(lds + VB + nxt * 8192 + vw_off) = vreg;
        asm volatile("s_waitcnt vmcnt(0) lgkmcnt(0)" ::: "memory"); __builtin_amdgcn_s_barrier(); asm volatile("" ::: "memory");
    }
#undef RK_DMA
#undef SB_
}


#ifndef DSA_REP
#define DSA_REP 0
#endif
constexpr int DSA_SC = 0, DSA_KST = 131072, DSA_IDX = 147456, DSA_WQ = 155648;
__device__ __forceinline__ unsigned fkey(float f) { const unsigned u = __float_as_uint(f); return (u & 0x80000000u) ? ~u : (u | 0x80000000u); }
__device__ __forceinline__ int bcnt(bool p) { return __popcll(__ballot(p)); }
#define SUMF(a_, b_) ((a_) + (b_))
#define WAVE_RED(OP, v) do { v = OP(v, __int_as_float(__builtin_amdgcn_update_dpp(__float_as_int(v), __float_as_int(v), 0xB1, 0xf, 0xf, true))); \
        v = OP(v, __int_as_float(__builtin_amdgcn_update_dpp(__float_as_int(v), __float_as_int(v), 0x4E, 0xf, 0xf, true))); \
        v = OP(v, __int_as_float(__builtin_amdgcn_update_dpp(__float_as_int(v), __float_as_int(v), 0x141, 0xf, 0xf, true))); \
        v = OP(v, __int_as_float(__builtin_amdgcn_update_dpp(__float_as_int(v), __float_as_int(v), 0x140, 0xf, 0xf, true))); \
        v = OP(OP(__int_as_float(__builtin_amdgcn_readlane(__float_as_int(v), 0)), __int_as_float(__builtin_amdgcn_readlane(__float_as_int(v), 16))), \
               OP(__int_as_float(__builtin_amdgcn_readlane(__float_as_int(v), 32)), __int_as_float(__builtin_amdgcn_readlane(__float_as_int(v), 48)))); } while (0)

template <int NB>
__device__ __forceinline__ void dsa_topk_t(const LAS float* sc, LAS unsigned short* il, int limit, int lane) {
    const int nb = limit >> 6;
    float v[NB];
#pragma unroll
    for (int i = 0; i < NB; ++i) v[i] = (i < nb) ? sc[64 * i + lane] : -INFINITY;
    float mn = INFINITY, mx = -INFINITY;
#pragma unroll
    for (int i = 0; i < NB; ++i) { mn = fminf(mn, (i < nb) ? v[i] : INFINITY); mx = fmaxf(mx, v[i]); }
    WAVE_RED(fminf, mn); WAVE_RED(fmaxf, mx);
    float lo = mn, hi = INFINITY; int clo = limit, chi = 0;
#pragma unroll 1
    for (int it = 0; it < 64 && clo - chi > 64; ++it) {
        const float top = (hi == INFINITY) ? mx : hi; const float mid = 0.5f * lo + 0.5f * top;
        if (!(mid > lo) || !(mid < hi)) break;
        int c = 0;
#pragma unroll
        for (int i = 0; i < NB; ++i) c += (v[i] >= mid) ? 1 : 0;
        float cf = (float)c; WAVE_RED(SUMF, cf); c = (int)cf;
        if (c >= TOPK) { lo = mid; clo = c; } else { hi = mid; chi = c; }
    }
    const int r = TOPK - chi; unsigned T; int ngt, neq;
    if (clo - chi <= 64) {
        int filled = 0;
#pragma unroll
        for (int i = 0; i < NB; ++i) { const bool in = (v[i] >= lo) && (v[i] < hi);
            const unsigned long long m = __ballot(in); const int pos = filled + __builtin_amdgcn_mbcnt_hi((unsigned)(m >> 32), __builtin_amdgcn_mbcnt_lo((unsigned)m, 0));
            if (in) ((LAS unsigned*)il)[pos] = fkey(v[i]);
            filled += __popcll(m); }
        asm volatile("s_waitcnt lgkmcnt(0)" ::: "memory");
        const unsigned ck = (lane < filled) ? ((LAS unsigned*)il)[lane] : 0u;
        T = 0u;
#pragma unroll 4
        for (int bit = 31; bit >= 0; --bit) { const unsigned cand = T | (1u << bit); if (bcnt(ck >= cand) >= r) T = cand; }
        ngt = chi + bcnt(ck > T); neq = bcnt(ck == T);
    } else {
        T = 0u;
#pragma unroll 1
        for (int bit = 31; bit >= 0; --bit) { const unsigned cand = T | (1u << bit); int c = 0;
#pragma unroll
            for (int i = 0; i < NB; ++i) c += bcnt(i < nb && fkey(v[i]) >= cand);
            if (c >= TOPK) T = cand; }
        ngt = 0; neq = 0;
#pragma unroll
        for (int i = 0; i < NB; ++i) { const unsigned k = fkey(v[i]); ngt += bcnt(i < nb && k > T); neq += bcnt(i < nb && k == T); }
    }
    const int need_eq = TOPK - ngt;
    asm volatile("s_waitcnt lgkmcnt(0)" ::: "memory");
    int base = 0, tb = 0;
    const bool alleq = (neq == need_eq);
#pragma unroll
    for (int i = 0; i < NB; ++i) if (i < nb) { const unsigned k = fkey(v[i]);
        bool f = k >= T;
        if (!alleq) { const bool eq = (k == T); const unsigned long long me = __ballot(eq);
            const int er = tb + __builtin_amdgcn_mbcnt_hi((unsigned)(me >> 32), __builtin_amdgcn_mbcnt_lo((unsigned)me, 0));
            f = (k > T) || (eq && er < need_eq); tb += __popcll(me); }
        const unsigned long long mf = __ballot(f); const int pos = base + __builtin_amdgcn_mbcnt_hi((unsigned)(mf >> 32), __builtin_amdgcn_mbcnt_lo((unsigned)mf, 0));
        if (f && pos < TOPK) il[pos] = (unsigned short)(64 * i + lane);
        base += __popcll(mf); }
}
__device__ __forceinline__ void dsa_topk(const LAS float* sc, LAS unsigned short* il, int limit, int lane) {
    if (limit <= 512) dsa_topk_t<8>(sc, il, limit, lane);
    else if (limit <= 1024) dsa_topk_t<16>(sc, il, limit, lane);
    else dsa_topk_t<32>(sc, il, limit, lane);
}

struct DsaQ { bf16x8 qf[4]; f32x4 ps; };
__device__ __forceinline__ DsaQ dsa_load_q(const bf16_t* QH, const float* PS, size_t trow, int lane) {
    const int li = lane & 15, g = lane >> 4; DsaQ q;
#pragma unroll
    for (int s = 0; s < 4; ++s) { q.qf[s] = (bf16x8){0, 0, 0, 0, 0, 0, 0, 0}; if (li < 8) q.qf[s] = *(const bf16x8*)(QH + trow * 1024 + li * 128 + 32 * s + 8 * g); }
    q.ps = (f32x4){1.f, 1.f, 1.f, 1.f};
    if (li < 8) { const float* pp = PS + (size_t)((li >> 1) * 8 + (li & 1) * 4) * M + trow; q.ps = (f32x4){pp[0], pp[(size_t)M], pp[(size_t)2 * M], pp[(size_t)3 * M]}; }
    return q;
}
__device__ __forceinline__ void dsa_attend(LAS unsigned char* wl, const LAS unsigned short* il, const LAS float* rctab, LAS float* rcl, const DsaQ& Q, const bf16_t* Cb, bf16_t* AO, size_t trow, int b, int count, float bound_l2, int lane) {
    const int li = lane & 15, g = lane >> 4;
    typedef __attribute__((address_space(3))) s16x4 lds_s16x4;
    bf16x8 qf[4];
#pragma unroll
    for (int s = 0; s < 4; ++s) qf[s] = Q.qf[s];
    const float rq = (li < 8) ? rsqrtf(((Q.ps[0] + Q.ps[1]) + (Q.ps[2] + Q.ps[3])) * (1.0f / 128.0f) + EPS) * 1.4426950408889634f : 0.f;
    const bf16_t* cbase = Cb + (size_t)b * SEQ * 128; const unsigned wlb = lds_addr(wl);
#define DSA_GATHER(ci_, buf_) do { const u32x4 kw_ = *(const LAS u32x4*)(il + 32 * (ci_) + 8 * (lane >> 4)); \
        _Pragma("unroll") for (int i = 0; i < 8; ++i) { const int row = 4 * i + (lane >> 4); const unsigned kk_ = (i < 2 ? kw_.x : i < 4 ? kw_.y : i < 6 ? kw_.z : kw_.w); const int key = (i & 1) ? (int)(kk_ >> 16) : (int)(kk_ & 0xffffu); \
        const int sc_ = (lane & 15) ^ ((row & 7) << 1); \
        glds16_asm(cbase + (size_t)key * 128 + sc_ * 8, wlb + (buf_) * 8192 + i * 1024); } } while (0)
    for (int pos = lane; pos < count; pos += 64) { const int e = pos & 31; rcl[(pos & ~31) + 4 * (e & 7) + (e >> 3)] = rctab[il[pos]]; }
    asm volatile("s_waitcnt lgkmcnt(0)" ::: "memory");
    f32x4 oacc[8];
#pragma unroll
    for (int d = 0; d < 8; ++d) oacc[d] = (f32x4){0.f, 0.f, 0.f, 0.f};
    float lsum = 0.f;
    const int nch = count >> 5;
    DSA_GATHER(0, 0);
#pragma unroll 1
    for (int ci = 0; ci < nch; ++ci) {
        const int cur = ci & 1;
        if (ci + 1 < nch) { DSA_GATHER(ci + 1, cur ^ 1); if (DSA_REP & 8) { DSA_GATHER(ci + 1, cur ^ 1); asm volatile("s_waitcnt vmcnt(16)" ::: "memory"); } else asm volatile("s_waitcnt vmcnt(8)" ::: "memory"); } else { asm volatile("s_waitcnt vmcnt(0)" ::: "memory"); }
        const LAS unsigned char* ct = wl + cur * 8192;
        f32x4 lt[2];
        bf16x8 ca[2][4];
#pragma unroll
        for (int T = 0; T < 2; ++T) { const int row = 16 * T + li; const LAS unsigned char* rp = ct + row * 256; const int sw = (row & 7) << 1;
#pragma unroll
            for (int s = 0; s < 4; ++s) ca[T][s] = *(const LAS bf16x8*)(rp + (((4 * s + g) ^ sw) * 16)); }
        f32x4 rcv[2];
#pragma unroll
        for (int T = 0; T < 2; ++T) rcv[T] = *(const LAS f32x4*)(rcl + 32 * ci + 16 * T + 4 * g);
        __builtin_amdgcn_sched_barrier(0);
#pragma unroll
        for (int T = 0; T < 2; ++T) { lt[T] = (f32x4){0.f, 0.f, 0.f, 0.f};
#pragma unroll
            for (int s = 0; s < 4; ++s) lt[T] = __builtin_amdgcn_mfma_f32_16x16x32_bf16(ca[T][s], qf[s], lt[T], 0, 0, 0); }
        bf16x8 cv[8];
#pragma unroll
        for (int dt = 0; dt < 8; ++dt) {
            const int r0 = 4 * g + (li >> 2), r1 = r0 + 16; const int cch = 2 * dt + ((li >> 1) & 1), hb = (li & 1) * 8;
            const s16x4 lo = __builtin_bit_cast(s16x4, __builtin_amdgcn_ds_read_tr16_b64_v4i16((lds_s16x4*)(ct + r0 * 256 + ((cch ^ ((r0 & 7) << 1)) * 16) + hb)));
            const s16x4 hi = __builtin_bit_cast(s16x4, __builtin_amdgcn_ds_read_tr16_b64_v4i16((lds_s16x4*)(ct + r1 * 256 + ((cch ^ ((r1 & 7) << 1)) * 16) + hb)));
            cv[dt] = cat4(lo, hi); }
        __builtin_amdgcn_sched_barrier(0);
        bf16x8 pf;
#pragma unroll
        for (int T = 0; T < 2; ++T) { float pv[4];
#pragma unroll
            for (int r = 0; r < 4; ++r) { pv[r] = __builtin_amdgcn_exp2f(lt[T][r] * rq * rcv[T][r] - bound_l2); lsum += pv[r]; }
            const unsigned w0 = pk2(pv[0], pv[1]), w1 = pk2(pv[2], pv[3]);
            pf[4 * T + 0] = (short)(w0 & 0xffff); pf[4 * T + 1] = (short)(w0 >> 16); pf[4 * T + 2] = (short)(w1 & 0xffff); pf[4 * T + 3] = (short)(w1 >> 16); }
#pragma unroll
        for (int dt = 0; dt < 8; ++dt) oacc[dt] = __builtin_amdgcn_mfma_f32_16x16x32_bf16(cv[dt], pf, oacc[dt], 0, 0, 0);
    }
#undef DSA_GATHER
    lsum += __shfl_xor(lsum, 16); lsum += __shfl_xor(lsum, 32);
    const float inv = 1.0f / lsum;
    if (li < 8) {
#pragma unroll
        for (int dt = 0; dt < 8; ++dt) { u32x2 o; o.x = pk2(oacc[dt][0] * inv, oacc[dt][1] * inv); o.y = pk2(oacc[dt][2] * inv, oacc[dt][3] * inv);
            *(u32x2*)(AO + trow * 1024 + li * 128 + 16 * dt + 4 * g) = o; }
    }
}

__device__ __forceinline__ void dsa_fast_phase(LAS unsigned char* lds, const bf16_t* QH, const bf16_t* Cb, const float* PS, const bf16_t* QI, const bf16_t* KI, const float* WI, const float* CSC, bf16_t* AO, int vcu, int G) {
    int tid_ = threadIdx.x; asm volatile("" : "+v"(tid_));
    const int tid = tid_, lane0 = tid & 63, w = __builtin_amdgcn_readfirstlane(tid >> 6);
    LAS unsigned char* wl = lds + DSA_SC + w * 16384; LAS float* rctab = (LAS float*)(lds + DSA_KST);
    LAS unsigned short* il0 = (LAS unsigned short*)(lds + DSA_IDX + (2 * w) * 512); LAS unsigned short* il1 = il0 + 256;
    float mxs = 0.f;
    for (int i = lane0; i < 128; i += 64) mxs = fmaxf(mxs, fabsf(CSC[i]));
#pragma unroll
    for (int o = 1; o < 64; o <<= 1) mxs = fmaxf(mxs, __shfl_xor(mxs, o));
    const float bound_l2 = mxs * 128.0f * 1.4426950408889634f;
    for (int wg = vcu; wg < 256; wg += G) {
        const int b = wg >> 5, r = wg & 31;
        __syncthreads();
        for (int k = tid; k < SEQ; k += NWAVES * 64) { const float* pp = PS + (size_t)32 * M + (size_t)b * SEQ + k;
            rctab[k] = rsqrtf(((pp[0] + pp[(size_t)M]) + (pp[(size_t)2 * M] + pp[(size_t)3 * M])) * (1.0f / 128.0f) + EPS); }
#pragma unroll 1
        for (int it = 0; it < 4; ++it) {
            int lane = lane0; asm volatile("" : "+v"(lane));
            const int li = lane & 15, g = lane >> 4;
            const int chunk = (it & 1) ? 31 - (r & 15) : (r & 15), sub = 2 * (r >> 4) + (it >> 1);
            const int t0 = chunk * 64 + sub * 16, limit = (chunk + 1) * 64;
            const size_t trow0 = (size_t)b * SEQ + t0 + 2 * w;
            const DsaQ Q0 = dsa_load_q(QH, PS, trow0, lane), Q1 = dsa_load_q(QH, PS, trow0 + 1, lane);
            LAS float* wqt = (LAS float*)(lds + DSA_WQ);
            if (limit > TOPK && tid < 128) { const int qq = tid >> 3, hh = tid & 7; const size_t row = (size_t)b * SEQ + t0 + qq;
                const float* ps = PS + (size_t)(40 + (hh >> 2) * 8 + ((hh >> 1) & 1) * 4 + 2 * (hh & 1)) * M + row;
                wqt[tid] = WI[row * 8 + hh] * rsqrtf((ps[0] + ps[(size_t)M]) * (1.0f / 64.0f) + EPS); }
            __syncthreads();
            if (limit > TOPK) {
                for (int srep = 0; srep < 1 + (DSA_REP & 1); ++srep) {
                bf16x8 af[8][2]; float wq[8][4];
                const size_t trowi = (size_t)b * SEQ + t0;
#pragma unroll
                for (int p = 0; p < 8; ++p) {
#pragma unroll
                    for (int sidx = 0; sidx < 2; ++sidx) af[p][sidx] = *(const bf16x8*)(QI + (trowi + 2 * p + (li >> 3)) * 512 + (li & 7) * 64 + 32 * sidx + 8 * g);
                    const f32x4 wv = *(const LAS f32x4*)(wqt + (2 * p + (g >> 1)) * 8 + 4 * (g & 1));
                    wq[p][0] = wv[0]; wq[p][1] = wv[1]; wq[p][2] = wv[2]; wq[p][3] = wv[3];
                    asm volatile("" ::: "memory"); }
                const int nst = limit >> 4;
                const bf16_t* kp = KI + ((size_t)b * SEQ + 16 * w + li) * 64 + 8 * g; const float* pp = PS + (size_t)36 * M + (size_t)b * SEQ + 16 * w + li;
                bf16x8 b0 = *(const bf16x8*)kp, b1 = *(const bf16x8*)(kp + 32); f32x2_t pk = (f32x2_t){pp[0], pp[(size_t)M]};
                bf16x8 d0 = b0, d1 = b1; f32x2_t pk2v = pk;
                if (w + 8 < nst) { kp += 8 * 16 * 64; pp += 8 * 16; d0 = *(const bf16x8*)kp; d1 = *(const bf16x8*)(kp + 32); pk2v = (f32x2_t){pp[0], pp[(size_t)M]}; }
#pragma unroll 1
                for (int st = w; st < nst; st += 8) {
                    const bf16x8 c0 = b0, c1 = b1; const float rk = rsqrtf((pk[0] + pk[1]) * (1.0f / 64.0f) + EPS);
                    b0 = d0; b1 = d1; pk = pk2v;
                    if (st + 16 < nst) { kp += 8 * 16 * 64; pp += 8 * 16; d0 = *(const bf16x8*)kp; d1 = *(const bf16x8*)(kp + 32); pk2v = (f32x2_t){pp[0], pp[(size_t)M]}; }
                    LAS float* so = (LAS float*)(lds + DSA_SC) + (g >> 1) * 2048 + 16 * st + li;
#pragma unroll
                    for (int p = 0; p < 8; ++p) {
                        f32x4 acc = (f32x4){0.f, 0.f, 0.f, 0.f};
                        acc = __builtin_amdgcn_mfma_f32_16x16x32_bf16(af[p][0], c0, acc, 0, 0, 0); acc = __builtin_amdgcn_mfma_f32_16x16x32_bf16(af[p][1], c1, acc, 0, 0, 0);
                        float part = (fmaxf(acc[0], 0.f) * wq[p][0] + fmaxf(acc[1], 0.f) * wq[p][1]) + (fmaxf(acc[2], 0.f) * wq[p][2] + fmaxf(acc[3], 0.f) * wq[p][3]);
                        {   const auto sw = __builtin_amdgcn_permlane16_swap(__float_as_uint(part), __float_as_uint(part), false, false);
                            part = __uint_as_float(sw[0]) + __uint_as_float(sw[1]); }
                        if ((g & 1) == 0) so[p * 4096] = part * rk + 0.0f;
                    }
                }
                __syncthreads();
                }
                for (int trep = 0; trep < 1 + ((DSA_REP >> 1) & 1); ++trep) {
                dsa_topk((const LAS float*)wl, il0, limit, lane);
                dsa_topk((const LAS float*)wl + 2048, il1, limit, lane); }
            } else {
                for (int j = lane; j < limit; j += 64) { il0[j] = (unsigned short)j; il1[j] = (unsigned short)j; }
            }
            const int count = limit < TOPK ? limit : TOPK;
            for (int arep = 0; arep < 1 + ((DSA_REP >> 2) & 1); ++arep) {
            dsa_attend(wl, il0, rctab, (LAS float*)(lds + DSA_KST + 8192 + w * 1024), Q0, Cb, AO, trow0, b, count, bound_l2, lane);
            dsa_attend(wl, il1, rctab, (LAS float*)(lds + DSA_KST + 8192 + w * 1024), Q1, Cb, AO, trow0 + 1, b, count, bound_l2, lane); }
        }
    }
    __syncthreads();
}

typedef const __attribute__((address_space(4))) Args* ArgsP;
__device__ __forceinline__ ArgsP fresh_args() { ArgsP p = (ArgsP)__builtin_amdgcn_kernarg_segment_ptr(); asm volatile("" : "+s"(p)); return p; }

__device__ __forceinline__ int fresh_bx() { int v = blockIdx.x; asm volatile("" : "+s"(v)); return v; }
__device__ __forceinline__ int fresh_gx() { int v = gridDim.x; asm volatile("" : "+s"(v)); return v; }
__global__ void __launch_bounds__(NWAVES * 64, 2) mega(Args args_unused) {
    extern __shared__ __attribute__((aligned(16))) unsigned char lds_raw[];
    LAS unsigned char* lds = (LAS unsigned char*)lds_raw;
    const int tid = threadIdx.x;
    for (int u = tid; u < (LDS_BYTES - LDSCTL_OFF) / 4; u += NWAVES * 64) ((LAS unsigned*)(lds + LDSCTL_OFF))[u] = 0u;
    __syncthreads();
    int lo, hi;
    {   ArgsP A = fresh_args(); lo = A->ph_lo; hi = A->ph_hi;
        if (hi - lo > 1) (void)xcd_barrier_post((unsigned*)(A->ws + WS_CTL) + CW_BAR + A->li * XCD_BAR_WORDS, (volatile LAS unsigned*)(lds + MISC_OFF) + 8); }
#ifndef PHMASK
#define PHMASK 0xffff
#endif
#define IN(k) (((PHMASK >> (k)) & 1) && lo <= (k) && (k) < hi)
#define SEAM(k) do { if (lo <= (k) && (k) + 1 < hi) { ArgsP A_ = fresh_args(); XcdBarrier b_; b_.bar = (unsigned*)(A_->ws + WS_CTL) + CW_BAR + A_->li * XCD_BAR_WORDS; b_.x = xb_xcc_id(); \
        b_.st = (volatile LAS unsigned*)(lds + MISC_OFF) + 8; xcd_barrier(b_); } } while (0)
#ifndef REPMASK
#define REPMASK 0
#endif
#define GBAR() do { ArgsP A_ = fresh_args(); XcdBarrier b_; b_.bar = (unsigned*)(A_->ws + WS_CTL) + CW_BAR + A_->li * XCD_BAR_WORDS; b_.x = xb_xcc_id(); \
        b_.st = (volatile LAS unsigned*)(lds + MISC_OFF) + 8; xcd_barrier(b_); } while (0)
#define REPEAT(k) for (int rep_ = 0; rep_ < 1 + ((REPMASK >> (k)) & 1); ++rep_)
#define REPBAR() do { if (rep_) GBAR(); } while (0)
#define GWS int t_ = threadIdx.x; asm volatile("" : "+v"(t_)); const int lane = t_ & 63, wave = __builtin_amdgcn_readfirstlane(t_ >> 6); const int G = fresh_gx(), bx = fresh_bx(); const int vcu = (G % 8 == 0) ? (bx % 8) * (G / 8) + bx / 8 : bx; \
        const int gw = vcu * NWAVES + wave, NGW = G * NWAVES; LAS float* scr = (LAS float*)(lds + wave * 16640); (void)lane; (void)gw; (void)NGW; (void)scr;
#define WCONV(Wp, K_, Nsrc_, N_, mode_, gain_, WT_) do { const int items_ = ((K_) / 64) * ((N_) / 64); \
        for (int it = gw; it < items_; it += NGW) p0_transpose_item((Wp), (K_), (Nsrc_), (N_), (mode_), (gain_), (WT_), scr, it, lane); } while (0)

    if (IN(PH_PRO)) REPEAT(PH_PRO) { REPBAR();
        GWS; ArgsP A = fresh_args(); unsigned char* ws = A->ws;
        constexpr int I0 = 16 * 28, I1 = I0 + 16 * 16, I2 = I1 + 16 * 96, I3 = I2 + 32 * 16, I4 = I3 + 16 * 88, I5 = I4 + 44 * 16, IX = I5 + M / 4;
        {   const float* x = A->in[0]; float* SS = (float*)(ws + WS_SS); bf16_t* XB = (bf16_t*)(ws + WS_XB);
#pragma unroll 1
            for (int it = gw; it < IX; it += NGW) {
                if (it < I0) p0_transpose_item(A->in[3], 1024, A_IN_COLS, A_IN_PAD, WM_AIN, A->in[1], (bf16_t*)(ws + WS_WAIN), scr, it, lane);
                else if (it < I1) p0_transpose_item(A->in[8], 1024, 1024, 1024, WM_NAT, (const float*)nullptr, (bf16_t*)(ws + WS_WAOUT), scr, it - I0, lane);
                else if (it < I2) p0_transpose_item(A->in[9], 1024, B_IN_COLS, B_IN_COLS, WM_NAT, A->in[1] + 1024, (bf16_t*)(ws + WS_WBIN), scr, it - I1, lane);
                else if (it < I3) p0_transpose_item(A->in[11], 2048, 1024, 1024, WM_NAT, A->in[10], (bf16_t*)(ws + WS_WBOUT), scr, it - I2, lane);
                else if (it < I4) p0_transpose_item(A->in[12], 1024, FF2, FF2, WM_FUP, A->in[2], (bf16_t*)(ws + WS_WFUP0), scr, it - I3, lane);
                else if (it < I5) p0_transpose_item(A->in[15], 2816, 1024, 1024, WM_NAT, (const float*)nullptr, (bf16_t*)(ws + WS_WFDN0), scr, it - I4, lane);
                else { const int row0 = (it - I5) * 4;
                    f32x4 v[4][4];
#pragma unroll
                    for (int r = 0; r < 4; ++r)
#pragma unroll
                        for (int q = 0; q < 4; ++q) v[r][q] = ((const f32x4*)(x + (size_t)(row0 + r) * DM))[q * 64 + lane];
#pragma unroll
                    for (int r = 0; r < 4; ++r)
#pragma unroll
                        for (int q = 0; q < 4; ++q) { const f32x4 w = v[r][q]; float sq = (w[0] * w[0] + w[1] * w[1]) + (w[2] * w[2] + w[3] * w[3]); sq = wave_sum(sq);
                            if (lane < 4) SS[(size_t)(q * 4 + lane) * M + row0 + r] = lane == 0 ? sq : 0.f;
                            u32x2 o; o.x = pk2(w[0], w[1]); o.y = pk2(w[2], w[3]); *(u32x2*)(XB + (size_t)(row0 + r) * DM + q * 256 + lane * 4) = o; } } } }
        {   float2* ROPE = (float2*)(ws + WS_ROPE);
            for (int e = gw * 64 + lane; e < 2048 * 128; e += NGW * 64) { const int t = e >> 7, i = e & 127;
                const float inv = exp2f(-(float)(2 * i) * (13.287712379549449f / 256.0f)), ang = (float)t * inv; float sn, cs; sincosf(ang, &sn, &cs); ROPE[e] = make_float2(cs, sn); } }
        {   float* CSC = (float*)(ws + WS_CSC); const float* a_q_g = A->in[4]; const float* a_k_g = A->in[5]; const float* a_iq_g = A->in[6]; const float* a_ik_g = A->in[7];
            for (int n = gw * 64 + lane; n < A_IN_PAD; n += NGW * 64) { float v;
                if (n < 1024) v = a_q_g[n & 127] * a_k_g[n & 127] * 0.08838834764831845f; else if (n < 1152) v = 1.0f; else if (n < 1216) v = a_ik_g[n - 1152];
                else if (n < 1224) v = 0.044194173824159216f; else if (n < 1280) v = 0.f; else v = a_iq_g[(n - 1280) & 63];
                CSC[n] = v; } }
    }
    SEAM(PH_PRO);
    if (IN(PH_A1)) REPEAT(PH_A1) { REPBAR();
        ArgsP A = fresh_args(); unsigned char* ws = A->ws;
        pg8::Gemm g{(const bf16_t*)(ws + WS_XB), (const bf16_t*)(ws + WS_WAIN), M, A_IN_PAD, 1024}; pg8::StaticOrder S; S.init(M, A_IN_PAD, fresh_gx(), fresh_bx());
        pg8::EpiA1 E{(const float*)(ws + WS_SS), (const float*)(ws + WS_CSC), (bf16_t*)(ws + WS_QH), (bf16_t*)(ws + WS_C), (bf16_t*)(ws + WS_KI), (bf16_t*)(ws + WS_QI), (float*)(ws + WS_WI), (float*)(ws + WS_PS)};
        pg8::gemm_phase(lds, g, S, E);
    }
    SEAM(PH_A1);
    if (IN(PH_A2)) REPEAT(PH_A2) { REPBAR();
        ArgsP A = fresh_args(); unsigned char* ws = A->ws; const int G = fresh_gx(), bx = fresh_bx(); const int vcu = (G % 8 == 0) ? (bx % 8) * (G / 8) + bx / 8 : bx;
        dsa_fast_phase(lds, (const bf16_t*)(ws + WS_QH), (const bf16_t*)(ws + WS_C), (const float*)(ws + WS_PS), (const bf16_t*)(ws + WS_QI), (const bf16_t*)(ws + WS_KI), (const float*)(ws + WS_WI), (const float*)(ws + WS_CSC), (bf16_t*)(ws + WS_AO), vcu, G);
    }
    SEAM(PH_A2);
    if (IN(PH_A3)) REPEAT(PH_A3) { REPBAR();
        ArgsP A = fresh_args(); unsigned char* ws = A->ws;
        pg8::Gemm g{(const bf16_t*)(ws + WS_AO), (const bf16_t*)(ws + WS_WAOUT), M, 1024, 1024}; pg8::StaticOrder S; S.init(M, 1024, fresh_gx(), fresh_bx());
        pg8::EpiRes<1> E{nullptr, nullptr, (bf16_t*)(ws + WS_XB), (float*)(ws + WS_SS)};
        pg8::gemm_phase(lds, g, S, E);
    }
    SEAM(PH_A3);
#define FFN_PHASES(LAYER, PH1, PH2) do { \
        if (IN(PH1)) REPEAT(PH1) { REPBAR(); \
            ArgsP A = fresh_args(); unsigned char* ws = A->ws; \
            pg8::Gemm g{(const bf16_t*)(ws + WS_XB), (const bf16_t*)(ws + ((LAYER) ? WS_WFUP1 : WS_WFUP0)), M, FF2, 1024}; pg8::StaticOrder S; S.init(M, FF2, fresh_gx(), fresh_bx()); \
            pg8::EpiF1 E{(const float*)(ws + WS_SS), A->in[13] + (size_t)(LAYER) * 3 * FF2, A->in[14] + (size_t)(LAYER) * FF2, (bf16_t*)(ws + ((LAYER) ? WS_H1 : WS_H0)), \
                         (float*)(ws + ((LAYER) ? WS_PART1 : WS_PART0)), (float*)(ws + ((LAYER) ? WS_HALO1 : WS_HALO0))}; \
            pg8::gemm_phase(lds, g, S, E); \
        } \
        SEAM(PH1); \
        if (IN(PH2)) { \
            ArgsP A = fresh_args(); unsigned char* ws = A->ws; bf16_t* Hb = (bf16_t*)(ws + ((LAYER) ? WS_H1 : WS_H0)); \
            pg8::Gemm g{Hb, (const bf16_t*)(ws + ((LAYER) ? WS_WFDN1 : WS_WFDN0)), M, 1024, D_FF}; pg8::StaticOrder S; S.init(M, 1024, fresh_gx(), fresh_bx()); \
            {   pg8::Unit u0; if (S.next(0, u0)) ffn_fixup(u0.pm, A->in[13] + (size_t)(LAYER) * 3 * FF2, (const float*)(ws + ((LAYER) ? WS_PART1 : WS_PART0)), (const float*)(ws + ((LAYER) ? WS_HALO1 : WS_HALO0)), Hb); \
                VM_WAIT(); __syncthreads(); } \
            if ((LAYER) == 0) { pg8::EpiRes<1> E{nullptr, nullptr, (bf16_t*)(ws + WS_XB), (float*)(ws + WS_SS)}; pg8::gemm_phase(lds, g, S, E); } \
            else { pg8::EpiRes<2> E{nullptr, A->out, (bf16_t*)(ws + WS_XB), nullptr}; pg8::gemm_phase(lds, g, S, E); } \
        } \
        SEAM(PH2); } while (0)
    FFN_PHASES(0, PH_F1A, PH_F2A);
    if (IN(PH_B1)) REPEAT(PH_B1) { REPBAR();
        ArgsP A = fresh_args(); unsigned char* ws = A->ws;
        pg8::Gemm g{(const bf16_t*)(ws + WS_XB), (const bf16_t*)(ws + WS_WBIN), M, 4096, 1024}; pg8::StaticOrder S; S.init(M, 4096, fresh_gx(), fresh_bx());
        pg8::EpiB1 E{(const float*)(ws + WS_SS), (const float2*)(ws + WS_ROPE), (bf16_t*)(ws + WS_QT), (bf16_t*)(ws + WS_KT), (bf16_t*)(ws + WS_VT)};
        pg8::gemm_phase(lds, g, S, E);
    }
    SEAM(PH_B1);
    if (IN(PH_B2)) REPEAT(PH_B2) { REPBAR();
        ArgsP A = fresh_args(); unsigned char* ws = A->ws;
        { const int G = fresh_gx(), bx = fresh_bx(); const int vcu = (G % 8 == 0) ? (bx % 8) * (G / 8) + bx / 8 : bx;
          for (int u = vcu; u < 256; u += G) ret_fast_phase(lds, (const bf16_t*)(ws + WS_QT), (const bf16_t*)(ws + WS_KT), (const bf16_t*)(ws + WS_VT), (bf16_t*)(ws + WS_RET), (float*)(ws + WS_SSR), u); }
    }
    SEAM(PH_B2);
    if (IN(PH_GATE)) REPEAT(PH_GATE) { REPBAR();
        {   ArgsP A = fresh_args(); unsigned char* ws = A->ws;
            pg8::Gemm g{(const bf16_t*)(ws + WS_XB), (const bf16_t*)(ws + WS_WBIN) + (size_t)4096 * 1024, M, 2048, 1024}; pg8::StaticOrder S; S.init(M, 2048, fresh_gx(), fresh_bx());
            pg8::EpiGate E{(const float*)(ws + WS_SS), (const float*)(ws + WS_SSR), (bf16_t*)(ws + WS_RET)};
            pg8::gemm_phase(lds, g, S, E); }
#if !defined(NO_WCONV2)
        {   GWS; ArgsP A = fresh_args(); unsigned char* ws = A->ws; constexpr int J0 = 16 * 88, J1 = J0 + 44 * 16;
#pragma unroll 1
            for (int it = gw; it < J1; it += NGW) {
                if (it < J0) p0_transpose_item(A->in[12] + (size_t)1024 * FF2, 1024, FF2, FF2, WM_FUP, A->in[2] + 1024, (bf16_t*)(ws + WS_WFUP1), scr, it, lane);
                else p0_transpose_item(A->in[15] + (size_t)2816 * 1024, 2816, 1024, 1024, WM_NAT, (const float*)nullptr, (bf16_t*)(ws + WS_WFDN1), scr, it - J0, lane); } }
#endif
    }
    SEAM(PH_GATE);
    if (IN(PH_B3)) REPEAT(PH_B3) { REPBAR();
        ArgsP A = fresh_args(); unsigned char* ws = A->ws;
        pg8::Gemm g{(const bf16_t*)(ws + WS_RET), (const bf16_t*)(ws + WS_WBOUT), M, 1024, 2048}; pg8::StaticOrder S; S.init(M, 1024, fresh_gx(), fresh_bx());
        pg8::EpiRes<1> E{nullptr, nullptr, (bf16_t*)(ws + WS_XB), (float*)(ws + WS_SS)};
        pg8::gemm_phase(lds, g, S, E);
    }
    SEAM(PH_B3);
    FFN_PHASES(1, PH_F1B, PH_F2B);
#undef FFN_PHASES
#undef IN
#undef SEAM
}

extern "C" void kernel_launch(void* const* d_in, const int* in_sizes, int n_in, void* d_out, int out_size, void* d_ws, size_t ws_size, hipStream_t stream) {
    static int grid = 0;
    if (grid == 0) {
        int dev = 0, cus = 0, per_cu = 0;
        (void)hipGetDevice(&dev); (void)hipDeviceGetAttribute(&cus, hipDeviceAttributeMultiprocessorCount, dev);
        (void)hipFuncSetAttribute((const void*)mega, hipFuncAttributeMaxDynamicSharedMemorySize, LDS_BYTES);
        if (hipOccupancyMaxActiveBlocksPerMultiprocessor(&per_cu, (const void*)mega, NWAVES * 64, LDS_BYTES) != hipSuccess || per_cu < 1)
            fprintf(stderr, "kernel_launch: occupancy query reports %d workgroups per CU\n", per_cu);
        (void)hipGetLastError();
        grid = cus > 0 ? cus : 256;
        if (grid != 256) fprintf(stderr, "kernel_launch: %d CUs (built for 256)\n", grid);
    }
    unsigned char* ws = (unsigned char*)d_ws;
    (void)hipMemsetAsync(ws + WS_CTL, 0, CTL_ZERO_BYTES, stream);
    Args a{};
    for (int i = 0; i < 16; ++i) a.in[i] = (const float*)d_in[i];
    a.out = (float*)d_out; a.ws = ws;
    auto launch = [&](int lo, int hi, int li) { a.ph_lo = lo; a.ph_hi = hi; a.li = li; hipLaunchKernelGGL(mega, dim3(grid), dim3(NWAVES * 64), LDS_BYTES, stream, a); };
    launch(0, PH_END, 0);
}
```

```cpp
#include <hip/hip_runtime.h>
#include <stdint.h>
#include <stdio.h>

typedef unsigned short bf16_t;
typedef short bf16x8 __attribute__((ext_vector_type(8)));
typedef float f32x4 __attribute__((ext_vector_type(4)));
typedef unsigned u32x4 __attribute__((ext_vector_type(4)));
typedef unsigned u32x2 __attribute__((ext_vector_type(2)));

#ifndef MK_LAUNCH_MODE
#define MK_LAUNCH_MODE 1
#endif

constexpr int BATCH = 8, SEQ = 2048, DM = 1024, M = BATCH * SEQ;
constexpr int TOPK = 256;
constexpr int A_IN_COLS = 1736, A_IN_PAD = 1792;
constexpr int O2 = 1152, O3 = 1664, O4 = 1728;
constexpr int B_IN_COLS = 6144;
constexpr int D_FF = 2816, FF2 = 5632;
constexpr float EPS = 1e-6f;

constexpr size_t MiB = 1u << 20;
constexpr size_t WS_CTL = 0, CTL_ZERO_BYTES = 65536;
constexpr size_t WS_SS = 1 * MiB;
constexpr size_t WS_WI = 2 * MiB;
constexpr size_t WS_CSC = 2 * MiB + 512 * 1024;
constexpr size_t WS_ROPE = 3 * MiB;
constexpr size_t WS_SSR = 249 * MiB;
constexpr size_t WS_WBIN = 8 * MiB;
constexpr size_t WS_WBOUT = 20 * MiB;
constexpr size_t WS_XB = 24 * MiB;
constexpr size_t WS_WAIN = 56 * MiB;
constexpr size_t WS_WAOUT = 60 * MiB;
constexpr size_t WS_QH = 64 * MiB;
constexpr size_t WS_AO = 96 * MiB;
constexpr size_t WS_QI = 128 * MiB;
constexpr size_t WS_C = 144 * MiB;
constexpr size_t WS_KI = 148 * MiB;
constexpr size_t WS_PS = 150 * MiB;
constexpr size_t WS_WFUP0 = 232 * MiB;
constexpr size_t WS_WFDN0 = 243 * MiB;
constexpr size_t WS_H0 = 64 * MiB;
constexpr size_t WS_PART0 = 152 * MiB;
constexpr size_t WS_HALO0 = 155 * MiB;
constexpr size_t WS_QT = 56 * MiB;
constexpr size_t WS_KT = 88 * MiB;
constexpr size_t WS_VT = 120 * MiB;
constexpr size_t WS_RET = 184 * MiB;
constexpr size_t WS_WFUP1 = 56 * MiB;
constexpr size_t WS_WFDN1 = 67 * MiB;
constexpr size_t WS_H1 = 88 * MiB;
constexpr size_t WS_PART1 = 176 * MiB;
constexpr size_t WS_HALO1 = 179 * MiB;

__device__ __forceinline__ unsigned short f2bf(float f) { unsigned u = __float_as_uint(f); return (unsigned short)((u + 0x7fffu + ((u >> 16) & 1u)) >> 16); }
__device__ __forceinline__ float bf2f(unsigned short h) { return __uint_as_float(((unsigned)h) << 16); }
__device__ __forceinline__ float bflo(unsigned w) { return __uint_as_float(w << 16); }
__device__ __forceinline__ float bfhi(unsigned w) { return __uint_as_float(w & 0xffff0000u); }
typedef __bf16 bf16x2_t __attribute__((ext_vector_type(2)));
typedef float f32x2_t __attribute__((ext_vector_type(2)));
__device__ __forceinline__ unsigned pk2(float lo, float hi) { const f32x2_t v = {lo, hi}; return __builtin_bit_cast(unsigned, __builtin_convertvector(v, bf16x2_t)); }
__device__ __forceinline__ float wave_sum(float v) {
#pragma unroll
    for (int o = 1; o < 64; o <<= 1) v += __shfl_xor(v, o);
    return v;
}
__device__ __forceinline__ float siluf(float x) { return x * __builtin_amdgcn_rcpf(1.0f + __builtin_amdgcn_exp2f(-1.4426950408889634f * x)); }
__device__ __forceinline__ float gamma_log(int h) { return h == 0 ? -0.031748698314580301f : h == 1 ? -0.015748356968139168f : h == 2 ? -0.0078431774610258787f : -0.0039138993211363287f; }

enum { WM_NAT = 0, WM_AIN = 1, WM_FUP = 2 };
__device__ __forceinline__ int wmap(int mode, int n) {
    if (mode == WM_NAT) return n;
    if (mode == WM_AIN) {
        if (n < 1152) return n;
        if (n < 1216) return O3 + (n - 1152);
        if (n < 1224) return O4 + (n - 1216);
        if (n < 1280) return -1;
        return O2 + (n - 1280);
    }
    const int p = n >> 8, bj = (n >> 7) & 1, i = n & 127;
    return bj * D_FF + 128 * p + i;
}

namespace pg8 {
#define PG8_LAS __attribute__((address_space(3)))
constexpr int BM = 256, BK = 64, HALF = 128, HTB = HALF * BK * 2, STAGE_BYTES = 8 * HTB, NXCD = 8, WGM = 8;
constexpr int XCH_OFF = 0, CWT_OFF = 2048, RT1_OFF = 6144, RT2_OFF = 14336;
__host__ __device__ __forceinline__ int lds_byte(int r, int c) { const int st = (r >> 4) * 2 + (c >> 5), rr = r & 15, cc = c & 31, ob = rr * 64 + cc * 2; return st * 1024 + (ob ^ (((ob >> 9) & 1) << 5)); }
__host__ __device__ __forceinline__ void stage_rc(int b, int& R, int& C) { const int st = b / 1024, sb = b % 1024, swz = sb ^ (((sb >> 9) & 1) << 5); R = (st >> 1) * 16 + swz / 64; C = (st & 1) * 32 + (swz % 64) / 2; }
__host__ __device__ __forceinline__ int perm32(int rho) { const int n = rho >> 4, i = rho & 15; return 8 * (i >> 2) + 4 * n + (i & 3); }
struct Unit { int pm, pn; };
struct Gemm { const bf16_t* A; const bf16_t* Bt; int M, N, K; };
struct StaticOrder {
    int nM, nN, nwg, G, c;
    __host__ __device__ __forceinline__ void init(int M_, int N_, int G_, int c_) { nM = M_ / BM; nN = N_ / BM; nwg = nM * nN; G = G_; c = c_; }
    __host__ __device__ __forceinline__ bool next(int i, Unit& u) const {
        const long L = (long)i * G + c; if (L >= nwg) return false;
        int wgid = (int)L; { const int q = nwg / NXCD, r = nwg % NXCD, xcd = wgid % NXCD, off = wgid / NXCD; wgid = (xcd < r ? xcd * (q + 1) : r * (q + 1) + (xcd - r) * q) + off; }
        const int nig = WGM * nN, gid = wgid / nig, fm = gid * WGM, gsz = (nM - fm) < WGM ? (nM - fm) : WGM;
        u.pm = fm + ((wgid % nig) % gsz); u.pn = (wgid % nig) / gsz; return true;
    }
};
__device__ __forceinline__ float rstd16(const float* ss16, int row) {
    float s = 0.f;
#pragma unroll
    for (int g = 0; g < 16; ++g) s += ss16[(size_t)g * M + row];
    return rsqrtf(s * (1.0f / DM) + EPS);
}
__device__ __forceinline__ float sel4(const float (&s)[4], int fq) { return fq == 0 ? s[0] : fq == 1 ? s[1] : fq == 2 ? s[2] : s[3]; }
__device__ __forceinline__ float ssq8(const f32x4 a, const f32x4 b) { return ((a[0] * a[0] + a[1] * a[1]) + (a[2] * a[2] + a[3] * a[3])) + ((b[0] * b[0] + b[1] * b[1]) + (b[2] * b[2] + b[3] * b[3])); }
__device__ __forceinline__ u32x4 pack8(const f32x4 a, const f32x4 b) { u32x4 w; w.x = pk2(a[0], a[1]); w.y = pk2(a[2], a[3]); w.z = pk2(b[0], b[1]); w.w = pk2(b[2], b[3]); return w; }

template <int MODE>
struct EpiRes {
    static constexpr bool PERM = true;
    static constexpr bool AROWPERM = false;
    const float* basef; float* out; bf16_t* xb; float* ss16;
    static constexpr int NTAB = 0;
    __device__ __forceinline__ void fill(PG8_LAS unsigned char*, int, const Unit&, int) const {}
    __device__ __forceinline__ void operator()(f32x4 (&acc)[2][2][4][2], const Unit& u, int ui, int wr, int wc, int fr, int fq, PG8_LAS unsigned char*) const {
        const int row0 = u.pm * BM + wr * 64 + fr, colb = u.pn * BM + wc * 32 + 8 * fq;
#pragma unroll
        for (int ai = 0; ai < 2; ++ai) {
            f32x4 bv[4][2][2];
#pragma unroll
            for (int m = 0; m < 4; ++m)
#pragma unroll
                for (int bj = 0; bj < 2; ++bj) { const size_t o = (size_t)(row0 + ai * HALF + m * 16) * DM + colb + bj * HALF;
                    if (MODE == 0) { bv[m][bj][0] = *(const f32x4*)(basef + o); bv[m][bj][1] = *(const f32x4*)(basef + o + 4); }
                    else { const u32x4 w = *(const u32x4*)(xb + o); bv[m][bj][0] = (f32x4){bflo(w.x), bfhi(w.x), bflo(w.y), bfhi(w.y)}; bv[m][bj][1] = (f32x4){bflo(w.z), bfhi(w.z), bflo(w.w), bfhi(w.w)}; } }
            float sm[4];
#pragma unroll
            for (int m = 0; m < 4; ++m) { const int row = row0 + ai * HALF + m * 16; float s = 0.f;
#pragma unroll
                for (int bj = 0; bj < 2; ++bj) { const size_t o = (size_t)row * DM + colb + bj * HALF;
                    const f32x4 v0 = acc[ai][bj][m][0] + bv[m][bj][0], v1 = acc[ai][bj][m][1] + bv[m][bj][1];
                    if (MODE == 2) { *(f32x4*)(out + o) = v0; *(f32x4*)(out + o + 4) = v1; }
                    else { s += ssq8(v0, v1); *(u32x4*)(xb + o) = pack8(v0, v1); } }
                if (MODE != 2) { s += __shfl_xor(s, 16); s += __shfl_xor(s, 32); }
                sm[m] = s; }
            if (MODE != 2) ss16[(size_t)(u.pn * 4 + wc) * M + u.pm * BM + ai * HALF + wr * 64 + 16 * fq + fr] = sel4(sm, fq);
            asm volatile("" ::: "memory"); }
    }
};
struct EpiA1 {
    static constexpr bool PERM = true;
    static constexpr bool AROWPERM = false;
    const float* ss16; const float* csc; bf16_t* Q; bf16_t* C; bf16_t* KI; bf16_t* QI; float* WI; float* PS;
    static constexpr int NTAB = 1;
    __device__ __forceinline__ void fill(PG8_LAS unsigned char* xl, int i, const Unit& u, int t) const { ((PG8_LAS float*)(xl + RT1_OFF))[i * 256 + t] = rstd16(ss16, u.pm * BM + t); }
    __device__ __forceinline__ void operator()(f32x4 (&acc)[2][2][4][2], const Unit& u, int ui, int wr, int wc, int fr, int fq, PG8_LAS unsigned char* xl) const {
        const int row0 = u.pm * BM + wr * 64 + fr, pn = u.pn;
        const PG8_LAS float* rt = (const PG8_LAS float*)(xl + RT1_OFF) + ui * 256 + wr * 64 + fr;
        float rs[2][4];
#pragma unroll
        for (int ai = 0; ai < 2; ++ai)
#pragma unroll
            for (int m = 0; m < 4; ++m) rs[ai][m] = rt[ai * HALF + m * 16];
#pragma unroll
        for (int bj = 0; bj < 2; ++bj) {
            const int cl = bj * HALF + wc * 32 + 8 * fq, gcol = pn * BM + cl;
            const f32x4 c0 = *(const f32x4*)(csc + gcol), c1 = *(const f32x4*)(csc + gcol + 4);
            bf16_t* dst; int ld; bool st16 = true, stwi = false;
            if (pn < 4) { dst = Q + gcol; ld = 1024; }
            else if (pn == 4) { if (bj == 0) { dst = C + cl; ld = 128; } else if (wc < 2) { dst = KI + (wc * 32 + 8 * fq); ld = 64; } else { dst = Q; ld = 0; st16 = false; stwi = (wc == 2) && (fq == 0); } }
            else { dst = QI + (pn - 5) * 256 + cl; ld = 512; }
#pragma unroll
            for (int ai = 0; ai < 2; ++ai) { float sm[4];
#pragma unroll
                for (int m = 0; m < 4; ++m) { const int row = row0 + ai * HALF + m * 16; const float r = rs[ai][m];
                    const f32x4 v0 = acc[ai][bj][m][0] * r, v1 = acc[ai][bj][m][1] * r;
                    float s = ssq8(v0, v1); s += __shfl_xor(s, 16); s += __shfl_xor(s, 32); sm[m] = s;
                    const f32x4 o0 = v0 * c0, o1 = v1 * c1;
                    if (st16) *(u32x4*)(dst + (size_t)row * ld) = pack8(o0, o1);
                    if (stwi) { *(f32x4*)(WI + (size_t)row * 8) = o0; *(f32x4*)(WI + (size_t)row * 8 + 4) = o1; }
                    if (m & 1) asm volatile("" ::: "memory"); }
                PS[(size_t)(pn * 8 + bj * 4 + wc) * M + u.pm * BM + ai * HALF + wr * 64 + 16 * fq + fr] = sel4(sm, fq); }
        }
    }
};
struct EpiF1 {
    static constexpr bool PERM = false;
    static constexpr bool AROWPERM = true;
    static constexpr int NTAB = 1;
    const float* ss16; const float* cw; const float* cb; bf16_t* H; float* PART; float* HALO;
    __device__ __forceinline__ void fill(PG8_LAS unsigned char* xl, int i, const Unit& u, int t) const { ((PG8_LAS float*)(xl + RT1_OFF))[i * 256 + t] = rstd16(ss16, u.pm * BM + t); }
    __device__ __forceinline__ void operator()(f32x4 (&acc)[2][2][4][2], const Unit& u, int ui, int wr, int wc, int fr, int fq, PG8_LAS unsigned char* xl) const {
        const int trow0 = 8 * (16 * wr + fr), grow0 = u.pm * BM + trow0, hcol = 128 * u.pn + 32 * wc + 4 * fq, tcol = 32 * wc + 4 * fq;
        const PG8_LAS float* rt = (const PG8_LAS float*)(xl + RT1_OFF) + ui * 256 + trow0;
        {   const f32x4 r0 = *(const PG8_LAS f32x4*)rt, r1 = *(const PG8_LAS f32x4*)(rt + 4);
#pragma unroll
            for (int m = 0; m < 4; ++m)
#pragma unroll
                for (int bj = 0; bj < 2; ++bj) { acc[0][bj][m][0] *= r0[m]; acc[0][bj][m][1] *= r0[m]; acc[1][bj][m][0] *= r1[m]; acc[1][bj][m][1] *= r1[m]; } }
        {   PG8_LAS float* cwt = (PG8_LAS float*)(xl + CWT_OFF); const int tid = ((wr * 4 + wc) * 4 + fq) * 16 + fr;
#pragma unroll
            for (int r = 0; r < 2; ++r) { const int idx = tid + r * 512, k = idx >> 8, c = idx & 255, orig = (c < 128) ? 128 * u.pn + c : D_FF + 128 * u.pn + (c - 128);
                cwt[idx] = (k < 3) ? cw[(size_t)k * FF2 + orig] : cb[orig]; } }
        PG8_LAS f32x4* X = (PG8_LAS f32x4*)(xl + XCH_OFF) + (wc * 4 + fq) * 8;
        if (wr == 0 && fr == 15) {
#pragma unroll
            for (int bj = 0; bj < 2; ++bj)
#pragma unroll
                for (int e = 0; e < 2; ++e)
#pragma unroll
                    for (int n = 0; n < 2; ++n) X[(bj * 2 + e) * 2 + n] = acc[1][bj][2 + e][n];
        }
        asm volatile("s_waitcnt vmcnt(0) lgkmcnt(0)" ::: "memory"); __builtin_amdgcn_s_barrier(); asm volatile("" ::: "memory");
        const bool need_fix = (wr == 0) && (fr == 0) && ((u.pm & 7) != 0);
        const bool give_halo = (wr == 1) && (fr == 15);
        const bool take_x = (wr == 1) && (fr == 0);
        float* part = PART + (size_t)u.pm * (2 * 2 * D_FF) + hcol;
        float* halo = HALO + (size_t)u.pm * (2 * 2 * D_FF) + hcol;
        const PG8_LAS float* cwt = (const PG8_LAS float*)(xl + CWT_OFF) + tcol;
#pragma unroll
        for (int n = 0; n < 2; ++n) {
            f32x4 pa[2], pb[2];
#pragma unroll
            for (int e = 0; e < 2; ++e) {
                f32x4 ha = (f32x4){0.f, 0.f, 0.f, 0.f}, hb = (f32x4){0.f, 0.f, 0.f, 0.f};
                if (take_x) { ha = X[(0 * 2 + e) * 2 + n]; hb = X[(1 * 2 + e) * 2 + n]; }
#pragma unroll
                for (int j = 0; j < 4; ++j) {
                    pa[e][j] = __int_as_float(__builtin_amdgcn_update_dpp(__float_as_int(ha[j]), __float_as_int(acc[1][0][2 + e][n][j]), 0x111, 0xf, 0xf, false));
                    pb[e][j] = __int_as_float(__builtin_amdgcn_update_dpp(__float_as_int(hb[j]), __float_as_int(acc[1][1][2 + e][n][j]), 0x111, 0xf, 0xf, false)); } }
            const f32x4 wa0 = *(const PG8_LAS f32x4*)(cwt + 16 * n), wa1 = *(const PG8_LAS f32x4*)(cwt + 256 + 16 * n), wa2 = *(const PG8_LAS f32x4*)(cwt + 512 + 16 * n), ba = *(const PG8_LAS f32x4*)(cwt + 768 + 16 * n);
            const f32x4 wb0 = *(const PG8_LAS f32x4*)(cwt + 128 + 16 * n), wb1 = *(const PG8_LAS f32x4*)(cwt + 384 + 16 * n), wb2 = *(const PG8_LAS f32x4*)(cwt + 640 + 16 * n), bb = *(const PG8_LAS f32x4*)(cwt + 896 + 16 * n);
            if (give_halo) {
                *(f32x4*)(halo + 16 * n) = acc[1][0][2][n]; *(f32x4*)(halo + D_FF + 16 * n) = acc[1][1][2][n];
                *(f32x4*)(halo + 2 * D_FF + 16 * n) = acc[1][0][3][n]; *(f32x4*)(halo + 3 * D_FF + 16 * n) = acc[1][1][3][n]; }
            u32x2 wprev = (u32x2){0u, 0u};
#pragma unroll
            for (int e = 0; e < 8; ++e) {
                const f32x4 ua = acc[e >> 2][0][e & 3][n], ub = acc[e >> 2][1][e & 3][n];
                const f32x4 ua1 = e >= 1 ? acc[(e - 1) >> 2][0][(e - 1) & 3][n] : pa[1], ub1 = e >= 1 ? acc[(e - 1) >> 2][1][(e - 1) & 3][n] : pb[1];
                const f32x4 ua2 = e >= 2 ? acc[(e - 2) >> 2][0][(e - 2) & 3][n] : pa[e], ub2 = e >= 2 ? acc[(e - 2) >> 2][1][(e - 2) & 3][n] : pb[e];
                const f32x4 av = ba + wa2 * ua + wa1 * ua1 + wa0 * ua2, bv = bb + wb2 * ub + wb1 * ub1 + wb0 * ub2;
                if (e < 2 && need_fix) { *(f32x4*)(part + (size_t)e * 2 * D_FF + 16 * n) = av; *(f32x4*)(part + (size_t)e * 2 * D_FF + D_FF + 16 * n) = bv; }
                u32x2 w; w.x = pk2(siluf(av[0]) * bv[0], siluf(av[1]) * bv[1]); w.y = pk2(siluf(av[2]) * bv[2], siluf(av[3]) * bv[3]);
                if ((e & 1) == 0) wprev = w;
                else {
                    const auto sx = __builtin_amdgcn_permlane16_swap(wprev.x, w.x, false, false), sy = __builtin_amdgcn_permlane16_swap(wprev.y, w.y, false, false);
                    u32x4 w4; w4.x = sx[0]; w4.y = sy[0]; w4.z = sx[1]; w4.w = sy[1];
                    *(u32x4*)(H + (size_t)(grow0 + e - 1 + (fq & 1)) * D_FF + 128 * u.pn + 32 * wc + 16 * n + 4 * (fq & 2)) = w4; }
            }
            asm volatile("" ::: "memory");
        }
    }
};
struct EpiB1 {
    static constexpr bool PERM = false;
    static constexpr bool AROWPERM = true;
    static constexpr int NTAB = 1;
    const float* ss16; const float2* rope; bf16_t* QT; bf16_t* KT; bf16_t* VT;
    __device__ __forceinline__ void fill(PG8_LAS unsigned char* xl, int i, const Unit& u, int t) const { ((PG8_LAS float*)(xl + RT1_OFF))[i * 256 + t] = rstd16(ss16, u.pm * BM + t); }
    __device__ __forceinline__ void operator()(f32x4 (&acc)[2][2][4][2], const Unit& u, int ui, int wr, int wc, int fr, int fq, PG8_LAS unsigned char* xl) const {
        const int trow0 = 8 * (16 * wr + fr), grow0 = u.pm * BM + trow0, pn = u.pn, t0 = grow0 & (SEQ - 1);
        const PG8_LAS float* rt = (const PG8_LAS float*)(xl + RT1_OFF) + ui * 256 + trow0;
        const f32x4 r0 = *(const PG8_LAS f32x4*)rt, r1 = *(const PG8_LAS f32x4*)(rt + 4);
        if (pn < 8) {
            const int h = pn & 3; const bool isk = pn >= 4; const float lg = gamma_log(h);
            bf16_t* dbase = (isk ? KT : QT) + (size_t)grow0 * 1024 + h * 256 + 32 * wc + 4 * (fq & 2);
            float sc[8];
#pragma unroll
            for (int e = 0; e < 8; ++e) { const int pos = (t0 + e) & 63; sc[e] = (e < 4 ? r0[e & 3] : r1[e & 3]) * (isk ? 0.0625f * __expf(-(float)(pos + 1) * lg) : __expf((float)(pos + 1) * lg)); }
#pragma unroll
            for (int n = 0; n < 2; ++n) {
                const int i0 = 32 * wc + 16 * n + 4 * fq;
                f32x4 cur[2], dw[2];
                {   const f32x4* rp = (const f32x4*)(rope + (size_t)t0 * 128 + i0); const f32x4* rw = (const f32x4*)(rope + (size_t)128 + i0); cur[0] = rp[0]; cur[1] = rp[1]; dw[0] = rw[0]; dw[1] = rw[1]; }
                u32x2 p1 = (u32x2){0u, 0u}, p2 = (u32x2){0u, 0u};
#pragma unroll
                for (int e = 0; e < 8; ++e) {
                    const f32x4 c0 = cur[0], c1 = cur[1];
                    const f32x4 x1 = acc[e >> 2][0][e & 3][n] * sc[e], x2 = acc[e >> 2][1][e & 3][n] * sc[e];
                    f32x4 o1, o2;
                    o1[0] = x1[0] * c0[0] - x2[0] * c0[1]; o2[0] = x1[0] * c0[1] + x2[0] * c0[0];
                    o1[1] = x1[1] * c0[2] - x2[1] * c0[3]; o2[1] = x1[1] * c0[3] + x2[1] * c0[2];
                    o1[2] = x1[2] * c1[0] - x2[2] * c1[1]; o2[2] = x1[2] * c1[1] + x2[2] * c1[0];
                    o1[3] = x1[3] * c1[2] - x2[3] * c1[3]; o2[3] = x1[3] * c1[3] + x2[3] * c1[2];
                    u32x2 w1, w2; w1.x = pk2(o1[0], o1[1]); w1.y = pk2(o1[2], o1[3]); w2.x = pk2(o2[0], o2[1]); w2.y = pk2(o2[2], o2[3]);
                    if ((e & 1) == 0) { p1 = w1; p2 = w2; }
                    else {
                        const auto ax = __builtin_amdgcn_permlane16_swap(p1.x, w1.x, false, false), ay = __builtin_amdgcn_permlane16_swap(p1.y, w1.y, false, false);
                        const auto bx = __builtin_amdgcn_permlane16_swap(p2.x, w2.x, false, false), by = __builtin_amdgcn_permlane16_swap(p2.y, w2.y, false, false);
                        bf16_t* d = dbase + (size_t)(e - 1 + (fq & 1)) * 1024 + 16 * n;
                        u32x4 v1; v1.x = ax[0]; v1.y = ay[0]; v1.z = ax[1]; v1.w = ay[1]; *(u32x4*)d = v1;
                        u32x4 v2; v2.x = bx[0]; v2.y = by[0]; v2.z = bx[1]; v2.w = by[1]; *(u32x4*)(d + 128) = v2; }
                    if (e < 7) {
#pragma unroll
                        for (int q = 0; q < 2; ++q) { const f32x4 c = cur[q], dd = dw[q]; f32x4 nx;
                            nx[0] = c[0] * dd[0] - c[1] * dd[1]; nx[1] = c[1] * dd[0] + c[0] * dd[1]; nx[2] = c[2] * dd[2] - c[3] * dd[3]; nx[3] = c[3] * dd[2] + c[2] * dd[3]; cur[q] = nx; } }
                }
                asm volatile("" ::: "memory");
            }
        } else {
            const int b = grow0 / SEQ;
            bf16_t* dst = VT + ((size_t)b * 2048 + (pn - 8) * 256 + 32 * wc + 4 * fq) * SEQ + t0;
#pragma unroll
            for (int bj = 0; bj < 2; ++bj)
#pragma unroll
                for (int n = 0; n < 2; ++n)
#pragma unroll
                    for (int j = 0; j < 4; ++j) { u32x4 w;
                        w.x = pk2(acc[0][bj][0][n][j] * r0[0], acc[0][bj][1][n][j] * r0[1]); w.y = pk2(acc[0][bj][2][n][j] * r0[2], acc[0][bj][3][n][j] * r0[3]);
                        w.z = pk2(acc[1][bj][0][n][j] * r1[0], acc[1][bj][1][n][j] * r1[1]); w.w = pk2(acc[1][bj][2][n][j] * r1[2], acc[1][bj][3][n][j] * r1[3]);
                        *(u32x4*)(dst + (size_t)(128 * bj + 16 * n + j) * SEQ) = w; }
        }
    }
};
struct EpiGate {
    static constexpr bool PERM = true;
    static constexpr bool AROWPERM = false;
    static constexpr int NTAB = 1;
    const float* ss16; const float* ssr; bf16_t* RET;
    __device__ __forceinline__ void fill(PG8_LAS unsigned char* xl, int i, const Unit& u, int t) const {
        const int row = u.pm * BM + t;
        ((PG8_LAS float*)(xl + RT1_OFF))[i * 256 + t] = rstd16(ss16, row);
        const f32x4* sp = (const f32x4*)(ssr + ((size_t)row * 4 + (u.pn >> 1)) * 16); const f32x4 s0 = sp[0], s1 = sp[1], s2 = sp[2], s3 = sp[3];
        ((PG8_LAS float*)(xl + RT2_OFF))[i * 256 + t] = rsqrtf(((((s0[0] + s0[1]) + (s0[2] + s0[3])) + ((s1[0] + s1[1]) + (s1[2] + s1[3]))) + (((s2[0] + s2[1]) + (s2[2] + s2[3])) + ((s3[0] + s3[1]) + (s3[2] + s3[3])))) * (1.0f / 512.0f) + EPS);
    }
    __device__ __forceinline__ void operator()(f32x4 (&acc)[2][2][4][2], const Unit& u, int ui, int wr, int wc, int fr, int fq, PG8_LAS unsigned char* xl) const {
        const int row0 = u.pm * BM + wr * 64 + fr, colb = u.pn * BM + wc * 32 + 8 * fq;
        const PG8_LAS float* rt = (const PG8_LAS float*)(xl + RT1_OFF) + ui * 256 + wr * 64 + fr;
        const PG8_LAS float* rt2 = (const PG8_LAS float*)(xl + RT2_OFF) + ui * 256 + wr * 64 + fr;
        u32x4 rvv[2][4][2];
#pragma unroll
        for (int ai = 0; ai < 2; ++ai)
#pragma unroll
            for (int m = 0; m < 4; ++m)
#pragma unroll
                for (int bj = 0; bj < 2; ++bj) rvv[ai][m][bj] = *(const u32x4*)(RET + (size_t)(row0 + ai * HALF + m * 16) * 2048 + colb + bj * HALF);
#pragma unroll
        for (int ai = 0; ai < 2; ++ai)
#pragma unroll
            for (int m = 0; m < 4; ++m) { const int row = row0 + ai * HALF + m * 16; const float r = rt[ai * HALF + m * 16], rh = rt2[ai * HALF + m * 16];
#pragma unroll
                for (int bj = 0; bj < 2; ++bj) { bf16_t* p = RET + (size_t)row * 2048 + colb + bj * HALF; const u32x4 rv = rvv[ai][m][bj];
                    const f32x4 g0 = acc[ai][bj][m][0] * r, g1 = acc[ai][bj][m][1] * r; f32x4 y0, y1;
                    y0[0] = bflo(rv.x) * rh * siluf(g0[0]); y0[1] = bfhi(rv.x) * rh * siluf(g0[1]); y0[2] = bflo(rv.y) * rh * siluf(g0[2]); y0[3] = bfhi(rv.y) * rh * siluf(g0[3]);
                    y1[0] = bflo(rv.z) * rh * siluf(g1[0]); y1[1] = bfhi(rv.z) * rh * siluf(g1[1]); y1[2] = bflo(rv.w) * rh * siluf(g1[2]); y1[3] = bfhi(rv.w) * rh * siluf(g1[3]);
                    *(u32x4*)p = pack8(y0, y1); } }
    }
};

template <class Epi, class Sched>
__device__ __forceinline__ void gemm_phase(PG8_LAS unsigned char* lds, const Gemm g, const Sched& S, const Epi& E) {
    int tid_ = threadIdx.x; asm volatile("" : "+v"(tid_));
    const int tid = tid_, wid = __builtin_amdgcn_readfirstlane(tid >> 6), lane = tid & 63, wr = wid >> 2, wc = wid & 3, fr = lane & 15, fq = lane >> 4;
    const int K = g.K, nt = K / BK;
    unsigned voffA0[2], voffA1[2], voffB[2];
#pragma unroll
    for (int i = 0; i < 2; ++i) { int R, C; stage_rc(tid * 16 + i * 8192, R, C); const int Rb = Epi::PERM ? (R & ~31) + perm32(R & 31) : R;
        int ra0, ra1;
        if (Epi::AROWPERM) { const int base = ((R >> 6) * 16 + (R & 15)) * 8 + ((R >> 4) & 3); ra0 = base; ra1 = base + 4; } else { ra0 = R; ra1 = R + HALF; }
        voffA0[i] = (unsigned)(ra0 * K + C) * 2u; voffA1[i] = (unsigned)(ra1 * K + C) * 2u; voffB[i] = (unsigned)(Rb * K + C) * 2u; }
    const size_t kstep = (size_t)(BK * 2);
    const size_t hstep = (size_t)HALF * K * 2;
    const size_t tstep = 2 * hstep;
    const unsigned ldsw = (unsigned)wid * 1024u;
    const int aoff = lds_byte(wr * 64 + fr, fq * 8), boff = lds_byte(wc * 32 + fr, fq * 8);
#define PG8_SA(b, h) (((b) * 2 + (h)) * HTB)
#define PG8_SB(b, h) ((4 + (b) * 2 + (h)) * HTB)
#define PG8_STAGE(bufoff, gbase, voff) do { _Pragma("unroll") for (int _i = 0; _i < 2; ++_i) \
        __builtin_amdgcn_global_load_lds((const unsigned*)((const char*)(gbase) + (voff)[_i]), (PG8_LAS unsigned*)(lds + (bufoff) + ldsw + _i * 8192), 16, 0, 0); } while (0)
#define PG8_LDA(dst, b, h) do { _Pragma("unroll") for (int m = 0; m < 4; ++m) _Pragma("unroll") for (int k = 0; k < 2; ++k) dst[m][k] = *(const PG8_LAS bf16x8*)(lds + PG8_SA(b, h) + aoff + m * 2048 + k * 1024); } while (0)
#define PG8_LDB(dst, b, h) do { _Pragma("unroll") for (int n = 0; n < 2; ++n) _Pragma("unroll") for (int k = 0; k < 2; ++k) dst[n][k] = *(const PG8_LAS bf16x8*)(lds + PG8_SB(b, h) + boff + n * 2048 + k * 1024); } while (0)
#define PG8_MMA(ai, bj, At, Bt) do { __builtin_amdgcn_s_setprio(1); _Pragma("unroll") for (int m = 0; m < 4; ++m) _Pragma("unroll") for (int n = 0; n < 2; ++n) _Pragma("unroll") for (int k = 0; k < 2; ++k) \
        acc[ai][bj][m][n] = __builtin_amdgcn_mfma_f32_16x16x32_bf16(Bt[n][k], At[m][k], acc[ai][bj][m][n], 0, 0, 0); __builtin_amdgcn_s_setprio(0); } while (0)
#define PG8_WAIT_V(n) asm volatile("s_waitcnt vmcnt(" #n ")" ::: "memory")
#define PG8_WAIT_L(n) asm volatile("s_waitcnt lgkmcnt(" #n ")" ::: "memory")
#define PG8_BAR __builtin_amdgcn_s_barrier()
#define PG8_SCHED __builtin_amdgcn_sched_barrier(0)
    Unit cur, nxt; int ui = 0;
    if (!S.next(0, cur)) return;
    f32x4 acc[2][2][4][2];
#pragma unroll
    for (int a = 0; a < 2; ++a)
#pragma unroll
        for (int b = 0; b < 2; ++b)
#pragma unroll
            for (int m = 0; m < 4; ++m)
#pragma unroll
                for (int n = 0; n < 2; ++n) acc[a][b][m][n] = (f32x4){0.f, 0.f, 0.f, 0.f};
    bf16x8 At[4][2], B0[2][2], B1[2][2];
    const char* cA = (const char*)g.A + (size_t)cur.pm * tstep; const char* cB = (const char*)g.Bt + (size_t)cur.pn * tstep;
    PG8_STAGE(PG8_SB(0, 0), cB, voffB); PG8_STAGE(PG8_SB(0, 1), cB + hstep, voffB); PG8_STAGE(PG8_SA(0, 0), cA, voffA0); PG8_STAGE(PG8_SA(0, 1), cA, voffA1);
    if constexpr (Epi::NTAB > 0) {
#pragma unroll 1
        for (int i = tid >> 8; i < 8; i += 2) { Unit uu; if (!S.next(i, uu)) break; E.fill(lds + STAGE_BYTES, i, uu, tid & 255); asm volatile("" ::: "memory"); }
        asm volatile("s_waitcnt lgkmcnt(0)" ::: "memory");
    }
    if (wr == 1) PG8_BAR;
    PG8_WAIT_V(2); PG8_BAR;
    PG8_STAGE(PG8_SB(1, 0), cB + kstep, voffB); PG8_STAGE(PG8_SA(1, 0), cA + kstep, voffA0); PG8_STAGE(PG8_SB(1, 1), cB + hstep + kstep, voffB);
    PG8_WAIT_V(6); PG8_BAR;
    for (;;) {
        const bool has_next = S.next(ui + 1, nxt);
        const char* nA = has_next ? (const char*)g.A + (size_t)nxt.pm * tstep : cA; const char* nB = has_next ? (const char*)g.Bt + (size_t)nxt.pn * tstep : cB;
        for (int t = 0; t < nt; t += 2) {
            const bool last = (t == nt - 2);
            const char* a1 = cA + (size_t)(t + 1) * kstep;
            const char* a2 = last ? nA : cA + (size_t)(t + 2) * kstep; const char* b2 = last ? nB : cB + (size_t)(t + 2) * kstep;
            const char* a3 = a2 + kstep; const char* b3 = b2 + kstep;
            PG8_LDB(B0, 0, 0); PG8_LDB(B1, 0, 1); PG8_SCHED; PG8_LDA(At, 0, 0); PG8_STAGE(PG8_SA(1, 1), a1, voffA1);
            PG8_WAIT_V(8); PG8_WAIT_L(0); PG8_BAR; PG8_MMA(0, 0, At, B0); PG8_MMA(0, 1, At, B1); PG8_BAR; PG8_SCHED;
            PG8_LDA(At, 0, 1); PG8_STAGE(PG8_SB(0, 0), b2, voffB); PG8_STAGE(PG8_SB(0, 1), b2 + hstep, voffB); PG8_STAGE(PG8_SA(0, 0), a2, voffA0);
            PG8_WAIT_V(8); PG8_WAIT_L(0); PG8_BAR; PG8_MMA(1, 0, At, B0); PG8_MMA(1, 1, At, B1); PG8_BAR; PG8_SCHED;
            PG8_LDB(B0, 1, 0); PG8_LDB(B1, 1, 1); PG8_SCHED; PG8_LDA(At, 1, 0); PG8_STAGE(PG8_SA(0, 1), a2, voffA1);
            PG8_WAIT_V(8); PG8_WAIT_L(0); PG8_BAR; PG8_MMA(0, 0, At, B0); PG8_MMA(0, 1, At, B1); PG8_BAR; PG8_SCHED;
            PG8_LDA(At, 1, 1); PG8_STAGE(PG8_SB(1, 0), b3, voffB); PG8_STAGE(PG8_SB(1, 1), b3 + hstep, voffB); PG8_STAGE(PG8_SA(1, 0), a3, voffA0);
            PG8_WAIT_V(8); PG8_WAIT_L(0); PG8_BAR; PG8_MMA(1, 0, At, B0); PG8_MMA(1, 1, At, B1); PG8_BAR; PG8_SCHED;
        }
        if (wr == 0) PG8_BAR;
        E(acc, cur, ui, wr, wc, fr, fq, lds + STAGE_BYTES);
        if (!has_next) break;
#pragma unroll
        for (int a = 0; a < 2; ++a)
#pragma unroll
            for (int b = 0; b < 2; ++b)
#pragma unroll
                for (int m = 0; m < 4; ++m)
#pragma unroll
                    for (int n = 0; n < 2; ++n) acc[a][b][m][n] = (f32x4){0.f, 0.f, 0.f, 0.f};
        cur = nxt; cA = nA; cB = nB; ++ui;
        if (wr == 1) PG8_BAR;
    }
    PG8_WAIT_V(0);
    PG8_BAR;
#undef PG8_SA
#undef PG8_SB
#undef PG8_STAGE
#undef PG8_LDA
#undef PG8_LDB
#undef PG8_MMA
#undef PG8_WAIT_V
#undef PG8_WAIT_L
#undef PG8_BAR
#undef PG8_SCHED
}
}

constexpr int NWAVES = 8;
constexpr int RING_BYTES = 131072, LDS_BYTES = 163840, LDSCTL_OFF = LDS_BYTES - 512, MISC_OFF = LDSCTL_OFF + 320;
#define GAS __attribute__((address_space(1)))
#define LAS __attribute__((address_space(3)))
typedef GAS unsigned gu32;
#define RLX_AGENT __ATOMIC_RELAXED, __HIP_MEMORY_SCOPE_AGENT
#define LDS_WAIT() asm volatile("s_waitcnt lgkmcnt(0)" ::: "memory")
#define VM_WAIT() asm volatile("s_waitcnt vmcnt(0)" ::: "memory")
constexpr int CW_BAR = 4096;
#define XB_TMO      128
#define XB_XCNT(j)  (256  + 64 * (j))
#define XB_XSUB(j)  (1280 + 64 * (j))
#define XB_XGEN(j)  (2304 + 64 * (j))
#define XB_TOP      3328
#define XB_TOPGEN   3392
#define XCD_BAR_WORDS 3456
#define XB_SPIN_CAP (1u << 18)
__device__ __forceinline__ unsigned xb_ld(unsigned* p)              { return __hip_atomic_load(p, __ATOMIC_RELAXED, __HIP_MEMORY_SCOPE_AGENT); }
__device__ __forceinline__ unsigned xb_add(unsigned* p, unsigned v) { return __hip_atomic_fetch_add(p, v, __ATOMIC_RELAXED, __HIP_MEMORY_SCOPE_AGENT); }
__device__ __forceinline__ unsigned xb_xcc_id() { return (unsigned)__builtin_amdgcn_s_getreg((3 << 11) | 20) & 0xFu; }
#define XB_SPIN(cond, bar) do { unsigned _sp = 0; while (cond) { __builtin_amdgcn_s_sleep(1); \
    if ((++_sp & 255u) == 0u) { if (xb_ld(&(bar)[XB_TMO])) break; if (_sp > XB_SPIN_CAP) { atomicAdd(&(bar)[XB_TMO], 1u); break; } } } } while (0)
struct XcdBarrier { unsigned* bar; unsigned x; volatile LAS unsigned* st; };
__device__ __forceinline__ XcdBarrier xcd_barrier_post(unsigned* bar, volatile LAS unsigned* st) {
    XcdBarrier b; b.bar = bar; b.x = xb_xcc_id(); b.st = st;
    if (threadIdx.x == 0) (void)xb_add(&bar[XB_XCNT(b.x)], 1u);
    return b;
}
__device__ __forceinline__ void xcd_barrier_complete(unsigned* bar, unsigned x, unsigned& nloc, unsigned& nx) {
    const unsigned G = gridDim.x * gridDim.y * gridDim.z;
    unsigned sum, cnt, mine, sp = 0u;
    for (;;) {
        sum = 0u; cnt = 0u; mine = 0u;
#pragma unroll
        for (unsigned j = 0; j < 16; ++j) { const unsigned c = xb_ld(&bar[XB_XCNT(j)]); sum += c; cnt += (c > 0u) ? 1u : 0u; mine = (j == x) ? c : mine; }
        if (sum == G) break;
        __builtin_amdgcn_s_sleep(1);
        if ((++sp & 255u) == 0u) { if (xb_ld(&bar[XB_TMO])) break; if (sp > XB_SPIN_CAP) { atomicAdd(&bar[XB_TMO], 1u); break; } }
    }
    nloc = mine > 0u ? mine : 1u; nx = cnt > 0u ? cnt : 1u;
}
__device__ __forceinline__ void xcd_barrier(const XcdBarrier& b) {
    asm volatile("s_waitcnt vmcnt(0)" ::: "memory");
    __syncthreads();
    if (threadIdx.x == 0) {
        unsigned* bar = b.bar;
        __builtin_amdgcn_s_waitcnt(0);
        unsigned nloc = b.st[0], nx = b.st[1];
        if (nloc == 0u) { xcd_barrier_complete(bar, b.x, nloc, nx); b.st[0] = nloc; b.st[1] = nx; }
        const unsigned old = xb_add(&bar[XB_XSUB(b.x)], 1u);
        const unsigned gen = old / nloc;
        if (old + 1u == (gen + 1u) * nloc) {
            __builtin_amdgcn_fence(__ATOMIC_RELEASE, "agent");
            asm volatile("s_waitcnt vmcnt(0)" ::: "memory");
            const unsigned og = xb_add(&bar[XB_TOP], 1u);
            const unsigned tg = og / nx;
            if (og + 1u == (tg + 1u) * nx) xb_add(&bar[XB_TOPGEN], 1u);
            else XB_SPIN(xb_ld(&bar[XB_TOPGEN]) == tg, bar);
            __builtin_amdgcn_fence(__ATOMIC_ACQUIRE, "agent");
            xb_add(&bar[XB_XGEN(b.x)], 1u);
            asm volatile("s_waitcnt vmcnt(0)" ::: "memory");
        } else {
            XB_SPIN(xb_ld(&bar[XB_XGEN(b.x)]) == gen, bar);
            __builtin_amdgcn_fence(__ATOMIC_ACQUIRE, "agent");
            asm volatile("s_waitcnt vmcnt(0)" ::: "memory");
        }
    }
    __syncthreads();
}

struct Args { const float* in[16]; float* out; unsigned char* ws; int ph_lo, ph_hi, li, pad; };
enum { PH_PRO = 0, PH_A1, PH_A2, PH_A3, PH_F1A, PH_F2A, PH_B1, PH_B2, PH_GATE, PH_B3, PH_F1B, PH_F2B, PH_END };

__device__ __forceinline__ void p0_transpose_item(const float* W, int K, int Nsrc, int N, int mode, const float* gain, bf16_t* WT, LAS float* scr, int item, int lane) {
    const int nblk = N / 64, kb = item / nblk, nb = item % nblk, k0 = 64 * kb, n0 = 64 * nb;
    const int src = wmap(mode, n0 + lane);
    const float* wp = W + (size_t)k0 * Nsrc + (src >= 0 ? src : 0);
#pragma unroll
    for (int h = 0; h < 2; ++h) { float v[32];
#pragma unroll
        for (int i = 0; i < 32; ++i) v[i] = wp[(size_t)(32 * h + i) * Nsrc];
#pragma unroll
        for (int i = 0; i < 32; ++i) { float x = v[i]; if (gain) x *= gain[k0 + 32 * h + i]; if (src < 0) x = 0.f; scr[(32 * h + i) * 65 + lane] = x; } }
    LDS_WAIT(); asm volatile("" ::: "memory");
    const int kq = (lane & 3) * 16;
#pragma unroll
    for (int j = 0; j < 4; ++j) { const int n = (lane >> 2) + 16 * j; const LAS float* sp = scr + kq * 65 + n;
        u32x4 o0, o1;
        o0.x = pk2(sp[0 * 65], sp[1 * 65]); o0.y = pk2(sp[2 * 65], sp[3 * 65]); o0.z = pk2(sp[4 * 65], sp[5 * 65]); o0.w = pk2(sp[6 * 65], sp[7 * 65]);
        o1.x = pk2(sp[8 * 65], sp[9 * 65]); o1.y = pk2(sp[10 * 65], sp[11 * 65]); o1.z = pk2(sp[12 * 65], sp[13 * 65]); o1.w = pk2(sp[14 * 65], sp[15 * 65]);
        bf16_t* dst = WT + (size_t)(n0 + n) * K + k0 + kq; *(u32x4*)dst = o0; *(u32x4*)(dst + 8) = o1; }
    LDS_WAIT(); asm volatile("" ::: "memory");
}
__device__ __forceinline__ void ffn_fixup(int pm, const float* cw, const float* PART, const float* HALO, bf16_t* H) {
    if ((pm & 7) == 0) return;
    int tid = threadIdx.x; asm volatile("" : "+v"(tid));
    const float* part = PART + (size_t)pm * (4 * D_FF); const float* halo = HALO + (size_t)(pm - 1) * (4 * D_FF);
#pragma unroll
    for (int idx0 = 0; idx0 < 2 * D_FF; idx0 += NWAVES * 64) { const int idx = idx0 + tid; const int e = idx / D_FF, c = idx - e * D_FF;
        float a = part[(size_t)e * 2 * D_FF + c], b = part[(size_t)e * 2 * D_FF + D_FF + c];
        const float ha0 = halo[c], hb0 = halo[D_FF + c], ha1 = halo[2 * D_FF + c], hb1 = halo[3 * D_FF + c];
        const float wa0 = cw[c], wa1 = cw[FF2 + c], wb0 = cw[D_FF + c], wb1 = cw[FF2 + D_FF + c];
        if (e == 0) { a += wa1 * ha1 + wa0 * ha0; b += wb1 * hb1 + wb0 * hb0; } else { a += wa0 * ha1; b += wb0 * hb1; }
        H[(size_t)(pm * 256 + e) * D_FF + c] = f2bf(siluf(a) * b); }
}


__device__ __forceinline__ void glds16_asm(const void* gsrc, unsigned lds_dst) {
    unsigned keep; asm volatile("s_mov_b32 %0, m0\n\ts_mov_b32 m0, %2\n\ts_nop 0\n\tglobal_load_lds_dwordx4 %1, off\n\ts_mov_b32 m0, %0" : "=&s"(keep) : "v"(gsrc), "s"(lds_dst) : "memory"); }
__device__ __forceinline__ unsigned lds_addr(LAS unsigned char* p) { return (unsigned)__builtin_amdgcn_readfirstlane((int)(unsigned)(size_t)p); }

typedef short s16x4 __attribute__((ext_vector_type(4)));
__device__ __forceinline__ bf16x8 cat4(s16x4 a, s16x4 b) { bf16x8 r; r[0] = a[0]; r[1] = a[1]; r[2] = a[2]; r[3] = a[3]; r[4] = b[0]; r[5] = b[1]; r[6] = b[2]; r[7] = b[3]; return r; }
__device__ __forceinline__ void ret_fast_phase(LAS unsigned char* lds, const bf16_t* QT, const bf16_t* KT, const bf16_t* VT, bf16_t* RET, float* SSR, int unit) {
    int tid_ = threadIdx.x; asm volatile("" : "+v"(tid_));
    const int tid = tid_, lane = tid & 63, w = __builtin_amdgcn_readfirstlane(tid >> 6), li = lane & 15, g = lane >> 4;
    const int blk = unit & 7, h = (unit >> 3) & 3, b = unit >> 5;
    const float g64 = __expf(64.0f * gamma_log(h));
    const bool isR = w < 4; const int qt = w & 3, u = w & 3;
    constexpr int KB = 0, VB = 65536, ST = 81920;
    typedef __attribute__((address_space(3))) s16x4 lds_s16x4;
    for (int e = tid; e < 2048; e += 512) *(LAS u32x4*)(lds + ST + e * 16) = (u32x4){0u, 0u, 0u, 0u};
    f32x4 rg[16];
#pragma unroll
    for (int i = 0; i < 16; ++i) rg[i] = (f32x4){0.f, 0.f, 0.f, 0.f};
    const size_t rowb = (size_t)b * SEQ;
    const bf16_t* kbase = KT + rowb * 1024 + h * 256;
    const bf16_t* qbase = QT + (rowb + 16 * qt + li) * 1024 + h * 256 + 8 * g;
    const bf16_t* vbase = VT + ((size_t)b * 2048 + h * 512 + blk * 64 + (tid >> 3)) * SEQ + 8 * (tid & 7);
    const unsigned vw_off = (unsigned)((tid >> 3) * 128 + (((2 * (tid & 7)) ^ ((tid >> 3) & 14)) * 8));
    unsigned ksrc[8];
#pragma unroll
    for (int i = 0; i < 8; ++i) { const int row = 2 * (8 * u + i) + (lane >> 5), p = lane & 31, c = p ^ ((row & 7) << 1); ksrc[i] = (unsigned)(row * 2048 + c * 16); }
#define RK_DMA(n_, buf_) do { const char* kb_ = (const char*)(kbase + (size_t)(n_) * 64 * 1024); const unsigned ld_ = lds_addr(lds + KB + (buf_) * 32768 + (8 * u) * 1024); _Pragma("unroll") for (int i = 0; i < 8; ++i) \
        glds16_asm(kb_ + ksrc[i], ld_ + i * 1024); } while (0)
    u32x4 vreg;
    if (!isR) { RK_DMA(0, 0); }
    vreg = *(const u32x4*)(vbase);
    if (isR) {
#pragma unroll
        for (int ks = 0; ks < 8; ++ks) rg[ks] = *(const f32x4*)(qbase + 32 * ks); }
    *(LAS u32x4*)(lds + VB + vw_off) = vreg;
    asm volatile("s_waitcnt vmcnt(0) lgkmcnt(0)" ::: "memory"); __builtin_amdgcn_s_barrier(); asm volatile("" ::: "memory");
#pragma unroll 1
    for (int n = 0; n < 32; ++n) {
        const int cur = n & 1, nxt = cur ^ 1;
        LAS unsigned char* kb = lds + KB + cur * 32768; LAS unsigned char* vb = lds + VB + cur * 8192; LAS unsigned char* sb = lds + ST + cur * 32768;
        if (n + 1 < 32) vreg = *(const u32x4*)(vbase + (size_t)(n + 1) * 64);
        if (isR) {
            if (n + 1 < 32) {
#pragma unroll
                for (int ks = 0; ks < 8; ++ks) rg[8 + ks] = *(const f32x4*)(qbase + (size_t)(n + 1) * 64 * 1024 + 32 * ks); }
            const int sw = (li & 7) << 1;
#define LDROWS(dst, base, tile) do { const LAS unsigned char* rp_ = (base) + (16 * (tile) + li) * 512; _Pragma("unroll") for (int ks = 0; ks < 8; ++ks) dst[ks] = *(const LAS bf16x8*)(rp_ + (((4 * ks + g) ^ sw) * 16)); } while (0)
#define MMA8(acc_, fr_) do { _Pragma("unroll") for (int ks = 0; ks < 8; ++ks) acc_ = __builtin_amdgcn_mfma_f32_16x16x32_bf16(fr_[ks], __builtin_bit_cast(bf16x8, rg[ks]), acc_, 0, 0, 0); } while (0)
#define SFIN(k_, a_) do { if (qt == (k_)) { _Pragma("unroll") for (int r = 0; r < 4; ++r) a_[r] = (4 * g + r <= li) ? a_[r] : 0.f; } u32x2 pk_; pk_.x = pk2(a_[0], a_[1]); pk_.y = pk2(a_[2], a_[3]); sfr[k_] = __builtin_bit_cast(s16x4, pk_); } while (0)
#define SB_ __builtin_amdgcn_sched_barrier(0)
            bf16x8 fa[8], fb[8]; f32x4 racc[4]; s16x4 sfr[4];
#pragma unroll
            for (int t = 0; t < 4; ++t) { racc[t] = (f32x4){0.f, 0.f, 0.f, 0.f}; sfr[t] = (s16x4){0, 0, 0, 0}; }
            LDROWS(fa, sb, 0); SB_;
            LDROWS(fb, sb, 1); SB_; MMA8(racc[0], fa); SB_;
            LDROWS(fa, sb, 2); SB_; MMA8(racc[1], fb); SB_;
            LDROWS(fb, sb, 3); SB_; MMA8(racc[2], fa); SB_;
            LDROWS(fa, kb, 0); SB_; MMA8(racc[3], fb); SB_;
            if (qt >= 1) { LDROWS(fb, kb, 1); }
            SB_;
            { f32x4 a = (f32x4){0.f, 0.f, 0.f, 0.f}; MMA8(a, fa); SFIN(0, a); }
            SB_;
            if (qt >= 1) { if (qt >= 2) { LDROWS(fa, kb, 2); } SB_; f32x4 a = (f32x4){0.f, 0.f, 0.f, 0.f}; MMA8(a, fb); SFIN(1, a); }
            SB_;
            if (qt >= 2) { if (qt >= 3) { LDROWS(fb, kb, 3); } SB_; f32x4 a = (f32x4){0.f, 0.f, 0.f, 0.f}; MMA8(a, fa); SFIN(2, a); }
            SB_;
            bf16x8 vf0[4], vf1[4];
#pragma unroll
            for (int t = 0; t < 4; ++t) { const int row = 16 * t + li; const LAS unsigned char* vp = vb + row * 128; const int f = row & 14;
                vf0[t] = cat4(*(const LAS s16x4*)(vp + (((g) ^ f) * 8)), *(const LAS s16x4*)(vp + (((4 + g) ^ f) * 8)));
                vf1[t] = cat4(*(const LAS s16x4*)(vp + (((8 + g) ^ f) * 8)), *(const LAS s16x4*)(vp + (((12 + g) ^ f) * 8))); }
            SB_;
            if (qt >= 3) { f32x4 a = (f32x4){0.f, 0.f, 0.f, 0.f}; MMA8(a, fb); SFIN(3, a); }
            SB_;
            const bf16x8 sf0 = cat4(sfr[0], sfr[1]), sf1 = cat4(sfr[2], sfr[3]);
            float ssq = 0.f; u32x2 pkt[4];
#pragma unroll
            for (int t = 0; t < 4; ++t) {
                f32x4 acc = __builtin_amdgcn_mfma_f32_16x16x32_bf16(vf0[t], sf0, racc[t], 0, 0, 0);
                if (qt >= 2) acc = __builtin_amdgcn_mfma_f32_16x16x32_bf16(vf1[t], sf1, acc, 0, 0, 0);
                ssq += (acc[0] * acc[0] + acc[1] * acc[1]) + (acc[2] * acc[2] + acc[3] * acc[3]);
                pkt[t].x = pk2(acc[0], acc[1]); pkt[t].y = pk2(acc[2], acc[3]); }
#undef LDROWS
#undef MMA8
#undef SFIN
            bf16_t* rrow = RET + (rowb + n * 64 + 16 * qt + li) * 2048 + h * 512 + blk * 64 + 16 * (g & 1) + 4 * (g & 2);
#pragma unroll
            for (int pp = 0; pp < 2; ++pp) {
                const auto sx = __builtin_amdgcn_permlane16_swap(pkt[2 * pp].x, pkt[2 * pp + 1].x, false, false), sy = __builtin_amdgcn_permlane16_swap(pkt[2 * pp].y, pkt[2 * pp + 1].y, false, false);
                u32x4 w4; w4.x = sx[0]; w4.y = sy[0]; w4.z = sx[1]; w4.w = sy[1];
                *(u32x4*)(rrow + 32 * pp) = w4; }
            ssq += __shfl_xor(ssq, 16); ssq += __shfl_xor(ssq, 32);
            if (g < 2) SSR[((rowb + n * 64 + 16 * qt + li) * 4 + h) * 16 + blk * 2 + g] = g ? 0.f : ssq;
#pragma unroll
            for (int ks = 0; ks < 8; ++ks) rg[ks] = rg[8 + ks];
        } else {
            if (n + 1 < 32) { RK_DMA(n + 1, nxt); }
            bf16x8 vf[4][2];
#pragma unroll
            for (int t = 0; t < 4; ++t)
#pragma unroll
                for (int kp = 0; kp < 2; ++kp) { const int row = 16 * t + li; const LAS unsigned char* rp = vb + row * 128; const int f = row & 14;
                    const s16x4 lo = *(const LAS s16x4*)(rp + (((8 * kp + g) ^ f) * 8)), hi = *(const LAS s16x4*)(rp + (((8 * kp + 4 + g) ^ f) * 8)); vf[t][kp] = cat4(lo, hi); }
            bf16x8 ua[4][2];
#pragma unroll
            for (int d = 0; d < 4; ++d) {
#pragma unroll
                for (int kp = 0; kp < 2; ++kp) { const int dkt = 4 * u + d;
                    const int r0 = 32 * kp + 4 * g + (li >> 2), r1 = r0 + 16;
                    const int cch = 2 * dkt + ((li >> 1) & 1), hb = (li & 1) * 8;
                    const s16x4 lo = __builtin_bit_cast(s16x4, __builtin_amdgcn_ds_read_tr16_b64_v4i16((lds_s16x4*)(kb + r0 * 512 + ((cch ^ ((r0 & 7) << 1)) * 16) + hb)));
                    const s16x4 hi = __builtin_bit_cast(s16x4, __builtin_amdgcn_ds_read_tr16_b64_v4i16((lds_s16x4*)(kb + r1 * 512 + ((cch ^ ((r1 & 7) << 1)) * 16) + hb)));
                    ua[d][kp] = cat4(lo, hi); }
                if (d == 1) __builtin_amdgcn_sched_barrier(0); }
            __builtin_amdgcn_sched_barrier(0);
#pragma unroll
            for (int d = 0; d < 4; ++d)
#pragma unroll
                for (int kp = 0; kp < 2; ++kp)
#pragma unroll
                    for (int t = 0; t < 4; ++t) rg[4 * d + t] = __builtin_amdgcn_mfma_f32_16x16x32_bf16(ua[d][kp], vf[t][kp], rg[4 * d + t], 0, 0, 0);
            LAS unsigned char* sn = lds + ST + nxt * 32768;
#pragma unroll
            for (int d = 0; d < 4; ++d)
#pragma unroll
                for (int t = 0; t < 4; ++t) { rg[4 * d + t] *= g64; const int row = 16 * t + li, dkt = 4 * u + d;
                    u32x2 pk; pk.x = pk2(rg[4 * d + t][0], rg[4 * d + t][1]); pk.y = pk2(rg[4 * d + t][2], rg[4 * d + t][3]);
                    *(LAS u32x2*)(sn + row * 512 + (((2 * dkt + (g >> 1)) ^ ((row & 7) << 1)) * 16) + (g & 1) * 8) = pk; }
        }
        if (n + 1 < 32) *(LAS u32x4*)(lds + VB + nxt * 8192 + vw_off) = vreg;
        asm volatile("s_waitcnt vmcnt(0) lgkmcnt(0)" ::: "memory"); __builtin_amdgcn_s_barrier(); asm volatile("" ::: "memory");
    }
#undef RK_DMA
#undef SB_
}


#ifndef DSA_REP
#define DSA_REP 0
#endif
constexpr int DSA_SC = 0, DSA_KST = 131072, DSA_IDX = 147456, DSA_WQ = 155648;
__device__ __forceinline__ unsigned fkey(float f) { const unsigned u = __float_as_uint(f); return (u & 0x80000000u) ? ~u : (u | 0x80000000u); }
__device__ __forceinline__ int bcnt(bool p) { return __popcll(__ballot(p)); }
#define SUMF(a_, b_) ((a_) + (b_))
#define WAVE_RED(OP, v) do { v = OP(v, __int_as_float(__builtin_amdgcn_update_dpp(__float_as_int(v), __float_as_int(v), 0xB1, 0xf, 0xf, true))); \
        v = OP(v, __int_as_float(__builtin_amdgcn_update_dpp(__float_as_int(v), __float_as_int(v), 0x4E, 0xf, 0xf, true))); \
        v = OP(v, __int_as_float(__builtin_amdgcn_update_dpp(__float_as_int(v), __float_as_int(v), 0x141, 0xf, 0xf, true))); \
        v = OP(v, __int_as_float(__builtin_amdgcn_update_dpp(__float_as_int(v), __float_as_int(v), 0x140, 0xf, 0xf, true))); \
        v = OP(OP(__int_as_float(__builtin_amdgcn_readlane(__float_as_int(v), 0)), __int_as_float(__builtin_amdgcn_readlane(__float_as_int(v), 16))), \
               OP(__int_as_float(__builtin_amdgcn_readlane(__float_as_int(v), 32)), __int_as_float(__builtin_amdgcn_readlane(__float_as_int(v), 48)))); } while (0)

template <int NB>
__device__ __forceinline__ void dsa_topk_t(const LAS float* sc, LAS unsigned short* il, int limit, int lane) {
    const int nb = limit >> 6;
    float v[NB];
#pragma unroll
    for (int i = 0; i < NB; ++i) v[i] = (i < nb) ? sc[64 * i + lane] : -INFINITY;
    float mn = INFINITY, mx = -INFINITY;
#pragma unroll
    for (int i = 0; i < NB; ++i) { mn = fminf(mn, (i < nb) ? v[i] : INFINITY); mx = fmaxf(mx, v[i]); }
    WAVE_RED(fminf, mn); WAVE_RED(fmaxf, mx);
    float lo = mn, hi = INFINITY; int clo = limit, chi = 0;
#pragma unroll 1
    for (int it = 0; it < 64 && clo - chi > 64; ++it) {
        const float top = (hi == INFINITY) ? mx : hi; const float mid = 0.5f * lo + 0.5f * top;
        if (!(mid > lo) || !(mid < hi)) break;
        int c = 0;
#pragma unroll
        for (int i = 0; i < NB; ++i) c += (v[i] >= mid) ? 1 : 0;
        float cf = (float)c; WAVE_RED(SUMF, cf); c = (int)cf;
        if (c >= TOPK) { lo = mid; clo = c; } else { hi = mid; chi = c; }
    }
    const int r = TOPK - chi; unsigned T; int ngt, neq;
    if (clo - chi <= 64) {
        int filled = 0;
#pragma unroll
        for (int i = 0; i < NB; ++i) { const bool in = (v[i] >= lo) && (v[i] < hi);
            const unsigned long long m = __ballot(in); const int pos = filled + __builtin_amdgcn_mbcnt_hi((unsigned)(m >> 32), __builtin_amdgcn_mbcnt_lo((unsigned)m, 0));
            if (in) ((LAS unsigned*)il)[pos] = fkey(v[i]);
            filled += __popcll(m); }
        asm volatile("s_waitcnt lgkmcnt(0)" ::: "memory");
        const unsigned ck = (lane < filled) ? ((LAS unsigned*)il)[lane] : 0u;
        T = 0u;
#pragma unroll 4
        for (int bit = 31; bit >= 0; --bit) { const unsigned cand = T | (1u << bit); if (bcnt(ck >= cand) >= r) T = cand; }
        ngt = chi + bcnt(ck > T); neq = bcnt(ck == T);
    } else {
        T = 0u;
#pragma unroll 1
        for (int bit = 31; bit >= 0; --bit) { const unsigned cand = T | (1u << bit); int c = 0;
#pragma unroll
            for (int i = 0; i < NB; ++i) c += bcnt(i < nb && fkey(v[i]) >= cand);
            if (c >= TOPK) T = cand; }
        ngt = 0; neq = 0;
#pragma unroll
        for (int i = 0; i < NB; ++i) { const unsigned k = fkey(v[i]); ngt += bcnt(i < nb && k > T); neq += bcnt(i < nb && k == T); }
    }
    const int need_eq = TOPK - ngt;
    asm volatile("s_waitcnt lgkmcnt(0)" ::: "memory");
    int base = 0, tb = 0;
    const bool alleq = (neq == need_eq);
#pragma unroll
    for (int i = 0; i < NB; ++i) if (i < nb) { const unsigned k = fkey(v[i]);
        bool f = k >= T;
        if (!alleq) { const bool eq = (k == T); const unsigned long long me = __ballot(eq);
            const int er = tb + __builtin_amdgcn_mbcnt_hi((unsigned)(me >> 32), __builtin_amdgcn_mbcnt_lo((unsigned)me, 0));
            f = (k > T) || (eq && er < need_eq); tb += __popcll(me); }
        const unsigned long long mf = __ballot(f); const int pos = base + __builtin_amdgcn_mbcnt_hi((unsigned)(mf >> 32), __builtin_amdgcn_mbcnt_lo((unsigned)mf, 0));
        if (f && pos < TOPK) il[pos] = (unsigned short)(64 * i + lane);
        base += __popcll(mf); }
}
__device__ __forceinline__ void dsa_topk(const LAS float* sc, LAS unsigned short* il, int limit, int lane) {
    if (limit <= 512) dsa_topk_t<8>(sc, il, limit, lane);
    else if (limit <= 1024) dsa_topk_t<16>(sc, il, limit, lane);
    else dsa_topk_t<32>(sc, il, limit, lane);
}

struct DsaQ { bf16x8 qf[4]; f32x4 ps; };
__device__ __forceinline__ DsaQ dsa_load_q(const bf16_t* QH, const float* PS, size_t trow, int lane) {
    const int li = lane & 15, g = lane >> 4; DsaQ q;
#pragma unroll
    for (int s = 0; s < 4; ++s) { q.qf[s] = (bf16x8){0, 0, 0, 0, 0, 0, 0, 0}; if (li < 8) q.qf[s] = *(const bf16x8*)(QH + trow * 1024 + li * 128 + 32 * s + 8 * g); }
    q.ps = (f32x4){1.f, 1.f, 1.f, 1.f};
    if (li < 8) { const float* pp = PS + (size_t)((li >> 1) * 8 + (li & 1) * 4) * M + trow; q.ps = (f32x4){pp[0], pp[(size_t)M], pp[(size_t)2 * M], pp[(size_t)3 * M]}; }
    return q;
}
__device__ __forceinline__ void dsa_attend(LAS unsigned char* wl, const LAS unsigned short* il, const LAS float* rctab, LAS float* rcl, const DsaQ& Q, const bf16_t* Cb, bf16_t* AO, size_t trow, int b, int count, float bound_l2, int lane) {
    const int li = lane & 15, g = lane >> 4;
    typedef __attribute__((address_space(3))) s16x4 lds_s16x4;
    bf16x8 qf[4];
#pragma unroll
    for (int s = 0; s < 4; ++s) qf[s] = Q.qf[s];
    const float rq = (li < 8) ? rsqrtf(((Q.ps[0] + Q.ps[1]) + (Q.ps[2] + Q.ps[3])) * (1.0f / 128.0f) + EPS) * 1.4426950408889634f : 0.f;
    const bf16_t* cbase = Cb + (size_t)b * SEQ * 128; const unsigned wlb = lds_addr(wl);
#define DSA_GATHER(ci_, buf_) do { const u32x4 kw_ = *(const LAS u32x4*)(il + 32 * (ci_) + 8 * (lane >> 4)); \
        _Pragma("unroll") for (int i = 0; i < 8; ++i) { const int row = 4 * i + (lane >> 4); const unsigned kk_ = (i < 2 ? kw_.x : i < 4 ? kw_.y : i < 6 ? kw_.z : kw_.w); const int key = (i & 1) ? (int)(kk_ >> 16) : (int)(kk_ & 0xffffu); \
        const int sc_ = (lane & 15) ^ ((row & 7) << 1); \
        glds16_asm(cbase + (size_t)key * 128 + sc_ * 8, wlb + (buf_) * 8192 + i * 1024); } } while (0)
    for (int pos = lane; pos < count; pos += 64) { const int e = pos & 31; rcl[(pos & ~31) + 4 * (e & 7) + (e >> 3)] = rctab[il[pos]]; }
    asm volatile("s_waitcnt lgkmcnt(0)" ::: "memory");
    f32x4 oacc[8];
#pragma unroll
    for (int d = 0; d < 8; ++d) oacc[d] = (f32x4){0.f, 0.f, 0.f, 0.f};
    float lsum = 0.f;
    const int nch = count >> 5;
    DSA_GATHER(0, 0);
#pragma unroll 1
    for (int ci = 0; ci < nch; ++ci) {
        const int cur = ci & 1;
        if (ci + 1 < nch) { DSA_GATHER(ci + 1, cur ^ 1); if (DSA_REP & 8) { DSA_GATHER(ci + 1, cur ^ 1); asm volatile("s_waitcnt vmcnt(16)" ::: "memory"); } else asm volatile("s_waitcnt vmcnt(8)" ::: "memory"); } else { asm volatile("s_waitcnt vmcnt(0)" ::: "memory"); }
        const LAS unsigned char* ct = wl + cur * 8192;
        f32x4 lt[2];
        bf16x8 ca[2][4];
#pragma unroll
        for (int T = 0; T < 2; ++T) { const int row = 16 * T + li; const LAS unsigned char* rp = ct + row * 256; const int sw = (row & 7) << 1;
#pragma unroll
            for (int s = 0; s < 4; ++s) ca[T][s] = *(const LAS bf16x8*)(rp + (((4 * s + g) ^ sw) * 16)); }
        f32x4 rcv[2];
#pragma unroll
        for (int T = 0; T < 2; ++T) rcv[T] = *(const LAS f32x4*)(rcl + 32 * ci + 16 * T + 4 * g);
        __builtin_amdgcn_sched_barrier(0);
#pragma unroll
        for (int T = 0; T < 2; ++T) { lt[T] = (f32x4){0.f, 0.f, 0.f, 0.f};
#pragma unroll
            for (int s = 0; s < 4; ++s) lt[T] = __builtin_amdgcn_mfma_f32_16x16x32_bf16(ca[T][s], qf[s], lt[T], 0, 0, 0); }
        bf16x8 cv[8];
#pragma unroll
        for (int dt = 0; dt < 8; ++dt) {
            const int r0 = 4 * g + (li >> 2), r1 = r0 + 16; const int cch = 2 * dt + ((li >> 1) & 1), hb = (li & 1) * 8;
            const s16x4 lo = __builtin_bit_cast(s16x4, __builtin_amdgcn_ds_read_tr16_b64_v4i16((lds_s16x4*)(ct + r0 * 256 + ((cch ^ ((r0 & 7) << 1)) * 16) + hb)));
            const s16x4 hi = __builtin_bit_cast(s16x4, __builtin_amdgcn_ds_read_tr16_b64_v4i16((lds_s16x4*)(ct + r1 * 256 + ((cch ^ ((r1 & 7) << 1)) * 16) + hb)));
            cv[dt] = cat4(lo, hi); }
        __builtin_amdgcn_sched_barrier(0);
        bf16x8 pf;
#pragma unroll
        for (int T = 0; T < 2; ++T) { float pv[4];
#pragma unroll
            for (int r = 0; r < 4; ++r) { pv[r] = __builtin_amdgcn_exp2f(lt[T][r] * rq * rcv[T][r] - bound_l2); lsum += pv[r]; }
            const unsigned w0 = pk2(pv[0], pv[1]), w1 = pk2(pv[2], pv[3]);
            pf[4 * T + 0] = (short)(w0 & 0xffff); pf[4 * T + 1] = (short)(w0 >> 16); pf[4 * T + 2] = (short)(w1 & 0xffff); pf[4 * T + 3] = (short)(w1 >> 16); }
#pragma unroll
        for (int dt = 0; dt < 8; ++dt) oacc[dt] = __builtin_amdgcn_mfma_f32_16x16x32_bf16(cv[dt], pf, oacc[dt], 0, 0, 0);
    }
#undef DSA_GATHER
    lsum += __shfl_xor(lsum, 16); lsum += __shfl_xor(lsum, 32);
    const float inv = 1.0f / lsum;
    if (li < 8) {
#pragma unroll
        for (int dt = 0; dt < 8; ++dt) { u32x2 o; o.x = pk2(oacc[dt][0] * inv, oacc[dt][1] * inv); o.y = pk2(oacc[dt][2] * inv, oacc[dt][3] * inv);
            *(u32x2*)(AO + trow * 1024 + li * 128 + 16 * dt + 4 * g) = o; }
    }
}

__device__ __forceinline__ void dsa_fast_phase(LAS unsigned char* lds, const bf16_t* QH, const bf16_t* Cb, const float* PS, const bf16_t* QI, const bf16_t* KI, const float* WI, const float* CSC, bf16_t* AO, int vcu, int G) {
    int tid_ = threadIdx.x; asm volatile("" : "+v"(tid_));
    const int tid = tid_, lane0 = tid & 63, w = __builtin_amdgcn_readfirstlane(tid >> 6);
    LAS unsigned char* wl = lds + DSA_SC + w * 16384; LAS float* rctab = (LAS float*)(lds + DSA_KST);
    LAS unsigned short* il0 = (LAS unsigned short*)(lds + DSA_IDX + (2 * w) * 512); LAS unsigned short* il1 = il0 + 256;
    float mxs = 0.f;
    for (int i = lane0; i < 128; i += 64) mxs = fmaxf(mxs, fabsf(CSC[i]));
#pragma unroll
    for (int o = 1; o < 64; o <<= 1) mxs = fmaxf(mxs, __shfl_xor(mxs, o));
    const float bound_l2 = mxs * 128.0f * 1.4426950408889634f;
    for (int wg = vcu; wg < 256; wg += G) {
        const int b = wg >> 5, r = wg & 31;
        __syncthreads();
        for (int k = tid; k < SEQ; k += NWAVES * 64) { const float* pp = PS + (size_t)32 * M + (size_t)b * SEQ + k;
            rctab[k] = rsqrtf(((pp[0] + pp[(size_t)M]) + (pp[(size_t)2 * M] + pp[(size_t)3 * M])) * (1.0f / 128.0f) + EPS); }
#pragma unroll 1
        for (int it = 0; it < 4; ++it) {
            int lane = lane0; asm volatile("" : "+v"(lane));
            const int li = lane & 15, g = lane >> 4;
            const int chunk = (it & 1) ? 31 - (r & 15) : (r & 15), sub = 2 * (r >> 4) + (it >> 1);
            const int t0 = chunk * 64 + sub * 16, limit = (chunk + 1) * 64;
            const size_t trow0 = (size_t)b * SEQ + t0 + 2 * w;
            const DsaQ Q0 = dsa_load_q(QH, PS, trow0, lane), Q1 = dsa_load_q(QH, PS, trow0 + 1, lane);
            LAS float* wqt = (LAS float*)(lds + DSA_WQ);
            if (limit > TOPK && tid < 128) { const int qq = tid >> 3, hh = tid & 7; const size_t row = (size_t)b * SEQ + t0 + qq;
                const float* ps = PS + (size_t)(40 + (hh >> 2) * 8 + ((hh >> 1) & 1) * 4 + 2 * (hh & 1)) * M + row;
                wqt[tid] = WI[row * 8 + hh] * rsqrtf((ps[0] + ps[(size_t)M]) * (1.0f / 64.0f) + EPS); }
            __syncthreads();
            if (limit > TOPK) {
                for (int srep = 0; srep < 1 + (DSA_REP & 1); ++srep) {
                bf16x8 af[8][2]; float wq[8][4];
                const size_t trowi = (size_t)b * SEQ + t0;
#pragma unroll
                for (int p = 0; p < 8; ++p) {
#pragma unroll
                    for (int sidx = 0; sidx < 2; ++sidx) af[p][sidx] = *(const bf16x8*)(QI + (trowi + 2 * p + (li >> 3)) * 512 + (li & 7) * 64 + 32 * sidx + 8 * g);
                    const f32x4 wv = *(const LAS f32x4*)(wqt + (2 * p + (g >> 1)) * 8 + 4 * (g & 1));
                    wq[p][0] = wv[0]; wq[p][1] = wv[1]; wq[p][2] = wv[2]; wq[p][3] = wv[3];
                    asm volatile("" ::: "memory"); }
                const int nst = limit >> 4;
                const bf16_t* kp = KI + ((size_t)b * SEQ + 16 * w + li) * 64 + 8 * g; const float* pp = PS + (size_t)36 * M + (size_t)b * SEQ + 16 * w + li;
                bf16x8 b0 = *(const bf16x8*)kp, b1 = *(const bf16x8*)(kp + 32); f32x2_t pk = (f32x2_t){pp[0], pp[(size_t)M]};
                bf16x8 d0 = b0, d1 = b1; f32x2_t pk2v = pk;
                if (w + 8 < nst) { kp += 8 * 16 * 64; pp += 8 * 16; d0 = *(const bf16x8*)kp; d1 = *(const bf16x8*)(kp + 32); pk2v = (f32x2_t){pp[0], pp[(size_t)M]}; }
#pragma unroll 1
                for (int st = w; st < nst; st += 8) {
                    const bf16x8 c0 = b0, c1 = b1; const float rk = rsqrtf((pk[0] + pk[1]) * (1.0f / 64.0f) + EPS);
                    b0 = d0; b1 = d1; pk = pk2v;
                    if (st + 16 < nst) { kp += 8 * 16 * 64; pp += 8 * 16; d0 = *(const bf16x8*)kp; d1 = *(const bf16x8*)(kp + 32); pk2v = (f32x2_t){pp[0], pp[(size_t)M]}; }
                    LAS float* so = (LAS float*)(lds + DSA_SC) + (g >> 1) * 2048 + 16 * st + li;
#pragma unroll
                    for (int p = 0; p < 8; ++p) {
                        f32x4 acc = (f32x4){0.f, 0.f, 0.f, 0.f};
                        acc = __builtin_amdgcn_mfma_f32_16x16x32_bf16(af[p][0], c0, acc, 0, 0, 0); acc = __builtin_amdgcn_mfma_f32_16x16x32_bf16(af[p][1], c1, acc, 0, 0, 0);
                        float part = (fmaxf(acc[0], 0.f) * wq[p][0] + fmaxf(acc[1], 0.f) * wq[p][1]) + (fmaxf(acc[2], 0.f) * wq[p][2] + fmaxf(acc[3], 0.f) * wq[p][3]);
                        {   const auto sw = __builtin_amdgcn_permlane16_swap(__float_as_uint(part), __float_as_uint(part), false, false);
                            part = __uint_as_float(sw[0]) + __uint_as_float(sw[1]); }
                        if ((g & 1) == 0) so[p * 4096] = part * rk + 0.0f;
                    }
                }
                __syncthreads();
                }
                for (int trep = 0; trep < 1 + ((DSA_REP >> 1) & 1); ++trep) {
                dsa_topk((const LAS float*)wl, il0, limit, lane);
                dsa_topk((const LAS float*)wl + 2048, il1, limit, lane); }
            } else {
                for (int j = lane; j < limit; j += 64) { il0[j] = (unsigned short)j; il1[j] = (unsigned short)j; }
            }
            const int count = limit < TOPK ? limit : TOPK;
            for (int arep = 0; arep < 1 + ((DSA_REP >> 2) & 1); ++arep) {
            dsa_attend(wl, il0, rctab, (LAS float*)(lds + DSA_KST + 8192 + w * 1024), Q0, Cb, AO, trow0, b, count, bound_l2, lane);
            dsa_attend(wl, il1, rctab, (LAS float*)(lds + DSA_KST + 8192 + w * 1024), Q1, Cb, AO, trow0 + 1, b, count, bound_l2, lane); }
        }
    }
    __syncthreads();
}

typedef const __attribute__((address_space(4))) Args* ArgsP;
__device__ __forceinline__ ArgsP fresh_args() { ArgsP p = (ArgsP)__builtin_amdgcn_kernarg_segment_ptr(); asm volatile("" : "+s"(p)); return p; }

__device__ __forceinline__ int fresh_bx() { int v = blockIdx.x; asm volatile("" : "+s"(v)); return v; }
__device__ __forceinline__ int fresh_gx() { int v = gridDim.x; asm volatile("" : "+s"(v)); return v; }
__global__ void __launch_bounds__(NWAVES * 64, 2) mega(Args args_unused) {
    extern __shared__ __attribute__((aligned(16))) unsigned char lds_raw[];
    LAS unsigned char* lds = (LAS unsigned char*)lds_raw;
    const int tid = threadIdx.x;
    for (int u = tid; u < (LDS_BYTES - LDSCTL_OFF) / 4; u += NWAVES * 64) ((LAS unsigned*)(lds + LDSCTL_OFF))[u] = 0u;
    __syncthreads();
    int lo, hi;
    {   ArgsP A = fresh_args(); lo = A->ph_lo; hi = A->ph_hi;
        if (hi - lo > 1) (void)xcd_barrier_post((unsigned*)(A->ws + WS_CTL) + CW_BAR + A->li * XCD_BAR_WORDS, (volatile LAS unsigned*)(lds + MISC_OFF) + 8); }
#ifndef PHMASK
#define PHMASK 0xffff
#endif
#define IN(k) (((PHMASK >> (k)) & 1) && lo <= (k) && (k) < hi)
#define SEAM(k) do { if (lo <= (k) && (k) + 1 < hi) { ArgsP A_ = fresh_args(); XcdBarrier b_; b_.bar = (unsigned*)(A_->ws + WS_CTL) + CW_BAR + A_->li * XCD_BAR_WORDS; b_.x = xb_xcc_id(); \
        b_.st = (volatile LAS unsigned*)(lds + MISC_OFF) + 8; xcd_barrier(b_); } } while (0)
#ifndef REPMASK
#define REPMASK 0
#endif
#define GBAR() do { ArgsP A_ = fresh_args(); XcdBarrier b_; b_.bar = (unsigned*)(A_->ws + WS_CTL) + CW_BAR + A_->li * XCD_BAR_WORDS; b_.x = xb_xcc_id(); \
        b_.st = (volatile LAS unsigned*)(lds + MISC_OFF) + 8; xcd_barrier(b_); } while (0)
#define REPEAT(k) for (int rep_ = 0; rep_ < 1 + ((REPMASK >> (k)) & 1); ++rep_)
#define REPBAR() do { if (rep_) GBAR(); } while (0)
#define GWS int t_ = threadIdx.x; asm volatile("" : "+v"(t_)); const int lane = t_ & 63, wave = __builtin_amdgcn_readfirstlane(t_ >> 6); const int G = fresh_gx(), bx = fresh_bx(); const int vcu = (G % 8 == 0) ? (bx % 8) * (G / 8) + bx / 8 : bx; \
        const int gw = vcu * NWAVES + wave, NGW = G * NWAVES; LAS float* scr = (LAS float*)(lds + wave * 16640); (void)lane; (void)gw; (void)NGW; (void)scr;
#define WCONV(Wp, K_, Nsrc_, N_, mode_, gain_, WT_) do { const int items_ = ((K_) / 64) * ((N_) / 64); \
        for (int it = gw; it < items_; it += NGW) p0_transpose_item((Wp), (K_), (Nsrc_), (N_), (mode_), (gain_), (WT_), scr, it, lane); } while (0)

    if (IN(PH_PRO)) REPEAT(PH_PRO) { REPBAR();
        GWS; ArgsP A = fresh_args(); unsigned char* ws = A->ws;
        constexpr int I0 = 16 * 28, I1 = I0 + 16 * 16, I4 = I1 + 16 * 88, I5 = I4 + 44 * 16, IX = I5 + M / 4;
        {   const float* x = A->in[0]; float* SS = (float*)(ws + WS_SS); bf16_t* XB = (bf16_t*)(ws + WS_XB);
#pragma unroll 1
            for (int it = gw; it < IX; it += NGW) {
                if (it < I0) p0_transpose_item(A->in[3], 1024, A_IN_COLS, A_IN_PAD, WM_AIN, A->in[1], (bf16_t*)(ws + WS_WAIN), scr, it, lane);
                else if (it < I1) p0_transpose_item(A->in[8], 1024, 1024, 1024, WM_NAT, (const float*)nullptr, (bf16_t*)(ws + WS_WAOUT), scr, it - I0, lane);
                else if (it < I4) p0_transpose_item(A->in[12], 1024, FF2, FF2, WM_FUP, A->in[2], (bf16_t*)(ws + WS_WFUP0), scr, it - I1, lane);
                else if (it < I5) p0_transpose_item(A->in[15], 2816, 1024, 1024, WM_NAT, (const float*)nullptr, (bf16_t*)(ws + WS_WFDN0), scr, it - I4, lane);
                else { const int row0 = (it - I5) * 4;
                    f32x4 v[4][4];
#pragma unroll
                    for (int r = 0; r < 4; ++r)
#pragma unroll
                        for (int q = 0; q < 4; ++q) v[r][q] = ((const f32x4*)(x + (size_t)(row0 + r) * DM))[q * 64 + lane];
#pragma unroll
                    for (int r = 0; r < 4; ++r)
#pragma unroll
                        for (int q = 0; q < 4; ++q) { const f32x4 w = v[r][q]; float sq = (w[0] * w[0] + w[1] * w[1]) + (w[2] * w[2] + w[3] * w[3]); sq = wave_sum(sq);
                            if (lane < 4) SS[(size_t)(q * 4 + lane) * M + row0 + r] = lane == 0 ? sq : 0.f;
                            u32x2 o; o.x = pk2(w[0], w[1]); o.y = pk2(w[2], w[3]); *(u32x2*)(XB + (size_t)(row0 + r) * DM + q * 256 + lane * 4) = o; } } } }
        {   float2* ROPE = (float2*)(ws + WS_ROPE);
            for (int e = gw * 64 + lane; e < 2048 * 128; e += NGW * 64) { const int t = e >> 7, i = e & 127;
                const float inv = exp2f(-(float)(2 * i) * (13.287712379549449f / 256.0f)), ang = (float)t * inv; float sn, cs; sincosf(ang, &sn, &cs); ROPE[e] = make_float2(cs, sn); } }
        {   float* CSC = (float*)(ws + WS_CSC); const float* a_q_g = A->in[4]; const float* a_k_g = A->in[5]; const float* a_iq_g = A->in[6]; const float* a_ik_g = A->in[7];
            for (int n = gw * 64 + lane; n < A_IN_PAD; n += NGW * 64) { float v;
                if (n < 1024) v = a_q_g[n & 127] * a_k_g[n & 127] * 0.08838834764831845f; else if (n < 1152) v = 1.0f; else if (n < 1216) v = a_ik_g[n - 1152];
                else if (n < 1224) v = 0.044194173824159216f; else if (n < 1280) v = 0.f; else v = a_iq_g[(n - 1280) & 63];
                CSC[n] = v; } }
    }
    SEAM(PH_PRO);
    if (IN(PH_A1)) REPEAT(PH_A1) { REPBAR();
        ArgsP A = fresh_args(); unsigned char* ws = A->ws;
        pg8::Gemm g{(const bf16_t*)(ws + WS_XB), (const bf16_t*)(ws + WS_WAIN), M, A_IN_PAD, 1024}; pg8::StaticOrder S; S.init(M, A_IN_PAD, fresh_gx(), fresh_bx());
        pg8::EpiA1 E{(const float*)(ws + WS_SS), (const float*)(ws + WS_CSC), (bf16_t*)(ws + WS_QH), (bf16_t*)(ws + WS_C), (bf16_t*)(ws + WS_KI), (bf16_t*)(ws + WS_QI), (float*)(ws + WS_WI), (float*)(ws + WS_PS)};
        pg8::gemm_phase(lds, g, S, E);
    }
    SEAM(PH_A1);
    if (IN(PH_A2)) REPEAT(PH_A2) { REPBAR();
        ArgsP A = fresh_args(); unsigned char* ws = A->ws; const int G = fresh_gx(), bx = fresh_bx(); const int vcu = (G % 8 == 0) ? (bx % 8) * (G / 8) + bx / 8 : bx;
        dsa_fast_phase(lds, (const bf16_t*)(ws + WS_QH), (const bf16_t*)(ws + WS_C), (const float*)(ws + WS_PS), (const bf16_t*)(ws + WS_QI), (const bf16_t*)(ws + WS_KI), (const float*)(ws + WS_WI), (const float*)(ws + WS_CSC), (bf16_t*)(ws + WS_AO), vcu, G);
    }
    SEAM(PH_A2);
    if (IN(PH_A3)) REPEAT(PH_A3) { REPBAR();
        ArgsP A = fresh_args(); unsigned char* ws = A->ws;
        pg8::Gemm g{(const bf16_t*)(ws + WS_AO), (const bf16_t*)(ws + WS_WAOUT), M, 1024, 1024}; pg8::StaticOrder S; S.init(M, 1024, fresh_gx(), fresh_bx());
        pg8::EpiRes<1> E{nullptr, nullptr, (bf16_t*)(ws + WS_XB), (float*)(ws + WS_SS)};
        pg8::gemm_phase(lds, g, S, E);
    }
    SEAM(PH_A3);
#define FFN_PHASES(LAYER, PH1, PH2) do { \
        if (IN(PH1)) REPEAT(PH1) { REPBAR(); \
            ArgsP A = fresh_args(); unsigned char* ws = A->ws; \
            pg8::Gemm g{(const bf16_t*)(ws + WS_XB), (const bf16_t*)(ws + ((LAYER) ? WS_WFUP1 : WS_WFUP0)), M, FF2, 1024}; pg8::StaticOrder S; S.init(M, FF2, fresh_gx(), fresh_bx()); \
            pg8::EpiF1 E{(const float*)(ws + WS_SS), A->in[13] + (size_t)(LAYER) * 3 * FF2, A->in[14] + (size_t)(LAYER) * FF2, (bf16_t*)(ws + ((LAYER) ? WS_H1 : WS_H0)), \
                         (float*)(ws + ((LAYER) ? WS_PART1 : WS_PART0)), (float*)(ws + ((LAYER) ? WS_HALO1 : WS_HALO0))}; \
            pg8::gemm_phase(lds, g, S, E); \
            {     \
                int t_ = threadIdx.x; asm volatile("" : "+v"(t_)); const int lane = t_ & 63, wave = __builtin_amdgcn_readfirstlane(t_ >> 6); LAS float* scr = (LAS float*)(lds + wave * 16640); \
                const int G_ = fresh_gx(), c_ = fresh_bx(); const int rem_ = ((M / 256) * (FF2 / 256)) % G_; \
                if (c_ >= rem_) { const int nw_ = (G_ - rem_) * NWAVES, w0_ = (c_ - rem_) * NWAVES + wave; \
                    if ((LAYER) == 0) { _Pragma("unroll 1") for (int it = w0_; it < 16 * 96 + 32 * 16; it += nw_) { \
                        if (it < 16 * 96) p0_transpose_item(A->in[9], 1024, B_IN_COLS, B_IN_COLS, WM_NAT, A->in[1] + 1024, (bf16_t*)(ws + WS_WBIN), scr, it, lane); \
                        else p0_transpose_item(A->in[11], 2048, 1024, 1024, WM_NAT, A->in[10], (bf16_t*)(ws + WS_WBOUT), scr, it - 16 * 96, lane); } } \
                    else { _Pragma("unroll 1") for (int it = w0_; it < 44 * 16; it += nw_) \
                        p0_transpose_item(A->in[15] + (size_t)2816 * 1024, 2816, 1024, 1024, WM_NAT, (const float*)nullptr, (bf16_t*)(ws + WS_WFDN1), scr, it, lane); } } } \
        } \
        SEAM(PH1); \
        if (IN(PH2)) { \
            ArgsP A = fresh_args(); unsigned char* ws = A->ws; bf16_t* Hb = (bf16_t*)(ws + ((LAYER) ? WS_H1 : WS_H0)); \
            pg8::Gemm g{Hb, (const bf16_t*)(ws + ((LAYER) ? WS_WFDN1 : WS_WFDN0)), M, 1024, D_FF}; pg8::StaticOrder S; S.init(M, 1024, fresh_gx(), fresh_bx()); \
            {   pg8::Unit u0; if (S.next(0, u0)) ffn_fixup(u0.pm, A->in[13] + (size_t)(LAYER) * 3 * FF2, (const float*)(ws + ((LAYER) ? WS_PART1 : WS_PART0)), (const float*)(ws + ((LAYER) ? WS_HALO1 : WS_HALO0)), Hb); \
                VM_WAIT(); __syncthreads(); } \
            if ((LAYER) == 0) { pg8::EpiRes<1> E{nullptr, nullptr, (bf16_t*)(ws + WS_XB), (float*)(ws + WS_SS)}; pg8::gemm_phase(lds, g, S, E); } \
            else { pg8::EpiRes<2> E{nullptr, A->out, (bf16_t*)(ws + WS_XB), nullptr}; pg8::gemm_phase(lds, g, S, E); } \
        } \
        SEAM(PH2); } while (0)
    FFN_PHASES(0, PH_F1A, PH_F2A);
    if (IN(PH_B1)) REPEAT(PH_B1) { REPBAR();
        ArgsP A = fresh_args(); unsigned char* ws = A->ws;
        pg8::Gemm g{(const bf16_t*)(ws + WS_XB), (const bf16_t*)(ws + WS_WBIN), M, 4096, 1024}; pg8::StaticOrder S; S.init(M, 4096, fresh_gx(), fresh_bx());
        pg8::EpiB1 E{(const float*)(ws + WS_SS), (const float2*)(ws + WS_ROPE), (bf16_t*)(ws + WS_QT), (bf16_t*)(ws + WS_KT), (bf16_t*)(ws + WS_VT)};
        pg8::gemm_phase(lds, g, S, E);
    }
    SEAM(PH_B1);
    if (IN(PH_B2)) REPEAT(PH_B2) { REPBAR();
        ArgsP A = fresh_args(); unsigned char* ws = A->ws;
        { const int G = fresh_gx(), bx = fresh_bx(); const int vcu = (G % 8 == 0) ? (bx % 8) * (G / 8) + bx / 8 : bx;
          for (int u = vcu; u < 256; u += G) ret_fast_phase(lds, (const bf16_t*)(ws + WS_QT), (const bf16_t*)(ws + WS_KT), (const bf16_t*)(ws + WS_VT), (bf16_t*)(ws + WS_RET), (float*)(ws + WS_SSR), u); }
    }
    SEAM(PH_B2);
    if (IN(PH_GATE)) REPEAT(PH_GATE) { REPBAR();
        {   ArgsP A = fresh_args(); unsigned char* ws = A->ws;
            pg8::Gemm g{(const bf16_t*)(ws + WS_XB), (const bf16_t*)(ws + WS_WBIN) + (size_t)4096 * 1024, M, 2048, 1024}; pg8::StaticOrder S; S.init(M, 2048, fresh_gx(), fresh_bx());
            pg8::EpiGate E{(const float*)(ws + WS_SS), (const float*)(ws + WS_SSR), (bf16_t*)(ws + WS_RET)};
            pg8::gemm_phase(lds, g, S, E); }
#if !defined(NO_WCONV2)
        {   GWS; ArgsP A = fresh_args(); unsigned char* ws = A->ws; constexpr int J0 = 16 * 88;
#pragma unroll 1
            for (int it = gw; it < J0; it += NGW) p0_transpose_item(A->in[12] + (size_t)1024 * FF2, 1024, FF2, FF2, WM_FUP, A->in[2] + 1024, (bf16_t*)(ws + WS_WFUP1), scr, it, lane); }
#endif
    }
    SEAM(PH_GATE);
    if (IN(PH_B3)) REPEAT(PH_B3) { REPBAR();
        ArgsP A = fresh_args(); unsigned char* ws = A->ws;
        pg8::Gemm g{(const bf16_t*)(ws + WS_RET), (const bf16_t*)(ws + WS_WBOUT), M, 1024, 2048}; pg8::StaticOrder S; S.init(M, 1024, fresh_gx(), fresh_bx());
        pg8::EpiRes<1> E{nullptr, nullptr, (bf16_t*)(ws + WS_XB), (float*)(ws + WS_SS)};
        pg8::gemm_phase(lds, g, S, E);
    }
    SEAM(PH_B3);
    FFN_PHASES(1, PH_F1B, PH_F2B);
#undef FFN_PHASES
#undef IN
#undef SEAM
}

extern "C" void kernel_launch(void* const* d_in, const int* in_sizes, int n_in, void* d_out, int out_size, void* d_ws, size_t ws_size, hipStream_t stream) {
    static int grid = 0;
    if (grid == 0) {
        int dev = 0, cus = 0, per_cu = 0;
        (void)hipGetDevice(&dev); (void)hipDeviceGetAttribute(&cus, hipDeviceAttributeMultiprocessorCount, dev);
        (void)hipFuncSetAttribute((const void*)mega, hipFuncAttributeMaxDynamicSharedMemorySize, LDS_BYTES);
        if (hipOccupancyMaxActiveBlocksPerMultiprocessor(&per_cu, (const void*)mega, NWAVES * 64, LDS_BYTES) != hipSuccess || per_cu < 1)
            fprintf(stderr, "kernel_launch: occupancy query reports %d workgroups per CU\n", per_cu);
        (void)hipGetLastError();
        grid = cus > 0 ? cus : 256;
        if (grid != 256) fprintf(stderr, "kernel_launch: %d CUs (built for 256)\n", grid);
    }
    unsigned char* ws = (unsigned char*)d_ws;
    (void)hipMemsetAsync(ws + WS_CTL, 0, CTL_ZERO_BYTES, stream);
    Args a{};
    for (int i = 0; i < 16; ++i) a.in[i] = (const float*)d_in[i];
    a.out = (float*)d_out; a.ws = ws;
    auto launch = [&](int lo, int hi, int li) { a.ph_lo = lo; a.ph_hi = hi; a.li = li; hipLaunchKernelGGL(mega, dim3(grid), dim3(NWAVES * 64), LDS_BYTES, stream, a); };
    launch(0, PH_END, 0);
}
```

```cpp
#include <hip/hip_runtime.h>
#include <stdint.h>
#include <stdio.h>

typedef unsigned short bf16_t;
typedef short bf16x8 __attribute__((ext_vector_type(8)));
typedef float f32x4 __attribute__((ext_vector_type(4)));
typedef unsigned u32x4 __attribute__((ext_vector_type(4)));
typedef unsigned u32x2 __attribute__((ext_vector_type(2)));

#ifndef MK_LAUNCH_MODE
#define MK_LAUNCH_MODE 1
#endif

constexpr int BATCH = 8, SEQ = 2048, DM = 1024, M = BATCH * SEQ;
constexpr int TOPK = 256;
constexpr int A_IN_COLS = 1736, A_IN_PAD = 1792;
constexpr int O2 = 1152, O3 = 1664, O4 = 1728;
constexpr int B_IN_COLS = 6144;
constexpr int D_FF = 2816, FF2 = 5632;
constexpr float EPS = 1e-6f;

constexpr size_t MiB = 1u << 20;
constexpr size_t WS_CTL = 0, CTL_ZERO_BYTES = 65536;
constexpr size_t WS_SS = 1 * MiB;
constexpr size_t WS_WI = 2 * MiB;
constexpr size_t WS_CSC = 2 * MiB + 512 * 1024;
constexpr size_t WS_ROPE = 3 * MiB;
constexpr size_t WS_SSR = 249 * MiB;
constexpr size_t WS_WBIN = 8 * MiB;
constexpr size_t WS_WBOUT = 20 * MiB;
constexpr size_t WS_XB = 24 * MiB;
constexpr size_t WS_WAIN = 56 * MiB;
constexpr size_t WS_WAOUT = 60 * MiB;
constexpr size_t WS_QH = 64 * MiB;
constexpr size_t WS_AO = 96 * MiB;
constexpr size_t WS_QI = 128 * MiB;
constexpr size_t WS_C = 144 * MiB;
constexpr size_t WS_KI = 148 * MiB;
constexpr size_t WS_PS = 150 * MiB;
constexpr size_t WS_WFUP0 = 232 * MiB;
constexpr size_t WS_WFDN0 = 243 * MiB;
constexpr size_t WS_H0 = 64 * MiB;
constexpr size_t WS_PART0 = 152 * MiB;
constexpr size_t WS_HALO0 = 155 * MiB;
constexpr size_t WS_QT = 56 * MiB;
constexpr size_t WS_KT = 88 * MiB;
constexpr size_t WS_VT = 120 * MiB;
constexpr size_t WS_RET = 184 * MiB;
constexpr size_t WS_WFUP1 = 56 * MiB;
constexpr size_t WS_WFDN1 = 67 * MiB;
constexpr size_t WS_H1 = 88 * MiB;
constexpr size_t WS_PART1 = 176 * MiB;
constexpr size_t WS_HALO1 = 179 * MiB;

__device__ __forceinline__ unsigned short f2bf(float f) { unsigned u = __float_as_uint(f); return (unsigned short)((u + 0x7fffu + ((u >> 16) & 1u)) >> 16); }
__device__ __forceinline__ float bf2f(unsigned short h) { return __uint_as_float(((unsigned)h) << 16); }
__device__ __forceinline__ float bflo(unsigned w) { return __uint_as_float(w << 16); }
__device__ __forceinline__ float bfhi(unsigned w) { return __uint_as_float(w & 0xffff0000u); }
typedef __bf16 bf16x2_t __attribute__((ext_vector_type(2)));
typedef float f32x2_t __attribute__((ext_vector_type(2)));
__device__ __forceinline__ unsigned pk2(float lo, float hi) { const f32x2_t v = {lo, hi}; return __builtin_bit_cast(unsigned, __builtin_convertvector(v, bf16x2_t)); }
__device__ __forceinline__ float wave_sum(float v) {
#pragma unroll
    for (int o = 1; o < 64; o <<= 1) v += __shfl_xor(v, o);
    return v;
}
__device__ __forceinline__ float siluf(float x) { return x * __builtin_amdgcn_rcpf(1.0f + __builtin_amdgcn_exp2f(-1.4426950408889634f * x)); }
__device__ __forceinline__ float gamma_log(int h) { return h == 0 ? -0.031748698314580301f : h == 1 ? -0.015748356968139168f : h == 2 ? -0.0078431774610258787f : -0.0039138993211363287f; }

enum { WM_NAT = 0, WM_AIN = 1, WM_FUP = 2 };
__device__ __forceinline__ int wmap(int mode, int n) {
    if (mode == WM_NAT) return n;
    if (mode == WM_AIN) {
        if (n < 1152) return n;
        if (n < 1216) return O3 + (n - 1152);
        if (n < 1224) return O4 + (n - 1216);
        if (n < 1280) return -1;
        return O2 + (n - 1280);
    }
    const int p = n >> 8, bj = (n >> 7) & 1, i = n & 127;
    return bj * D_FF + 128 * p + i;
}

namespace pg8 {
#define PG8_LAS __attribute__((address_space(3)))
constexpr int BM = 256, BK = 64, HALF = 128, HTB = HALF * BK * 2, STAGE_BYTES = 8 * HTB, NXCD = 8, WGM = 8;
constexpr int XCH_OFF = 0, CWT_OFF = 2048, RT1_OFF = 6144, RT2_OFF = 14336;
__host__ __device__ __forceinline__ int lds_byte(int r, int c) { const int st = (r >> 4) * 2 + (c >> 5), rr = r & 15, cc = c & 31, ob = rr * 64 + cc * 2; return st * 1024 + (ob ^ (((ob >> 9) & 1) << 5)); }
__host__ __device__ __forceinline__ void stage_rc(int b, int& R, int& C) { const int st = b / 1024, sb = b % 1024, swz = sb ^ (((sb >> 9) & 1) << 5); R = (st >> 1) * 16 + swz / 64; C = (st & 1) * 32 + (swz % 64) / 2; }
__host__ __device__ __forceinline__ int perm32(int rho) { const int n = rho >> 4, i = rho & 15; return 8 * (i >> 2) + 4 * n + (i & 3); }
struct Unit { int pm, pn; };
struct Gemm { const bf16_t* A; const bf16_t* Bt; int M, N, K; };
struct StaticOrder {
    int nM, nN, nwg, G, c;
    __host__ __device__ __forceinline__ void init(int M_, int N_, int G_, int c_) { nM = M_ / BM; nN = N_ / BM; nwg = nM * nN; G = G_; c = c_; }
    __host__ __device__ __forceinline__ bool next(int i, Unit& u) const {
        const long L = (long)i * G + c; if (L >= nwg) return false;
        int wgid = (int)L; { const int q = nwg / NXCD, r = nwg % NXCD, xcd = wgid % NXCD, off = wgid / NXCD; wgid = (xcd < r ? xcd * (q + 1) : r * (q + 1) + (xcd - r) * q) + off; }
        const int nig = WGM * nN, gid = wgid / nig, fm = gid * WGM, gsz = (nM - fm) < WGM ? (nM - fm) : WGM;
        u.pm = fm + ((wgid % nig) % gsz); u.pn = (wgid % nig) / gsz; return true;
    }
};
__device__ __forceinline__ float rstd16(const float* ss16, int row) {
    float s = 0.f;
#pragma unroll
    for (int g = 0; g < 16; ++g) s += ss16[(size_t)g * M + row];
    return rsqrtf(s * (1.0f / DM) + EPS);
}
__device__ __forceinline__ float sel4(const float (&s)[4], int fq) { return fq == 0 ? s[0] : fq == 1 ? s[1] : fq == 2 ? s[2] : s[3]; }
__device__ __forceinline__ float ssq8(const f32x4 a, const f32x4 b) { return ((a[0] * a[0] + a[1] * a[1]) + (a[2] * a[2] + a[3] * a[3])) + ((b[0] * b[0] + b[1] * b[1]) + (b[2] * b[2] + b[3] * b[3])); }
__device__ __forceinline__ u32x4 pack8(const f32x4 a, const f32x4 b) { u32x4 w; w.x = pk2(a[0], a[1]); w.y = pk2(a[2], a[3]); w.z = pk2(b[0], b[1]); w.w = pk2(b[2], b[3]); return w; }

template <int MODE>
struct EpiRes {
    static constexpr bool PERM = true;
    static constexpr bool AROWPERM = false;
    const float* basef; float* out; bf16_t* xb; float* ss16;
    static constexpr int NTAB = 0;
    __device__ __forceinline__ void fill(PG8_LAS unsigned char*, int, const Unit&, int) const {}
    __device__ __forceinline__ void operator()(f32x4 (&acc)[2][2][4][2], const Unit& u, int ui, int wr, int wc, int fr, int fq, PG8_LAS unsigned char*) const {
        const int row0 = u.pm * BM + wr * 64 + fr, colb = u.pn * BM + wc * 32 + 8 * fq;
#pragma unroll
        for (int ai = 0; ai < 2; ++ai) {
            f32x4 bv[4][2][2];
#pragma unroll
            for (int m = 0; m < 4; ++m)
#pragma unroll
                for (int bj = 0; bj < 2; ++bj) { const size_t o = (size_t)(row0 + ai * HALF + m * 16) * DM + colb + bj * HALF;
                    if (MODE == 0) { bv[m][bj][0] = *(const f32x4*)(basef + o); bv[m][bj][1] = *(const f32x4*)(basef + o + 4); }
                    else { const u32x4 w = *(const u32x4*)(xb + o); bv[m][bj][0] = (f32x4){bflo(w.x), bfhi(w.x), bflo(w.y), bfhi(w.y)}; bv[m][bj][1] = (f32x4){bflo(w.z), bfhi(w.z), bflo(w.w), bfhi(w.w)}; } }
            float sm[4];
#pragma unroll
            for (int m = 0; m < 4; ++m) { const int row = row0 + ai * HALF + m * 16; float s = 0.f;
#pragma unroll
                for (int bj = 0; bj < 2; ++bj) { const size_t o = (size_t)row * DM + colb + bj * HALF;
                    const f32x4 v0 = acc[ai][bj][m][0] + bv[m][bj][0], v1 = acc[ai][bj][m][1] + bv[m][bj][1];
                    if (MODE == 2) { *(f32x4*)(out + o) = v0; *(f32x4*)(out + o + 4) = v1; }
                    else { s += ssq8(v0, v1); *(u32x4*)(xb + o) = pack8(v0, v1); } }
                if (MODE != 2) { s += __shfl_xor(s, 16); s += __shfl_xor(s, 32); }
                sm[m] = s; }
            if (MODE != 2) ss16[(size_t)(u.pn * 4 + wc) * M + u.pm * BM + ai * HALF + wr * 64 + 16 * fq + fr] = sel4(sm, fq);
            asm volatile("" ::: "memory"); }
    }
};
struct EpiA1 {
    static constexpr bool PERM = true;
    static constexpr bool AROWPERM = false;
    const float* ss16; const float* csc; bf16_t* Q; bf16_t* C; bf16_t* KI; bf16_t* QI; float* WI; float* PS;
    static constexpr int NTAB = 1;
    __device__ __forceinline__ void fill(PG8_LAS unsigned char* xl, int i, const Unit& u, int t) const { ((PG8_LAS float*)(xl + RT1_OFF))[i * 256 + t] = rstd16(ss16, u.pm * BM + t); }
    __device__ __forceinline__ void operator()(f32x4 (&acc)[2][2][4][2], const Unit& u, int ui, int wr, int wc, int fr, int fq, PG8_LAS unsigned char* xl) const {
        const int row0 = u.pm * BM + wr * 64 + fr, pn = u.pn;
        const PG8_LAS float* rt = (const PG8_LAS float*)(xl + RT1_OFF) + ui * 256 + wr * 64 + fr;
        float rs[2][4];
#pragma unroll
        for (int ai = 0; ai < 2; ++ai)
#pragma unroll
            for (int m = 0; m < 4; ++m) rs[ai][m] = rt[ai * HALF + m * 16];
#pragma unroll
        for (int bj = 0; bj < 2; ++bj) {
            const int cl = bj * HALF + wc * 32 + 8 * fq, gcol = pn * BM + cl;
            const f32x4 c0 = *(const f32x4*)(csc + gcol), c1 = *(const f32x4*)(csc + gcol + 4);
            bf16_t* dst; int ld; bool st16 = true, stwi = false;
            if (pn < 4) { dst = Q + gcol; ld = 1024; }
            else if (pn == 4) { if (bj == 0) { dst = C + cl; ld = 128; } else if (wc < 2) { dst = KI + (wc * 32 + 8 * fq); ld = 64; } else { dst = Q; ld = 0; st16 = false; stwi = (wc == 2) && (fq == 0); } }
            else { dst = QI + (pn - 5) * 256 + cl; ld = 512; }
#pragma unroll
            for (int ai = 0; ai < 2; ++ai) { float sm[4];
#pragma unroll
                for (int m = 0; m < 4; ++m) { const int row = row0 + ai * HALF + m * 16; const float r = rs[ai][m];
                    const f32x4 v0 = acc[ai][bj][m][0] * r, v1 = acc[ai][bj][m][1] * r;
                    float s = ssq8(v0, v1); s += __shfl_xor(s, 16); s += __shfl_xor(s, 32); sm[m] = s;
                    const f32x4 o0 = v0 * c0, o1 = v1 * c1;
                    if (st16) *(u32x4*)(dst + (size_t)row * ld) = pack8(o0, o1);
                    if (stwi) { *(f32x4*)(WI + (size_t)row * 8) = o0; *(f32x4*)(WI + (size_t)row * 8 + 4) = o1; }
                    if (m & 1) asm volatile("" ::: "memory"); }
                PS[(size_t)(pn * 8 + bj * 4 + wc) * M + u.pm * BM + ai * HALF + wr * 64 + 16 * fq + fr] = sel4(sm, fq); }
        }
    }
};
struct EpiF1 {
    static constexpr bool PERM = false;
    static constexpr bool AROWPERM = true;
    static constexpr int NTAB = 1;
    const float* ss16; const float* cw; const float* cb; bf16_t* H; float* PART; float* HALO;
    __device__ __forceinline__ void fill(PG8_LAS unsigned char* xl, int i, const Unit& u, int t) const { ((PG8_LAS float*)(xl + RT1_OFF))[i * 256 + t] = rstd16(ss16, u.pm * BM + t); }
    __device__ __forceinline__ void operator()(f32x4 (&acc)[2][2][4][2], const Unit& u, int ui, int wr, int wc, int fr, int fq, PG8_LAS unsigned char* xl) const {
        const int trow0 = 8 * (16 * wr + fr), grow0 = u.pm * BM + trow0, hcol = 128 * u.pn + 32 * wc + 4 * fq, tcol = 32 * wc + 4 * fq;
        const PG8_LAS float* rt = (const PG8_LAS float*)(xl + RT1_OFF) + ui * 256 + trow0;
        {   const f32x4 r0 = *(const PG8_LAS f32x4*)rt, r1 = *(const PG8_LAS f32x4*)(rt + 4);
#pragma unroll
            for (int m = 0; m < 4; ++m)
#pragma unroll
                for (int bj = 0; bj < 2; ++bj) { acc[0][bj][m][0] *= r0[m]; acc[0][bj][m][1] *= r0[m]; acc[1][bj][m][0] *= r1[m]; acc[1][bj][m][1] *= r1[m]; } }
        {   PG8_LAS float* cwt = (PG8_LAS float*)(xl + CWT_OFF); const int tid = ((wr * 4 + wc) * 4 + fq) * 16 + fr;
#pragma unroll
            for (int r = 0; r < 2; ++r) { const int idx = tid + r * 512, k = idx >> 8, c = idx & 255, orig = (c < 128) ? 128 * u.pn + c : D_FF + 128 * u.pn + (c - 128);
                cwt[idx] = (k < 3) ? cw[(size_t)k * FF2 + orig] : cb[orig]; } }
        PG8_LAS f32x4* X = (PG8_LAS f32x4*)(xl + XCH_OFF) + (wc * 4 + fq) * 8;
        if (wr == 0 && fr == 15) {
#pragma unroll
            for (int bj = 0; bj < 2; ++bj)
#pragma unroll
                for (int e = 0; e < 2; ++e)
#pragma unroll
                    for (int n = 0; n < 2; ++n) X[(bj * 2 + e) * 2 + n] = acc[1][bj][2 + e][n];
        }
        asm volatile("s_waitcnt vmcnt(0) lgkmcnt(0)" ::: "memory"); __builtin_amdgcn_s_barrier(); asm volatile("" ::: "memory");
        const bool need_fix = (wr == 0) && (fr == 0) && ((u.pm & 7) != 0);
        const bool give_halo = (wr == 1) && (fr == 15);
        const bool take_x = (wr == 1) && (fr == 0);
        float* part = PART + (size_t)u.pm * (2 * 2 * D_FF) + hcol;
        float* halo = HALO + (size_t)u.pm * (2 * 2 * D_FF) + hcol;
        const PG8_LAS float* cwt = (const PG8_LAS float*)(xl + CWT_OFF) + tcol;
#pragma unroll
        for (int n = 0; n < 2; ++n) {
            f32x4 pa[2], pb[2];
#pragma unroll
            for (int e = 0; e < 2; ++e) {
                f32x4 ha = (f32x4){0.f, 0.f, 0.f, 0.f}, hb = (f32x4){0.f, 0.f, 0.f, 0.f};
                if (take_x) { ha = X[(0 * 2 + e) * 2 + n]; hb = X[(1 * 2 + e) * 2 + n]; }
#pragma unroll
                for (int j = 0; j < 4; ++j) {
                    pa[e][j] = __int_as_float(__builtin_amdgcn_update_dpp(__float_as_int(ha[j]), __float_as_int(acc[1][0][2 + e][n][j]), 0x111, 0xf, 0xf, false));
                    pb[e][j] = __int_as_float(__builtin_amdgcn_update_dpp(__float_as_int(hb[j]), __float_as_int(acc[1][1][2 + e][n][j]), 0x111, 0xf, 0xf, false)); } }
            const f32x4 wa0 = *(const PG8_LAS f32x4*)(cwt + 16 * n), wa1 = *(const PG8_LAS f32x4*)(cwt + 256 + 16 * n), wa2 = *(const PG8_LAS f32x4*)(cwt + 512 + 16 * n), ba = *(const PG8_LAS f32x4*)(cwt + 768 + 16 * n);
            const f32x4 wb0 = *(const PG8_LAS f32x4*)(cwt + 128 + 16 * n), wb1 = *(const PG8_LAS f32x4*)(cwt + 384 + 16 * n), wb2 = *(const PG8_LAS f32x4*)(cwt + 640 + 16 * n), bb = *(const PG8_LAS f32x4*)(cwt + 896 + 16 * n);
            if (give_halo) {
                *(f32x4*)(halo + 16 * n) = acc[1][0][2][n]; *(f32x4*)(halo + D_FF + 16 * n) = acc[1][1][2][n];
                *(f32x4*)(halo + 2 * D_FF + 16 * n) = acc[1][0][3][n]; *(f32x4*)(halo + 3 * D_FF + 16 * n) = acc[1][1][3][n]; }
            u32x2 wprev = (u32x2){0u, 0u};
#pragma unroll
            for (int e = 0; e < 8; ++e) {
                const f32x4 ua = acc[e >> 2][0][e & 3][n], ub = acc[e >> 2][1][e & 3][n];
                const f32x4 ua1 = e >= 1 ? acc[(e - 1) >> 2][0][(e - 1) & 3][n] : pa[1], ub1 = e >= 1 ? acc[(e - 1) >> 2][1][(e - 1) & 3][n] : pb[1];
                const f32x4 ua2 = e >= 2 ? acc[(e - 2) >> 2][0][(e - 2) & 3][n] : pa[e], ub2 = e >= 2 ? acc[(e - 2) >> 2][1][(e - 2) & 3][n] : pb[e];
                const f32x4 av = ba + wa2 * ua + wa1 * ua1 + wa0 * ua2, bv = bb + wb2 * ub + wb1 * ub1 + wb0 * ub2;
                if (e < 2 && need_fix) { *(f32x4*)(part + (size_t)e * 2 * D_FF + 16 * n) = av; *(f32x4*)(part + (size_t)e * 2 * D_FF + D_FF + 16 * n) = bv; }
                u32x2 w; w.x = pk2(siluf(av[0]) * bv[0], siluf(av[1]) * bv[1]); w.y = pk2(siluf(av[2]) * bv[2], siluf(av[3]) * bv[3]);
                if ((e & 1) == 0) wprev = w;
                else {
                    const auto sx = __builtin_amdgcn_permlane16_swap(wprev.x, w.x, false, false), sy = __builtin_amdgcn_permlane16_swap(wprev.y, w.y, false, false);
                    u32x4 w4; w4.x = sx[0]; w4.y = sy[0]; w4.z = sx[1]; w4.w = sy[1];
                    *(u32x4*)(H + (size_t)(grow0 + e - 1 + (fq & 1)) * D_FF + 128 * u.pn + 32 * wc + 16 * n + 4 * (fq & 2)) = w4; }
            }
            asm volatile("" ::: "memory");
        }
    }
};
struct EpiB1 {
    static constexpr bool PERM = false;
    static constexpr bool AROWPERM = true;
    static constexpr int NTAB = 1;
    const float* ss16; const float2* rope; bf16_t* QT; bf16_t* KT; bf16_t* VT;
    __device__ __forceinline__ void fill(PG8_LAS unsigned char* xl, int i, const Unit& u, int t) const { ((PG8_LAS float*)(xl + RT1_OFF))[i * 256 + t] = rstd16(ss16, u.pm * BM + t); }
    __device__ __forceinline__ void operator()(f32x4 (&acc)[2][2][4][2], const Unit& u, int ui, int wr, int wc, int fr, int fq, PG8_LAS unsigned char* xl) const {
        const int trow0 = 8 * (16 * wr + fr), grow0 = u.pm * BM + trow0, pn = u.pn, t0 = grow0 & (SEQ - 1);
        const PG8_LAS float* rt = (const PG8_LAS float*)(xl + RT1_OFF) + ui * 256 + trow0;
        const f32x4 r0 = *(const PG8_LAS f32x4*)rt, r1 = *(const PG8_LAS f32x4*)(rt + 4);
        if (pn < 8) {
            const int h = pn & 3; const bool isk = pn >= 4; const float lg = gamma_log(h);
            bf16_t* dbase = (isk ? KT : QT) + (size_t)grow0 * 1024 + h * 256 + 32 * wc + 4 * (fq & 2);
            float sc[8];
#pragma unroll
            for (int e = 0; e < 8; ++e) { const int pos = (t0 + e) & 63; sc[e] = (e < 4 ? r0[e & 3] : r1[e & 3]) * (isk ? 0.0625f * __expf(-(float)(pos + 1) * lg) : __expf((float)(pos + 1) * lg)); }
#pragma unroll
            for (int n = 0; n < 2; ++n) {
                const int i0 = 32 * wc + 16 * n + 4 * fq;
                f32x4 cur[2], dw[2];
                {   const f32x4* rp = (const f32x4*)(rope + (size_t)t0 * 128 + i0); const f32x4* rw = (const f32x4*)(rope + (size_t)128 + i0); cur[0] = rp[0]; cur[1] = rp[1]; dw[0] = rw[0]; dw[1] = rw[1]; }
                u32x2 p1 = (u32x2){0u, 0u}, p2 = (u32x2){0u, 0u};
#pragma unroll
                for (int e = 0; e < 8; ++e) {
                    const f32x4 c0 = cur[0], c1 = cur[1];
                    const f32x4 x1 = acc[e >> 2][0][e & 3][n] * sc[e], x2 = acc[e >> 2][1][e & 3][n] * sc[e];
                    f32x4 o1, o2;
                    o1[0] = x1[0] * c0[0] - x2[0] * c0[1]; o2[0] = x1[0] * c0[1] + x2[0] * c0[0];
                    o1[1] = x1[1] * c0[2] - x2[1] * c0[3]; o2[1] = x1[1] * c0[3] + x2[1] * c0[2];
                    o1[2] = x1[2] * c1[0] - x2[2] * c1[1]; o2[2] = x1[2] * c1[1] + x2[2] * c1[0];
                    o1[3] = x1[3] * c1[2] - x2[3] * c1[3]; o2[3] = x1[3] * c1[3] + x2[3] * c1[2];
                    u32x2 w1, w2; w1.x = pk2(o1[0], o1[1]); w1.y = pk2(o1[2], o1[3]); w2.x = pk2(o2[0], o2[1]); w2.y = pk2(o2[2], o2[3]);
                    if ((e & 1) == 0) { p1 = w1; p2 = w2; }
                    else {
                        const auto ax = __builtin_amdgcn_permlane16_swap(p1.x, w1.x, false, false), ay = __builtin_amdgcn_permlane16_swap(p1.y, w1.y, false, false);
                        const auto bx = __builtin_amdgcn_permlane16_swap(p2.x, w2.x, false, false), by = __builtin_amdgcn_permlane16_swap(p2.y, w2.y, false, false);
                        bf16_t* d = dbase + (size_t)(e - 1 + (fq & 1)) * 1024 + 16 * n;
                        u32x4 v1; v1.x = ax[0]; v1.y = ay[0]; v1.z = ax[1]; v1.w = ay[1]; *(u32x4*)d = v1;
                        u32x4 v2; v2.x = bx[0]; v2.y = by[0]; v2.z = bx[1]; v2.w = by[1]; *(u32x4*)(d + 128) = v2; }
                    if (e < 7) {
#pragma unroll
                        for (int q = 0; q < 2; ++q) { const f32x4 c = cur[q], dd = dw[q]; f32x4 nx;
                            nx[0] = c[0] * dd[0] - c[1] * dd[1]; nx[1] = c[1] * dd[0] + c[0] * dd[1]; nx[2] = c[2] * dd[2] - c[3] * dd[3]; nx[3] = c[3] * dd[2] + c[2] * dd[3]; cur[q] = nx; } }
                }
                asm volatile("" ::: "memory");
            }
        } else {
            const int b = grow0 / SEQ;
            bf16_t* dst = VT + ((size_t)b * 2048 + (pn - 8) * 256 + 32 * wc + 4 * fq) * SEQ + t0;
#pragma unroll
            for (int bj = 0; bj < 2; ++bj)
#pragma unroll
                for (int n = 0; n < 2; ++n)
#pragma unroll
                    for (int j = 0; j < 4; ++j) { u32x4 w;
                        w.x = pk2(acc[0][bj][0][n][j] * r0[0], acc[0][bj][1][n][j] * r0[1]); w.y = pk2(acc[0][bj][2][n][j] * r0[2], acc[0][bj][3][n][j] * r0[3]);
                        w.z = pk2(acc[1][bj][0][n][j] * r1[0], acc[1][bj][1][n][j] * r1[1]); w.w = pk2(acc[1][bj][2][n][j] * r1[2], acc[1][bj][3][n][j] * r1[3]);
                        *(u32x4*)(dst + (size_t)(128 * bj + 16 * n + j) * SEQ) = w; }
        }
    }
};
struct EpiGate {
    static constexpr bool PERM = true;
    static constexpr bool AROWPERM = false;
    static constexpr int NTAB = 1;
    const float* ss16; const float* ssr; bf16_t* RET;
    __device__ __forceinline__ void fill(PG8_LAS unsigned char* xl, int i, const Unit& u, int t) const {
        const int row = u.pm * BM + t;
        ((PG8_LAS float*)(xl + RT1_OFF))[i * 256 + t] = rstd16(ss16, row);
        const f32x4* sp = (const f32x4*)(ssr + ((size_t)row * 4 + (u.pn >> 1)) * 16); const f32x4 s0 = sp[0], s1 = sp[1], s2 = sp[2], s3 = sp[3];
        ((PG8_LAS float*)(xl + RT2_OFF))[i * 256 + t] = rsqrtf(((((s0[0] + s0[1]) + (s0[2] + s0[3])) + ((s1[0] + s1[1]) + (s1[2] + s1[3]))) + (((s2[0] + s2[1]) + (s2[2] + s2[3])) + ((s3[0] + s3[1]) + (s3[2] + s3[3])))) * (1.0f / 512.0f) + EPS);
    }
    __device__ __forceinline__ void operator()(f32x4 (&acc)[2][2][4][2], const Unit& u, int ui, int wr, int wc, int fr, int fq, PG8_LAS unsigned char* xl) const {
        const int row0 = u.pm * BM + wr * 64 + fr, colb = u.pn * BM + wc * 32 + 8 * fq;
        const PG8_LAS float* rt = (const PG8_LAS float*)(xl + RT1_OFF) + ui * 256 + wr * 64 + fr;
        const PG8_LAS float* rt2 = (const PG8_LAS float*)(xl + RT2_OFF) + ui * 256 + wr * 64 + fr;
        u32x4 rvv[2][4][2];
#pragma unroll
        for (int ai = 0; ai < 2; ++ai)
#pragma unroll
            for (int m = 0; m < 4; ++m)
#pragma unroll
                for (int bj = 0; bj < 2; ++bj) rvv[ai][m][bj] = *(const u32x4*)(RET + (size_t)(row0 + ai * HALF + m * 16) * 2048 + colb + bj * HALF);
#pragma unroll
        for (int ai = 0; ai < 2; ++ai)
#pragma unroll
            for (int m = 0; m < 4; ++m) { const int row = row0 + ai * HALF + m * 16; const float r = rt[ai * HALF + m * 16], rh = rt2[ai * HALF + m * 16];
#pragma unroll
                for (int bj = 0; bj < 2; ++bj) { bf16_t* p = RET + (size_t)row * 2048 + colb + bj * HALF; const u32x4 rv = rvv[ai][m][bj];
                    const f32x4 g0 = acc[ai][bj][m][0] * r, g1 = acc[ai][bj][m][1] * r; f32x4 y0, y1;
                    y0[0] = bflo(rv.x) * rh * siluf(g0[0]); y0[1] = bfhi(rv.x) * rh * siluf(g0[1]); y0[2] = bflo(rv.y) * rh * siluf(g0[2]); y0[3] = bfhi(rv.y) * rh * siluf(g0[3]);
                    y1[0] = bflo(rv.z) * rh * siluf(g1[0]); y1[1] = bfhi(rv.z) * rh * siluf(g1[1]); y1[2] = bflo(rv.w) * rh * siluf(g1[2]); y1[3] = bfhi(rv.w) * rh * siluf(g1[3]);
                    *(u32x4*)p = pack8(y0, y1); } }
    }
};

template <class Epi, class Sched>
__device__ __forceinline__ void gemm_phase(PG8_LAS unsigned char* lds, const Gemm g, const Sched& S, const Epi& E) {
    int tid_ = threadIdx.x; asm volatile("" : "+v"(tid_));
    const int tid = tid_, wid = __builtin_amdgcn_readfirstlane(tid >> 6), lane = tid & 63, wr = wid >> 2, wc = wid & 3, fr = lane & 15, fq = lane >> 4;
    const int K = g.K, nt = K / BK;
    unsigned voffA0[2], voffA1[2], voffB[2];
#pragma unroll
    for (int i = 0; i < 2; ++i) { int R, C; stage_rc(tid * 16 + i * 8192, R, C); const int Rb = Epi::PERM ? (R & ~31) + perm32(R & 31) : R;
        int ra0, ra1;
        if (Epi::AROWPERM) { const int base = ((R >> 6) * 16 + (R & 15)) * 8 + ((R >> 4) & 3); ra0 = base; ra1 = base + 4; } else { ra0 = R; ra1 = R + HALF; }
        voffA0[i] = (unsigned)(ra0 * K + C) * 2u; voffA1[i] = (unsigned)(ra1 * K + C) * 2u; voffB[i] = (unsigned)(Rb * K + C) * 2u; }
    const size_t kstep = (size_t)(BK * 2);
    const size_t hstep = (size_t)HALF * K * 2;
    const size_t tstep = 2 * hstep;
    const unsigned ldsw = (unsigned)wid * 1024u;
    const int aoff = lds_byte(wr * 64 + fr, fq * 8), boff = lds_byte(wc * 32 + fr, fq * 8);
#define PG8_SA(b, h) (((b) * 2 + (h)) * HTB)
#define PG8_SB(b, h) ((4 + (b) * 2 + (h)) * HTB)
#define PG8_STAGE(bufoff, gbase, voff) do { _Pragma("unroll") for (int _i = 0; _i < 2; ++_i) \
        __builtin_amdgcn_global_load_lds((const unsigned*)((const char*)(gbase) + (voff)[_i]), (PG8_LAS unsigned*)(lds + (bufoff) + ldsw + _i * 8192), 16, 0, 0); } while (0)
#define PG8_LDA(dst, b, h) do { _Pragma("unroll") for (int m = 0; m < 4; ++m) _Pragma("unroll") for (int k = 0; k < 2; ++k) dst[m][k] = *(const PG8_LAS bf16x8*)(lds + PG8_SA(b, h) + aoff + m * 2048 + k * 1024); } while (0)
#define PG8_LDB(dst, b, h) do { _Pragma("unroll") for (int n = 0; n < 2; ++n) _Pragma("unroll") for (int k = 0; k < 2; ++k) dst[n][k] = *(const PG8_LAS bf16x8*)(lds + PG8_SB(b, h) + boff + n * 2048 + k * 1024); } while (0)
#define PG8_MMA(ai, bj, At, Bt) do { __builtin_amdgcn_s_setprio(1); _Pragma("unroll") for (int m = 0; m < 4; ++m) _Pragma("unroll") for (int n = 0; n < 2; ++n) _Pragma("unroll") for (int k = 0; k < 2; ++k) \
        acc[ai][bj][m][n] = __builtin_amdgcn_mfma_f32_16x16x32_bf16(Bt[n][k], At[m][k], acc[ai][bj][m][n], 0, 0, 0); __builtin_amdgcn_s_setprio(0); } while (0)
#define PG8_WAIT_V(n) asm volatile("s_waitcnt vmcnt(" #n ")" ::: "memory")
#define PG8_WAIT_L(n) asm volatile("s_waitcnt lgkmcnt(" #n ")" ::: "memory")
#define PG8_BAR __builtin_amdgcn_s_barrier()
#define PG8_SCHED __builtin_amdgcn_sched_barrier(0)
    Unit cur, nxt; int ui = 0;
    if (!S.next(0, cur)) return;
    f32x4 acc[2][2][4][2];
#pragma unroll
    for (int a = 0; a < 2; ++a)
#pragma unroll
        for (int b = 0; b < 2; ++b)
#pragma unroll
            for (int m = 0; m < 4; ++m)
#pragma unroll
                for (int n = 0; n < 2; ++n) acc[a][b][m][n] = (f32x4){0.f, 0.f, 0.f, 0.f};
    bf16x8 At[4][2], B0[2][2], B1[2][2];
    const char* cA = (const char*)g.A + (size_t)cur.pm * tstep; const char* cB = (const char*)g.Bt + (size_t)cur.pn * tstep;
    PG8_STAGE(PG8_SB(0, 0), cB, voffB); PG8_STAGE(PG8_SB(0, 1), cB + hstep, voffB); PG8_STAGE(PG8_SA(0, 0), cA, voffA0); PG8_STAGE(PG8_SA(0, 1), cA, voffA1);
    if constexpr (Epi::NTAB > 0) {
#pragma unroll 1
        for (int i = tid >> 8; i < 8; i += 2) { Unit uu; if (!S.next(i, uu)) break; E.fill(lds + STAGE_BYTES, i, uu, tid & 255); asm volatile("" ::: "memory"); }
        asm volatile("s_waitcnt lgkmcnt(0)" ::: "memory");
    }
    if (wr == 1) PG8_BAR;
    PG8_WAIT_V(2); PG8_BAR;
    PG8_STAGE(PG8_SB(1, 0), cB + kstep, voffB); PG8_STAGE(PG8_SA(1, 0), cA + kstep, voffA0); PG8_STAGE(PG8_SB(1, 1), cB + hstep + kstep, voffB);
    PG8_WAIT_V(6); PG8_BAR;
    for (;;) {
        const bool has_next = S.next(ui + 1, nxt);
        const char* nA = has_next ? (const char*)g.A + (size_t)nxt.pm * tstep : cA; const char* nB = has_next ? (const char*)g.Bt + (size_t)nxt.pn * tstep : cB;
        for (int t = 0; t < nt; t += 2) {
            const bool last = (t == nt - 2);
            const char* a1 = cA + (size_t)(t + 1) * kstep;
            const char* a2 = last ? nA : cA + (size_t)(t + 2) * kstep; const char* b2 = last ? nB : cB + (size_t)(t + 2) * kstep;
            const char* a3 = a2 + kstep; const char* b3 = b2 + kstep;
            PG8_LDB(B0, 0, 0); PG8_LDB(B1, 0, 1); PG8_SCHED; PG8_LDA(At, 0, 0); PG8_STAGE(PG8_SA(1, 1), a1, voffA1);
            PG8_WAIT_V(8); PG8_WAIT_L(0); PG8_BAR; PG8_MMA(0, 0, At, B0); PG8_MMA(0, 1, At, B1); PG8_BAR; PG8_SCHED;
            PG8_LDA(At, 0, 1); PG8_STAGE(PG8_SB(0, 0), b2, voffB); PG8_STAGE(PG8_SB(0, 1), b2 + hstep, voffB); PG8_STAGE(PG8_SA(0, 0), a2, voffA0);
            PG8_WAIT_V(8); PG8_WAIT_L(0); PG8_BAR; PG8_MMA(1, 0, At, B0); PG8_MMA(1, 1, At, B1); PG8_BAR; PG8_SCHED;
            PG8_LDB(B0, 1, 0); PG8_LDB(B1, 1, 1); PG8_SCHED; PG8_LDA(At, 1, 0); PG8_STAGE(PG8_SA(0, 1), a2, voffA1);
            PG8_WAIT_V(8); PG8_WAIT_L(0); PG8_BAR; PG8_MMA(0, 0, At, B0); PG8_MMA(0, 1, At, B1); PG8_BAR; PG8_SCHED;
            PG8_LDA(At, 1, 1); PG8_STAGE(PG8_SB(1, 0), b3, voffB); PG8_STAGE(PG8_SB(1, 1), b3 + hstep, voffB); PG8_STAGE(PG8_SA(1, 0), a3, voffA0);
            PG8_WAIT_V(8); PG8_WAIT_L(0); PG8_BAR; PG8_MMA(1, 0, At, B0); PG8_MMA(1, 1, At, B1); PG8_BAR; PG8_SCHED;
        }
        if (wr == 0) PG8_BAR;
        E(acc, cur, ui, wr, wc, fr, fq, lds + STAGE_BYTES);
        if (!has_next) break;
#pragma unroll
        for (int a = 0; a < 2; ++a)
#pragma unroll
            for (int b = 0; b < 2; ++b)
#pragma unroll
                for (int m = 0; m < 4; ++m)
#pragma unroll
                    for (int n = 0; n < 2; ++n) acc[a][b][m][n] = (f32x4){0.f, 0.f, 0.f, 0.f};
        cur = nxt; cA = nA; cB = nB; ++ui;
        if (wr == 1) PG8_BAR;
    }
    PG8_WAIT_V(0);
    PG8_BAR;
#undef PG8_SA
#undef PG8_SB
#undef PG8_STAGE
#undef PG8_LDA
#undef PG8_LDB
#undef PG8_MMA
#undef PG8_WAIT_V
#undef PG8_WAIT_L
#undef PG8_BAR
#undef PG8_SCHED
}
}

constexpr int NWAVES = 8;
constexpr int RING_BYTES = 131072, LDS_BYTES = 163840, LDSCTL_OFF = LDS_BYTES - 512, MISC_OFF = LDSCTL_OFF + 320;
#define GAS __attribute__((address_space(1)))
#define LAS __attribute__((address_space(3)))
typedef GAS unsigned gu32;
#define RLX_AGENT __ATOMIC_RELAXED, __HIP_MEMORY_SCOPE_AGENT
#define LDS_WAIT() asm volatile("s_waitcnt lgkmcnt(0)" ::: "memory")
#define VM_WAIT() asm volatile("s_waitcnt vmcnt(0)" ::: "memory")
constexpr int CW_BAR = 4096;
#define XB_TMO      128
#define XB_XCNT(j)  (256  + 64 * (j))
#define XB_XSUB(j)  (1280 + 64 * (j))
#define XB_XGEN(j)  (2304 + 64 * (j))
#define XB_TOP      3328
#define XB_TOPGEN   3392
#define XCD_BAR_WORDS 3456
#define XB_SPIN_CAP (1u << 18)
__device__ __forceinline__ unsigned xb_ld(unsigned* p)              { return __hip_atomic_load(p, __ATOMIC_RELAXED, __HIP_MEMORY_SCOPE_AGENT); }
__device__ __forceinline__ unsigned xb_add(unsigned* p, unsigned v) { return __hip_atomic_fetch_add(p, v, __ATOMIC_RELAXED, __HIP_MEMORY_SCOPE_AGENT); }
__device__ __forceinline__ unsigned xb_xcc_id() { return (unsigned)__builtin_amdgcn_s_getreg((3 << 11) | 20) & 0xFu; }
#define XB_SPIN(cond, bar) do { unsigned _sp = 0; while (cond) { __builtin_amdgcn_s_sleep(1); \
    if ((++_sp & 255u) == 0u) { if (xb_ld(&(bar)[XB_TMO])) break; if (_sp > XB_SPIN_CAP) { atomicAdd(&(bar)[XB_TMO], 1u); break; } } } } while (0)
struct XcdBarrier { unsigned* bar; unsigned x; volatile LAS unsigned* st; };
__device__ __forceinline__ XcdBarrier xcd_barrier_post(unsigned* bar, volatile LAS unsigned* st) {
    XcdBarrier b; b.bar = bar; b.x = xb_xcc_id(); b.st = st;
    if (threadIdx.x == 0) (void)xb_add(&bar[XB_XCNT(b.x)], 1u);
    return b;
}
__device__ __forceinline__ void xcd_barrier_complete(unsigned* bar, unsigned x, unsigned& nloc, unsigned& nx) {
    const unsigned G = gridDim.x * gridDim.y * gridDim.z;
    unsigned sum, cnt, mine, sp = 0u;
    for (;;) {
        sum = 0u; cnt = 0u; mine = 0u;
#pragma unroll
        for (unsigned j = 0; j < 16; ++j) { const unsigned c = xb_ld(&bar[XB_XCNT(j)]); sum += c; cnt += (c > 0u) ? 1u : 0u; mine = (j == x) ? c : mine; }
        if (sum == G) break;
        __builtin_amdgcn_s_sleep(1);
        if ((++sp & 255u) == 0u) { if (xb_ld(&bar[XB_TMO])) break; if (sp > XB_SPIN_CAP) { atomicAdd(&bar[XB_TMO], 1u); break; } }
    }
    nloc = mine > 0u ? mine : 1u; nx = cnt > 0u ? cnt : 1u;
}
__device__ __forceinline__ void xcd_barrier(const XcdBarrier& b) {
    asm volatile("s_waitcnt vmcnt(0)" ::: "memory");
    __syncthreads();
    if (threadIdx.x == 0) {
        unsigned* bar = b.bar;
        __builtin_amdgcn_s_waitcnt(0);
        unsigned nloc = b.st[0], nx = b.st[1];
        if (nloc == 0u) { xcd_barrier_complete(bar, b.x, nloc, nx); b.st[0] = nloc; b.st[1] = nx; }
        const unsigned old = xb_add(&bar[XB_XSUB(b.x)], 1u);
        const unsigned gen = old / nloc;
        if (old + 1u == (gen + 1u) * nloc) {
            __builtin_amdgcn_fence(__ATOMIC_RELEASE, "agent");
            asm volatile("s_waitcnt vmcnt(0)" ::: "memory");
            const unsigned og = xb_add(&bar[XB_TOP], 1u);
            const unsigned tg = og / nx;
            if (og + 1u == (tg + 1u) * nx) xb_add(&bar[XB_TOPGEN], 1u);
            else XB_SPIN(xb_ld(&bar[XB_TOPGEN]) == tg, bar);
            __builtin_amdgcn_fence(__ATOMIC_ACQUIRE, "agent");
            xb_add(&bar[XB_XGEN(b.x)], 1u);
            asm volatile("s_waitcnt vmcnt(0)" ::: "memory");
        } else {
            XB_SPIN(xb_ld(&bar[XB_XGEN(b.x)]) == gen, bar);
            __builtin_amdgcn_fence(__ATOMIC_ACQUIRE, "agent");
            asm volatile("s_waitcnt vmcnt(0)" ::: "memory");
        }
    }
    __syncthreads();
}

struct Args { const float* in[16]; float* out; unsigned char* ws; int ph_lo, ph_hi, li, pad; };
constexpr int A1T = 320;
enum { PH_PRO = 0, PH_A1, PH_A2, PH_A3, PH_F1A, PH_F2A, PH_B1, PH_B2, PH_GATE, PH_B3, PH_F1B, PH_F2B, PH_END };

__device__ __forceinline__ void p0_transpose_item(const float* W, int K, int Nsrc, int N, int mode, const float* gain, bf16_t* WT, LAS float* scr, int item, int lane) {
    const int nblk = N / 64, kb = item / nblk, nb = item % nblk, k0 = 64 * kb, n0 = 64 * nb;
    const int src = wmap(mode, n0 + lane);
    const float* wp = W + (size_t)k0 * Nsrc + (src >= 0 ? src : 0);
#pragma unroll
    for (int h = 0; h < 2; ++h) { float v[32];
#pragma unroll
        for (int i = 0; i < 32; ++i) v[i] = wp[(size_t)(32 * h + i) * Nsrc];
#pragma unroll
        for (int i = 0; i < 32; ++i) { float x = v[i]; if (gain) x *= gain[k0 + 32 * h + i]; if (src < 0) x = 0.f; scr[(32 * h + i) * 65 + lane] = x; } }
    LDS_WAIT(); asm volatile("" ::: "memory");
    const int kq = (lane & 3) * 16;
#pragma unroll
    for (int j = 0; j < 4; ++j) { const int n = (lane >> 2) + 16 * j; const LAS float* sp = scr + kq * 65 + n;
        u32x4 o0, o1;
        o0.x = pk2(sp[0 * 65], sp[1 * 65]); o0.y = pk2(sp[2 * 65], sp[3 * 65]); o0.z = pk2(sp[4 * 65], sp[5 * 65]); o0.w = pk2(sp[6 * 65], sp[7 * 65]);
        o1.x = pk2(sp[8 * 65], sp[9 * 65]); o1.y = pk2(sp[10 * 65], sp[11 * 65]); o1.z = pk2(sp[12 * 65], sp[13 * 65]); o1.w = pk2(sp[14 * 65], sp[15 * 65]);
        bf16_t* dst = WT + (size_t)(n0 + n) * K + k0 + kq; *(u32x4*)dst = o0; *(u32x4*)(dst + 8) = o1; }
    LDS_WAIT(); asm volatile("" ::: "memory");
}
__device__ __forceinline__ void ffn_fixup(int pm, const float* cw, const float* PART, const float* HALO, bf16_t* H) {
    if ((pm & 7) == 0) return;
    int tid = threadIdx.x; asm volatile("" : "+v"(tid));
    const float* part = PART + (size_t)pm * (4 * D_FF); const float* halo = HALO + (size_t)(pm - 1) * (4 * D_FF);
#pragma unroll
    for (int idx0 = 0; idx0 < 2 * D_FF; idx0 += NWAVES * 64) { const int idx = idx0 + tid; const int e = idx / D_FF, c = idx - e * D_FF;
        float a = part[(size_t)e * 2 * D_FF + c], b = part[(size_t)e * 2 * D_FF + D_FF + c];
        const float ha0 = halo[c], hb0 = halo[D_FF + c], ha1 = halo[2 * D_FF + c], hb1 = halo[3 * D_FF + c];
        const float wa0 = cw[c], wa1 = cw[FF2 + c], wb0 = cw[D_FF + c], wb1 = cw[FF2 + D_FF + c];
        if (e == 0) { a += wa1 * ha1 + wa0 * ha0; b += wb1 * hb1 + wb0 * hb0; } else { a += wa0 * ha1; b += wb0 * hb1; }
        H[(size_t)(pm * 256 + e) * D_FF + c] = f2bf(siluf(a) * b); }
}


__device__ __forceinline__ void glds16_asm(const void* gsrc, unsigned lds_dst) {
    unsigned keep; asm volatile("s_mov_b32 %0, m0\n\ts_mov_b32 m0, %2\n\ts_nop 0\n\tglobal_load_lds_dwordx4 %1, off\n\ts_mov_b32 m0, %0" : "=&s"(keep) : "v"(gsrc), "s"(lds_dst) : "memory"); }
__device__ __forceinline__ unsigned lds_addr(LAS unsigned char* p) { return (unsigned)__builtin_amdgcn_readfirstlane((int)(unsigned)(size_t)p); }

typedef short s16x4 __attribute__((ext_vector_type(4)));
__device__ __forceinline__ bf16x8 cat4(s16x4 a, s16x4 b) { bf16x8 r; r[0] = a[0]; r[1] = a[1]; r[2] = a[2]; r[3] = a[3]; r[4] = b[0]; r[5] = b[1]; r[6] = b[2]; r[7] = b[3]; return r; }
__device__ __forceinline__ void ret_fast_phase(LAS unsigned char* lds, const bf16_t* QT, const bf16_t* KT, const bf16_t* VT, bf16_t* RET, float* SSR, int unit) {
    int tid_ = threadIdx.x; asm volatile("" : "+v"(tid_));
    const int tid = tid_, lane = tid & 63, w = __builtin_amdgcn_readfirstlane(tid >> 6), li = lane & 15, g = lane >> 4;
    const int blk = unit & 7, h = (unit >> 3) & 3, b = unit >> 5;
    const float g64 = __expf(64.0f * gamma_log(h));
    const bool isR = w < 4; const int qt = w & 3, u = w & 3;
    constexpr int KB = 0, VB = 65536, ST = 81920;
    typedef __attribute__((address_space(3))) s16x4 lds_s16x4;
    for (int e = tid; e < 2048; e += 512) *(LAS u32x4*)(lds + ST + e * 16) = (u32x4){0u, 0u, 0u, 0u};
    f32x4 rg[16];
#pragma unroll
    for (int i = 0; i < 16; ++i) rg[i] = (f32x4){0.f, 0.f, 0.f, 0.f};
    const size_t rowb = (size_t)b * SEQ;
    const bf16_t* kbase = KT + rowb * 1024 + h * 256;
    const bf16_t* qbase = QT + (rowb + 16 * qt + li) * 1024 + h * 256 + 8 * g;
    const bf16_t* vbase = VT + ((size_t)b * 2048 + h * 512 + blk * 64 + (tid >> 3)) * SEQ + 8 * (tid & 7);
    const unsigned vw_off = (unsigned)((tid >> 3) * 128 + (((2 * (tid & 7)) ^ ((tid >> 3) & 14)) * 8));
    unsigned ksrc[8];
#pragma unroll
    for (int i = 0; i < 8; ++i) { const int row = 2 * (8 * u + i) + (lane >> 5), p = lane & 31, c = p ^ ((row & 7) << 1); ksrc[i] = (unsigned)(row * 2048 + c * 16); }
#define RK_DMA(n_, buf_) do { const char* kb_ = (const char*)(kbase + (size_t)(n_) * 64 * 1024); const unsigned ld_ = lds_addr(lds + KB + (buf_) * 32768 + (8 * u) * 1024); _Pragma("unroll") for (int i = 0; i < 8; ++i) \
        glds16_asm(kb_ + ksrc[i], ld_ + i * 1024); } while (0)
    u32x4 vreg;
    if (!isR) { RK_DMA(0, 0); }
    vreg = *(const u32x4*)(vbase);
    if (isR) {
#pragma unroll
        for (int ks = 0; ks < 8; ++ks) rg[ks] = *(const f32x4*)(qbase + 32 * ks); }
    *(LAS u32x4*)(lds + VB + vw_off) = vreg;
    asm volatile("s_waitcnt vmcnt(0) lgkmcnt(0)" ::: "memory"); __builtin_amdgcn_s_barrier(); asm volatile("" ::: "memory");
#pragma unroll 1
    for (int n = 0; n < 32; ++n) {
        const int cur = n & 1, nxt = cur ^ 1;
        LAS unsigned char* kb = lds + KB + cur * 32768; LAS unsigned char* vb = lds + VB + cur * 8192; LAS unsigned char* sb = lds + ST + cur * 32768;
        if (n + 1 < 32) vreg = *(const u32x4*)(vbase + (size_t)(n + 1) * 64);
        if (isR) {
            if (n + 1 < 32) {
#pragma unroll
                for (int ks = 0; ks < 8; ++ks) rg[8 + ks] = *(const f32x4*)(qbase + (size_t)(n + 1) * 64 * 1024 + 32 * ks); }
            const int sw = (li & 7) << 1;
#define LDROWS(dst, base, tile) do { const LAS unsigned char* rp_ = (base) + (16 * (tile) + li) * 512; _Pragma("unroll") for (int ks = 0; ks < 8; ++ks) dst[ks] = *(const LAS bf16x8*)(rp_ + (((4 * ks + g) ^ sw) * 16)); } while (0)
#define MMA8(acc_, fr_) do { _Pragma("unroll") for (int ks = 0; ks < 8; ++ks) acc_ = __builtin_amdgcn_mfma_f32_16x16x32_bf16(fr_[ks], __builtin_bit_cast(bf16x8, rg[ks]), acc_, 0, 0, 0); } while (0)
#define SFIN(k_, a_) do { if (qt == (k_)) { _Pragma("unroll") for (int r = 0; r < 4; ++r) a_[r] = (4 * g + r <= li) ? a_[r] : 0.f; } u32x2 pk_; pk_.x = pk2(a_[0], a_[1]); pk_.y = pk2(a_[2], a_[3]); sfr[k_] = __builtin_bit_cast(s16x4, pk_); } while (0)
#define SB_ __builtin_amdgcn_sched_barrier(0)
            bf16x8 fa[8], fb[8]; f32x4 racc[4]; s16x4 sfr[4];
#pragma unroll
            for (int t = 0; t < 4; ++t) { racc[t] = (f32x4){0.f, 0.f, 0.f, 0.f}; sfr[t] = (s16x4){0, 0, 0, 0}; }
            LDROWS(fa, sb, 0); SB_;
            LDROWS(fb, sb, 1); SB_; MMA8(racc[0], fa); SB_;
            LDROWS(fa, sb, 2); SB_; MMA8(racc[1], fb); SB_;
            LDROWS(fb, sb, 3); SB_; MMA8(racc[2], fa); SB_;
            LDROWS(fa, kb, 0); SB_; MMA8(racc[3], fb); SB_;
            if (qt >= 1) { LDROWS(fb, kb, 1); }
            SB_;
            { f32x4 a = (f32x4){0.f, 0.f, 0.f, 0.f}; MMA8(a, fa); SFIN(0, a); }
            SB_;
            if (qt >= 1) { if (qt >= 2) { LDROWS(fa, kb, 2); } SB_; f32x4 a = (f32x4){0.f, 0.f, 0.f, 0.f}; MMA8(a, fb); SFIN(1, a); }
            SB_;
            if (qt >= 2) { if (qt >= 3) { LDROWS(fb, kb, 3); } SB_; f32x4 a = (f32x4){0.f, 0.f, 0.f, 0.f}; MMA8(a, fa); SFIN(2, a); }
            SB_;
            bf16x8 vf0[4], vf1[4];
#pragma unroll
            for (int t = 0; t < 4; ++t) { const int row = 16 * t + li; const LAS unsigned char* vp = vb + row * 128; const int f = row & 14;
                vf0[t] = cat4(*(const LAS s16x4*)(vp + (((g) ^ f) * 8)), *(const LAS s16x4*)(vp + (((4 + g) ^ f) * 8)));
                vf1[t] = cat4(*(const LAS s16x4*)(vp + (((8 + g) ^ f) * 8)), *(const LAS s16x4*)(vp + (((12 + g) ^ f) * 8))); }
            SB_;
            if (qt >= 3) { f32x4 a = (f32x4){0.f, 0.f, 0.f, 0.f}; MMA8(a, fb); SFIN(3, a); }
            SB_;
            const bf16x8 sf0 = cat4(sfr[0], sfr[1]), sf1 = cat4(sfr[2], sfr[3]);
            float ssq = 0.f; u32x2 pkt[4];
#pragma unroll
            for (int t = 0; t < 4; ++t) {
                f32x4 acc = __builtin_amdgcn_mfma_f32_16x16x32_bf16(vf0[t], sf0, racc[t], 0, 0, 0);
                if (qt >= 2) acc = __builtin_amdgcn_mfma_f32_16x16x32_bf16(vf1[t], sf1, acc, 0, 0, 0);
                ssq += (acc[0] * acc[0] + acc[1] * acc[1]) + (acc[2] * acc[2] + acc[3] * acc[3]);
                pkt[t].x = pk2(acc[0], acc[1]); pkt[t].y = pk2(acc[2], acc[3]); }
#undef LDROWS
#undef MMA8
#undef SFIN
            bf16_t* rrow = RET + (rowb + n * 64 + 16 * qt + li) * 2048 + h * 512 + blk * 64 + 16 * (g & 1) + 4 * (g & 2);
#pragma unroll
            for (int pp = 0; pp < 2; ++pp) {
                const auto sx = __builtin_amdgcn_permlane16_swap(pkt[2 * pp].x, pkt[2 * pp + 1].x, false, false), sy = __builtin_amdgcn_permlane16_swap(pkt[2 * pp].y, pkt[2 * pp + 1].y, false, false);
                u32x4 w4; w4.x = sx[0]; w4.y = sy[0]; w4.z = sx[1]; w4.w = sy[1];
                *(u32x4*)(rrow + 32 * pp) = w4; }
            ssq += __shfl_xor(ssq, 16); ssq += __shfl_xor(ssq, 32);
            if (g < 2) SSR[((rowb + n * 64 + 16 * qt + li) * 4 + h) * 16 + blk * 2 + g] = g ? 0.f : ssq;
#pragma unroll
            for (int ks = 0; ks < 8; ++ks) rg[ks] = rg[8 + ks];
        } else {
            if (n + 1 < 32) { RK_DMA(n + 1, nxt); }
            bf16x8 vf[4][2];
#pragma unroll
            for (int t = 0; t < 4; ++t)
#pragma unroll
                for (int kp = 0; kp < 2; ++kp) { const int row = 16 * t + li; const LAS unsigned char* rp = vb + row * 128; const int f = row & 14;
                    const s16x4 lo = *(const LAS s16x4*)(rp + (((8 * kp + g) ^ f) * 8)), hi = *(const LAS s16x4*)(rp + (((8 * kp + 4 + g) ^ f) * 8)); vf[t][kp] = cat4(lo, hi); }
            bf16x8 ua[4][2];
#pragma unroll
            for (int d = 0; d < 4; ++d) {
#pragma unroll
                for (int kp = 0; kp < 2; ++kp) { const int dkt = 4 * u + d;
                    const int r0 = 32 * kp + 4 * g + (li >> 2), r1 = r0 + 16;
                    const int cch = 2 * dkt + ((li >> 1) & 1), hb = (li & 1) * 8;
                    const s16x4 lo = __builtin_bit_cast(s16x4, __builtin_amdgcn_ds_read_tr16_b64_v4i16((lds_s16x4*)(kb + r0 * 512 + ((cch ^ ((r0 & 7) << 1)) * 16) + hb)));
                    const s16x4 hi = __builtin_bit_cast(s16x4, __builtin_amdgcn_ds_read_tr16_b64_v4i16((lds_s16x4*)(kb + r1 * 512 + ((cch ^ ((r1 & 7) << 1)) * 16) + hb)));
                    ua[d][kp] = cat4(lo, hi); }
                if (d == 1) __builtin_amdgcn_sched_barrier(0); }
            __builtin_amdgcn_sched_barrier(0);
#pragma unroll
            for (int d = 0; d < 4; ++d)
#pragma unroll
                for (int kp = 0; kp < 2; ++kp)
#pragma unroll
                    for (int t = 0; t < 4; ++t) rg[4 * d + t] = __builtin_amdgcn_mfma_f32_16x16x32_bf16(ua[d][kp], vf[t][kp], rg[4 * d + t], 0, 0, 0);
            LAS unsigned char* sn = lds + ST + nxt * 32768;
#pragma unroll
            for (int d = 0; d < 4; ++d)
#pragma unroll
                for (int t = 0; t < 4; ++t) { rg[4 * d + t] *= g64; const int row = 16 * t + li, dkt = 4 * u + d;
                    u32x2 pk; pk.x = pk2(rg[4 * d + t][0], rg[4 * d + t][1]); pk.y = pk2(rg[4 * d + t][2], rg[4 * d + t][3]);
                    *(LAS u32x2*)(sn + row * 512 + (((2 * dkt + (g >> 1)) ^ ((row & 7) << 1)) * 16) + (g & 1) * 8) = pk; }
        }
        if (n + 1 < 32) *(LAS u32x4*)(lds + VB + nxt * 8192 + vw_off) = vreg;
        asm volatile("s_waitcnt vmcnt(0) lgkmcnt(0)" ::: "memory"); __builtin_amdgcn_s_barrier(); asm volatile("" ::: "memory");
    }
#undef RK_DMA
#undef SB_
}


#ifndef DSA_REP
#define DSA_REP 0
#endif
constexpr int DSA_SC = 0, DSA_KST = 131072, DSA_IDX = 147456, DSA_WQ = 155648;
__device__ __forceinline__ unsigned fkey(float f) { const unsigned u = __float_as_uint(f); return (u & 0x80000000u) ? ~u : (u | 0x80000000u); }
__device__ __forceinline__ int bcnt(bool p) { return __popcll(__ballot(p)); }
#define SUMF(a_, b_) ((a_) + (b_))
#define WAVE_RED(OP, v) do { v = OP(v, __int_as_float(__builtin_amdgcn_update_dpp(__float_as_int(v), __float_as_int(v), 0xB1, 0xf, 0xf, true))); \
        v = OP(v, __int_as_float(__builtin_amdgcn_update_dpp(__float_as_int(v), __float_as_int(v), 0x4E, 0xf, 0xf, true))); \
        v = OP(v, __int_as_float(__builtin_amdgcn_update_dpp(__float_as_int(v), __float_as_int(v), 0x141, 0xf, 0xf, true))); \
        v = OP(v, __int_as_float(__builtin_amdgcn_update_dpp(__float_as_int(v), __float_as_int(v), 0x140, 0xf, 0xf, true))); \
        v = OP(OP(__int_as_float(__builtin_amdgcn_readlane(__float_as_int(v), 0)), __int_as_float(__builtin_amdgcn_readlane(__float_as_int(v), 16))), \
               OP(__int_as_float(__builtin_amdgcn_readlane(__float_as_int(v), 32)), __int_as_float(__builtin_amdgcn_readlane(__float_as_int(v), 48)))); } while (0)

template <int NB>
__device__ __forceinline__ void dsa_topk_t(const LAS float* sc, LAS unsigned short* il, int limit, int lane) {
    const int nb = limit >> 6;
    float v[NB];
#pragma unroll
    for (int i = 0; i < NB; ++i) v[i] = (i < nb) ? sc[64 * i + lane] : -INFINITY;
    float mn = INFINITY, mx = -INFINITY;
#pragma unroll
    for (int i = 0; i < NB; ++i) { mn = fminf(mn, (i < nb) ? v[i] : INFINITY); mx = fmaxf(mx, v[i]); }
    WAVE_RED(fminf, mn); WAVE_RED(fmaxf, mx);
    float lo = mn, hi = INFINITY; int clo = limit, chi = 0;
#pragma unroll 1
    for (int it = 0; it < 64 && clo - chi > 64; ++it) {
        const float top = (hi == INFINITY) ? mx : hi; const float mid = 0.5f * lo + 0.5f * top;
        if (!(mid > lo) || !(mid < hi)) break;
        int c = 0;
#pragma unroll
        for (int i = 0; i < NB; ++i) c += (v[i] >= mid) ? 1 : 0;
        float cf = (float)c; WAVE_RED(SUMF, cf); c = (int)cf;
        if (c >= TOPK) { lo = mid; clo = c; } else { hi = mid; chi = c; }
    }
    const int r = TOPK - chi; unsigned T; int ngt, neq;
    if (clo - chi <= 64) {
        int filled = 0;
#pragma unroll
        for (int i = 0; i < NB; ++i) { const bool in = (v[i] >= lo) && (v[i] < hi);
            const unsigned long long m = __ballot(in); const int pos = filled + __builtin_amdgcn_mbcnt_hi((unsigned)(m >> 32), __builtin_amdgcn_mbcnt_lo((unsigned)m, 0));
            if (in) ((LAS unsigned*)il)[pos] = fkey(v[i]);
            filled += __popcll(m); }
        asm volatile("s_waitcnt lgkmcnt(0)" ::: "memory");
        const unsigned ck = (lane < filled) ? ((LAS unsigned*)il)[lane] : 0u;
        T = 0u;
#pragma unroll 4
        for (int bit = 31; bit >= 0; --bit) { const unsigned cand = T | (1u << bit); if (bcnt(ck >= cand) >= r) T = cand; }
        ngt = chi + bcnt(ck > T); neq = bcnt(ck == T);
    } else {
        T = 0u;
#pragma unroll 1
        for (int bit = 31; bit >= 0; --bit) { const unsigned cand = T | (1u << bit); int c = 0;
#pragma unroll
            for (int i = 0; i < NB; ++i) c += bcnt(i < nb && fkey(v[i]) >= cand);
            if (c >= TOPK) T = cand; }
        ngt = 0; neq = 0;
#pragma unroll
        for (int i = 0; i < NB; ++i) { const unsigned k = fkey(v[i]); ngt += bcnt(i < nb && k > T); neq += bcnt(i < nb && k == T); }
    }
    const int need_eq = TOPK - ngt;
    asm volatile("s_waitcnt lgkmcnt(0)" ::: "memory");
    int base = 0, tb = 0;
    const bool alleq = (neq == need_eq);
#pragma unroll
    for (int i = 0; i < NB; ++i) if (i < nb) { const unsigned k = fkey(v[i]);
        bool f = k >= T;
        if (!alleq) { const bool eq = (k == T); const unsigned long long me = __ballot(eq);
            const int er = tb + __builtin_amdgcn_mbcnt_hi((unsigned)(me >> 32), __builtin_amdgcn_mbcnt_lo((unsigned)me, 0));
            f = (k > T) || (eq && er < need_eq); tb += __popcll(me); }
        const unsigned long long mf = __ballot(f); const int pos = base + __builtin_amdgcn_mbcnt_hi((unsigned)(mf >> 32), __builtin_amdgcn_mbcnt_lo((unsigned)mf, 0));
        if (f && pos < TOPK) il[pos] = (unsigned short)(64 * i + lane);
        base += __popcll(mf); }
}
__device__ __forceinline__ void dsa_topk(const LAS float* sc, LAS unsigned short* il, int limit, int lane) {
    if (limit <= 512) dsa_topk_t<8>(sc, il, limit, lane);
    else if (limit <= 1024) dsa_topk_t<16>(sc, il, limit, lane);
    else dsa_topk_t<32>(sc, il, limit, lane);
}

struct DsaQ { bf16x8 qf[4]; f32x4 ps; };
__device__ __forceinline__ DsaQ dsa_load_q(const bf16_t* QH, const float* PS, size_t trow, int lane) {
    const int li = lane & 15, g = lane >> 4; DsaQ q;
#pragma unroll
    for (int s = 0; s < 4; ++s) { q.qf[s] = (bf16x8){0, 0, 0, 0, 0, 0, 0, 0}; if (li < 8) q.qf[s] = *(const bf16x8*)(QH + trow * 1024 + li * 128 + 32 * s + 8 * g); }
    q.ps = (f32x4){1.f, 1.f, 1.f, 1.f};
    if (li < 8) { const float* pp = PS + (size_t)((li >> 1) * 8 + (li & 1) * 4) * M + trow; q.ps = (f32x4){pp[0], pp[(size_t)M], pp[(size_t)2 * M], pp[(size_t)3 * M]}; }
    return q;
}
__device__ __forceinline__ void dsa_attend(LAS unsigned char* wl, const LAS unsigned short* il, const LAS float* rctab, LAS float* rcl, const DsaQ& Q, const bf16_t* Cb, bf16_t* AO, size_t trow, int b, int count, float bound_l2, int lane) {
    const int li = lane & 15, g = lane >> 4;
    typedef __attribute__((address_space(3))) s16x4 lds_s16x4;
    bf16x8 qf[4];
#pragma unroll
    for (int s = 0; s < 4; ++s) qf[s] = Q.qf[s];
    const float rq = (li < 8) ? rsqrtf(((Q.ps[0] + Q.ps[1]) + (Q.ps[2] + Q.ps[3])) * (1.0f / 128.0f) + EPS) * 1.4426950408889634f : 0.f;
    const bf16_t* cbase = Cb + (size_t)b * SEQ * 128; const unsigned wlb = lds_addr(wl);
#define DSA_GATHER(ci_, buf_) do { const u32x4 kw_ = *(const LAS u32x4*)(il + 32 * (ci_) + 8 * (lane >> 4)); \
        _Pragma("unroll") for (int i = 0; i < 8; ++i) { const int row = 4 * i + (lane >> 4); const unsigned kk_ = (i < 2 ? kw_.x : i < 4 ? kw_.y : i < 6 ? kw_.z : kw_.w); const int key = (i & 1) ? (int)(kk_ >> 16) : (int)(kk_ & 0xffffu); \
        const int sc_ = (lane & 15) ^ ((row & 7) << 1); \
        glds16_asm(cbase + (size_t)key * 128 + sc_ * 8, wlb + (buf_) * 8192 + i * 1024); } } while (0)
    for (int pos = lane; pos < count; pos += 64) { const int e = pos & 31; rcl[(pos & ~31) + 4 * (e & 7) + (e >> 3)] = rctab[il[pos]]; }
    asm volatile("s_waitcnt lgkmcnt(0)" ::: "memory");
    f32x4 oacc[8];
#pragma unroll
    for (int d = 0; d < 8; ++d) oacc[d] = (f32x4){0.f, 0.f, 0.f, 0.f};
    float lsum = 0.f;
    const int nch = count >> 5;
    DSA_GATHER(0, 0);
#pragma unroll 1
    for (int ci = 0; ci < nch; ++ci) {
        const int cur = ci & 1;
        if (ci + 1 < nch) { DSA_GATHER(ci + 1, cur ^ 1); if (DSA_REP & 8) { DSA_GATHER(ci + 1, cur ^ 1); asm volatile("s_waitcnt vmcnt(16)" ::: "memory"); } else asm volatile("s_waitcnt vmcnt(8)" ::: "memory"); } else { asm volatile("s_waitcnt vmcnt(0)" ::: "memory"); }
        const LAS unsigned char* ct = wl + cur * 8192;
        f32x4 lt[2];
        bf16x8 ca[2][4];
#pragma unroll
        for (int T = 0; T < 2; ++T) { const int row = 16 * T + li; const LAS unsigned char* rp = ct + row * 256; const int sw = (row & 7) << 1;
#pragma unroll
            for (int s = 0; s < 4; ++s) ca[T][s] = *(const LAS bf16x8*)(rp + (((4 * s + g) ^ sw) * 16)); }
        f32x4 rcv[2];
#pragma unroll
        for (int T = 0; T < 2; ++T) rcv[T] = *(const LAS f32x4*)(rcl + 32 * ci + 16 * T + 4 * g);
        __builtin_amdgcn_sched_barrier(0);
#pragma unroll
        for (int T = 0; T < 2; ++T) { lt[T] = (f32x4){0.f, 0.f, 0.f, 0.f};
#pragma unroll
            for (int s = 0; s < 4; ++s) lt[T] = __builtin_amdgcn_mfma_f32_16x16x32_bf16(ca[T][s], qf[s], lt[T], 0, 0, 0); }
        bf16x8 cv[8];
#pragma unroll
        for (int dt = 0; dt < 8; ++dt) {
            const int r0 = 4 * g + (li >> 2), r1 = r0 + 16; const int cch = 2 * dt + ((li >> 1) & 1), hb = (li & 1) * 8;
            const s16x4 lo = __builtin_bit_cast(s16x4, __builtin_amdgcn_ds_read_tr16_b64_v4i16((lds_s16x4*)(ct + r0 * 256 + ((cch ^ ((r0 & 7) << 1)) * 16) + hb)));
            const s16x4 hi = __builtin_bit_cast(s16x4, __builtin_amdgcn_ds_read_tr16_b64_v4i16((lds_s16x4*)(ct + r1 * 256 + ((cch ^ ((r1 & 7) << 1)) * 16) + hb)));
            cv[dt] = cat4(lo, hi); }
        __builtin_amdgcn_sched_barrier(0);
        bf16x8 pf;
#pragma unroll
        for (int T = 0; T < 2; ++T) { float pv[4];
#pragma unroll
            for (int r = 0; r < 4; ++r) { pv[r] = __builtin_amdgcn_exp2f(lt[T][r] * rq * rcv[T][r] - bound_l2); lsum += pv[r]; }
            const unsigned w0 = pk2(pv[0], pv[1]), w1 = pk2(pv[2], pv[3]);
            pf[4 * T + 0] = (short)(w0 & 0xffff); pf[4 * T + 1] = (short)(w0 >> 16); pf[4 * T + 2] = (short)(w1 & 0xffff); pf[4 * T + 3] = (short)(w1 >> 16); }
#pragma unroll
        for (int dt = 0; dt < 8; ++dt) oacc[dt] = __builtin_amdgcn_mfma_f32_16x16x32_bf16(cv[dt], pf, oacc[dt], 0, 0, 0);
    }
#undef DSA_GATHER
    lsum += __shfl_xor(lsum, 16); lsum += __shfl_xor(lsum, 32);
    const float inv = 1.0f / lsum;
    if (li < 8) {
#pragma unroll
        for (int dt = 0; dt < 8; ++dt) { u32x2 o; o.x = pk2(oacc[dt][0] * inv, oacc[dt][1] * inv); o.y = pk2(oacc[dt][2] * inv, oacc[dt][3] * inv);
            *(u32x2*)(AO + trow * 1024 + li * 128 + 16 * dt + 4 * g) = o; }
    }
}

__device__ __forceinline__ void dsa_fast_phase(LAS unsigned char* lds, const bf16_t* QH, const bf16_t* Cb, const float* PS, const bf16_t* QI, const bf16_t* KI, const float* WI, const float* CSC, bf16_t* AO, int vcu, int G) {
    int tid_ = threadIdx.x; asm volatile("" : "+v"(tid_));
    const int tid = tid_, lane0 = tid & 63, w = __builtin_amdgcn_readfirstlane(tid >> 6);
    LAS unsigned char* wl = lds + DSA_SC + w * 16384; LAS float* rctab = (LAS float*)(lds + DSA_KST);
    LAS unsigned short* il0 = (LAS unsigned short*)(lds + DSA_IDX + (2 * w) * 512); LAS unsigned short* il1 = il0 + 256;
    float mxs = 0.f;
    for (int i = lane0; i < 128; i += 64) mxs = fmaxf(mxs, fabsf(CSC[i]));
#pragma unroll
    for (int o = 1; o < 64; o <<= 1) mxs = fmaxf(mxs, __shfl_xor(mxs, o));
    const float bound_l2 = mxs * 128.0f * 1.4426950408889634f;
    for (int wg = vcu; wg < 256; wg += G) {
        const int b = wg >> 5, r = wg & 31;
        __syncthreads();
        for (int k = tid; k < SEQ; k += NWAVES * 64) { const float* pp = PS + (size_t)32 * M + (size_t)b * SEQ + k;
            rctab[k] = rsqrtf(((pp[0] + pp[(size_t)M]) + (pp[(size_t)2 * M] + pp[(size_t)3 * M])) * (1.0f / 128.0f) + EPS); }
#pragma unroll 1
        for (int it = 0; it < 4; ++it) {
            int lane = lane0; asm volatile("" : "+v"(lane));
            const int li = lane & 15, g = lane >> 4;
            const int chunk = (it & 1) ? 31 - (r & 15) : (r & 15), sub = 2 * (r >> 4) + (it >> 1);
            const int t0 = chunk * 64 + sub * 16, limit = (chunk + 1) * 64;
            const size_t trow0 = (size_t)b * SEQ + t0 + 2 * w;
            const DsaQ Q0 = dsa_load_q(QH, PS, trow0, lane), Q1 = dsa_load_q(QH, PS, trow0 + 1, lane);
            LAS float* wqt = (LAS float*)(lds + DSA_WQ);
            if (limit > TOPK && tid < 128) { const int qq = tid >> 3, hh = tid & 7; const size_t row = (size_t)b * SEQ + t0 + qq;
                const float* ps = PS + (size_t)(40 + (hh >> 2) * 8 + ((hh >> 1) & 1) * 4 + 2 * (hh & 1)) * M + row;
                wqt[tid] = WI[row * 8 + hh] * rsqrtf((ps[0] + ps[(size_t)M]) * (1.0f / 64.0f) + EPS); }
            __syncthreads();
            if (limit > TOPK) {
                for (int srep = 0; srep < 1 + (DSA_REP & 1); ++srep) {
                bf16x8 af[8][2]; float wq[8][4];
                const size_t trowi = (size_t)b * SEQ + t0;
#pragma unroll
                for (int p = 0; p < 8; ++p) {
#pragma unroll
                    for (int sidx = 0; sidx < 2; ++sidx) af[p][sidx] = *(const bf16x8*)(QI + (trowi + 2 * p + (li >> 3)) * 512 + (li & 7) * 64 + 32 * sidx + 8 * g);
                    const f32x4 wv = *(const LAS f32x4*)(wqt + (2 * p + (g >> 1)) * 8 + 4 * (g & 1));
                    wq[p][0] = wv[0]; wq[p][1] = wv[1]; wq[p][2] = wv[2]; wq[p][3] = wv[3];
                    asm volatile("" ::: "memory"); }
                const int nst = limit >> 4;
                const bf16_t* kp = KI + ((size_t)b * SEQ + 16 * w + li) * 64 + 8 * g; const float* pp = PS + (size_t)36 * M + (size_t)b * SEQ + 16 * w + li;
                bf16x8 b0 = *(const bf16x8*)kp, b1 = *(const bf16x8*)(kp + 32); f32x2_t pk = (f32x2_t){pp[0], pp[(size_t)M]};
                bf16x8 d0 = b0, d1 = b1; f32x2_t pk2v = pk;
                if (w + 8 < nst) { kp += 8 * 16 * 64; pp += 8 * 16; d0 = *(const bf16x8*)kp; d1 = *(const bf16x8*)(kp + 32); pk2v = (f32x2_t){pp[0], pp[(size_t)M]}; }
#pragma unroll 1
                for (int st = w; st < nst; st += 8) {
                    const bf16x8 c0 = b0, c1 = b1; const float rk = rsqrtf((pk[0] + pk[1]) * (1.0f / 64.0f) + EPS);
                    b0 = d0; b1 = d1; pk = pk2v;
                    if (st + 16 < nst) { kp += 8 * 16 * 64; pp += 8 * 16; d0 = *(const bf16x8*)kp; d1 = *(const bf16x8*)(kp + 32); pk2v = (f32x2_t){pp[0], pp[(size_t)M]}; }
                    LAS float* so = (LAS float*)(lds + DSA_SC) + (g >> 1) * 2048 + 16 * st + li;
#pragma unroll
                    for (int p = 0; p < 8; ++p) {
                        f32x4 acc = (f32x4){0.f, 0.f, 0.f, 0.f};
                        acc = __builtin_amdgcn_mfma_f32_16x16x32_bf16(af[p][0], c0, acc, 0, 0, 0); acc = __builtin_amdgcn_mfma_f32_16x16x32_bf16(af[p][1], c1, acc, 0, 0, 0);
                        float part = (fmaxf(acc[0], 0.f) * wq[p][0] + fmaxf(acc[1], 0.f) * wq[p][1]) + (fmaxf(acc[2], 0.f) * wq[p][2] + fmaxf(acc[3], 0.f) * wq[p][3]);
                        {   const auto sw = __builtin_amdgcn_permlane16_swap(__float_as_uint(part), __float_as_uint(part), false, false);
                            part = __uint_as_float(sw[0]) + __uint_as_float(sw[1]); }
                        if ((g & 1) == 0) so[p * 4096] = part * rk + 0.0f;
                    }
                }
                __syncthreads();
                }
                for (int trep = 0; trep < 1 + ((DSA_REP >> 1) & 1); ++trep) {
                dsa_topk((const LAS float*)wl, il0, limit, lane);
                dsa_topk((const LAS float*)wl + 2048, il1, limit, lane); }
            } else {
                for (int j = lane; j < limit; j += 64) { il0[j] = (unsigned short)j; il1[j] = (unsigned short)j; }
            }
            const int count = limit < TOPK ? limit : TOPK;
            for (int arep = 0; arep < 1 + ((DSA_REP >> 2) & 1); ++arep) {
            dsa_attend(wl, il0, rctab, (LAS float*)(lds + DSA_KST + 8192 + w * 1024), Q0, Cb, AO, trow0, b, count, bound_l2, lane);
            dsa_attend(wl, il1, rctab, (LAS float*)(lds + DSA_KST + 8192 + w * 1024), Q1, Cb, AO, trow0 + 1, b, count, bound_l2, lane); }
        }
    }
    __syncthreads();
}

typedef const __attribute__((address_space(4))) Args* ArgsP;
__device__ __forceinline__ ArgsP fresh_args() { ArgsP p = (ArgsP)__builtin_amdgcn_kernarg_segment_ptr(); asm volatile("" : "+s"(p)); return p; }

__device__ __forceinline__ int fresh_bx() { int v = blockIdx.x; asm volatile("" : "+s"(v)); return v; }
__device__ __forceinline__ int fresh_gx() { int v = gridDim.x; asm volatile("" : "+s"(v)); return v; }
__global__ void __launch_bounds__(NWAVES * 64, 2) mega(Args args_unused) {
    extern __shared__ __attribute__((aligned(16))) unsigned char lds_raw[];
    LAS unsigned char* lds = (LAS unsigned char*)lds_raw;
    const int tid = threadIdx.x;
    for (int u = tid; u < (LDS_BYTES - LDSCTL_OFF) / 4; u += NWAVES * 64) ((LAS unsigned*)(lds + LDSCTL_OFF))[u] = 0u;
    __syncthreads();
    int lo, hi;
    {   ArgsP A = fresh_args(); lo = A->ph_lo; hi = A->ph_hi;
        if (hi - lo > 1) (void)xcd_barrier_post((unsigned*)(A->ws + WS_CTL) + CW_BAR + A->li * XCD_BAR_WORDS, (volatile LAS unsigned*)(lds + MISC_OFF) + 8); }
#ifndef PHMASK
#define PHMASK 0xffff
#endif
#define IN(k) (((PHMASK >> (k)) & 1) && lo <= (k) && (k) < hi)
#define SEAM(k) do { if (lo <= (k) && (k) + 1 < hi) { ArgsP A_ = fresh_args(); XcdBarrier b_; b_.bar = (unsigned*)(A_->ws + WS_CTL) + CW_BAR + A_->li * XCD_BAR_WORDS; b_.x = xb_xcc_id(); \
        b_.st = (volatile LAS unsigned*)(lds + MISC_OFF) + 8; xcd_barrier(b_); } } while (0)
#ifndef REPMASK
#define REPMASK 0
#endif
#define GBAR() do { ArgsP A_ = fresh_args(); XcdBarrier b_; b_.bar = (unsigned*)(A_->ws + WS_CTL) + CW_BAR + A_->li * XCD_BAR_WORDS; b_.x = xb_xcc_id(); \
        b_.st = (volatile LAS unsigned*)(lds + MISC_OFF) + 8; xcd_barrier(b_); } while (0)
#define REPEAT(k) for (int rep_ = 0; rep_ < 1 + ((REPMASK >> (k)) & 1); ++rep_)
#define REPBAR() do { if (rep_) GBAR(); } while (0)
#define GWS int t_ = threadIdx.x; asm volatile("" : "+v"(t_)); const int lane = t_ & 63, wave = __builtin_amdgcn_readfirstlane(t_ >> 6); const int G = fresh_gx(), bx = fresh_bx(); const int vcu = (G % 8 == 0) ? (bx % 8) * (G / 8) + bx / 8 : bx; \
        const int gw = vcu * NWAVES + wave, NGW = G * NWAVES; LAS float* scr = (LAS float*)(lds + wave * 16640); (void)lane; (void)gw; (void)NGW; (void)scr;
#define WCONV(Wp, K_, Nsrc_, N_, mode_, gain_, WT_) do { const int items_ = ((K_) / 64) * ((N_) / 64); \
        for (int it = gw; it < items_; it += NGW) p0_transpose_item((Wp), (K_), (Nsrc_), (N_), (mode_), (gain_), (WT_), scr, it, lane); } while (0)

    if (IN(PH_PRO)) REPEAT(PH_PRO) { REPBAR();
        GWS; ArgsP A = fresh_args(); unsigned char* ws = A->ws;
        constexpr int I0 = 16 * 28, I1 = I0 + 16 * 16, I5 = I1 + (16 * 88 - A1T), IX = I5 + M / 4;
        {   const float* x = A->in[0]; float* SS = (float*)(ws + WS_SS); bf16_t* XB = (bf16_t*)(ws + WS_XB);
#pragma unroll 1
            for (int it = gw; it < IX; it += NGW) {
                if (it < I0) p0_transpose_item(A->in[3], 1024, A_IN_COLS, A_IN_PAD, WM_AIN, A->in[1], (bf16_t*)(ws + WS_WAIN), scr, it, lane);
                else if (it < I1) p0_transpose_item(A->in[8], 1024, 1024, 1024, WM_NAT, (const float*)nullptr, (bf16_t*)(ws + WS_WAOUT), scr, it - I0, lane);
                else if (it < I5) p0_transpose_item(A->in[12], 1024, FF2, FF2, WM_FUP, A->in[2], (bf16_t*)(ws + WS_WFUP0), scr, it - I1 + A1T, lane);
                else { const int row0 = (it - I5) * 4;
                    f32x4 v[4][4];
#pragma unroll
                    for (int r = 0; r < 4; ++r)
#pragma unroll
                        for (int q = 0; q < 4; ++q) v[r][q] = ((const f32x4*)(x + (size_t)(row0 + r) * DM))[q * 64 + lane];
#pragma unroll
                    for (int r = 0; r < 4; ++r)
#pragma unroll
                        for (int q = 0; q < 4; ++q) { const f32x4 w = v[r][q]; float sq = (w[0] * w[0] + w[1] * w[1]) + (w[2] * w[2] + w[3] * w[3]); sq = wave_sum(sq);
                            if (lane < 4) SS[(size_t)(q * 4 + lane) * M + row0 + r] = lane == 0 ? sq : 0.f;
                            u32x2 o; o.x = pk2(w[0], w[1]); o.y = pk2(w[2], w[3]); *(u32x2*)(XB + (size_t)(row0 + r) * DM + q * 256 + lane * 4) = o; } } } }
        {   float2* ROPE = (float2*)(ws + WS_ROPE);
            for (int e = gw * 64 + lane; e < 2048 * 128; e += NGW * 64) { const int t = e >> 7, i = e & 127;
                const float inv = exp2f(-(float)(2 * i) * (13.287712379549449f / 256.0f)), ang = (float)t * inv; float sn, cs; sincosf(ang, &sn, &cs); ROPE[e] = make_float2(cs, sn); } }
        {   float* CSC = (float*)(ws + WS_CSC); const float* a_q_g = A->in[4]; const float* a_k_g = A->in[5]; const float* a_iq_g = A->in[6]; const float* a_ik_g = A->in[7];
            for (int n = gw * 64 + lane; n < A_IN_PAD; n += NGW * 64) { float v;
                if (n < 1024) v = a_q_g[n & 127] * a_k_g[n & 127] * 0.08838834764831845f; else if (n < 1152) v = 1.0f; else if (n < 1216) v = a_ik_g[n - 1152];
                else if (n < 1224) v = 0.044194173824159216f; else if (n < 1280) v = 0.f; else v = a_iq_g[(n - 1280) & 63];
                CSC[n] = v; } }
    }
    SEAM(PH_PRO);
    if (IN(PH_A1)) REPEAT(PH_A1) { REPBAR();
        ArgsP A = fresh_args(); unsigned char* ws = A->ws;
        pg8::Gemm g{(const bf16_t*)(ws + WS_XB), (const bf16_t*)(ws + WS_WAIN), M, A_IN_PAD, 1024}; pg8::StaticOrder S; S.init(M, A_IN_PAD, fresh_gx(), fresh_bx());
        pg8::EpiA1 E{(const float*)(ws + WS_SS), (const float*)(ws + WS_CSC), (bf16_t*)(ws + WS_QH), (bf16_t*)(ws + WS_C), (bf16_t*)(ws + WS_KI), (bf16_t*)(ws + WS_QI), (float*)(ws + WS_WI), (float*)(ws + WS_PS)};
        pg8::gemm_phase(lds, g, S, E);
        {
            int t_ = threadIdx.x; asm volatile("" : "+v"(t_)); const int lane = t_ & 63, wave = __builtin_amdgcn_readfirstlane(t_ >> 6); LAS float* scr = (LAS float*)(lds + wave * 16640);
            const int G_ = fresh_gx(), c_ = fresh_bx(); const int rem_ = ((M / 256) * (A_IN_PAD / 256)) % G_;
            if (c_ >= rem_) { const int nw_ = (G_ - rem_) * NWAVES, w0_ = (c_ - rem_) * NWAVES + wave;
#pragma unroll 1
                for (int it = w0_; it < A1T + 44 * 16; it += nw_) {
                    if (it < A1T) p0_transpose_item(A->in[12], 1024, FF2, FF2, WM_FUP, A->in[2], (bf16_t*)(ws + WS_WFUP0), scr, it, lane);
                    else p0_transpose_item(A->in[15], 2816, 1024, 1024, WM_NAT, (const float*)nullptr, (bf16_t*)(ws + WS_WFDN0), scr, it - A1T, lane); } } }
    }
    SEAM(PH_A1);
    if (IN(PH_A2)) REPEAT(PH_A2) { REPBAR();
        ArgsP A = fresh_args(); unsigned char* ws = A->ws; const int G = fresh_gx(), bx = fresh_bx(); const int vcu = (G % 8 == 0) ? (bx % 8) * (G / 8) + bx / 8 : bx;
        dsa_fast_phase(lds, (const bf16_t*)(ws + WS_QH), (const bf16_t*)(ws + WS_C), (const float*)(ws + WS_PS), (const bf16_t*)(ws + WS_QI), (const bf16_t*)(ws + WS_KI), (const float*)(ws + WS_WI), (const float*)(ws + WS_CSC), (bf16_t*)(ws + WS_AO), vcu, G);
    }
    SEAM(PH_A2);
    if (IN(PH_A3)) REPEAT(PH_A3) { REPBAR();
        ArgsP A = fresh_args(); unsigned char* ws = A->ws;
        pg8::Gemm g{(const bf16_t*)(ws + WS_AO), (const bf16_t*)(ws + WS_WAOUT), M, 1024, 1024}; pg8::StaticOrder S; S.init(M, 1024, fresh_gx(), fresh_bx());
        pg8::EpiRes<1> E{nullptr, nullptr, (bf16_t*)(ws + WS_XB), (float*)(ws + WS_SS)};
        pg8::gemm_phase(lds, g, S, E);
    }
    SEAM(PH_A3);
#define FFN_PHASES(LAYER, PH1, PH2) do { \
        if (IN(PH1)) REPEAT(PH1) { REPBAR(); \
            ArgsP A = fresh_args(); unsigned char* ws = A->ws; \
            pg8::Gemm g{(const bf16_t*)(ws + WS_XB), (const bf16_t*)(ws + ((LAYER) ? WS_WFUP1 : WS_WFUP0)), M, FF2, 1024}; pg8::StaticOrder S; S.init(M, FF2, fresh_gx(), fresh_bx()); \
            pg8::EpiF1 E{(const float*)(ws + WS_SS), A->in[13] + (size_t)(LAYER) * 3 * FF2, A->in[14] + (size_t)(LAYER) * FF2, (bf16_t*)(ws + ((LAYER) ? WS_H1 : WS_H0)), \
                         (float*)(ws + ((LAYER) ? WS_PART1 : WS_PART0)), (float*)(ws + ((LAYER) ? WS_HALO1 : WS_HALO0))}; \
            pg8::gemm_phase(lds, g, S, E); \
            {     \
                int t_ = threadIdx.x; asm volatile("" : "+v"(t_)); const int lane = t_ & 63, wave = __builtin_amdgcn_readfirstlane(t_ >> 6); LAS float* scr = (LAS float*)(lds + wave * 16640); \
                const int G_ = fresh_gx(), c_ = fresh_bx(); const int rem_ = ((M / 256) * (FF2 / 256)) % G_; \
                if (c_ >= rem_) { const int nw_ = (G_ - rem_) * NWAVES, w0_ = (c_ - rem_) * NWAVES + wave; \
                    if ((LAYER) == 0) { _Pragma("unroll 1") for (int it = w0_; it < 16 * 96 + 32 * 16; it += nw_) { \
                        if (it < 16 * 96) p0_transpose_item(A->in[9], 1024, B_IN_COLS, B_IN_COLS, WM_NAT, A->in[1] + 1024, (bf16_t*)(ws + WS_WBIN), scr, it, lane); \
                        else p0_transpose_item(A->in[11], 2048, 1024, 1024, WM_NAT, A->in[10], (bf16_t*)(ws + WS_WBOUT), scr, it - 16 * 96, lane); } } \
                    else { _Pragma("unroll 1") for (int it = w0_; it < 44 * 16; it += nw_) \
                        p0_transpose_item(A->in[15] + (size_t)2816 * 1024, 2816, 1024, 1024, WM_NAT, (const float*)nullptr, (bf16_t*)(ws + WS_WFDN1), scr, it, lane); } } } \
        } \
        SEAM(PH1); \
        if (IN(PH2)) { \
            ArgsP A = fresh_args(); unsigned char* ws = A->ws; bf16_t* Hb = (bf16_t*)(ws + ((LAYER) ? WS_H1 : WS_H0)); \
            pg8::Gemm g{Hb, (const bf16_t*)(ws + ((LAYER) ? WS_WFDN1 : WS_WFDN0)), M, 1024, D_FF}; pg8::StaticOrder S; S.init(M, 1024, fresh_gx(), fresh_bx()); \
            {   pg8::Unit u0; if (S.next(0, u0)) ffn_fixup(u0.pm, A->in[13] + (size_t)(LAYER) * 3 * FF2, (const float*)(ws + ((LAYER) ? WS_PART1 : WS_PART0)), (const float*)(ws + ((LAYER) ? WS_HALO1 : WS_HALO0)), Hb); \
                VM_WAIT(); __syncthreads(); } \
            if ((LAYER) == 0) { pg8::EpiRes<1> E{nullptr, nullptr, (bf16_t*)(ws + WS_XB), (float*)(ws + WS_SS)}; pg8::gemm_phase(lds, g, S, E); } \
            else { pg8::EpiRes<2> E{nullptr, A->out, (bf16_t*)(ws + WS_XB), nullptr}; pg8::gemm_phase(lds, g, S, E); } \
        } \
        SEAM(PH2); } while (0)
    FFN_PHASES(0, PH_F1A, PH_F2A);
    if (IN(PH_B1)) REPEAT(PH_B1) { REPBAR();
        ArgsP A = fresh_args(); unsigned char* ws = A->ws;
        pg8::Gemm g{(const bf16_t*)(ws + WS_XB), (const bf16_t*)(ws + WS_WBIN), M, 4096, 1024}; pg8::StaticOrder S; S.init(M, 4096, fresh_gx(), fresh_bx());
        pg8::EpiB1 E{(const float*)(ws + WS_SS), (const float2*)(ws + WS_ROPE), (bf16_t*)(ws + WS_QT), (bf16_t*)(ws + WS_KT), (bf16_t*)(ws + WS_VT)};
        pg8::gemm_phase(lds, g, S, E);
    }
    SEAM(PH_B1);
    if (IN(PH_B2)) REPEAT(PH_B2) { REPBAR();
        ArgsP A = fresh_args(); unsigned char* ws = A->ws;
        { const int G = fresh_gx(), bx = fresh_bx(); const int vcu = (G % 8 == 0) ? (bx % 8) * (G / 8) + bx / 8 : bx;
          for (int u = vcu; u < 256; u += G) ret_fast_phase(lds, (const bf16_t*)(ws + WS_QT), (const bf16_t*)(ws + WS_KT), (const bf16_t*)(ws + WS_VT), (bf16_t*)(ws + WS_RET), (float*)(ws + WS_SSR), u); }
    }
    SEAM(PH_B2);
    if (IN(PH_GATE)) REPEAT(PH_GATE) { REPBAR();
        {   ArgsP A = fresh_args(); unsigned char* ws = A->ws;
            pg8::Gemm g{(const bf16_t*)(ws + WS_XB), (const bf16_t*)(ws + WS_WBIN) + (size_t)4096 * 1024, M, 2048, 1024}; pg8::StaticOrder S; S.init(M, 2048, fresh_gx(), fresh_bx());
            pg8::EpiGate E{(const float*)(ws + WS_SS), (const float*)(ws + WS_SSR), (bf16_t*)(ws + WS_RET)};
            pg8::gemm_phase(lds, g, S, E); }
#if !defined(NO_WCONV2)
        {   GWS; ArgsP A = fresh_args(); unsigned char* ws = A->ws; constexpr int J0 = 16 * 88;
#pragma unroll 1
            for (int it = gw; it < J0; it += NGW) p0_transpose_item(A->in[12] + (size_t)1024 * FF2, 1024, FF2, FF2, WM_FUP, A->in[2] + 1024, (bf16_t*)(ws + WS_WFUP1), scr, it, lane); }
#endif
    }
    SEAM(PH_GATE);
    if (IN(PH_B3)) REPEAT(PH_B3) { REPBAR();
        ArgsP A = fresh_args(); unsigned char* ws = A->ws;
        pg8::Gemm g{(const bf16_t*)(ws + WS_RET), (const bf16_t*)(ws + WS_WBOUT), M, 1024, 2048}; pg8::StaticOrder S; S.init(M, 1024, fresh_gx(), fresh_bx());
        pg8::EpiRes<1> E{nullptr, nullptr, (bf16_t*)(ws + WS_XB), (float*)(ws + WS_SS)};
        pg8::gemm_phase(lds, g, S, E);
    }
    SEAM(PH_B3);
    FFN_PHASES(1, PH_F1B, PH_F2B);
#undef FFN_PHASES
#undef IN
#undef SEAM
}

extern "C" void kernel_launch(void* const* d_in, const int* in_sizes, int n_in, void* d_out, int out_size, void* d_ws, size_t ws_size, hipStream_t stream) {
    static int grid = 0;
    if (grid == 0) {
        int dev = 0, cus = 0, per_cu = 0;
        (void)hipGetDevice(&dev); (void)hipDeviceGetAttribute(&cus, hipDeviceAttributeMultiprocessorCount, dev);
        (void)hipFuncSetAttribute((const void*)mega, hipFuncAttributeMaxDynamicSharedMemorySize, LDS_BYTES);
        if (hipOccupancyMaxActiveBlocksPerMultiprocessor(&per_cu, (const void*)mega, NWAVES * 64, LDS_BYTES) != hipSuccess || per_cu < 1)
            fprintf(stderr, "kernel_launch: occupancy query reports %d workgroups per CU\n", per_cu);
        (void)hipGetLastError();
        grid = cus > 0 ? cus : 256;
        if (grid != 256) fprintf(stderr, "kernel_launch: %d CUs (built for 256)\n", grid);
    }
    unsigned char* ws = (unsigned char*)d_ws;
    (void)hipMemsetAsync(ws + WS_CTL, 0, CTL_ZERO_BYTES, stream);
    Args a{};
    for (int i = 0; i < 16; ++i) a.in[i] = (const float*)d_in[i];
    a.out = (float*)d_out; a.ws = ws;
    auto launch = [&](int lo, int hi, int li) { a.ph_lo = lo; a.ph_hi = hi; a.li = li; hipLaunchKernelGGL(mega, dim3(grid), dim3(NWAVES * 64), LDS_BYTES, stream, a); };
    launch(0, PH_END, 0);
}
```

```cpp
#include <hip/hip_runtime.h>
#include <stdint.h>
#include <stdio.h>

typedef unsigned short bf16_t;
typedef short bf16x8 __attribute__((ext_vector_type(8)));
typedef float f32x4 __attribute__((ext_vector_type(4)));
typedef unsigned u32x4 __attribute__((ext_vector_type(4)));
typedef unsigned u32x2 __attribute__((ext_vector_type(2)));

#ifndef MK_LAUNCH_MODE
#define MK_LAUNCH_MODE 1
#endif

constexpr int BATCH = 8, SEQ = 2048, DM = 1024, M = BATCH * SEQ;
constexpr int TOPK = 256;
constexpr int A_IN_COLS = 1736, A_IN_PAD = 1792;
constexpr int O2 = 1152, O3 = 1664, O4 = 1728;
constexpr int B_IN_COLS = 6144;
constexpr int D_FF = 2816, FF2 = 5632;
constexpr float EPS = 1e-6f;

constexpr size_t MiB = 1u << 20;
constexpr size_t WS_CTL = 0, CTL_ZERO_BYTES = 65536;
constexpr size_t WS_SS = 1 * MiB;
constexpr size_t WS_WI = 2 * MiB;
constexpr size_t WS_CSC = 2 * MiB + 512 * 1024;
constexpr size_t WS_ROPE = 3 * MiB;
constexpr size_t WS_SSR = 249 * MiB;
constexpr size_t WS_WBIN = 8 * MiB;
constexpr size_t WS_WBOUT = 20 * MiB;
constexpr size_t WS_XB = 24 * MiB;
constexpr size_t WS_WAIN = 56 * MiB;
constexpr size_t WS_WAOUT = 60 * MiB;
constexpr size_t WS_QH = 64 * MiB;
constexpr size_t WS_AO = 96 * MiB;
constexpr size_t WS_QI = 128 * MiB;
constexpr size_t WS_C = 144 * MiB;
constexpr size_t WS_KI = 148 * MiB;
constexpr size_t WS_PS = 150 * MiB;
constexpr size_t WS_WFUP0 = 232 * MiB;
constexpr size_t WS_WFDN0 = 243 * MiB;
constexpr size_t WS_H0 = 64 * MiB;
constexpr size_t WS_PART0 = 152 * MiB;
constexpr size_t WS_HALO0 = 155 * MiB;
constexpr size_t WS_QT = 56 * MiB;
constexpr size_t WS_KT = 88 * MiB;
constexpr size_t WS_VT = 120 * MiB;
constexpr size_t WS_RET = 184 * MiB;
constexpr size_t WS_WFUP1 = 56 * MiB;
constexpr size_t WS_WFDN1 = 67 * MiB;
constexpr size_t WS_H1 = 88 * MiB;
constexpr size_t WS_PART1 = 176 * MiB;
constexpr size_t WS_HALO1 = 179 * MiB;

__device__ __forceinline__ unsigned short f2bf(float f) { unsigned u = __float_as_uint(f); return (unsigned short)((u + 0x7fffu + ((u >> 16) & 1u)) >> 16); }
__device__ __forceinline__ float bf2f(unsigned short h) { return __uint_as_float(((unsigned)h) << 16); }
__device__ __forceinline__ float bflo(unsigned w) { return __uint_as_float(w << 16); }
__device__ __forceinline__ float bfhi(unsigned w) { return __uint_as_float(w & 0xffff0000u); }
typedef __bf16 bf16x2_t __attribute__((ext_vector_type(2)));
typedef float f32x2_t __attribute__((ext_vector_type(2)));
__device__ __forceinline__ unsigned pk2(float lo, float hi) { const f32x2_t v = {lo, hi}; return __builtin_bit_cast(unsigned, __builtin_convertvector(v, bf16x2_t)); }
__device__ __forceinline__ float wave_sum(float v) {
#pragma unroll
    for (int o = 1; o < 64; o <<= 1) v += __shfl_xor(v, o);
    return v;
}
__device__ __forceinline__ float siluf(float x) { return x * __builtin_amdgcn_rcpf(1.0f + __builtin_amdgcn_exp2f(-1.4426950408889634f * x)); }
__device__ __forceinline__ float gamma_log(int h) { return h == 0 ? -0.031748698314580301f : h == 1 ? -0.015748356968139168f : h == 2 ? -0.0078431774610258787f : -0.0039138993211363287f; }

enum { WM_NAT = 0, WM_AIN = 1, WM_FUP = 2 };
__device__ __forceinline__ int wmap(int mode, int n) {
    if (mode == WM_NAT) return n;
    if (mode == WM_AIN) {
        if (n < 1152) return n;
        if (n < 1216) return O3 + (n - 1152);
        if (n < 1224) return O4 + (n - 1216);
        if (n < 1280) return -1;
        return O2 + (n - 1280);
    }
    const int p = n >> 8, bj = (n >> 7) & 1, i = n & 127;
    return bj * D_FF + 128 * p + i;
}

namespace pg8 {
#define PG8_LAS __attribute__((address_space(3)))
constexpr int BM = 256, BK = 64, HALF = 128, HTB = HALF * BK * 2, STAGE_BYTES = 8 * HTB, NXCD = 8, WGM = 8;
constexpr int XCH_OFF = 0, CWT_OFF = 2048, RT1_OFF = 6144, RT2_OFF = 14336;
__host__ __device__ __forceinline__ int lds_byte(int r, int c) { const int st = (r >> 4) * 2 + (c >> 5), rr = r & 15, cc = c & 31, ob = rr * 64 + cc * 2; return st * 1024 + (ob ^ (((ob >> 9) & 1) << 5)); }
__host__ __device__ __forceinline__ void stage_rc(int b, int& R, int& C) { const int st = b / 1024, sb = b % 1024, swz = sb ^ (((sb >> 9) & 1) << 5); R = (st >> 1) * 16 + swz / 64; C = (st & 1) * 32 + (swz % 64) / 2; }
__host__ __device__ __forceinline__ int perm32(int rho) { const int n = rho >> 4, i = rho & 15; return 8 * (i >> 2) + 4 * n + (i & 3); }
struct Unit { int pm, pn; };
struct Gemm { const bf16_t* A; const bf16_t* Bt; int M, N, K; };
struct StaticOrder {
    int nM, nN, nwg, G, c;
    __host__ __device__ __forceinline__ void init(int M_, int N_, int G_, int c_) { nM = M_ / BM; nN = N_ / BM; nwg = nM * nN; G = G_; c = c_; }
    __host__ __device__ __forceinline__ bool next(int i, Unit& u) const {
        const long L = (long)i * G + c; if (L >= nwg) return false;
        int wgid = (int)L; { const int q = nwg / NXCD, r = nwg % NXCD, xcd = wgid % NXCD, off = wgid / NXCD; wgid = (xcd < r ? xcd * (q + 1) : r * (q + 1) + (xcd - r) * q) + off; }
        const int nig = WGM * nN, gid = wgid / nig, fm = gid * WGM, gsz = (nM - fm) < WGM ? (nM - fm) : WGM;
        u.pm = fm + ((wgid % nig) % gsz); u.pn = (wgid % nig) / gsz; return true;
    }
};
__device__ __forceinline__ float rstd16(const float* ss16, int row) {
    float s = 0.f;
#pragma unroll
    for (int g = 0; g < 16; ++g) s += ss16[(size_t)g * M + row];
    return rsqrtf(s * (1.0f / DM) + EPS);
}
__device__ __forceinline__ float sel4(const float (&s)[4], int fq) { return fq == 0 ? s[0] : fq == 1 ? s[1] : fq == 2 ? s[2] : s[3]; }
__device__ __forceinline__ float ssq8(const f32x4 a, const f32x4 b) { return ((a[0] * a[0] + a[1] * a[1]) + (a[2] * a[2] + a[3] * a[3])) + ((b[0] * b[0] + b[1] * b[1]) + (b[2] * b[2] + b[3] * b[3])); }
__device__ __forceinline__ u32x4 pack8(const f32x4 a, const f32x4 b) { u32x4 w; w.x = pk2(a[0], a[1]); w.y = pk2(a[2], a[3]); w.z = pk2(b[0], b[1]); w.w = pk2(b[2], b[3]); return w; }

template <int MODE>
struct EpiRes {
    static constexpr bool PERM = true;
    static constexpr bool AROWPERM = false;
    const float* basef; float* out; bf16_t* xb; float* ss16;
    static constexpr int NTAB = 0;
    __device__ __forceinline__ void fill(PG8_LAS unsigned char*, int, const Unit&, int) const {}
    __device__ __forceinline__ void operator()(f32x4 (&acc)[2][2][4][2], const Unit& u, int ui, int wr, int wc, int fr, int fq, PG8_LAS unsigned char*) const {
        const int row0 = u.pm * BM + wr * 64 + fr, colb = u.pn * BM + wc * 32 + 8 * fq;
#pragma unroll
        for (int ai = 0; ai < 2; ++ai) {
            f32x4 bv[4][2][2];
#pragma unroll
            for (int m = 0; m < 4; ++m)
#pragma unroll
                for (int bj = 0; bj < 2; ++bj) { const size_t o = (size_t)(row0 + ai * HALF + m * 16) * DM + colb + bj * HALF;
                    if (MODE == 0) { bv[m][bj][0] = *(const f32x4*)(basef + o); bv[m][bj][1] = *(const f32x4*)(basef + o + 4); }
                    else { const u32x4 w = *(const u32x4*)(xb + o); bv[m][bj][0] = (f32x4){bflo(w.x), bfhi(w.x), bflo(w.y), bfhi(w.y)}; bv[m][bj][1] = (f32x4){bflo(w.z), bfhi(w.z), bflo(w.w), bfhi(w.w)}; } }
            float sm[4];
#pragma unroll
            for (int m = 0; m < 4; ++m) { const int row = row0 + ai * HALF + m * 16; float s = 0.f;
#pragma unroll
                for (int bj = 0; bj < 2; ++bj) { const size_t o = (size_t)row * DM + colb + bj * HALF;
                    const f32x4 v0 = acc[ai][bj][m][0] + bv[m][bj][0], v1 = acc[ai][bj][m][1] + bv[m][bj][1];
                    if (MODE == 2) { *(f32x4*)(out + o) = v0; *(f32x4*)(out + o + 4) = v1; }
                    else { s += ssq8(v0, v1); *(u32x4*)(xb + o) = pack8(v0, v1); } }
                if (MODE != 2) { s += __shfl_xor(s, 16); s += __shfl_xor(s, 32); }
                sm[m] = s; }
            if (MODE != 2) ss16[(size_t)(u.pn * 4 + wc) * M + u.pm * BM + ai * HALF + wr * 64 + 16 * fq + fr] = sel4(sm, fq);
            asm volatile("" ::: "memory"); }
    }
};
struct EpiA1 {
    static constexpr bool PERM = true;
    static constexpr bool AROWPERM = false;
    const float* ss16; const float* csc; bf16_t* Q; bf16_t* C; bf16_t* KI; bf16_t* QI; float* WI; float* PS;
    static constexpr int NTAB = 1;
    __device__ __forceinline__ void fill(PG8_LAS unsigned char* xl, int i, const Unit& u, int t) const { ((PG8_LAS float*)(xl + RT1_OFF))[i * 256 + t] = rstd16(ss16, u.pm * BM + t); }
    __device__ __forceinline__ void operator()(f32x4 (&acc)[2][2][4][2], const Unit& u, int ui, int wr, int wc, int fr, int fq, PG8_LAS unsigned char* xl) const {
        const int row0 = u.pm * BM + wr * 64 + fr, pn = u.pn;
        const PG8_LAS float* rt = (const PG8_LAS float*)(xl + RT1_OFF) + ui * 256 + wr * 64 + fr;
        float rs[2][4];
#pragma unroll
        for (int ai = 0; ai < 2; ++ai)
#pragma unroll
            for (int m = 0; m < 4; ++m) rs[ai][m] = rt[ai * HALF + m * 16];
#pragma unroll
        for (int bj = 0; bj < 2; ++bj) {
            const int cl = bj * HALF + wc * 32 + 8 * fq, gcol = pn * BM + cl;
            const f32x4 c0 = *(const f32x4*)(csc + gcol), c1 = *(const f32x4*)(csc + gcol + 4);
            bf16_t* dst; int ld; bool st16 = true, stwi = false;
            if (pn < 4) { dst = Q + gcol; ld = 1024; }
            else if (pn == 4) { if (bj == 0) { dst = C + cl; ld = 128; } else if (wc < 2) { dst = KI + (wc * 32 + 8 * fq); ld = 64; } else { dst = Q; ld = 0; st16 = false; stwi = (wc == 2) && (fq == 0); } }
            else { dst = QI + (pn - 5) * 256 + cl; ld = 512; }
#pragma unroll
            for (int ai = 0; ai < 2; ++ai) { float sm[4];
#pragma unroll
                for (int m = 0; m < 4; ++m) { const int row = row0 + ai * HALF + m * 16; const float r = rs[ai][m];
                    const f32x4 v0 = acc[ai][bj][m][0] * r, v1 = acc[ai][bj][m][1] * r;
                    float s = ssq8(v0, v1); s += __shfl_xor(s, 16); s += __shfl_xor(s, 32); sm[m] = s;
                    const f32x4 o0 = v0 * c0, o1 = v1 * c1;
                    if (st16) *(u32x4*)(dst + (size_t)row * ld) = pack8(o0, o1);
                    if (stwi) { *(f32x4*)(WI + (size_t)row * 8) = o0; *(f32x4*)(WI + (size_t)row * 8 + 4) = o1; }
                    if (m & 1) asm volatile("" ::: "memory"); }
                PS[(size_t)(pn * 8 + bj * 4 + wc) * M + u.pm * BM + ai * HALF + wr * 64 + 16 * fq + fr] = sel4(sm, fq); }
        }
    }
};
struct EpiF1 {
    static constexpr bool PERM = false;
    static constexpr bool AROWPERM = true;
    static constexpr int NTAB = 1;
    const float* ss16; const float* cw; const float* cb; bf16_t* H; float* PART; float* HALO;
    __device__ __forceinline__ void fill(PG8_LAS unsigned char* xl, int i, const Unit& u, int t) const { ((PG8_LAS float*)(xl + RT1_OFF))[i * 256 + t] = rstd16(ss16, u.pm * BM + t); }
    __device__ __forceinline__ void operator()(f32x4 (&acc)[2][2][4][2], const Unit& u, int ui, int wr, int wc, int fr, int fq, PG8_LAS unsigned char* xl) const {
        const int trow0 = 8 * (16 * wr + fr), grow0 = u.pm * BM + trow0, hcol = 128 * u.pn + 32 * wc + 4 * fq, tcol = 32 * wc + 4 * fq;
        const PG8_LAS float* rt = (const PG8_LAS float*)(xl + RT1_OFF) + ui * 256 + trow0;
        {   const f32x4 r0 = *(const PG8_LAS f32x4*)rt, r1 = *(const PG8_LAS f32x4*)(rt + 4);
#pragma unroll
            for (int m = 0; m < 4; ++m)
#pragma unroll
                for (int bj = 0; bj < 2; ++bj) { acc[0][bj][m][0] *= r0[m]; acc[0][bj][m][1] *= r0[m]; acc[1][bj][m][0] *= r1[m]; acc[1][bj][m][1] *= r1[m]; } }
        {   PG8_LAS float* cwt = (PG8_LAS float*)(xl + CWT_OFF); const int tid = ((wr * 4 + wc) * 4 + fq) * 16 + fr;
#pragma unroll
            for (int r = 0; r < 2; ++r) { const int idx = tid + r * 512, k = idx >> 8, c = idx & 255, orig = (c < 128) ? 128 * u.pn + c : D_FF + 128 * u.pn + (c - 128);
                cwt[idx] = (k < 3) ? cw[(size_t)k * FF2 + orig] : cb[orig]; } }
        PG8_LAS f32x4* X = (PG8_LAS f32x4*)(xl + XCH_OFF) + (wc * 4 + fq) * 8;
        if (wr == 0 && fr == 15) {
#pragma unroll
            for (int bj = 0; bj < 2; ++bj)
#pragma unroll
                for (int e = 0; e < 2; ++e)
#pragma unroll
                    for (int n = 0; n < 2; ++n) X[(bj * 2 + e) * 2 + n] = acc[1][bj][2 + e][n];
        }
        asm volatile("s_waitcnt vmcnt(0) lgkmcnt(0)" ::: "memory"); __builtin_amdgcn_s_barrier(); asm volatile("" ::: "memory");
        const bool need_fix = (wr == 0) && (fr == 0) && ((u.pm & 7) != 0);
        const bool give_halo = (wr == 1) && (fr == 15);
        const bool take_x = (wr == 1) && (fr == 0);
        float* part = PART + (size_t)u.pm * (2 * 2 * D_FF) + hcol;
        float* halo = HALO + (size_t)u.pm * (2 * 2 * D_FF) + hcol;
        const PG8_LAS float* cwt = (const PG8_LAS float*)(xl + CWT_OFF) + tcol;
#pragma unroll
        for (int n = 0; n < 2; ++n) {
            f32x4 pa[2], pb[2];
#pragma unroll
            for (int e = 0; e < 2; ++e) {
                f32x4 ha = (f32x4){0.f, 0.f, 0.f, 0.f}, hb = (f32x4){0.f, 0.f, 0.f, 0.f};
                if (take_x) { ha = X[(0 * 2 + e) * 2 + n]; hb = X[(1 * 2 + e) * 2 + n]; }
#pragma unroll
                for (int j = 0; j < 4; ++j) {
                    pa[e][j] = __int_as_float(__builtin_amdgcn_update_dpp(__float_as_int(ha[j]), __float_as_int(acc[1][0][2 + e][n][j]), 0x111, 0xf, 0xf, false));
                    pb[e][j] = __int_as_float(__builtin_amdgcn_update_dpp(__float_as_int(hb[j]), __float_as_int(acc[1][1][2 + e][n][j]), 0x111, 0xf, 0xf, false)); } }
            const f32x4 wa0 = *(const PG8_LAS f32x4*)(cwt + 16 * n), wa1 = *(const PG8_LAS f32x4*)(cwt + 256 + 16 * n), wa2 = *(const PG8_LAS f32x4*)(cwt + 512 + 16 * n), ba = *(const PG8_LAS f32x4*)(cwt + 768 + 16 * n);
            const f32x4 wb0 = *(const PG8_LAS f32x4*)(cwt + 128 + 16 * n), wb1 = *(const PG8_LAS f32x4*)(cwt + 384 + 16 * n), wb2 = *(const PG8_LAS f32x4*)(cwt + 640 + 16 * n), bb = *(const PG8_LAS f32x4*)(cwt + 896 + 16 * n);
            if (give_halo) {
                *(f32x4*)(halo + 16 * n) = acc[1][0][2][n]; *(f32x4*)(halo + D_FF + 16 * n) = acc[1][1][2][n];
                *(f32x4*)(halo + 2 * D_FF + 16 * n) = acc[1][0][3][n]; *(f32x4*)(halo + 3 * D_FF + 16 * n) = acc[1][1][3][n]; }
            u32x2 wprev = (u32x2){0u, 0u};
#pragma unroll
            for (int e = 0; e < 8; ++e) {
                const f32x4 ua = acc[e >> 2][0][e & 3][n], ub = acc[e >> 2][1][e & 3][n];
                const f32x4 ua1 = e >= 1 ? acc[(e - 1) >> 2][0][(e - 1) & 3][n] : pa[1], ub1 = e >= 1 ? acc[(e - 1) >> 2][1][(e - 1) & 3][n] : pb[1];
                const f32x4 ua2 = e >= 2 ? acc[(e - 2) >> 2][0][(e - 2) & 3][n] : pa[e], ub2 = e >= 2 ? acc[(e - 2) >> 2][1][(e - 2) & 3][n] : pb[e];
                const f32x4 av = ba + wa2 * ua + wa1 * ua1 + wa0 * ua2, bv = bb + wb2 * ub + wb1 * ub1 + wb0 * ub2;
                if (e < 2 && need_fix) { *(f32x4*)(part + (size_t)e * 2 * D_FF + 16 * n) = av; *(f32x4*)(part + (size_t)e * 2 * D_FF + D_FF + 16 * n) = bv; }
                u32x2 w; w.x = pk2(siluf(av[0]) * bv[0], siluf(av[1]) * bv[1]); w.y = pk2(siluf(av[2]) * bv[2], siluf(av[3]) * bv[3]);
                if ((e & 1) == 0) wprev = w;
                else {
                    const auto sx = __builtin_amdgcn_permlane16_swap(wprev.x, w.x, false, false), sy = __builtin_amdgcn_permlane16_swap(wprev.y, w.y, false, false);
                    u32x4 w4; w4.x = sx[0]; w4.y = sy[0]; w4.z = sx[1]; w4.w = sy[1];
                    *(u32x4*)(H + (size_t)(grow0 + e - 1 + (fq & 1)) * D_FF + 128 * u.pn + 32 * wc + 16 * n + 4 * (fq & 2)) = w4; }
            }
            asm volatile("" ::: "memory");
        }
    }
};
struct EpiB1 {
    static constexpr bool PERM = false;
    static constexpr bool AROWPERM = true;
    static constexpr int NTAB = 1;
    const float* ss16; const float2* rope; bf16_t* QT; bf16_t* KT; bf16_t* VT;
    __device__ __forceinline__ void fill(PG8_LAS unsigned char* xl, int i, const Unit& u, int t) const { ((PG8_LAS float*)(xl + RT1_OFF))[i * 256 + t] = rstd16(ss16, u.pm * BM + t); }
    __device__ __forceinline__ void operator()(f32x4 (&acc)[2][2][4][2], const Unit& u, int ui, int wr, int wc, int fr, int fq, PG8_LAS unsigned char* xl) const {
        const int trow0 = 8 * (16 * wr + fr), grow0 = u.pm * BM + trow0, pn = u.pn, t0 = grow0 & (SEQ - 1);
        const PG8_LAS float* rt = (const PG8_LAS float*)(xl + RT1_OFF) + ui * 256 + trow0;
        const f32x4 r0 = *(const PG8_LAS f32x4*)rt, r1 = *(const PG8_LAS f32x4*)(rt + 4);
        if (pn < 8) {
            const int h = pn & 3; const bool isk = pn >= 4; const float lg = gamma_log(h);
            bf16_t* dbase = (isk ? KT : QT) + (size_t)grow0 * 1024 + h * 256 + 32 * wc + 4 * (fq & 2);
            float sc[8];
#pragma unroll
            for (int e = 0; e < 8; ++e) { const int pos = (t0 + e) & 63; sc[e] = (e < 4 ? r0[e & 3] : r1[e & 3]) * (isk ? 0.0625f * __expf(-(float)(pos + 1) * lg) : __expf((float)(pos + 1) * lg)); }
#pragma unroll
            for (int n = 0; n < 2; ++n) {
                const int i0 = 32 * wc + 16 * n + 4 * fq;
                f32x4 cur[2], dw[2];
                {   const f32x4* rp = (const f32x4*)(rope + (size_t)t0 * 128 + i0); const f32x4* rw = (const f32x4*)(rope + (size_t)128 + i0); cur[0] = rp[0]; cur[1] = rp[1]; dw[0] = rw[0]; dw[1] = rw[1]; }
                u32x2 p1 = (u32x2){0u, 0u}, p2 = (u32x2){0u, 0u};
#pragma unroll
                for (int e = 0; e < 8; ++e) {
                    const f32x4 c0 = cur[0], c1 = cur[1];
                    const f32x4 x1 = acc[e >> 2][0][e & 3][n] * sc[e], x2 = acc[e >> 2][1][e & 3][n] * sc[e];
                    f32x4 o1, o2;
                    o1[0] = x1[0] * c0[0] - x2[0] * c0[1]; o2[0] = x1[0] * c0[1] + x2[0] * c0[0];
                    o1[1] = x1[1] * c0[2] - x2[1] * c0[3]; o2[1] = x1[1] * c0[3] + x2[1] * c0[2];
                    o1[2] = x1[2] * c1[0] - x2[2] * c1[1]; o2[2] = x1[2] * c1[1] + x2[2] * c1[0];
                    o1[3] = x1[3] * c1[2] - x2[3] * c1[3]; o2[3] = x1[3] * c1[3] + x2[3] * c1[2];
                    u32x2 w1, w2; w1.x = pk2(o1[0], o1[1]); w1.y = pk2(o1[2], o1[3]); w2.x = pk2(o2[0], o2[1]); w2.y = pk2(o2[2], o2[3]);
                    if ((e & 1) == 0) { p1 = w1; p2 = w2; }
                    else {
                        const auto ax = __builtin_amdgcn_permlane16_swap(p1.x, w1.x, false, false), ay = __builtin_amdgcn_permlane16_swap(p1.y, w1.y, false, false);
                        const auto bx = __builtin_amdgcn_permlane16_swap(p2.x, w2.x, false, false), by = __builtin_amdgcn_permlane16_swap(p2.y, w2.y, false, false);
                        bf16_t* d = dbase + (size_t)(e - 1 + (fq & 1)) * 1024 + 16 * n;
                        u32x4 v1; v1.x = ax[0]; v1.y = ay[0]; v1.z = ax[1]; v1.w = ay[1]; *(u32x4*)d = v1;
                        u32x4 v2; v2.x = bx[0]; v2.y = by[0]; v2.z = bx[1]; v2.w = by[1]; *(u32x4*)(d + 128) = v2; }
                    if (e < 7) {
#pragma unroll
                        for (int q = 0; q < 2; ++q) { const f32x4 c = cur[q], dd = dw[q]; f32x4 nx;
                            nx[0] = c[0] * dd[0] - c[1] * dd[1]; nx[1] = c[1] * dd[0] + c[0] * dd[1]; nx[2] = c[2] * dd[2] - c[3] * dd[3]; nx[3] = c[3] * dd[2] + c[2] * dd[3]; cur[q] = nx; } }
                }
                asm volatile("" ::: "memory");
            }
        } else {
            const int b = grow0 / SEQ;
            bf16_t* dst = VT + ((size_t)b * 2048 + (pn - 8) * 256 + 32 * wc + 4 * fq) * SEQ + t0;
#pragma unroll
            for (int bj = 0; bj < 2; ++bj)
#pragma unroll
                for (int n = 0; n < 2; ++n)
#pragma unroll
                    for (int j = 0; j < 4; ++j) { u32x4 w;
                        w.x = pk2(acc[0][bj][0][n][j] * r0[0], acc[0][bj][1][n][j] * r0[1]); w.y = pk2(acc[0][bj][2][n][j] * r0[2], acc[0][bj][3][n][j] * r0[3]);
                        w.z = pk2(acc[1][bj][0][n][j] * r1[0], acc[1][bj][1][n][j] * r1[1]); w.w = pk2(acc[1][bj][2][n][j] * r1[2], acc[1][bj][3][n][j] * r1[3]);
                        *(u32x4*)(dst + (size_t)(128 * bj + 16 * n + j) * SEQ) = w; }
        }
    }
};
struct EpiGate {
    static constexpr bool PERM = true;
    static constexpr bool AROWPERM = false;
    static constexpr int NTAB = 1;
    const float* ss16; const float* ssr; bf16_t* RET;
    __device__ __forceinline__ void fill(PG8_LAS unsigned char* xl, int i, const Unit& u, int t) const {
        const int row = u.pm * BM + t;
        ((PG8_LAS float*)(xl + RT1_OFF))[i * 256 + t] = rstd16(ss16, row);
        const f32x4* sp = (const f32x4*)(ssr + ((size_t)row * 4 + (u.pn >> 1)) * 16); const f32x4 s0 = sp[0], s1 = sp[1], s2 = sp[2], s3 = sp[3];
        ((PG8_LAS float*)(xl + RT2_OFF))[i * 256 + t] = rsqrtf(((((s0[0] + s0[1]) + (s0[2] + s0[3])) + ((s1[0] + s1[1]) + (s1[2] + s1[3]))) + (((s2[0] + s2[1]) + (s2[2] + s2[3])) + ((s3[0] + s3[1]) + (s3[2] + s3[3])))) * (1.0f / 512.0f) + EPS);
    }
    __device__ __forceinline__ void operator()(f32x4 (&acc)[2][2][4][2], const Unit& u, int ui, int wr, int wc, int fr, int fq, PG8_LAS unsigned char* xl) const {
        const int row0 = u.pm * BM + wr * 64 + fr, colb = u.pn * BM + wc * 32 + 8 * fq;
        const PG8_LAS float* rt = (const PG8_LAS float*)(xl + RT1_OFF) + ui * 256 + wr * 64 + fr;
        const PG8_LAS float* rt2 = (const PG8_LAS float*)(xl + RT2_OFF) + ui * 256 + wr * 64 + fr;
        u32x4 rvv[2][4][2];
#pragma unroll
        for (int ai = 0; ai < 2; ++ai)
#pragma unroll
            for (int m = 0; m < 4; ++m)
#pragma unroll
                for (int bj = 0; bj < 2; ++bj) rvv[ai][m][bj] = *(const u32x4*)(RET + (size_t)(row0 + ai * HALF + m * 16) * 2048 + colb + bj * HALF);
#pragma unroll
        for (int ai = 0; ai < 2; ++ai)
#pragma unroll
            for (int m = 0; m < 4; ++m) { const int row = row0 + ai * HALF + m * 16; const float r = rt[ai * HALF + m * 16], rh = rt2[ai * HALF + m * 16];
#pragma unroll
                for (int bj = 0; bj < 2; ++bj) { bf16_t* p = RET + (size_t)row * 2048 + colb + bj * HALF; const u32x4 rv = rvv[ai][m][bj];
                    const f32x4 g0 = acc[ai][bj][m][0] * r, g1 = acc[ai][bj][m][1] * r; f32x4 y0, y1;
                    y0[0] = bflo(rv.x) * rh * siluf(g0[0]); y0[1] = bfhi(rv.x) * rh * siluf(g0[1]); y0[2] = bflo(rv.y) * rh * siluf(g0[2]); y0[3] = bfhi(rv.y) * rh * siluf(g0[3]);
                    y1[0] = bflo(rv.z) * rh * siluf(g1[0]); y1[1] = bfhi(rv.z) * rh * siluf(g1[1]); y1[2] = bflo(rv.w) * rh * siluf(g1[2]); y1[3] = bfhi(rv.w) * rh * siluf(g1[3]);
                    *(u32x4*)p = pack8(y0, y1); } }
    }
};

template <class Epi, class Sched>
__device__ __forceinline__ void gemm_phase(PG8_LAS unsigned char* lds, const Gemm g, const Sched& S, const Epi& E) {
    int tid_ = threadIdx.x; asm volatile("" : "+v"(tid_));
    const int tid = tid_, wid = __builtin_amdgcn_readfirstlane(tid >> 6), lane = tid & 63, wr = wid >> 2, wc = wid & 3, fr = lane & 15, fq = lane >> 4;
    const int K = g.K, nt = K / BK;
    unsigned voffA0[2], voffA1[2], voffB[2];
#pragma unroll
    for (int i = 0; i < 2; ++i) { int R, C; stage_rc(tid * 16 + i * 8192, R, C); const int Rb = Epi::PERM ? (R & ~31) + perm32(R & 31) : R;
        int ra0, ra1;
        if (Epi::AROWPERM) { const int base = ((R >> 6) * 16 + (R & 15)) * 8 + ((R >> 4) & 3); ra0 = base; ra1 = base + 4; } else { ra0 = R; ra1 = R + HALF; }
        voffA0[i] = (unsigned)(ra0 * K + C) * 2u; voffA1[i] = (unsigned)(ra1 * K + C) * 2u; voffB[i] = (unsigned)(Rb * K + C) * 2u; }
    const size_t kstep = (size_t)(BK * 2);
    const size_t hstep = (size_t)HALF * K * 2;
    const size_t tstep = 2 * hstep;
    const unsigned ldsw = (unsigned)wid * 1024u;
    const int aoff = lds_byte(wr * 64 + fr, fq * 8), boff = lds_byte(wc * 32 + fr, fq * 8);
#define PG8_SA(b, h) (((b) * 2 + (h)) * HTB)
#define PG8_SB(b, h) ((4 + (b) * 2 + (h)) * HTB)
#define PG8_STAGE(bufoff, gbase, voff) do { _Pragma("unroll") for (int _i = 0; _i < 2; ++_i) \
        __builtin_amdgcn_global_load_lds((const unsigned*)((const char*)(gbase) + (voff)[_i]), (PG8_LAS unsigned*)(lds + (bufoff) + ldsw + _i * 8192), 16, 0, 0); } while (0)
#define PG8_LDA(dst, b, h) do { _Pragma("unroll") for (int m = 0; m < 4; ++m) _Pragma("unroll") for (int k = 0; k < 2; ++k) dst[m][k] = *(const PG8_LAS bf16x8*)(lds + PG8_SA(b, h) + aoff + m * 2048 + k * 1024); } while (0)
#define PG8_LDB(dst, b, h) do { _Pragma("unroll") for (int n = 0; n < 2; ++n) _Pragma("unroll") for (int k = 0; k < 2; ++k) dst[n][k] = *(const PG8_LAS bf16x8*)(lds + PG8_SB(b, h) + boff + n * 2048 + k * 1024); } while (0)
#define PG8_MMA(ai, bj, At, Bt) do { __builtin_amdgcn_s_setprio(1); _Pragma("unroll") for (int m = 0; m < 4; ++m) _Pragma("unroll") for (int n = 0; n < 2; ++n) _Pragma("unroll") for (int k = 0; k < 2; ++k) \
        acc[ai][bj][m][n] = __builtin_amdgcn_mfma_f32_16x16x32_bf16(Bt[n][k], At[m][k], acc[ai][bj][m][n], 0, 0, 0); __builtin_amdgcn_s_setprio(0); } while (0)
#define PG8_WAIT_V(n) asm volatile("s_waitcnt vmcnt(" #n ")" ::: "memory")
#define PG8_WAIT_L(n) asm volatile("s_waitcnt lgkmcnt(" #n ")" ::: "memory")
#define PG8_BAR __builtin_amdgcn_s_barrier()
#define PG8_SCHED __builtin_amdgcn_sched_barrier(0)
    Unit cur, nxt; int ui = 0;
    if (!S.next(0, cur)) return;
    f32x4 acc[2][2][4][2];
#pragma unroll
    for (int a = 0; a < 2; ++a)
#pragma unroll
        for (int b = 0; b < 2; ++b)
#pragma unroll
            for (int m = 0; m < 4; ++m)
#pragma unroll
                for (int n = 0; n < 2; ++n) acc[a][b][m][n] = (f32x4){0.f, 0.f, 0.f, 0.f};
    bf16x8 At[4][2], B0[2][2], B1[2][2];
    const char* cA = (const char*)g.A + (size_t)cur.pm * tstep; const char* cB = (const char*)g.Bt + (size_t)cur.pn * tstep;
    PG8_STAGE(PG8_SB(0, 0), cB, voffB); PG8_STAGE(PG8_SB(0, 1), cB + hstep, voffB); PG8_STAGE(PG8_SA(0, 0), cA, voffA0); PG8_STAGE(PG8_SA(0, 1), cA, voffA1);
    if constexpr (Epi::NTAB > 0) {
#pragma unroll 1
        for (int i = tid >> 8; i < 8; i += 2) { Unit uu; if (!S.next(i, uu)) break; E.fill(lds + STAGE_BYTES, i, uu, tid & 255); asm volatile("" ::: "memory"); }
        asm volatile("s_waitcnt lgkmcnt(0)" ::: "memory");
    }
    if (wr == 1) PG8_BAR;
    PG8_WAIT_V(2); PG8_BAR;
    PG8_STAGE(PG8_SB(1, 0), cB + kstep, voffB); PG8_STAGE(PG8_SA(1, 0), cA + kstep, voffA0); PG8_STAGE(PG8_SB(1, 1), cB + hstep + kstep, voffB);
    PG8_WAIT_V(6); PG8_BAR;
    for (;;) {
        const bool has_next = S.next(ui + 1, nxt);
        const char* nA = has_next ? (const char*)g.A + (size_t)nxt.pm * tstep : cA; const char* nB = has_next ? (const char*)g.Bt + (size_t)nxt.pn * tstep : cB;
        for (int t = 0; t < nt; t += 2) {
            const bool last = (t == nt - 2);
            const char* a1 = cA + (size_t)(t + 1) * kstep;
            const char* a2 = last ? nA : cA + (size_t)(t + 2) * kstep; const char* b2 = last ? nB : cB + (size_t)(t + 2) * kstep;
            const char* a3 = a2 + kstep; const char* b3 = b2 + kstep;
            PG8_LDB(B0, 0, 0); PG8_LDB(B1, 0, 1); PG8_SCHED; PG8_LDA(At, 0, 0); PG8_STAGE(PG8_SA(1, 1), a1, voffA1);
            PG8_WAIT_V(8); PG8_WAIT_L(0); PG8_BAR; PG8_MMA(0, 0, At, B0); PG8_MMA(0, 1, At, B1); PG8_BAR; PG8_SCHED;
            PG8_LDA(At, 0, 1); PG8_STAGE(PG8_SB(0, 0), b2, voffB); PG8_STAGE(PG8_SB(0, 1), b2 + hstep, voffB); PG8_STAGE(PG8_SA(0, 0), a2, voffA0);
            PG8_WAIT_V(8); PG8_WAIT_L(0); PG8_BAR; PG8_MMA(1, 0, At, B0); PG8_MMA(1, 1, At, B1); PG8_BAR; PG8_SCHED;
            PG8_LDB(B0, 1, 0); PG8_LDB(B1, 1, 1); PG8_SCHED; PG8_LDA(At, 1, 0); PG8_STAGE(PG8_SA(0, 1), a2, voffA1);
            PG8_WAIT_V(8); PG8_WAIT_L(0); PG8_BAR; PG8_MMA(0, 0, At, B0); PG8_MMA(0, 1, At, B1); PG8_BAR; PG8_SCHED;
            PG8_LDA(At, 1, 1); PG8_STAGE(PG8_SB(1, 0), b3, voffB); PG8_STAGE(PG8_SB(1, 1), b3 + hstep, voffB); PG8_STAGE(PG8_SA(1, 0), a3, voffA0);
            PG8_WAIT_V(8); PG8_WAIT_L(0); PG8_BAR; PG8_MMA(1, 0, At, B0); PG8_MMA(1, 1, At, B1); PG8_BAR; PG8_SCHED;
        }
        if (wr == 0) PG8_BAR;
        E(acc, cur, ui, wr, wc, fr, fq, lds + STAGE_BYTES);
        if (!has_next) break;
#pragma unroll
        for (int a = 0; a < 2; ++a)
#pragma unroll
            for (int b = 0; b < 2; ++b)
#pragma unroll
                for (int m = 0; m < 4; ++m)
#pragma unroll
                    for (int n = 0; n < 2; ++n) acc[a][b][m][n] = (f32x4){0.f, 0.f, 0.f, 0.f};
        cur = nxt; cA = nA; cB = nB; ++ui;
        if (wr == 1) PG8_BAR;
    }
    PG8_WAIT_V(0);
    PG8_BAR;
#undef PG8_SA
#undef PG8_SB
#undef PG8_STAGE
#undef PG8_LDA
#undef PG8_LDB
#undef PG8_MMA
#undef PG8_WAIT_V
#undef PG8_WAIT_L
#undef PG8_BAR
#undef PG8_SCHED
}
}

constexpr int NWAVES = 8;
constexpr int RING_BYTES = 131072, LDS_BYTES = 163840, LDSCTL_OFF = LDS_BYTES - 512, MISC_OFF = LDSCTL_OFF + 320;
#define GAS __attribute__((address_space(1)))
#define LAS __attribute__((address_space(3)))
typedef GAS unsigned gu32;
#define RLX_AGENT __ATOMIC_RELAXED, __HIP_MEMORY_SCOPE_AGENT
#define LDS_WAIT() asm volatile("s_waitcnt lgkmcnt(0)" ::: "memory")
#define VM_WAIT() asm volatile("s_waitcnt vmcnt(0)" ::: "memory")
constexpr int CW_BAR = 4096;
#define XB_TMO      128
#define XB_XCNT(j)  (256  + 64 * (j))
#define XB_XSUB(j)  (1280 + 64 * (j))
#define XB_XGEN(j)  (2304 + 64 * (j))
#define XB_TOP      3328
#define XB_TOPGEN   3392
#define XCD_BAR_WORDS 3456
#define XB_SPIN_CAP (1u << 18)
__device__ __forceinline__ unsigned xb_ld(unsigned* p)              { return __hip_atomic_load(p, __ATOMIC_RELAXED, __HIP_MEMORY_SCOPE_AGENT); }
__device__ __forceinline__ unsigned xb_add(unsigned* p, unsigned v) { return __hip_atomic_fetch_add(p, v, __ATOMIC_RELAXED, __HIP_MEMORY_SCOPE_AGENT); }
__device__ __forceinline__ unsigned xb_xcc_id() { return (unsigned)__builtin_amdgcn_s_getreg((3 << 11) | 20) & 0xFu; }
#define XB_SPIN(cond, bar) do { unsigned _sp = 0; while (cond) { __builtin_amdgcn_s_sleep(1); \
    if ((++_sp & 255u) == 0u) { if (xb_ld(&(bar)[XB_TMO])) break; if (_sp > XB_SPIN_CAP) { atomicAdd(&(bar)[XB_TMO], 1u); break; } } } } while (0)
struct XcdBarrier { unsigned* bar; unsigned x; volatile LAS unsigned* st; };
__device__ __forceinline__ XcdBarrier xcd_barrier_post(unsigned* bar, volatile LAS unsigned* st) {
    XcdBarrier b; b.bar = bar; b.x = xb_xcc_id(); b.st = st;
    if (threadIdx.x == 0) (void)xb_add(&bar[XB_XCNT(b.x)], 1u);
    return b;
}
__device__ __forceinline__ void xcd_barrier_complete(unsigned* bar, unsigned x, unsigned& nloc, unsigned& nx) {
    const unsigned G = gridDim.x * gridDim.y * gridDim.z;
    unsigned sum, cnt, mine, sp = 0u;
    for (;;) {
        sum = 0u; cnt = 0u; mine = 0u;
#pragma unroll
        for (unsigned j = 0; j < 16; ++j) { const unsigned c = xb_ld(&bar[XB_XCNT(j)]); sum += c; cnt += (c > 0u) ? 1u : 0u; mine = (j == x) ? c : mine; }
        if (sum == G) break;
        __builtin_amdgcn_s_sleep(1);
        if ((++sp & 255u) == 0u) { if (xb_ld(&bar[XB_TMO])) break; if (sp > XB_SPIN_CAP) { atomicAdd(&bar[XB_TMO], 1u); break; } }
    }
    nloc = mine > 0u ? mine : 1u; nx = cnt > 0u ? cnt : 1u;
}
__device__ __forceinline__ void xcd_barrier(const XcdBarrier& b) {
    asm volatile("s_waitcnt vmcnt(0)" ::: "memory");
    __syncthreads();
    if (threadIdx.x == 0) {
        unsigned* bar = b.bar;
        __builtin_amdgcn_s_waitcnt(0);
        unsigned nloc = b.st[0], nx = b.st[1];
        if (nloc == 0u) { xcd_barrier_complete(bar, b.x, nloc, nx); b.st[0] = nloc; b.st[1] = nx; }
        const unsigned old = xb_add(&bar[XB_XSUB(b.x)], 1u);
        const unsigned gen = old / nloc;
        if (old + 1u == (gen + 1u) * nloc) {
            __builtin_amdgcn_fence(__ATOMIC_RELEASE, "agent");
            asm volatile("s_waitcnt vmcnt(0)" ::: "memory");
            const unsigned og = xb_add(&bar[XB_TOP], 1u);
            const unsigned tg = og / nx;
            if (og + 1u == (tg + 1u) * nx) xb_add(&bar[XB_TOPGEN], 1u);
            else XB_SPIN(xb_ld(&bar[XB_TOPGEN]) == tg, bar);
            __builtin_amdgcn_fence(__ATOMIC_ACQUIRE, "agent");
            xb_add(&bar[XB_XGEN(b.x)], 1u);
            asm volatile("s_waitcnt vmcnt(0)" ::: "memory");
        } else {
            XB_SPIN(xb_ld(&bar[XB_XGEN(b.x)]) == gen, bar);
            __builtin_amdgcn_fence(__ATOMIC_ACQUIRE, "agent");
            asm volatile("s_waitcnt vmcnt(0)" ::: "memory");
        }
    }
    __syncthreads();
}

struct Args { const float* in[16]; float* out; unsigned char* ws; int ph_lo, ph_hi, li, pad; };
constexpr int A1T = 320;
enum { PH_PRO = 0, PH_A1, PH_A2, PH_A3, PH_F1A, PH_F2A, PH_B1, PH_B2, PH_GATE, PH_B3, PH_F1B, PH_F2B, PH_END };

__device__ __forceinline__ void p0_transpose_item(const float* W, int K, int Nsrc, int N, int mode, const float* gain, bf16_t* WT, LAS float* scr, int item, int lane) {
    const int nblk = N / 64, kb = item / nblk, nb = item % nblk, k0 = 64 * kb, n0 = 64 * nb;
    const int src = wmap(mode, n0 + lane);
    const float* wp = W + (size_t)k0 * Nsrc + (src >= 0 ? src : 0);
#pragma unroll
    for (int h = 0; h < 2; ++h) { float v[32];
#pragma unroll
        for (int i = 0; i < 32; ++i) v[i] = wp[(size_t)(32 * h + i) * Nsrc];
#pragma unroll
        for (int i = 0; i < 32; ++i) { float x = v[i]; if (gain) x *= gain[k0 + 32 * h + i]; if (src < 0) x = 0.f; scr[(32 * h + i) * 65 + lane] = x; } }
    LDS_WAIT(); asm volatile("" ::: "memory");
    const int kq = (lane & 3) * 16;
#pragma unroll
    for (int j = 0; j < 4; ++j) { const int n = (lane >> 2) + 16 * j; const LAS float* sp = scr + kq * 65 + n;
        u32x4 o0, o1;
        o0.x = pk2(sp[0 * 65], sp[1 * 65]); o0.y = pk2(sp[2 * 65], sp[3 * 65]); o0.z = pk2(sp[4 * 65], sp[5 * 65]); o0.w = pk2(sp[6 * 65], sp[7 * 65]);
        o1.x = pk2(sp[8 * 65], sp[9 * 65]); o1.y = pk2(sp[10 * 65], sp[11 * 65]); o1.z = pk2(sp[12 * 65], sp[13 * 65]); o1.w = pk2(sp[14 * 65], sp[15 * 65]);
        bf16_t* dst = WT + (size_t)(n0 + n) * K + k0 + kq; *(u32x4*)dst = o0; *(u32x4*)(dst + 8) = o1; }
    LDS_WAIT(); asm volatile("" ::: "memory");
}
__device__ __forceinline__ void ffn_fixup(int pm, const float* cw, const float* PART, const float* HALO, bf16_t* H) {
    if ((pm & 7) == 0) return;
    int tid = threadIdx.x; asm volatile("" : "+v"(tid));
    const float* part = PART + (size_t)pm * (4 * D_FF); const float* halo = HALO + (size_t)(pm - 1) * (4 * D_FF);
#pragma unroll
    for (int idx0 = 0; idx0 < 2 * D_FF; idx0 += NWAVES * 64) { const int idx = idx0 + tid; const int e = idx / D_FF, c = idx - e * D_FF;
        float a = part[(size_t)e * 2 * D_FF + c], b = part[(size_t)e * 2 * D_FF + D_FF + c];
        const float ha0 = halo[c], hb0 = halo[D_FF + c], ha1 = halo[2 * D_FF + c], hb1 = halo[3 * D_FF + c];
        const float wa0 = cw[c], wa1 = cw[FF2 + c], wb0 = cw[D_FF + c], wb1 = cw[FF2 + D_FF + c];
        if (e == 0) { a += wa1 * ha1 + wa0 * ha0; b += wb1 * hb1 + wb0 * hb0; } else { a += wa0 * ha1; b += wb0 * hb1; }
        H[(size_t)(pm * 256 + e) * D_FF + c] = f2bf(siluf(a) * b); }
}


__device__ __forceinline__ void glds16_asm(const void* gsrc, unsigned lds_dst) {
    unsigned keep; asm volatile("s_mov_b32 %0, m0\n\ts_mov_b32 m0, %2\n\ts_nop 0\n\tglobal_load_lds_dwordx4 %1, off\n\ts_mov_b32 m0, %0" : "=&s"(keep) : "v"(gsrc), "s"(lds_dst) : "memory"); }
__device__ __forceinline__ unsigned lds_addr(LAS unsigned char* p) { return (unsigned)__builtin_amdgcn_readfirstlane((int)(unsigned)(size_t)p); }

typedef short s16x4 __attribute__((ext_vector_type(4)));
__device__ __forceinline__ bf16x8 cat4(s16x4 a, s16x4 b) { bf16x8 r; r[0] = a[0]; r[1] = a[1]; r[2] = a[2]; r[3] = a[3]; r[4] = b[0]; r[5] = b[1]; r[6] = b[2]; r[7] = b[3]; return r; }
__device__ __forceinline__ void ret_fast_phase(LAS unsigned char* lds, const bf16_t* QT, const bf16_t* KT, const bf16_t* VT, bf16_t* RET, float* SSR, int unit) {
    int tid_ = threadIdx.x; asm volatile("" : "+v"(tid_));
    const int tid = tid_, lane = tid & 63, w = __builtin_amdgcn_readfirstlane(tid >> 6), li = lane & 15, g = lane >> 4;
    const int blk = unit & 7, h = (unit >> 3) & 3, b = unit >> 5;
    const float g64 = __expf(64.0f * gamma_log(h));
    const bool isR = w < 4; const int qt = w & 3, u = w & 3;
    constexpr int KB = 0, VB = 65536, ST = 81920;
    typedef __attribute__((address_space(3))) s16x4 lds_s16x4;
    for (int e = tid; e < 2048; e += 512) *(LAS u32x4*)(lds + ST + e * 16) = (u32x4){0u, 0u, 0u, 0u};
    f32x4 rg[16];
#pragma unroll
    for (int i = 0; i < 16; ++i) rg[i] = (f32x4){0.f, 0.f, 0.f, 0.f};
    const size_t rowb = (size_t)b * SEQ;
    const bf16_t* kbase = KT + rowb * 1024 + h * 256;
    const bf16_t* qbase = QT + (rowb + 16 * qt + li) * 1024 + h * 256 + 8 * g;
    const bf16_t* vbase = VT + ((size_t)b * 2048 + h * 512 + blk * 64 + (tid >> 3)) * SEQ + 8 * (tid & 7);
    const unsigned vw_off = (unsigned)((tid >> 3) * 128 + (((2 * (tid & 7)) ^ ((tid >> 3) & 14)) * 8));
#define KSRC(ln_, i_) ((unsigned)((16 * u + 2 * (i_) + ((ln_) >> 5)) * 2048 + ((((ln_) & 31) ^ (((2 * (i_) + ((ln_) >> 5)) & 7) << 1)) * 16)))
#define RK_DMA(n_, buf_) do { const char* kb_ = (const char*)(kbase + (size_t)(n_) * 64 * 1024); const unsigned ld_ = lds_addr(lds + KB + (buf_) * 32768 + (8 * u) * 1024); _Pragma("unroll") for (int i = 0; i < 8; ++i) \
        glds16_asm(kb_ + KSRC(lane, i), ld_ + i * 1024); } while (0)
    u32x4 vreg;
    if (!isR) { RK_DMA(0, 0); }
    vreg = *(const u32x4*)(vbase);
    if (isR) {
#pragma unroll
        for (int ks = 0; ks < 8; ++ks) rg[ks] = *(const f32x4*)(qbase + 32 * ks); }
    *(LAS u32x4*)(lds + VB + vw_off) = vreg;
    asm volatile("s_waitcnt vmcnt(0) lgkmcnt(0)" ::: "memory"); __builtin_amdgcn_s_barrier(); asm volatile("" ::: "memory");
#pragma unroll 1
    for (int n = 0; n < 32; ++n) {
        const int cur = n & 1, nxt = cur ^ 1;
        LAS unsigned char* kb = lds + KB + cur * 32768; LAS unsigned char* vb = lds + VB + cur * 8192; LAS unsigned char* sb = lds + ST + cur * 32768;
        if (n + 1 < 32) vreg = *(const u32x4*)(vbase + (size_t)(n + 1) * 64);
        if (isR) {
            const bf16_t* qnx = qbase + (size_t)(n + 1 < 32 ? n + 1 : n) * 64 * 1024;
#define QLD(j_) rg[8 + (j_)] = *(const f32x4*)(qnx + 32 * (j_))
            const int sw = (li & 7) << 1;
#define LDROWS(dst, base, tile) do { const LAS unsigned char* rp_ = (base) + (16 * (tile) + li) * 512; _Pragma("unroll") for (int ks = 0; ks < 8; ++ks) dst[ks] = *(const LAS bf16x8*)(rp_ + (((4 * ks + g) ^ sw) * 16)); } while (0)
#define MMA8(acc_, fr_) do { _Pragma("unroll") for (int ks = 0; ks < 8; ++ks) acc_ = __builtin_amdgcn_mfma_f32_16x16x32_bf16(fr_[ks], __builtin_bit_cast(bf16x8, rg[ks]), acc_, 0, 0, 0); } while (0)
#define SFIN(k_, a_) do { if (qt == (k_)) { _Pragma("unroll") for (int r = 0; r < 4; ++r) a_[r] = (4 * g + r <= li) ? a_[r] : 0.f; } u32x2 pk_; pk_.x = pk2(a_[0], a_[1]); pk_.y = pk2(a_[2], a_[3]); sfr[k_] = __builtin_bit_cast(s16x4, pk_); } while (0)
#define SB_ __builtin_amdgcn_sched_barrier(0)
            bf16x8 fa[8], fb[8], fc[8]; f32x4 racc[4]; s16x4 sfr[4];
#pragma unroll
            for (int t = 0; t < 4; ++t) { racc[t] = (f32x4){0.f, 0.f, 0.f, 0.f}; sfr[t] = (s16x4){0, 0, 0, 0}; }
            LDROWS(fa, sb, 0); LDROWS(fb, sb, 1); QLD(0); SB_;
            LDROWS(fc, sb, 2); QLD(1); SB_; MMA8(racc[0], fa); SB_;
            LDROWS(fa, sb, 3); QLD(2); SB_; MMA8(racc[1], fb); SB_;
            LDROWS(fb, kb, 0); QLD(3); SB_; MMA8(racc[2], fc); SB_;
            if (qt >= 1) { LDROWS(fc, kb, 1); }
            QLD(4); QLD(5); SB_; MMA8(racc[3], fa); SB_;
            if (qt >= 2) { LDROWS(fa, kb, 2); }
            QLD(6); QLD(7); SB_;
            { f32x4 a = (f32x4){0.f, 0.f, 0.f, 0.f}; MMA8(a, fb); SFIN(0, a); }
            SB_;
            if (qt >= 1) { if (qt >= 3) { LDROWS(fb, kb, 3); } SB_; f32x4 a = (f32x4){0.f, 0.f, 0.f, 0.f}; MMA8(a, fc); SFIN(1, a); }
            SB_;
            SB_;
            if (qt >= 2) { f32x4 a = (f32x4){0.f, 0.f, 0.f, 0.f}; MMA8(a, fa); SFIN(2, a); }
            SB_;
            bf16x8 vf0[4], vf1[4];
#pragma unroll
            for (int t = 0; t < 4; ++t) { const int row = 16 * t + li; const LAS unsigned char* vp = vb + row * 128; const int f = row & 14;
                vf0[t] = cat4(*(const LAS s16x4*)(vp + (((g) ^ f) * 8)), *(const LAS s16x4*)(vp + (((4 + g) ^ f) * 8)));
                vf1[t] = cat4(*(const LAS s16x4*)(vp + (((8 + g) ^ f) * 8)), *(const LAS s16x4*)(vp + (((12 + g) ^ f) * 8))); }
            SB_;
            if (qt >= 3) { f32x4 a = (f32x4){0.f, 0.f, 0.f, 0.f}; MMA8(a, fb); SFIN(3, a); }
            SB_;
            const bf16x8 sf0 = cat4(sfr[0], sfr[1]), sf1 = cat4(sfr[2], sfr[3]);
            float ssq = 0.f; u32x2 pkt[4];
#pragma unroll
            for (int t = 0; t < 4; ++t) {
                f32x4 acc = __builtin_amdgcn_mfma_f32_16x16x32_bf16(vf0[t], sf0, racc[t], 0, 0, 0);
                if (qt >= 2) acc = __builtin_amdgcn_mfma_f32_16x16x32_bf16(vf1[t], sf1, acc, 0, 0, 0);
                ssq += (acc[0] * acc[0] + acc[1] * acc[1]) + (acc[2] * acc[2] + acc[3] * acc[3]);
                pkt[t].x = pk2(acc[0], acc[1]); pkt[t].y = pk2(acc[2], acc[3]); }
#undef LDROWS
#undef MMA8
#undef SFIN
#undef QLD
            bf16_t* rrow = RET + (rowb + n * 64 + 16 * qt + li) * 2048 + h * 512 + blk * 64 + 16 * (g & 1) + 4 * (g & 2);
#pragma unroll
            for (int pp = 0; pp < 2; ++pp) {
                const auto sx = __builtin_amdgcn_permlane16_swap(pkt[2 * pp].x, pkt[2 * pp + 1].x, false, false), sy = __builtin_amdgcn_permlane16_swap(pkt[2 * pp].y, pkt[2 * pp + 1].y, false, false);
                u32x4 w4; w4.x = sx[0]; w4.y = sy[0]; w4.z = sx[1]; w4.w = sy[1];
                *(u32x4*)(rrow + 32 * pp) = w4; }
            ssq += __shfl_xor(ssq, 16); ssq += __shfl_xor(ssq, 32);
            if (g < 2) SSR[((rowb + n * 64 + 16 * qt + li) * 4 + h) * 16 + blk * 2 + g] = g ? 0.f : ssq;
#pragma unroll
            for (int ks = 0; ks < 8; ++ks) rg[ks] = rg[8 + ks];
        } else {
            const char* kb_n = (const char*)(kbase + (size_t)(n + 1 < 32 ? n + 1 : n) * 64 * 1024); const unsigned ld_n = lds_addr(lds + KB + nxt * 32768 + (8 * u) * 1024);
            int ln_ = lane; asm volatile("" : "+v"(ln_));
#define KDMA2(i_) do { if (n + 1 < 32) { glds16_asm(kb_n + KSRC(ln_, i_), ld_n + (i_) * 1024); glds16_asm(kb_n + KSRC(ln_, (i_) + 1), ld_n + ((i_) + 1) * 1024); } } while (0)
            KDMA2(0); KDMA2(2); KDMA2(4); KDMA2(6);
            bf16x8 vf[4][2];
#pragma unroll
            for (int t = 0; t < 4; ++t)
#pragma unroll
                for (int kp = 0; kp < 2; ++kp) { const int row = 16 * t + li; const LAS unsigned char* rp = vb + row * 128; const int f = row & 14;
                    const s16x4 lo = *(const LAS s16x4*)(rp + (((8 * kp + g) ^ f) * 8)), hi = *(const LAS s16x4*)(rp + (((8 * kp + 4 + g) ^ f) * 8)); vf[t][kp] = cat4(lo, hi); }
            bf16x8 ua[4][2];
#pragma unroll
            for (int d = 0; d < 4; ++d) {
#pragma unroll
                for (int kp = 0; kp < 2; ++kp) { const int dkt = 4 * u + d;
                    const int r0 = 32 * kp + 4 * g + (li >> 2), r1 = r0 + 16;
                    const int cch = 2 * dkt + ((li >> 1) & 1), hb = (li & 1) * 8;
                    const s16x4 lo = __builtin_bit_cast(s16x4, __builtin_amdgcn_ds_read_tr16_b64_v4i16((lds_s16x4*)(kb + r0 * 512 + ((cch ^ ((r0 & 7) << 1)) * 16) + hb)));
                    const s16x4 hi = __builtin_bit_cast(s16x4, __builtin_amdgcn_ds_read_tr16_b64_v4i16((lds_s16x4*)(kb + r1 * 512 + ((cch ^ ((r1 & 7) << 1)) * 16) + hb)));
                    ua[d][kp] = cat4(lo, hi); }
                if (d == 1) __builtin_amdgcn_sched_barrier(0); }
            __builtin_amdgcn_sched_barrier(0);
#pragma unroll
            for (int d = 0; d < 4; ++d) {
                __builtin_amdgcn_sched_barrier(0);
#pragma unroll
                for (int kp = 0; kp < 2; ++kp)
#pragma unroll
                    for (int t = 0; t < 4; ++t) rg[4 * d + t] = __builtin_amdgcn_mfma_f32_16x16x32_bf16(ua[d][kp], vf[t][kp], rg[4 * d + t], 0, 0, 0);
                __builtin_amdgcn_sched_barrier(0); }
#undef KDMA2
            LAS unsigned char* sn = lds + ST + nxt * 32768;
#pragma unroll
            for (int d = 0; d < 4; ++d)
#pragma unroll
                for (int t = 0; t < 4; ++t) { rg[4 * d + t] *= g64; const int row = 16 * t + li, dkt = 4 * u + d;
                    u32x2 pk; pk.x = pk2(rg[4 * d + t][0], rg[4 * d + t][1]); pk.y = pk2(rg[4 * d + t][2], rg[4 * d + t][3]);
                    *(LAS u32x2*)(sn + row * 512 + (((2 * dkt + (g >> 1)) ^ ((row & 7) << 1)) * 16) + (g & 1) * 8) = pk; }
        }
        if (n + 1 < 32) *(LAS u32x4*)(lds + VB + nxt * 8192 + vw_off) = vreg;
        asm volatile("s_waitcnt vmcnt(0) lgkmcnt(0)" ::: "memory"); __builtin_amdgcn_s_barrier(); asm volatile("" ::: "memory");
    }
#undef RK_DMA
#undef KSRC
#undef SB_
}


#ifndef DSA_REP
#define DSA_REP 0
#endif
constexpr int DSA_SC = 0, DSA_KST = 131072, DSA_IDX = 147456, DSA_WQ = 155648;
__device__ __forceinline__ unsigned fkey(float f) { const unsigned u = __float_as_uint(f); return (u & 0x80000000u) ? ~u : (u | 0x80000000u); }
__device__ __forceinline__ int bcnt(bool p) { return __popcll(__ballot(p)); }
#define SUMF(a_, b_) ((a_) + (b_))
#define WAVE_RED(OP, v) do { v = OP(v, __int_as_float(__builtin_amdgcn_update_dpp(__float_as_int(v), __float_as_int(v), 0xB1, 0xf, 0xf, true))); \
        v = OP(v, __int_as_float(__builtin_amdgcn_update_dpp(__float_as_int(v), __float_as_int(v), 0x4E, 0xf, 0xf, true))); \
        v = OP(v, __int_as_float(__builtin_amdgcn_update_dpp(__float_as_int(v), __float_as_int(v), 0x141, 0xf, 0xf, true))); \
        v = OP(v, __int_as_float(__builtin_amdgcn_update_dpp(__float_as_int(v), __float_as_int(v), 0x140, 0xf, 0xf, true))); \
        v = OP(OP(__int_as_float(__builtin_amdgcn_readlane(__float_as_int(v), 0)), __int_as_float(__builtin_amdgcn_readlane(__float_as_int(v), 16))), \
               OP(__int_as_float(__builtin_amdgcn_readlane(__float_as_int(v), 32)), __int_as_float(__builtin_amdgcn_readlane(__float_as_int(v), 48)))); } while (0)

template <int NB>
__device__ __forceinline__ void dsa_topk_t(const LAS float* sc, LAS unsigned short* il, int limit, int lane) {
    const int nb = limit >> 6;
    float v[NB];
#pragma unroll
    for (int i = 0; i < NB; ++i) v[i] = (i < nb) ? sc[64 * i + lane] : -INFINITY;
    float mn = INFINITY, mx = -INFINITY;
#pragma unroll
    for (int i = 0; i < NB; ++i) { mn = fminf(mn, (i < nb) ? v[i] : INFINITY); mx = fmaxf(mx, v[i]); }
    WAVE_RED(fminf, mn); WAVE_RED(fmaxf, mx);
    float lo = mn, hi = INFINITY; int clo = limit, chi = 0;
#pragma unroll 1
    for (int it = 0; it < 64 && clo - chi > 64; ++it) {
        const float top = (hi == INFINITY) ? mx : hi; const float mid = 0.5f * lo + 0.5f * top;
        if (!(mid > lo) || !(mid < hi)) break;
        int c = 0;
#pragma unroll
        for (int i = 0; i < NB; ++i) c += (v[i] >= mid) ? 1 : 0;
        float cf = (float)c; WAVE_RED(SUMF, cf); c = (int)cf;
        if (c >= TOPK) { lo = mid; clo = c; } else { hi = mid; chi = c; }
    }
    const int r = TOPK - chi; unsigned T; int ngt, neq;
    if (clo - chi <= 64) {
        int filled = 0;
#pragma unroll
        for (int i = 0; i < NB; ++i) { const bool in = (v[i] >= lo) && (v[i] < hi);
            const unsigned long long m = __ballot(in); const int pos = filled + __builtin_amdgcn_mbcnt_hi((unsigned)(m >> 32), __builtin_amdgcn_mbcnt_lo((unsigned)m, 0));
            if (in) ((LAS unsigned*)il)[pos] = fkey(v[i]);
            filled += __popcll(m); }
        asm volatile("s_waitcnt lgkmcnt(0)" ::: "memory");
        const unsigned ck = (lane < filled) ? ((LAS unsigned*)il)[lane] : 0u;
        T = 0u;
#pragma unroll 4
        for (int bit = 31; bit >= 0; --bit) { const unsigned cand = T | (1u << bit); if (bcnt(ck >= cand) >= r) T = cand; }
        ngt = chi + bcnt(ck > T); neq = bcnt(ck == T);
    } else {
        T = 0u;
#pragma unroll 1
        for (int bit = 31; bit >= 0; --bit) { const unsigned cand = T | (1u << bit); int c = 0;
#pragma unroll
            for (int i = 0; i < NB; ++i) c += bcnt(i < nb && fkey(v[i]) >= cand);
            if (c >= TOPK) T = cand; }
        ngt = 0; neq = 0;
#pragma unroll
        for (int i = 0; i < NB; ++i) { const unsigned k = fkey(v[i]); ngt += bcnt(i < nb && k > T); neq += bcnt(i < nb && k == T); }
    }
    const int need_eq = TOPK - ngt;
    asm volatile("s_waitcnt lgkmcnt(0)" ::: "memory");
    int base = 0, tb = 0;
    const bool alleq = (neq == need_eq);
#pragma unroll
    for (int i = 0; i < NB; ++i) if (i < nb) { const unsigned k = fkey(v[i]);
        bool f = k >= T;
        if (!alleq) { const bool eq = (k == T); const unsigned long long me = __ballot(eq);
            const int er = tb + __builtin_amdgcn_mbcnt_hi((unsigned)(me >> 32), __builtin_amdgcn_mbcnt_lo((unsigned)me, 0));
            f = (k > T) || (eq && er < need_eq); tb += __popcll(me); }
        const unsigned long long mf = __ballot(f); const int pos = base + __builtin_amdgcn_mbcnt_hi((unsigned)(mf >> 32), __builtin_amdgcn_mbcnt_lo((unsigned)mf, 0));
        if (f && pos < TOPK) il[pos] = (unsigned short)(64 * i + lane);
        base += __popcll(mf); }
}
__device__ __forceinline__ void dsa_topk(const LAS float* sc, LAS unsigned short* il, int limit, int lane) {
    if (limit <= 512) dsa_topk_t<8>(sc, il, limit, lane);
    else if (limit <= 1024) dsa_topk_t<16>(sc, il, limit, lane);
    else dsa_topk_t<32>(sc, il, limit, lane);
}

struct DsaQ { bf16x8 qf[4]; f32x4 ps; };
__device__ __forceinline__ DsaQ dsa_load_q(const bf16_t* QH, const float* PS, size_t trow, int lane) {
    const int li = lane & 15, g = lane >> 4; DsaQ q;
#pragma unroll
    for (int s = 0; s < 4; ++s) { q.qf[s] = (bf16x8){0, 0, 0, 0, 0, 0, 0, 0}; if (li < 8) q.qf[s] = *(const bf16x8*)(QH + trow * 1024 + li * 128 + 32 * s + 8 * g); }
    q.ps = (f32x4){1.f, 1.f, 1.f, 1.f};
    if (li < 8) { const float* pp = PS + (size_t)((li >> 1) * 8 + (li & 1) * 4) * M + trow; q.ps = (f32x4){pp[0], pp[(size_t)M], pp[(size_t)2 * M], pp[(size_t)3 * M]}; }
    return q;
}
__device__ __forceinline__ void dsa_attend(LAS unsigned char* wl, const LAS unsigned short* il, const LAS float* rctab, LAS float* rcl, const DsaQ& Q, const bf16_t* Cb, bf16_t* AO, size_t trow, int b, int count, float bound_l2, int lane) {
    const int li = lane & 15, g = lane >> 4;
    typedef __attribute__((address_space(3))) s16x4 lds_s16x4;
    bf16x8 qf[4];
#pragma unroll
    for (int s = 0; s < 4; ++s) qf[s] = Q.qf[s];
    const float rq = (li < 8) ? rsqrtf(((Q.ps[0] + Q.ps[1]) + (Q.ps[2] + Q.ps[3])) * (1.0f / 128.0f) + EPS) * 1.4426950408889634f : 0.f;
    const bf16_t* cbase = Cb + (size_t)b * SEQ * 128; const unsigned wlb = lds_addr(wl);
#define DSA_GATHER(ci_, buf_) do { const u32x4 kw_ = *(const LAS u32x4*)(il + 32 * (ci_) + 8 * (lane >> 4)); \
        _Pragma("unroll") for (int i = 0; i < 8; ++i) { const int row = 4 * i + (lane >> 4); const unsigned kk_ = (i < 2 ? kw_.x : i < 4 ? kw_.y : i < 6 ? kw_.z : kw_.w); const int key = (i & 1) ? (int)(kk_ >> 16) : (int)(kk_ & 0xffffu); \
        const int sc_ = (lane & 15) ^ ((row & 7) << 1); \
        glds16_asm(cbase + (size_t)key * 128 + sc_ * 8, wlb + (buf_) * 8192 + i * 1024); } } while (0)
    for (int pos = lane; pos < count; pos += 64) { const int e = pos & 31; rcl[(pos & ~31) + 4 * (e & 7) + (e >> 3)] = rctab[il[pos]]; }
    asm volatile("s_waitcnt lgkmcnt(0)" ::: "memory");
    f32x4 oacc[8];
#pragma unroll
    for (int d = 0; d < 8; ++d) oacc[d] = (f32x4){0.f, 0.f, 0.f, 0.f};
    float lsum = 0.f;
    const int nch = count >> 5;
    DSA_GATHER(0, 0);
#pragma unroll 1
    for (int ci = 0; ci < nch; ++ci) {
        const int cur = ci & 1;
        if (ci + 1 < nch) { DSA_GATHER(ci + 1, cur ^ 1); if (DSA_REP & 8) { DSA_GATHER(ci + 1, cur ^ 1); asm volatile("s_waitcnt vmcnt(16)" ::: "memory"); } else asm volatile("s_waitcnt vmcnt(8)" ::: "memory"); } else { asm volatile("s_waitcnt vmcnt(0)" ::: "memory"); }
        const LAS unsigned char* ct = wl + cur * 8192;
        f32x4 lt[2];
        bf16x8 ca[2][4];
#pragma unroll
        for (int T = 0; T < 2; ++T) { const int row = 16 * T + li; const LAS unsigned char* rp = ct + row * 256; const int sw = (row & 7) << 1;
#pragma unroll
            for (int s = 0; s < 4; ++s) ca[T][s] = *(const LAS bf16x8*)(rp + (((4 * s + g) ^ sw) * 16)); }
        f32x4 rcv[2];
#pragma unroll
        for (int T = 0; T < 2; ++T) rcv[T] = *(const LAS f32x4*)(rcl + 32 * ci + 16 * T + 4 * g);
        __builtin_amdgcn_sched_barrier(0);
#pragma unroll
        for (int T = 0; T < 2; ++T) { lt[T] = (f32x4){0.f, 0.f, 0.f, 0.f};
#pragma unroll
            for (int s = 0; s < 4; ++s) lt[T] = __builtin_amdgcn_mfma_f32_16x16x32_bf16(ca[T][s], qf[s], lt[T], 0, 0, 0); }
        bf16x8 cv[8];
#pragma unroll
        for (int dt = 0; dt < 8; ++dt) {
            const int r0 = 4 * g + (li >> 2), r1 = r0 + 16; const int cch = 2 * dt + ((li >> 1) & 1), hb = (li & 1) * 8;
            const s16x4 lo = __builtin_bit_cast(s16x4, __builtin_amdgcn_ds_read_tr16_b64_v4i16((lds_s16x4*)(ct + r0 * 256 + ((cch ^ ((r0 & 7) << 1)) * 16) + hb)));
            const s16x4 hi = __builtin_bit_cast(s16x4, __builtin_amdgcn_ds_read_tr16_b64_v4i16((lds_s16x4*)(ct + r1 * 256 + ((cch ^ ((r1 & 7) << 1)) * 16) + hb)));
            cv[dt] = cat4(lo, hi); }
        __builtin_amdgcn_sched_barrier(0);
        bf16x8 pf;
#pragma unroll
        for (int T = 0; T < 2; ++T) { float pv[4];
#pragma unroll
            for (int r = 0; r < 4; ++r) { pv[r] = __builtin_amdgcn_exp2f(lt[T][r] * rq * rcv[T][r] - bound_l2); lsum += pv[r]; }
            const unsigned w0 = pk2(pv[0], pv[1]), w1 = pk2(pv[2], pv[3]);
            pf[4 * T + 0] = (short)(w0 & 0xffff); pf[4 * T + 1] = (short)(w0 >> 16); pf[4 * T + 2] = (short)(w1 & 0xffff); pf[4 * T + 3] = (short)(w1 >> 16); }
#pragma unroll
        for (int dt = 0; dt < 8; ++dt) oacc[dt] = __builtin_amdgcn_mfma_f32_16x16x32_bf16(cv[dt], pf, oacc[dt], 0, 0, 0);
    }
#undef DSA_GATHER
    lsum += __shfl_xor(lsum, 16); lsum += __shfl_xor(lsum, 32);
    const float inv = 1.0f / lsum;
    if (li < 8) {
#pragma unroll
        for (int dt = 0; dt < 8; ++dt) { u32x2 o; o.x = pk2(oacc[dt][0] * inv, oacc[dt][1] * inv); o.y = pk2(oacc[dt][2] * inv, oacc[dt][3] * inv);
            *(u32x2*)(AO + trow * 1024 + li * 128 + 16 * dt + 4 * g) = o; }
    }
}

__device__ __forceinline__ void dsa_fast_phase(LAS unsigned char* lds, const bf16_t* QH, const bf16_t* Cb, const float* PS, const bf16_t* QI, const bf16_t* KI, const float* WI, const float* CSC, bf16_t* AO, int vcu, int G) {
    int tid_ = threadIdx.x; asm volatile("" : "+v"(tid_));
    const int tid = tid_, lane0 = tid & 63, w = __builtin_amdgcn_readfirstlane(tid >> 6);
    LAS unsigned char* wl = lds + DSA_SC + w * 16384; LAS float* rctab = (LAS float*)(lds + DSA_KST);
    LAS unsigned short* il0 = (LAS unsigned short*)(lds + DSA_IDX + (2 * w) * 512); LAS unsigned short* il1 = il0 + 256;
    float mxs = 0.f;
    for (int i = lane0; i < 128; i += 64) mxs = fmaxf(mxs, fabsf(CSC[i]));
#pragma unroll
    for (int o = 1; o < 64; o <<= 1) mxs = fmaxf(mxs, __shfl_xor(mxs, o));
    const float bound_l2 = mxs * 128.0f * 1.4426950408889634f;
    for (int wg = vcu; wg < 256; wg += G) {
        const int b = wg >> 5, r = wg & 31;
        __syncthreads();
        for (int k = tid; k < SEQ; k += NWAVES * 64) { const float* pp = PS + (size_t)32 * M + (size_t)b * SEQ + k;
            rctab[k] = rsqrtf(((pp[0] + pp[(size_t)M]) + (pp[(size_t)2 * M] + pp[(size_t)3 * M])) * (1.0f / 128.0f) + EPS); }
#pragma unroll 1
        for (int it = 0; it < 4; ++it) {
            int lane = lane0; asm volatile("" : "+v"(lane));
            const int li = lane & 15, g = lane >> 4;
            const int chunk = (it & 1) ? 31 - (r & 15) : (r & 15), sub = 2 * (r >> 4) + (it >> 1);
            const int t0 = chunk * 64 + sub * 16, limit = (chunk + 1) * 64;
            const size_t trow0 = (size_t)b * SEQ + t0 + 2 * w;
            const DsaQ Q0 = dsa_load_q(QH, PS, trow0, lane), Q1 = dsa_load_q(QH, PS, trow0 + 1, lane);
            LAS float* wqt = (LAS float*)(lds + DSA_WQ);
            if (limit > TOPK && tid < 128) { const int qq = tid >> 3, hh = tid & 7; const size_t row = (size_t)b * SEQ + t0 + qq;
                const float* ps = PS + (size_t)(40 + (hh >> 2) * 8 + ((hh >> 1) & 1) * 4 + 2 * (hh & 1)) * M + row;
                wqt[tid] = WI[row * 8 + hh] * rsqrtf((ps[0] + ps[(size_t)M]) * (1.0f / 64.0f) + EPS); }
            __syncthreads();
            if (limit > TOPK) {
                for (int srep = 0; srep < 1 + (DSA_REP & 1); ++srep) {
                bf16x8 af[8][2]; float wq[8][4];
                const size_t trowi = (size_t)b * SEQ + t0;
#pragma unroll
                for (int p = 0; p < 8; ++p) {
#pragma unroll
                    for (int sidx = 0; sidx < 2; ++sidx) af[p][sidx] = *(const bf16x8*)(QI + (trowi + 2 * p + (li >> 3)) * 512 + (li & 7) * 64 + 32 * sidx + 8 * g);
                    const f32x4 wv = *(const LAS f32x4*)(wqt + (2 * p + (g >> 1)) * 8 + 4 * (g & 1));
                    wq[p][0] = wv[0]; wq[p][1] = wv[1]; wq[p][2] = wv[2]; wq[p][3] = wv[3];
                    asm volatile("" ::: "memory"); }
                const int nst = limit >> 4;
                const bf16_t* kp = KI + ((size_t)b * SEQ + 16 * w + li) * 64 + 8 * g; const float* pp = PS + (size_t)36 * M + (size_t)b * SEQ + 16 * w + li;
                bf16x8 b0 = *(const bf16x8*)kp, b1 = *(const bf16x8*)(kp + 32); f32x2_t pk = (f32x2_t){pp[0], pp[(size_t)M]};
                bf16x8 d0 = b0, d1 = b1; f32x2_t pk2v = pk;
                if (w + 8 < nst) { kp += 8 * 16 * 64; pp += 8 * 16; d0 = *(const bf16x8*)kp; d1 = *(const bf16x8*)(kp + 32); pk2v = (f32x2_t){pp[0], pp[(size_t)M]}; }
#pragma unroll 1
                for (int st = w; st < nst; st += 8) {
                    const bf16x8 c0 = b0, c1 = b1; const float rk = rsqrtf((pk[0] + pk[1]) * (1.0f / 64.0f) + EPS);
                    b0 = d0; b1 = d1; pk = pk2v;
                    if (st + 16 < nst) { kp += 8 * 16 * 64; pp += 8 * 16; d0 = *(const bf16x8*)kp; d1 = *(const bf16x8*)(kp + 32); pk2v = (f32x2_t){pp[0], pp[(size_t)M]}; }
                    LAS float* so = (LAS float*)(lds + DSA_SC) + (g >> 1) * 2048 + 16 * st + li;
#pragma unroll
                    for (int p = 0; p < 8; ++p) {
                        f32x4 acc = (f32x4){0.f, 0.f, 0.f, 0.f};
                        acc = __builtin_amdgcn_mfma_f32_16x16x32_bf16(af[p][0], c0, acc, 0, 0, 0); acc = __builtin_amdgcn_mfma_f32_16x16x32_bf16(af[p][1], c1, acc, 0, 0, 0);
                        float part = (fmaxf(acc[0], 0.f) * wq[p][0] + fmaxf(acc[1], 0.f) * wq[p][1]) + (fmaxf(acc[2], 0.f) * wq[p][2] + fmaxf(acc[3], 0.f) * wq[p][3]);
                        {   const auto sw = __builtin_amdgcn_permlane16_swap(__float_as_uint(part), __float_as_uint(part), false, false);
                            part = __uint_as_float(sw[0]) + __uint_as_float(sw[1]); }
                        if ((g & 1) == 0) so[p * 4096] = part * rk + 0.0f;
                    }
                }
                __syncthreads();
                }
                for (int trep = 0; trep < 1 + ((DSA_REP >> 1) & 1); ++trep) {
                dsa_topk((const LAS float*)wl, il0, limit, lane);
                dsa_topk((const LAS float*)wl + 2048, il1, limit, lane); }
            } else {
                for (int j = lane; j < limit; j += 64) { il0[j] = (unsigned short)j; il1[j] = (unsigned short)j; }
            }
            const int count = limit < TOPK ? limit : TOPK;
            for (int arep = 0; arep < 1 + ((DSA_REP >> 2) & 1); ++arep) {
            dsa_attend(wl, il0, rctab, (LAS float*)(lds + DSA_KST + 8192 + w * 1024), Q0, Cb, AO, trow0, b, count, bound_l2, lane);
            dsa_attend(wl, il1, rctab, (LAS float*)(lds + DSA_KST + 8192 + w * 1024), Q1, Cb, AO, trow0 + 1, b, count, bound_l2, lane); }
        }
    }
    __syncthreads();
}

typedef const __attribute__((address_space(4))) Args* ArgsP;
__device__ __forceinline__ ArgsP fresh_args() { ArgsP p = (ArgsP)__builtin_amdgcn_kernarg_segment_ptr(); asm volatile("" : "+s"(p)); return p; }

__device__ __forceinline__ int fresh_bx() { int v = blockIdx.x; asm volatile("" : "+s"(v)); return v; }
__device__ __forceinline__ int fresh_gx() { int v = gridDim.x; asm volatile("" : "+s"(v)); return v; }
__global__ void __launch_bounds__(NWAVES * 64, 2) mega(Args args_unused) {
    extern __shared__ __attribute__((aligned(16))) unsigned char lds_raw[];
    LAS unsigned char* lds = (LAS unsigned char*)lds_raw;
    const int tid = threadIdx.x;
    for (int u = tid; u < (LDS_BYTES - LDSCTL_OFF) / 4; u += NWAVES * 64) ((LAS unsigned*)(lds + LDSCTL_OFF))[u] = 0u;
    __syncthreads();
    int lo, hi;
    {   ArgsP A = fresh_args(); lo = A->ph_lo; hi = A->ph_hi;
        if (hi - lo > 1) (void)xcd_barrier_post((unsigned*)(A->ws + WS_CTL) + CW_BAR + A->li * XCD_BAR_WORDS, (volatile LAS unsigned*)(lds + MISC_OFF) + 8); }
#ifndef PHMASK
#define PHMASK 0xffff
#endif
#define IN(k) (((PHMASK >> (k)) & 1) && lo <= (k) && (k) < hi)
#define SEAM(k) do { if (lo <= (k) && (k) + 1 < hi) { ArgsP A_ = fresh_args(); XcdBarrier b_; b_.bar = (unsigned*)(A_->ws + WS_CTL) + CW_BAR + A_->li * XCD_BAR_WORDS; b_.x = xb_xcc_id(); \
        b_.st = (volatile LAS unsigned*)(lds + MISC_OFF) + 8; xcd_barrier(b_); } } while (0)
#ifndef REPMASK
#define REPMASK 0
#endif
#define GBAR() do { ArgsP A_ = fresh_args(); XcdBarrier b_; b_.bar = (unsigned*)(A_->ws + WS_CTL) + CW_BAR + A_->li * XCD_BAR_WORDS; b_.x = xb_xcc_id(); \
        b_.st = (volatile LAS unsigned*)(lds + MISC_OFF) + 8; xcd_barrier(b_); } while (0)
#define REPEAT(k) for (int rep_ = 0; rep_ < 1 + ((REPMASK >> (k)) & 1); ++rep_)
#define REPBAR() do { if (rep_) GBAR(); } while (0)
#define GWS int t_ = threadIdx.x; asm volatile("" : "+v"(t_)); const int lane = t_ & 63, wave = __builtin_amdgcn_readfirstlane(t_ >> 6); const int G = fresh_gx(), bx = fresh_bx(); const int vcu = (G % 8 == 0) ? (bx % 8) * (G / 8) + bx / 8 : bx; \
        const int gw = vcu * NWAVES + wave, NGW = G * NWAVES; LAS float* scr = (LAS float*)(lds + wave * 16640); (void)lane; (void)gw; (void)NGW; (void)scr;
#define WCONV(Wp, K_, Nsrc_, N_, mode_, gain_, WT_) do { const int items_ = ((K_) / 64) * ((N_) / 64); \
        for (int it = gw; it < items_; it += NGW) p0_transpose_item((Wp), (K_), (Nsrc_), (N_), (mode_), (gain_), (WT_), scr, it, lane); } while (0)

    if (IN(PH_PRO)) REPEAT(PH_PRO) { REPBAR();
        GWS; ArgsP A = fresh_args(); unsigned char* ws = A->ws;
        constexpr int I0 = 16 * 28, I1 = I0 + 16 * 16, I5 = I1 + (16 * 88 - A1T), IX = I5 + M / 4;
        {   const float* x = A->in[0]; float* SS = (float*)(ws + WS_SS); bf16_t* XB = (bf16_t*)(ws + WS_XB);
#pragma unroll 1
            for (int it = gw; it < IX; it += NGW) {
                if (it < I0) p0_transpose_item(A->in[3], 1024, A_IN_COLS, A_IN_PAD, WM_AIN, A->in[1], (bf16_t*)(ws + WS_WAIN), scr, it, lane);
                else if (it < I1) p0_transpose_item(A->in[8], 1024, 1024, 1024, WM_NAT, (const float*)nullptr, (bf16_t*)(ws + WS_WAOUT), scr, it - I0, lane);
                else if (it < I5) p0_transpose_item(A->in[12], 1024, FF2, FF2, WM_FUP, A->in[2], (bf16_t*)(ws + WS_WFUP0), scr, it - I1 + A1T, lane);
                else { const int row0 = (it - I5) * 4;
                    f32x4 v[4][4];
#pragma unroll
                    for (int r = 0; r < 4; ++r)
#pragma unroll
                        for (int q = 0; q < 4; ++q) v[r][q] = ((const f32x4*)(x + (size_t)(row0 + r) * DM))[q * 64 + lane];
#pragma unroll
                    for (int r = 0; r < 4; ++r)
#pragma unroll
                        for (int q = 0; q < 4; ++q) { const f32x4 w = v[r][q]; float sq = (w[0] * w[0] + w[1] * w[1]) + (w[2] * w[2] + w[3] * w[3]); sq = wave_sum(sq);
                            if (lane < 4) SS[(size_t)(q * 4 + lane) * M + row0 + r] = lane == 0 ? sq : 0.f;
                            u32x2 o; o.x = pk2(w[0], w[1]); o.y = pk2(w[2], w[3]); *(u32x2*)(XB + (size_t)(row0 + r) * DM + q * 256 + lane * 4) = o; } } } }
        {   float2* ROPE = (float2*)(ws + WS_ROPE);
            for (int e = gw * 64 + lane; e < 2048 * 128; e += NGW * 64) { const int t = e >> 7, i = e & 127;
                const float inv = exp2f(-(float)(2 * i) * (13.287712379549449f / 256.0f)), ang = (float)t * inv; float sn, cs; sincosf(ang, &sn, &cs); ROPE[e] = make_float2(cs, sn); } }
        {   float* CSC = (float*)(ws + WS_CSC); const float* a_q_g = A->in[4]; const float* a_k_g = A->in[5]; const float* a_iq_g = A->in[6]; const float* a_ik_g = A->in[7];
            for (int n = gw * 64 + lane; n < A_IN_PAD; n += NGW * 64) { float v;
                if (n < 1024) v = a_q_g[n & 127] * a_k_g[n & 127] * 0.08838834764831845f; else if (n < 1152) v = 1.0f; else if (n < 1216) v = a_ik_g[n - 1152];
                else if (n < 1224) v = 0.044194173824159216f; else if (n < 1280) v = 0.f; else v = a_iq_g[(n - 1280) & 63];
                CSC[n] = v; } }
    }
    SEAM(PH_PRO);
    if (IN(PH_A1)) REPEAT(PH_A1) { REPBAR();
        ArgsP A = fresh_args(); unsigned char* ws = A->ws;
        pg8::Gemm g{(const bf16_t*)(ws + WS_XB), (const bf16_t*)(ws + WS_WAIN), M, A_IN_PAD, 1024}; pg8::StaticOrder S; S.init(M, A_IN_PAD, fresh_gx(), fresh_bx());
        pg8::EpiA1 E{(const float*)(ws + WS_SS), (const float*)(ws + WS_CSC), (bf16_t*)(ws + WS_QH), (bf16_t*)(ws + WS_C), (bf16_t*)(ws + WS_KI), (bf16_t*)(ws + WS_QI), (float*)(ws + WS_WI), (float*)(ws + WS_PS)};
        pg8::gemm_phase(lds, g, S, E);
        {
            int t_ = threadIdx.x; asm volatile("" : "+v"(t_)); const int lane = t_ & 63, wave = __builtin_amdgcn_readfirstlane(t_ >> 6); LAS float* scr = (LAS float*)(lds + wave * 16640);
            const int G_ = fresh_gx(), c_ = fresh_bx(); const int rem_ = ((M / 256) * (A_IN_PAD / 256)) % G_;
            if (c_ >= rem_) { const int nw_ = (G_ - rem_) * NWAVES, w0_ = (c_ - rem_) * NWAVES + wave;
#pragma unroll 1
                for (int it = w0_; it < A1T + 44 * 16; it += nw_) {
                    if (it < A1T) p0_transpose_item(A->in[12], 1024, FF2, FF2, WM_FUP, A->in[2], (bf16_t*)(ws + WS_WFUP0), scr, it, lane);
                    else p0_transpose_item(A->in[15], 2816, 1024, 1024, WM_NAT, (const float*)nullptr, (bf16_t*)(ws + WS_WFDN0), scr, it - A1T, lane); } } }
    }
    SEAM(PH_A1);
    if (IN(PH_A2)) REPEAT(PH_A2) { REPBAR();
        ArgsP A = fresh_args(); unsigned char* ws = A->ws; const int G = fresh_gx(), bx = fresh_bx(); const int vcu = (G % 8 == 0) ? (bx % 8) * (G / 8) + bx / 8 : bx;
        dsa_fast_phase(lds, (const bf16_t*)(ws + WS_QH), (const bf16_t*)(ws + WS_C), (const float*)(ws + WS_PS), (const bf16_t*)(ws + WS_QI), (const bf16_t*)(ws + WS_KI), (const float*)(ws + WS_WI), (const float*)(ws + WS_CSC), (bf16_t*)(ws + WS_AO), vcu, G);
    }
    SEAM(PH_A2);
    if (IN(PH_A3)) REPEAT(PH_A3) { REPBAR();
        ArgsP A = fresh_args(); unsigned char* ws = A->ws;
        pg8::Gemm g{(const bf16_t*)(ws + WS_AO), (const bf16_t*)(ws + WS_WAOUT), M, 1024, 1024}; pg8::StaticOrder S; S.init(M, 1024, fresh_gx(), fresh_bx());
        pg8::EpiRes<1> E{nullptr, nullptr, (bf16_t*)(ws + WS_XB), (float*)(ws + WS_SS)};
        pg8::gemm_phase(lds, g, S, E);
    }
    SEAM(PH_A3);
#define FFN_PHASES(LAYER, PH1, PH2) do { \
        if (IN(PH1)) REPEAT(PH1) { REPBAR(); \
            ArgsP A = fresh_args(); unsigned char* ws = A->ws; \
            pg8::Gemm g{(const bf16_t*)(ws + WS_XB), (const bf16_t*)(ws + ((LAYER) ? WS_WFUP1 : WS_WFUP0)), M, FF2, 1024}; pg8::StaticOrder S; S.init(M, FF2, fresh_gx(), fresh_bx()); \
            pg8::EpiF1 E{(const float*)(ws + WS_SS), A->in[13] + (size_t)(LAYER) * 3 * FF2, A->in[14] + (size_t)(LAYER) * FF2, (bf16_t*)(ws + ((LAYER) ? WS_H1 : WS_H0)), \
                         (float*)(ws + ((LAYER) ? WS_PART1 : WS_PART0)), (float*)(ws + ((LAYER) ? WS_HALO1 : WS_HALO0))}; \
            pg8::gemm_phase(lds, g, S, E); \
            {     \
                int t_ = threadIdx.x; asm volatile("" : "+v"(t_)); const int lane = t_ & 63, wave = __builtin_amdgcn_readfirstlane(t_ >> 6); LAS float* scr = (LAS float*)(lds + wave * 16640); \
                const int G_ = fresh_gx(), c_ = fresh_bx(); const int rem_ = ((M / 256) * (FF2 / 256)) % G_; \
                if (c_ >= rem_) { const int nw_ = (G_ - rem_) * NWAVES, w0_ = (c_ - rem_) * NWAVES + wave; \
                    if ((LAYER) == 0) { _Pragma("unroll 1") for (int it = w0_; it < 16 * 96 + 32 * 16; it += nw_) { \
                        if (it < 16 * 96) p0_transpose_item(A->in[9], 1024, B_IN_COLS, B_IN_COLS, WM_NAT, A->in[1] + 1024, (bf16_t*)(ws + WS_WBIN), scr, it, lane); \
                        else p0_transpose_item(A->in[11], 2048, 1024, 1024, WM_NAT, A->in[10], (bf16_t*)(ws + WS_WBOUT), scr, it - 16 * 96, lane); } } \
                    else { _Pragma("unroll 1") for (int it = w0_; it < 44 * 16; it += nw_) \
                        p0_transpose_item(A->in[15] + (size_t)2816 * 1024, 2816, 1024, 1024, WM_NAT, (const float*)nullptr, (bf16_t*)(ws + WS_WFDN1), scr, it, lane); } } } \
        } \
        SEAM(PH1); \
        if (IN(PH2)) { \
            ArgsP A = fresh_args(); unsigned char* ws = A->ws; bf16_t* Hb = (bf16_t*)(ws + ((LAYER) ? WS_H1 : WS_H0)); \
            pg8::Gemm g{Hb, (const bf16_t*)(ws + ((LAYER) ? WS_WFDN1 : WS_WFDN0)), M, 1024, D_FF}; pg8::StaticOrder S; S.init(M, 1024, fresh_gx(), fresh_bx()); \
            {   pg8::Unit u0; if (S.next(0, u0)) ffn_fixup(u0.pm, A->in[13] + (size_t)(LAYER) * 3 * FF2, (const float*)(ws + ((LAYER) ? WS_PART1 : WS_PART0)), (const float*)(ws + ((LAYER) ? WS_HALO1 : WS_HALO0)), Hb); \
                VM_WAIT(); __syncthreads(); } \
            if ((LAYER) == 0) { pg8::EpiRes<1> E{nullptr, nullptr, (bf16_t*)(ws + WS_XB), (float*)(ws + WS_SS)}; pg8::gemm_phase(lds, g, S, E); } \
            else { pg8::EpiRes<2> E{nullptr, A->out, (bf16_t*)(ws + WS_XB), nullptr}; pg8::gemm_phase(lds, g, S, E); } \
        } \
        SEAM(PH2); } while (0)
    FFN_PHASES(0, PH_F1A, PH_F2A);
    if (IN(PH_B1)) REPEAT(PH_B1) { REPBAR();
        ArgsP A = fresh_args(); unsigned char* ws = A->ws;
        pg8::Gemm g{(const bf16_t*)(ws + WS_XB), (const bf16_t*)(ws + WS_WBIN), M, 4096, 1024}; pg8::StaticOrder S; S.init(M, 4096, fresh_gx(), fresh_bx());
        pg8::EpiB1 E{(const float*)(ws + WS_SS), (const float2*)(ws + WS_ROPE), (bf16_t*)(ws + WS_QT), (bf16_t*)(ws + WS_KT), (bf16_t*)(ws + WS_VT)};
        pg8::gemm_phase(lds, g, S, E);
    }
    SEAM(PH_B1);
    if (IN(PH_B2)) REPEAT(PH_B2) { REPBAR();
        ArgsP A = fresh_args(); unsigned char* ws = A->ws;
        { const int G = fresh_gx(), bx = fresh_bx(); const int vcu = (G % 8 == 0) ? (bx % 8) * (G / 8) + bx / 8 : bx;
          for (int u = vcu; u < 256; u += G) ret_fast_phase(lds, (const bf16_t*)(ws + WS_QT), (const bf16_t*)(ws + WS_KT), (const bf16_t*)(ws + WS_VT), (bf16_t*)(ws + WS_RET), (float*)(ws + WS_SSR), u); }
    }
    SEAM(PH_B2);
    if (IN(PH_GATE)) REPEAT(PH_GATE) { REPBAR();
        {   ArgsP A = fresh_args(); unsigned char* ws = A->ws;
            pg8::Gemm g{(const bf16_t*)(ws + WS_XB), (const bf16_t*)(ws + WS_WBIN) + (size_t)4096 * 1024, M, 2048, 1024}; pg8::StaticOrder S; S.init(M, 2048, fresh_gx(), fresh_bx());
            pg8::EpiGate E{(const float*)(ws + WS_SS), (const float*)(ws + WS_SSR), (bf16_t*)(ws + WS_RET)};
            pg8::gemm_phase(lds, g, S, E); }
#if !defined(NO_WCONV2)
        {   GWS; ArgsP A = fresh_args(); unsigned char* ws = A->ws; constexpr int J0 = 16 * 88;
#pragma unroll 1
            for (int it = gw; it < J0; it += NGW) p0_transpose_item(A->in[12] + (size_t)1024 * FF2, 1024, FF2, FF2, WM_FUP, A->in[2] + 1024, (bf16_t*)(ws + WS_WFUP1), scr, it, lane); }
#endif
    }
    SEAM(PH_GATE);
    if (IN(PH_B3)) REPEAT(PH_B3) { REPBAR();
        ArgsP A = fresh_args(); unsigned char* ws = A->ws;
        pg8::Gemm g{(const bf16_t*)(ws + WS_RET), (const bf16_t*)(ws + WS_WBOUT), M, 1024, 2048}; pg8::StaticOrder S; S.init(M, 1024, fresh_gx(), fresh_bx());
        pg8::EpiRes<1> E{nullptr, nullptr, (bf16_t*)(ws + WS_XB), (float*)(ws + WS_SS)};
        pg8::gemm_phase(lds, g, S, E);
    }
    SEAM(PH_B3);
    FFN_PHASES(1, PH_F1B, PH_F2B);
#undef FFN_PHASES
#undef IN
#undef SEAM
}

extern "C" void kernel_launch(void* const* d_in, const int* in_sizes, int n_in, void* d_out, int out_size, void* d_ws, size_t ws_size, hipStream_t stream) {
    static int grid = 0;
    if (grid == 0) {
        int dev = 0, cus = 0, per_cu = 0;
        (void)hipGetDevice(&dev); (void)hipDeviceGetAttribute(&cus, hipDeviceAttributeMultiprocessorCount, dev);
        (void)hipFuncSetAttribute((const void*)mega, hipFuncAttributeMaxDynamicSharedMemorySize, LDS_BYTES);
        if (hipOccupancyMaxActiveBlocksPerMultiprocessor(&per_cu, (const void*)mega, NWAVES * 64, LDS_BYTES) != hipSuccess || per_cu < 1)
            fprintf(stderr, "kernel_launch: occupancy query reports %d workgroups per CU\n", per_cu);
        (void)hipGetLastError();
        grid = cus > 0 ? cus : 256;
        if (grid != 256) fprintf(stderr, "kernel_launch: %d CUs (built for 256)\n", grid);
    }
    unsigned char* ws = (unsigned char*)d_ws;
    (void)hipMemsetAsync(ws + WS_CTL, 0, CTL_ZERO_BYTES, stream);
    Args a{};
    for (int i = 0; i < 16; ++i) a.in[i] = (const float*)d_in[i];
    a.out = (float*)d_out; a.ws = ws;
    auto launch = [&](int lo, int hi, int li) { a.ph_lo = lo; a.ph_hi = hi; a.li = li; hipLaunchKernelGGL(mega, dim3(grid), dim3(NWAVES * 64), LDS_BYTES, stream, a); };
    launch(0, PH_END, 0);
}
```

```cpp
#include <hip/hip_runtime.h>
#include <stdint.h>
#include <stdio.h>

typedef unsigned short bf16_t;
typedef short bf16x8 __attribute__((ext_vector_type(8)));
typedef float f32x4 __attribute__((ext_vector_type(4)));
typedef unsigned u32x4 __attribute__((ext_vector_type(4)));
typedef unsigned u32x2 __attribute__((ext_vector_type(2)));

#ifndef MK_LAUNCH_MODE
#define MK_LAUNCH_MODE 1
#endif

constexpr int BATCH = 8, SEQ = 2048, DM = 1024, M = BATCH * SEQ;
constexpr int TOPK = 256;
constexpr int A_IN_COLS = 1736, A_IN_PAD = 1792;
constexpr int O2 = 1152, O3 = 1664, O4 = 1728;
constexpr int B_IN_COLS = 6144;
constexpr int D_FF = 2816, FF2 = 5632;
constexpr float EPS = 1e-6f;

constexpr size_t MiB = 1u << 20;
constexpr size_t WS_CTL = 0, CTL_ZERO_BYTES = 65536;
constexpr size_t WS_SS = 1 * MiB;
constexpr size_t WS_WI = 2 * MiB;
constexpr size_t WS_CSC = 2 * MiB + 512 * 1024;
constexpr size_t WS_ROPE = 3 * MiB;
constexpr size_t WS_SSR = 249 * MiB;
constexpr size_t WS_WBIN = 8 * MiB;
constexpr size_t WS_WBOUT = 20 * MiB;
constexpr size_t WS_XB = 24 * MiB;
constexpr size_t WS_WAIN = 56 * MiB;
constexpr size_t WS_WAOUT = 60 * MiB;
constexpr size_t WS_QH = 64 * MiB;
constexpr size_t WS_AO = 96 * MiB;
constexpr size_t WS_QI = 128 * MiB;
constexpr size_t WS_C = 144 * MiB;
constexpr size_t WS_KI = 148 * MiB;
constexpr size_t WS_PS = 150 * MiB;
constexpr size_t WS_WFUP0 = 232 * MiB;
constexpr size_t WS_WFDN0 = 243 * MiB;
constexpr size_t WS_H0 = 64 * MiB;
constexpr size_t WS_PART0 = 152 * MiB;
constexpr size_t WS_HALO0 = 155 * MiB;
constexpr size_t WS_QT = 56 * MiB;
constexpr size_t WS_KT = 88 * MiB;
constexpr size_t WS_VT = 120 * MiB;
constexpr size_t WS_RET = 184 * MiB;
constexpr size_t WS_WFUP1 = 56 * MiB;
constexpr size_t WS_WFDN1 = 67 * MiB;
constexpr size_t WS_H1 = 88 * MiB;
constexpr size_t WS_PART1 = 176 * MiB;
constexpr size_t WS_HALO1 = 179 * MiB;

__device__ __forceinline__ unsigned short f2bf(float f) { unsigned u = __float_as_uint(f); return (unsigned short)((u + 0x7fffu + ((u >> 16) & 1u)) >> 16); }
__device__ __forceinline__ float bf2f(unsigned short h) { return __uint_as_float(((unsigned)h) << 16); }
__device__ __forceinline__ float bflo(unsigned w) { return __uint_as_float(w << 16); }
__device__ __forceinline__ float bfhi(unsigned w) { return __uint_as_float(w & 0xffff0000u); }
typedef __bf16 bf16x2_t __attribute__((ext_vector_type(2)));
typedef float f32x2_t __attribute__((ext_vector_type(2)));
__device__ __forceinline__ unsigned pk2(float lo, float hi) { const f32x2_t v = {lo, hi}; return __builtin_bit_cast(unsigned, __builtin_convertvector(v, bf16x2_t)); }
__device__ __forceinline__ float wave_sum(float v) {
#pragma unroll
    for (int o = 1; o < 64; o <<= 1) v += __shfl_xor(v, o);
    return v;
}
__device__ __forceinline__ float siluf(float x) { return x * __builtin_amdgcn_rcpf(1.0f + __builtin_amdgcn_exp2f(-1.4426950408889634f * x)); }
__device__ __forceinline__ float gamma_log(int h) { return h == 0 ? -0.031748698314580301f : h == 1 ? -0.015748356968139168f : h == 2 ? -0.0078431774610258787f : -0.0039138993211363287f; }

enum { WM_NAT = 0, WM_AIN = 1, WM_FUP = 2 };
__device__ __forceinline__ int wmap(int mode, int n) {
    if (mode == WM_NAT) return n;
    if (mode == WM_AIN) {
        if (n < 1152) return n;
        if (n < 1216) return O3 + (n - 1152);
        if (n < 1224) return O4 + (n - 1216);
        if (n < 1280) return -1;
        return O2 + (n - 1280);
    }
    const int p = n >> 8, bj = (n >> 7) & 1, i = n & 127;
    return bj * D_FF + 128 * p + i;
}

namespace pg8 {
#define PG8_LAS __attribute__((address_space(3)))
constexpr int BM = 256, BK = 64, HALF = 128, HTB = HALF * BK * 2, STAGE_BYTES = 8 * HTB, NXCD = 8, WGM = 8;
constexpr int XCH_OFF = 0, CWT_OFF = 2048, RT1_OFF = 6144, RT2_OFF = 14336;
__host__ __device__ __forceinline__ int lds_byte(int r, int c) { const int st = (r >> 4) * 2 + (c >> 5), rr = r & 15, cc = c & 31, ob = rr * 64 + cc * 2; return st * 1024 + (ob ^ (((ob >> 9) & 1) << 5)); }
__host__ __device__ __forceinline__ void stage_rc(int b, int& R, int& C) { const int st = b / 1024, sb = b % 1024, swz = sb ^ (((sb >> 9) & 1) << 5); R = (st >> 1) * 16 + swz / 64; C = (st & 1) * 32 + (swz % 64) / 2; }
__host__ __device__ __forceinline__ int perm32(int rho) { const int n = rho >> 4, i = rho & 15; return 8 * (i >> 2) + 4 * n + (i & 3); }
struct Unit { int pm, pn; };
struct Gemm { const bf16_t* A; const bf16_t* Bt; int M, N, K; };
struct StaticOrder {
    int nM, nN, nwg, G, c;
    __host__ __device__ __forceinline__ void init(int M_, int N_, int G_, int c_) { nM = M_ / BM; nN = N_ / BM; nwg = nM * nN; G = G_; c = c_; }
    __host__ __device__ __forceinline__ bool next(int i, Unit& u) const {
        const long L = (long)i * G + c; if (L >= nwg) return false;
        int wgid = (int)L; { const int q = nwg / NXCD, r = nwg % NXCD, xcd = wgid % NXCD, off = wgid / NXCD; wgid = (xcd < r ? xcd * (q + 1) : r * (q + 1) + (xcd - r) * q) + off; }
        const int nig = WGM * nN, gid = wgid / nig, fm = gid * WGM, gsz = (nM - fm) < WGM ? (nM - fm) : WGM;
        u.pm = fm + ((wgid % nig) % gsz); u.pn = (wgid % nig) / gsz; return true;
    }
};
__device__ __forceinline__ float rstd16(const float* ss16, int row) {
    float s = 0.f;
#pragma unroll
    for (int g = 0; g < 16; ++g) s += ss16[(size_t)g * M + row];
    return rsqrtf(s * (1.0f / DM) + EPS);
}
__device__ __forceinline__ float sel4(const float (&s)[4], int fq) { return fq == 0 ? s[0] : fq == 1 ? s[1] : fq == 2 ? s[2] : s[3]; }
__device__ __forceinline__ float ssq8(const f32x4 a, const f32x4 b) { return ((a[0] * a[0] + a[1] * a[1]) + (a[2] * a[2] + a[3] * a[3])) + ((b[0] * b[0] + b[1] * b[1]) + (b[2] * b[2] + b[3] * b[3])); }
__device__ __forceinline__ u32x4 pack8(const f32x4 a, const f32x4 b) { u32x4 w; w.x = pk2(a[0], a[1]); w.y = pk2(a[2], a[3]); w.z = pk2(b[0], b[1]); w.w = pk2(b[2], b[3]); return w; }

template <int MODE>
struct EpiRes {
    static constexpr bool PERM = true;
    static constexpr bool AROWPERM = false;
    const float* basef; float* out; bf16_t* xb; float* ss16;
    static constexpr int NTAB = 0;
    __device__ __forceinline__ void fill(PG8_LAS unsigned char*, int, const Unit&, int) const {}
    __device__ __forceinline__ void operator()(f32x4 (&acc)[2][2][4][2], const Unit& u, int ui, int wr, int wc, int fr, int fq, PG8_LAS unsigned char*) const {
        const int row0 = u.pm * BM + wr * 64 + fr, colb = u.pn * BM + wc * 32 + 8 * fq;
#pragma unroll
        for (int ai = 0; ai < 2; ++ai) {
            f32x4 bv[4][2][2];
#pragma unroll
            for (int m = 0; m < 4; ++m)
#pragma unroll
                for (int bj = 0; bj < 2; ++bj) { const size_t o = (size_t)(row0 + ai * HALF + m * 16) * DM + colb + bj * HALF;
                    if (MODE == 0) { bv[m][bj][0] = *(const f32x4*)(basef + o); bv[m][bj][1] = *(const f32x4*)(basef + o + 4); }
                    else { const u32x4 w = *(const u32x4*)(xb + o); bv[m][bj][0] = (f32x4){bflo(w.x), bfhi(w.x), bflo(w.y), bfhi(w.y)}; bv[m][bj][1] = (f32x4){bflo(w.z), bfhi(w.z), bflo(w.w), bfhi(w.w)}; } }
            float sm[4];
#pragma unroll
            for (int m = 0; m < 4; ++m) { const int row = row0 + ai * HALF + m * 16; float s = 0.f;
#pragma unroll
                for (int bj = 0; bj < 2; ++bj) { const size_t o = (size_t)row * DM + colb + bj * HALF;
                    const f32x4 v0 = acc[ai][bj][m][0] + bv[m][bj][0], v1 = acc[ai][bj][m][1] + bv[m][bj][1];
                    if (MODE == 2) { *(f32x4*)(out + o) = v0; *(f32x4*)(out + o + 4) = v1; }
                    else { s += ssq8(v0, v1); *(u32x4*)(xb + o) = pack8(v0, v1); } }
                if (MODE != 2) { s += __shfl_xor(s, 16); s += __shfl_xor(s, 32); }
                sm[m] = s; }
            if (MODE != 2) ss16[(size_t)(u.pn * 4 + wc) * M + u.pm * BM + ai * HALF + wr * 64 + 16 * fq + fr] = sel4(sm, fq);
            asm volatile("" ::: "memory"); }
    }
};
struct EpiA1 {
    static constexpr bool PERM = true;
    static constexpr bool AROWPERM = false;
    const float* ss16; const float* csc; bf16_t* Q; bf16_t* C; bf16_t* KI; bf16_t* QI; float* WI; float* PS;
    static constexpr int NTAB = 1;
    __device__ __forceinline__ void fill(PG8_LAS unsigned char* xl, int i, const Unit& u, int t) const { ((PG8_LAS float*)(xl + RT1_OFF))[i * 256 + t] = rstd16(ss16, u.pm * BM + t); }
    __device__ __forceinline__ void operator()(f32x4 (&acc)[2][2][4][2], const Unit& u, int ui, int wr, int wc, int fr, int fq, PG8_LAS unsigned char* xl) const {
        const int row0 = u.pm * BM + wr * 64 + fr, pn = u.pn;
        const PG8_LAS float* rt = (const PG8_LAS float*)(xl + RT1_OFF) + ui * 256 + wr * 64 + fr;
        float rs[2][4];
#pragma unroll
        for (int ai = 0; ai < 2; ++ai)
#pragma unroll
            for (int m = 0; m < 4; ++m) rs[ai][m] = rt[ai * HALF + m * 16];
        f32x4 cs[2][2];
#pragma unroll
        for (int bj = 0; bj < 2; ++bj) { const int gcol = pn * BM + bj * HALF + wc * 32 + 8 * fq; cs[bj][0] = *(const f32x4*)(csc + gcol); cs[bj][1] = *(const f32x4*)(csc + gcol + 4); }
#pragma unroll
        for (int bj = 0; bj < 2; ++bj) {
            const int cl = bj * HALF + wc * 32 + 8 * fq, gcol = pn * BM + cl;
            const f32x4 c0 = cs[bj][0], c1 = cs[bj][1];
            bf16_t* dst; int ld; bool st16 = true, stwi = false;
            if (pn < 4) { dst = Q + gcol; ld = 1024; }
            else if (pn == 4) { if (bj == 0) { dst = C + cl; ld = 128; } else if (wc < 2) { dst = KI + (wc * 32 + 8 * fq); ld = 64; } else { dst = Q; ld = 0; st16 = false; stwi = (wc == 2) && (fq == 0); } }
            else { dst = QI + (pn - 5) * 256 + cl; ld = 512; }
#pragma unroll
            for (int ai = 0; ai < 2; ++ai) { float sm[4];
#pragma unroll
                for (int m = 0; m < 4; ++m) { const int row = row0 + ai * HALF + m * 16; const float r = rs[ai][m];
                    const f32x4 v0 = acc[ai][bj][m][0] * r, v1 = acc[ai][bj][m][1] * r;
                    float s = ssq8(v0, v1); s += __shfl_xor(s, 16); s += __shfl_xor(s, 32); sm[m] = s;
                    const f32x4 o0 = v0 * c0, o1 = v1 * c1;
                    if (st16) *(u32x4*)(dst + (size_t)row * ld) = pack8(o0, o1);
                    if (stwi) { *(f32x4*)(WI + (size_t)row * 8) = o0; *(f32x4*)(WI + (size_t)row * 8 + 4) = o1; }
                    if (m & 1) asm volatile("" ::: "memory"); }
                PS[(size_t)(pn * 8 + bj * 4 + wc) * M + u.pm * BM + ai * HALF + wr * 64 + 16 * fq + fr] = sel4(sm, fq); }
        }
    }
};
struct EpiF1 {
    static constexpr bool PERM = false;
    static constexpr bool AROWPERM = true;
    static constexpr int NTAB = 1;
    const float* ss16; const float* cw; const float* cb; bf16_t* H; float* PART; float* HALO;
    __device__ __forceinline__ void fill(PG8_LAS unsigned char* xl, int i, const Unit& u, int t) const { ((PG8_LAS float*)(xl + RT1_OFF))[i * 256 + t] = rstd16(ss16, u.pm * BM + t); }
    __device__ __forceinline__ void operator()(f32x4 (&acc)[2][2][4][2], const Unit& u, int ui, int wr, int wc, int fr, int fq, PG8_LAS unsigned char* xl) const {
        const int trow0 = 8 * (16 * wr + fr), grow0 = u.pm * BM + trow0, hcol = 128 * u.pn + 32 * wc + 4 * fq, tcol = 32 * wc + 4 * fq;
        const PG8_LAS float* rt = (const PG8_LAS float*)(xl + RT1_OFF) + ui * 256 + trow0;
        {   const f32x4 r0 = *(const PG8_LAS f32x4*)rt, r1 = *(const PG8_LAS f32x4*)(rt + 4);
#pragma unroll
            for (int m = 0; m < 4; ++m)
#pragma unroll
                for (int bj = 0; bj < 2; ++bj) { acc[0][bj][m][0] *= r0[m]; acc[0][bj][m][1] *= r0[m]; acc[1][bj][m][0] *= r1[m]; acc[1][bj][m][1] *= r1[m]; } }
        {   PG8_LAS float* cwt = (PG8_LAS float*)(xl + CWT_OFF); const int tid = ((wr * 4 + wc) * 4 + fq) * 16 + fr;
#pragma unroll
            for (int r = 0; r < 2; ++r) { const int idx = tid + r * 512, k = idx >> 8, c = idx & 255, orig = (c < 128) ? 128 * u.pn + c : D_FF + 128 * u.pn + (c - 128);
                cwt[idx] = (k < 3) ? cw[(size_t)k * FF2 + orig] : cb[orig]; } }
        PG8_LAS f32x4* X = (PG8_LAS f32x4*)(xl + XCH_OFF) + (wc * 4 + fq) * 8;
        if (wr == 0 && fr == 15) {
#pragma unroll
            for (int bj = 0; bj < 2; ++bj)
#pragma unroll
                for (int e = 0; e < 2; ++e)
#pragma unroll
                    for (int n = 0; n < 2; ++n) X[(bj * 2 + e) * 2 + n] = acc[1][bj][2 + e][n];
        }
        asm volatile("s_waitcnt vmcnt(0) lgkmcnt(0)" ::: "memory"); __builtin_amdgcn_s_barrier(); asm volatile("" ::: "memory");
        const bool need_fix = (wr == 0) && (fr == 0) && ((u.pm & 7) != 0);
        const bool give_halo = (wr == 1) && (fr == 15);
        const bool take_x = (wr == 1) && (fr == 0);
        float* part = PART + (size_t)u.pm * (2 * 2 * D_FF) + hcol;
        float* halo = HALO + (size_t)u.pm * (2 * 2 * D_FF) + hcol;
        const PG8_LAS float* cwt = (const PG8_LAS float*)(xl + CWT_OFF) + tcol;
#pragma unroll
        for (int n = 0; n < 2; ++n) {
            f32x4 pa[2], pb[2];
#pragma unroll
            for (int e = 0; e < 2; ++e) {
                f32x4 ha = (f32x4){0.f, 0.f, 0.f, 0.f}, hb = (f32x4){0.f, 0.f, 0.f, 0.f};
                if (take_x) { ha = X[(0 * 2 + e) * 2 + n]; hb = X[(1 * 2 + e) * 2 + n]; }
#pragma unroll
                for (int j = 0; j < 4; ++j) {
                    pa[e][j] = __int_as_float(__builtin_amdgcn_update_dpp(__float_as_int(ha[j]), __float_as_int(acc[1][0][2 + e][n][j]), 0x111, 0xf, 0xf, false));
                    pb[e][j] = __int_as_float(__builtin_amdgcn_update_dpp(__float_as_int(hb[j]), __float_as_int(acc[1][1][2 + e][n][j]), 0x111, 0xf, 0xf, false)); } }
            const f32x4 wa0 = *(const PG8_LAS f32x4*)(cwt + 16 * n), wa1 = *(const PG8_LAS f32x4*)(cwt + 256 + 16 * n), wa2 = *(const PG8_LAS f32x4*)(cwt + 512 + 16 * n), ba = *(const PG8_LAS f32x4*)(cwt + 768 + 16 * n);
            const f32x4 wb0 = *(const PG8_LAS f32x4*)(cwt + 128 + 16 * n), wb1 = *(const PG8_LAS f32x4*)(cwt + 384 + 16 * n), wb2 = *(const PG8_LAS f32x4*)(cwt + 640 + 16 * n), bb = *(const PG8_LAS f32x4*)(cwt + 896 + 16 * n);
            if (give_halo) {
                *(f32x4*)(halo + 16 * n) = acc[1][0][2][n]; *(f32x4*)(halo + D_FF + 16 * n) = acc[1][1][2][n];
                *(f32x4*)(halo + 2 * D_FF + 16 * n) = acc[1][0][3][n]; *(f32x4*)(halo + 3 * D_FF + 16 * n) = acc[1][1][3][n]; }
            u32x2 wprev = (u32x2){0u, 0u};
#pragma unroll
            for (int e = 0; e < 8; ++e) {
                const f32x4 ua = acc[e >> 2][0][e & 3][n], ub = acc[e >> 2][1][e & 3][n];
                const f32x4 ua1 = e >= 1 ? acc[(e - 1) >> 2][0][(e - 1) & 3][n] : pa[1], ub1 = e >= 1 ? acc[(e - 1) >> 2][1][(e - 1) & 3][n] : pb[1];
                const f32x4 ua2 = e >= 2 ? acc[(e - 2) >> 2][0][(e - 2) & 3][n] : pa[e], ub2 = e >= 2 ? acc[(e - 2) >> 2][1][(e - 2) & 3][n] : pb[e];
                const f32x4 av = ba + wa2 * ua + wa1 * ua1 + wa0 * ua2, bv = bb + wb2 * ub + wb1 * ub1 + wb0 * ub2;
                if (e < 2 && need_fix) { *(f32x4*)(part + (size_t)e * 2 * D_FF + 16 * n) = av; *(f32x4*)(part + (size_t)e * 2 * D_FF + D_FF + 16 * n) = bv; }
                u32x2 w; w.x = pk2(siluf(av[0]) * bv[0], siluf(av[1]) * bv[1]); w.y = pk2(siluf(av[2]) * bv[2], siluf(av[3]) * bv[3]);
                if ((e & 1) == 0) wprev = w;
                else {
                    const auto sx = __builtin_amdgcn_permlane16_swap(wprev.x, w.x, false, false), sy = __builtin_amdgcn_permlane16_swap(wprev.y, w.y, false, false);
                    u32x4 w4; w4.x = sx[0]; w4.y = sy[0]; w4.z = sx[1]; w4.w = sy[1];
                    *(u32x4*)(H + (size_t)(grow0 + e - 1 + (fq & 1)) * D_FF + 128 * u.pn + 32 * wc + 16 * n + 4 * (fq & 2)) = w4; }
            }
            asm volatile("" ::: "memory");
        }
    }
};
struct EpiB1 {
    static constexpr bool PERM = false;
    static constexpr bool AROWPERM = true;
    static constexpr int NTAB = 1;
    const float* ss16; const float2* rope; bf16_t* QT; bf16_t* KT; bf16_t* VT;
    __device__ __forceinline__ void fill(PG8_LAS unsigned char* xl, int i, const Unit& u, int t) const { ((PG8_LAS float*)(xl + RT1_OFF))[i * 256 + t] = rstd16(ss16, u.pm * BM + t); }
    __device__ __forceinline__ void operator()(f32x4 (&acc)[2][2][4][2], const Unit& u, int ui, int wr, int wc, int fr, int fq, PG8_LAS unsigned char* xl) const {
        const int trow0 = 8 * (16 * wr + fr), grow0 = u.pm * BM + trow0, pn = u.pn, t0 = grow0 & (SEQ - 1);
        const PG8_LAS float* rt = (const PG8_LAS float*)(xl + RT1_OFF) + ui * 256 + trow0;
        const f32x4 r0 = *(const PG8_LAS f32x4*)rt, r1 = *(const PG8_LAS f32x4*)(rt + 4);
        if (pn < 8) {
            const int h = pn & 3; const bool isk = pn >= 4; const float lg = gamma_log(h);
            bf16_t* dbase = (isk ? KT : QT) + (size_t)grow0 * 1024 + h * 256 + 32 * wc + 4 * (fq & 2);
            float sc[8];
#pragma unroll
            for (int e = 0; e < 8; ++e) { const int pos = (t0 + e) & 63; sc[e] = (e < 4 ? r0[e & 3] : r1[e & 3]) * (isk ? 0.0625f * __expf(-(float)(pos + 1) * lg) : __expf((float)(pos + 1) * lg)); }
            f32x4 curn[2][2], dwn[2][2];
#pragma unroll
            for (int n = 0; n < 2; ++n) { const int i0 = 32 * wc + 16 * n + 4 * fq;
                const f32x4* rp = (const f32x4*)((const float*)rope + (size_t)t0 * 256 + 2 * i0); const f32x4* rw = (const f32x4*)((const float*)rope + (size_t)256 + 2 * i0); curn[n][0] = rp[0]; curn[n][1] = rp[1]; dwn[n][0] = rw[0]; dwn[n][1] = rw[1]; }
#pragma unroll
            for (int n = 0; n < 2; ++n) {
                f32x4 C = curn[n][0], S = curn[n][1]; const f32x4 dC = dwn[n][0], dS = dwn[n][1];
                u32x2 p1 = (u32x2){0u, 0u}, p2 = (u32x2){0u, 0u};
#pragma unroll
                for (int e = 0; e < 8; ++e) {
                    const f32x4 x1 = acc[e >> 2][0][e & 3][n] * sc[e], x2 = acc[e >> 2][1][e & 3][n] * sc[e];
                    const f32x4 o1 = x1 * C - x2 * S, o2 = x1 * S + x2 * C;
                    u32x2 w1, w2; w1.x = pk2(o1[0], o1[1]); w1.y = pk2(o1[2], o1[3]); w2.x = pk2(o2[0], o2[1]); w2.y = pk2(o2[2], o2[3]);
                    if ((e & 1) == 0) { p1 = w1; p2 = w2; }
                    else {
                        const auto ax = __builtin_amdgcn_permlane16_swap(p1.x, w1.x, false, false), ay = __builtin_amdgcn_permlane16_swap(p1.y, w1.y, false, false);
                        const auto bx = __builtin_amdgcn_permlane16_swap(p2.x, w2.x, false, false), by = __builtin_amdgcn_permlane16_swap(p2.y, w2.y, false, false);
                        bf16_t* d = dbase + (size_t)(e - 1 + (fq & 1)) * 1024 + 16 * n;
                        u32x4 v1; v1.x = ax[0]; v1.y = ay[0]; v1.z = ax[1]; v1.w = ay[1]; *(u32x4*)d = v1;
                        u32x4 v2; v2.x = bx[0]; v2.y = by[0]; v2.z = bx[1]; v2.w = by[1]; *(u32x4*)(d + 128) = v2; }
                    if (e < 7) { const f32x4 Cn = C * dC - S * dS, Sn = S * dC + C * dS; C = Cn; S = Sn; }
                }
                asm volatile("" ::: "memory");
            }
        } else {
            const int b = grow0 / SEQ;
            bf16_t* dst = VT + ((size_t)b * 2048 + (pn - 8) * 256 + 32 * wc + 4 * fq) * SEQ + t0;
#pragma unroll
            for (int bj = 0; bj < 2; ++bj)
#pragma unroll
                for (int n = 0; n < 2; ++n)
#pragma unroll
                    for (int j = 0; j < 4; ++j) { u32x4 w;
                        w.x = pk2(acc[0][bj][0][n][j] * r0[0], acc[0][bj][1][n][j] * r0[1]); w.y = pk2(acc[0][bj][2][n][j] * r0[2], acc[0][bj][3][n][j] * r0[3]);
                        w.z = pk2(acc[1][bj][0][n][j] * r1[0], acc[1][bj][1][n][j] * r1[1]); w.w = pk2(acc[1][bj][2][n][j] * r1[2], acc[1][bj][3][n][j] * r1[3]);
                        *(u32x4*)(dst + (size_t)(128 * bj + 16 * n + j) * SEQ) = w; }
        }
    }
};
struct EpiGate {
    static constexpr bool PERM = true;
    static constexpr bool AROWPERM = false;
    static constexpr int NTAB = 1;
    const float* ss16; const float* ssr; bf16_t* RET;
    __device__ __forceinline__ void fill(PG8_LAS unsigned char* xl, int i, const Unit& u, int t) const {
        const int row = u.pm * BM + t;
        ((PG8_LAS float*)(xl + RT1_OFF))[i * 256 + t] = rstd16(ss16, row);
        const f32x4* sp = (const f32x4*)(ssr + ((size_t)row * 4 + (u.pn >> 1)) * 16); const f32x4 s0 = sp[0], s1 = sp[1], s2 = sp[2], s3 = sp[3];
        ((PG8_LAS float*)(xl + RT2_OFF))[i * 256 + t] = rsqrtf(((((s0[0] + s0[1]) + (s0[2] + s0[3])) + ((s1[0] + s1[1]) + (s1[2] + s1[3]))) + (((s2[0] + s2[1]) + (s2[2] + s2[3])) + ((s3[0] + s3[1]) + (s3[2] + s3[3])))) * (1.0f / 512.0f) + EPS);
    }
    __device__ __forceinline__ void operator()(f32x4 (&acc)[2][2][4][2], const Unit& u, int ui, int wr, int wc, int fr, int fq, PG8_LAS unsigned char* xl) const {
        const int row0 = u.pm * BM + wr * 64 + fr, colb = u.pn * BM + wc * 32 + 8 * fq;
        const PG8_LAS float* rt = (const PG8_LAS float*)(xl + RT1_OFF) + ui * 256 + wr * 64 + fr;
        const PG8_LAS float* rt2 = (const PG8_LAS float*)(xl + RT2_OFF) + ui * 256 + wr * 64 + fr;
        u32x4 rvv[2][4][2];
#pragma unroll
        for (int ai = 0; ai < 2; ++ai)
#pragma unroll
            for (int m = 0; m < 4; ++m)
#pragma unroll
                for (int bj = 0; bj < 2; ++bj) rvv[ai][m][bj] = __builtin_nontemporal_load((const u32x4*)(RET + (size_t)(row0 + ai * HALF + m * 16) * 2048 + colb + bj * HALF));
#pragma unroll
        for (int ai = 0; ai < 2; ++ai)
#pragma unroll
            for (int m = 0; m < 4; ++m) { const int row = row0 + ai * HALF + m * 16; const float r = rt[ai * HALF + m * 16], rh = rt2[ai * HALF + m * 16];
#pragma unroll
                for (int bj = 0; bj < 2; ++bj) { bf16_t* p = RET + (size_t)row * 2048 + colb + bj * HALF; const u32x4 rv = rvv[ai][m][bj];
                    const f32x4 g0 = acc[ai][bj][m][0] * r, g1 = acc[ai][bj][m][1] * r; f32x4 y0, y1;
                    y0[0] = bflo(rv.x) * rh * siluf(g0[0]); y0[1] = bfhi(rv.x) * rh * siluf(g0[1]); y0[2] = bflo(rv.y) * rh * siluf(g0[2]); y0[3] = bfhi(rv.y) * rh * siluf(g0[3]);
                    y1[0] = bflo(rv.z) * rh * siluf(g1[0]); y1[1] = bfhi(rv.z) * rh * siluf(g1[1]); y1[2] = bflo(rv.w) * rh * siluf(g1[2]); y1[3] = bfhi(rv.w) * rh * siluf(g1[3]);
                    *(u32x4*)p = pack8(y0, y1); } }
    }
};

template <class Epi, class Sched>
__device__ __forceinline__ void gemm_phase(PG8_LAS unsigned char* lds, const Gemm g, const Sched& S, const Epi& E) {
    int tid_ = threadIdx.x; asm volatile("" : "+v"(tid_));
    const int tid = tid_, wid = __builtin_amdgcn_readfirstlane(tid >> 6), lane = tid & 63, wr = wid >> 2, wc = wid & 3, fr = lane & 15, fq = lane >> 4;
    const int K = g.K, nt = K / BK;
    unsigned voffA0[2], voffA1[2], voffB[2];
#pragma unroll
    for (int i = 0; i < 2; ++i) { int R, C; stage_rc(tid * 16 + i * 8192, R, C); const int Rb = Epi::PERM ? (R & ~31) + perm32(R & 31) : R;
        int ra0, ra1;
        if (Epi::AROWPERM) { const int base = ((R >> 6) * 16 + (R & 15)) * 8 + ((R >> 4) & 3); ra0 = base; ra1 = base + 4; } else { ra0 = R; ra1 = R + HALF; }
        voffA0[i] = (unsigned)(ra0 * K + C) * 2u; voffA1[i] = (unsigned)(ra1 * K + C) * 2u; voffB[i] = (unsigned)(Rb * K + C) * 2u; }
    const size_t kstep = (size_t)(BK * 2);
    const size_t hstep = (size_t)HALF * K * 2;
    const size_t tstep = 2 * hstep;
    const unsigned ldsw = (unsigned)wid * 1024u;
    const unsigned ldsb = (unsigned)__builtin_amdgcn_readfirstlane((int)(unsigned)(size_t)lds) + ldsw;
    const int aoff = lds_byte(wr * 64 + fr, fq * 8), boff = lds_byte(wc * 32 + fr, fq * 8);
#define PG8_SA(b, h) (((b) * 2 + (h)) * HTB)
#define PG8_SB(b, h) ((4 + (b) * 2 + (h)) * HTB)
#define PG8_STAGE(bufoff, gbase, voff) do { _Pragma("unroll") for (int _i = 0; _i < 2; ++_i) { unsigned keep_; \
        asm volatile("s_mov_b32 %0, m0\n\ts_mov_b32 m0, %3\n\ts_nop 0\n\tglobal_load_lds_dwordx4 %1, %2\n\ts_mov_b32 m0, %0" : "=&s"(keep_) : "v"((voff)[_i]), "s"((const char*)(gbase)), "s"(ldsb + (unsigned)((bufoff) + _i * 8192)) : "memory"); } } while (0)
#define PG8_LDA(dst, b, h) do { _Pragma("unroll") for (int m = 0; m < 4; ++m) _Pragma("unroll") for (int k = 0; k < 2; ++k) dst[m][k] = *(const PG8_LAS bf16x8*)(lds + PG8_SA(b, h) + aoff + m * 2048 + k * 1024); } while (0)
#define PG8_LDB(dst, b, h) do { _Pragma("unroll") for (int n = 0; n < 2; ++n) _Pragma("unroll") for (int k = 0; k < 2; ++k) dst[n][k] = *(const PG8_LAS bf16x8*)(lds + PG8_SB(b, h) + boff + n * 2048 + k * 1024); } while (0)
#define PG8_MMA(ai, bj, At, Bt) do { __builtin_amdgcn_s_setprio(1); _Pragma("unroll") for (int m = 0; m < 4; ++m) _Pragma("unroll") for (int n = 0; n < 2; ++n) _Pragma("unroll") for (int k = 0; k < 2; ++k) \
        acc[ai][bj][m][n] = __builtin_amdgcn_mfma_f32_16x16x32_bf16(Bt[n][k], At[m][k], acc[ai][bj][m][n], 0, 0, 0); __builtin_amdgcn_s_setprio(0); } while (0)
#define PG8_WAIT_V(n) asm volatile("s_waitcnt vmcnt(" #n ")" ::: "memory")
#define PG8_WAIT_L(n) asm volatile("s_waitcnt lgkmcnt(" #n ")" ::: "memory")
#define PG8_BAR __builtin_amdgcn_s_barrier()
#define PG8_SCHED __builtin_amdgcn_sched_barrier(0)
    Unit cur, nxt; int ui = 0;
    if (!S.next(0, cur)) return;
    f32x4 acc[2][2][4][2];
#pragma unroll
    for (int a = 0; a < 2; ++a)
#pragma unroll
        for (int b = 0; b < 2; ++b)
#pragma unroll
            for (int m = 0; m < 4; ++m)
#pragma unroll
                for (int n = 0; n < 2; ++n) acc[a][b][m][n] = (f32x4){0.f, 0.f, 0.f, 0.f};
    bf16x8 At[4][2], B0[2][2], B1[2][2];
    const char* cA = (const char*)g.A + (size_t)cur.pm * tstep; const char* cB = (const char*)g.Bt + (size_t)cur.pn * tstep;
    PG8_STAGE(PG8_SB(0, 0), cB, voffB); PG8_STAGE(PG8_SB(0, 1), cB + hstep, voffB); PG8_STAGE(PG8_SA(0, 0), cA, voffA0); PG8_STAGE(PG8_SA(0, 1), cA, voffA1);
    if constexpr (Epi::NTAB > 0) {
#pragma unroll 1
        for (int i = tid >> 8; i < 8; i += 2) { Unit uu; if (!S.next(i, uu)) break; E.fill(lds + STAGE_BYTES, i, uu, tid & 255); asm volatile("" ::: "memory"); }
        asm volatile("s_waitcnt lgkmcnt(0)" ::: "memory");
    }
    if (wr == 1) PG8_BAR;
    PG8_WAIT_V(2); PG8_BAR;
    PG8_STAGE(PG8_SB(1, 0), cB + kstep, voffB); PG8_STAGE(PG8_SA(1, 0), cA + kstep, voffA0); PG8_STAGE(PG8_SB(1, 1), cB + hstep + kstep, voffB);
    PG8_WAIT_V(6); PG8_BAR;
    for (;;) {
        const bool has_next = S.next(ui + 1, nxt);
        const char* nA = has_next ? (const char*)g.A + (size_t)nxt.pm * tstep : cA; const char* nB = has_next ? (const char*)g.Bt + (size_t)nxt.pn * tstep : cB;
        for (int t = 0; t < nt; t += 2) {
            const bool last = (t == nt - 2);
            const char* a1 = cA + (size_t)(t + 1) * kstep;
            const char* a2 = last ? nA : cA + (size_t)(t + 2) * kstep; const char* b2 = last ? nB : cB + (size_t)(t + 2) * kstep;
            const char* a3 = a2 + kstep; const char* b3 = b2 + kstep;
            PG8_LDB(B0, 0, 0); PG8_LDB(B1, 0, 1); PG8_SCHED; PG8_LDA(At, 0, 0); PG8_STAGE(PG8_SA(1, 1), a1, voffA1);
            PG8_WAIT_V(8); PG8_WAIT_L(0); PG8_BAR; PG8_MMA(0, 0, At, B0); PG8_MMA(0, 1, At, B1); PG8_BAR; PG8_SCHED;
            PG8_LDA(At, 0, 1); PG8_STAGE(PG8_SB(0, 0), b2, voffB); PG8_STAGE(PG8_SB(0, 1), b2 + hstep, voffB); PG8_STAGE(PG8_SA(0, 0), a2, voffA0);
            PG8_WAIT_V(8); PG8_WAIT_L(0); PG8_BAR; PG8_MMA(1, 0, At, B0); PG8_MMA(1, 1, At, B1); PG8_BAR; PG8_SCHED;
            PG8_LDB(B0, 1, 0); PG8_LDB(B1, 1, 1); PG8_SCHED; PG8_LDA(At, 1, 0); PG8_STAGE(PG8_SA(0, 1), a2, voffA1);
            PG8_WAIT_V(8); PG8_WAIT_L(0); PG8_BAR; PG8_MMA(0, 0, At, B0); PG8_MMA(0, 1, At, B1); PG8_BAR; PG8_SCHED;
            PG8_LDA(At, 1, 1); PG8_STAGE(PG8_SB(1, 0), b3, voffB); PG8_STAGE(PG8_SB(1, 1), b3 + hstep, voffB); PG8_STAGE(PG8_SA(1, 0), a3, voffA0);
            PG8_WAIT_V(8); PG8_WAIT_L(0); PG8_BAR; PG8_MMA(1, 0, At, B0); PG8_MMA(1, 1, At, B1); PG8_BAR; PG8_SCHED;
        }
        if (wr == 0) PG8_BAR;
        E(acc, cur, ui, wr, wc, fr, fq, lds + STAGE_BYTES);
        if (!has_next) break;
#pragma unroll
        for (int a = 0; a < 2; ++a)
#pragma unroll
            for (int b = 0; b < 2; ++b)
#pragma unroll
                for (int m = 0; m < 4; ++m)
#pragma unroll
                    for (int n = 0; n < 2; ++n) acc[a][b][m][n] = (f32x4){0.f, 0.f, 0.f, 0.f};
        cur = nxt; cA = nA; cB = nB; ++ui;
        if (wr == 1) PG8_BAR;
    }
    PG8_WAIT_V(0);
    PG8_BAR;
#undef PG8_SA
#undef PG8_SB
#undef PG8_STAGE
#undef PG8_LDA
#undef PG8_LDB
#undef PG8_MMA
#undef PG8_WAIT_V
#undef PG8_WAIT_L
#undef PG8_BAR
#undef PG8_SCHED
}
}

constexpr int NWAVES = 8;
constexpr int RING_BYTES = 131072, LDS_BYTES = 163840, LDSCTL_OFF = LDS_BYTES - 512, MISC_OFF = LDSCTL_OFF + 320;
#define GAS __attribute__((address_space(1)))
#define LAS __attribute__((address_space(3)))
typedef GAS unsigned gu32;
#define RLX_AGENT __ATOMIC_RELAXED, __HIP_MEMORY_SCOPE_AGENT
#define LDS_WAIT() asm volatile("s_waitcnt lgkmcnt(0)" ::: "memory")
#define VM_WAIT() asm volatile("s_waitcnt vmcnt(0)" ::: "memory")
constexpr int CW_BAR = 4096;
#define XB_TMO      128
#define XB_XCNT(j)  (256  + 64 * (j))
#define XB_XSUB(j)  (1280 + 64 * (j))
#define XB_XGEN(j)  (2304 + 64 * (j))
#define XB_TOP      3328
#define XB_TOPGEN   3392
#define XCD_BAR_WORDS 3456
#define XB_SPIN_CAP (1u << 18)
__device__ __forceinline__ unsigned xb_ld(unsigned* p)              { return __hip_atomic_load(p, __ATOMIC_RELAXED, __HIP_MEMORY_SCOPE_AGENT); }
__device__ __forceinline__ unsigned xb_add(unsigned* p, unsigned v) { return __hip_atomic_fetch_add(p, v, __ATOMIC_RELAXED, __HIP_MEMORY_SCOPE_AGENT); }
__device__ __forceinline__ unsigned xb_xcc_id() { return (unsigned)__builtin_amdgcn_s_getreg((3 << 11) | 20) & 0xFu; }
#define XB_SPIN(cond, bar) do { unsigned _sp = 0; while (cond) { __builtin_amdgcn_s_sleep(1); \
    if ((++_sp & 255u) == 0u) { if (xb_ld(&(bar)[XB_TMO])) break; if (_sp > XB_SPIN_CAP) { atomicAdd(&(bar)[XB_TMO], 1u); break; } } } } while (0)
struct XcdBarrier { unsigned* bar; unsigned x; volatile LAS unsigned* st; };
__device__ __forceinline__ XcdBarrier xcd_barrier_post(unsigned* bar, volatile LAS unsigned* st) {
    XcdBarrier b; b.bar = bar; b.x = xb_xcc_id(); b.st = st;
    if (threadIdx.x == 0) (void)xb_add(&bar[XB_XCNT(b.x)], 1u);
    return b;
}
__device__ __forceinline__ void xcd_barrier_complete(unsigned* bar, unsigned x, unsigned& nloc, unsigned& nx) {
    const unsigned G = gridDim.x * gridDim.y * gridDim.z;
    unsigned sum, cnt, mine, sp = 0u;
    for (;;) {
        sum = 0u; cnt = 0u; mine = 0u;
#pragma unroll
        for (unsigned j = 0; j < 16; ++j) { const unsigned c = xb_ld(&bar[XB_XCNT(j)]); sum += c; cnt += (c > 0u) ? 1u : 0u; mine = (j == x) ? c : mine; }
        if (sum == G) break;
        __builtin_amdgcn_s_sleep(1);
        if ((++sp & 255u) == 0u) { if (xb_ld(&bar[XB_TMO])) break; if (sp > XB_SPIN_CAP) { atomicAdd(&bar[XB_TMO], 1u); break; } }
    }
    nloc = mine > 0u ? mine : 1u; nx = cnt > 0u ? cnt : 1u;
}
__device__ __forceinline__ void xcd_barrier(const XcdBarrier& b) {
    asm volatile("s_waitcnt vmcnt(0)" ::: "memory");
    __syncthreads();
    if (threadIdx.x == 0) {
        unsigned* bar = b.bar;
        __builtin_amdgcn_s_waitcnt(0);
        unsigned nloc = b.st[0], nx = b.st[1];
        if (nloc == 0u) { xcd_barrier_complete(bar, b.x, nloc, nx); b.st[0] = nloc; b.st[1] = nx; }
        const unsigned old = xb_add(&bar[XB_XSUB(b.x)], 1u);
        const unsigned gen = old / nloc;
        if (old + 1u == (gen + 1u) * nloc) {
            __builtin_amdgcn_fence(__ATOMIC_RELEASE, "agent");
            asm volatile("s_waitcnt vmcnt(0)" ::: "memory");
            const unsigned og = xb_add(&bar[XB_TOP], 1u);
            const unsigned tg = og / nx;
            if (og + 1u == (tg + 1u) * nx) xb_add(&bar[XB_TOPGEN], 1u);
            else XB_SPIN(xb_ld(&bar[XB_TOPGEN]) == tg, bar);
            __builtin_amdgcn_fence(__ATOMIC_ACQUIRE, "agent");
            xb_add(&bar[XB_XGEN(b.x)], 1u);
            asm volatile("s_waitcnt vmcnt(0)" ::: "memory");
        } else {
            XB_SPIN(xb_ld(&bar[XB_XGEN(b.x)]) == gen, bar);
            __builtin_amdgcn_fence(__ATOMIC_ACQUIRE, "agent");
            asm volatile("s_waitcnt vmcnt(0)" ::: "memory");
        }
    }
    __syncthreads();
}

struct Args { const float* in[16]; float* out; unsigned char* ws; int ph_lo, ph_hi, li, pad; };
constexpr int A1T = 320;
enum { PH_PRO = 0, PH_A1, PH_A2, PH_A3, PH_F1A, PH_F2A, PH_B1, PH_B2, PH_GATE, PH_B3, PH_F1B, PH_F2B, PH_END };

__device__ __forceinline__ void p0_transpose_item(const float* W, int K, int Nsrc, int N, int mode, const float* gain, bf16_t* WT, LAS float* scr, int item, int lane) {
    const int nblk = N / 64, kb = item / nblk, nb = item % nblk, k0 = 64 * kb, n0 = 64 * nb;
    const int src = wmap(mode, n0 + lane);
    const float* wp = W + (size_t)k0 * Nsrc + (src >= 0 ? src : 0);
    const float gv = gain ? gain[k0 + lane] : 1.0f;
#pragma unroll
    for (int h = 0; h < 2; ++h) { float v[32];
#pragma unroll
        for (int i = 0; i < 32; ++i) v[i] = __builtin_nontemporal_load(wp + (size_t)(32 * h + i) * Nsrc);
#pragma unroll
        for (int i = 0; i < 32; ++i) { float x = v[i] * __int_as_float(__builtin_amdgcn_readlane(__float_as_int(gv), 32 * h + i)); if (src < 0) x = 0.f; scr[(32 * h + i) * 65 + lane] = x; } }
    LDS_WAIT(); asm volatile("" ::: "memory");
    const int kq = (lane & 3) * 16;
#pragma unroll
    for (int j = 0; j < 4; ++j) { const int n = (lane >> 2) + 16 * j; const LAS float* sp = scr + kq * 65 + n;
        u32x4 o0, o1;
        o0.x = pk2(sp[0 * 65], sp[1 * 65]); o0.y = pk2(sp[2 * 65], sp[3 * 65]); o0.z = pk2(sp[4 * 65], sp[5 * 65]); o0.w = pk2(sp[6 * 65], sp[7 * 65]);
        o1.x = pk2(sp[8 * 65], sp[9 * 65]); o1.y = pk2(sp[10 * 65], sp[11 * 65]); o1.z = pk2(sp[12 * 65], sp[13 * 65]); o1.w = pk2(sp[14 * 65], sp[15 * 65]);
        bf16_t* dst = WT + (size_t)(n0 + n) * K + k0 + kq; *(u32x4*)dst = o0; *(u32x4*)(dst + 8) = o1; }
    LDS_WAIT(); asm volatile("" ::: "memory");
}
__device__ __forceinline__ void ffn_fixup(int pm, const float* cw, const float* PART, const float* HALO, bf16_t* H) {
    if ((pm & 7) == 0) return;
    int tid = threadIdx.x; asm volatile("" : "+v"(tid));
    const float* part = PART + (size_t)pm * (4 * D_FF); const float* halo = HALO + (size_t)(pm - 1) * (4 * D_FF);
    constexpr int NE = 2 * D_FF / (NWAVES * 64);
    float va[NE], vb[NE], h0a[NE], h0b[NE], h1a[NE], h1b[NE], w0a[NE], w1a[NE], w0b[NE], w1b[NE];
#pragma unroll
    for (int i = 0; i < NE; ++i) { const int idx = i * (NWAVES * 64) + tid; const int e = idx >= D_FF ? 1 : 0, c = idx - e * D_FF;
        va[i] = part[(size_t)e * 2 * D_FF + c]; vb[i] = part[(size_t)e * 2 * D_FF + D_FF + c];
        h0a[i] = halo[c]; h0b[i] = halo[D_FF + c]; h1a[i] = halo[2 * D_FF + c]; h1b[i] = halo[3 * D_FF + c];
        w0a[i] = cw[c]; w1a[i] = cw[FF2 + c]; w0b[i] = cw[D_FF + c]; w1b[i] = cw[FF2 + D_FF + c]; }
#pragma unroll
    for (int i = 0; i < NE; ++i) { const int idx = i * (NWAVES * 64) + tid; const int e = idx >= D_FF ? 1 : 0, c = idx - e * D_FF;
        const float ka1 = e ? w0a[i] : w1a[i], ka0 = e ? 0.f : w0a[i], kb1 = e ? w0b[i] : w1b[i], kb0 = e ? 0.f : w0b[i];
        const float a = va[i] + (ka1 * h1a[i] + ka0 * h0a[i]), b = vb[i] + (kb1 * h1b[i] + kb0 * h0b[i]);
        H[(size_t)(pm * 256 + e) * D_FF + c] = f2bf(siluf(a) * b); }
}


__device__ __forceinline__ void glds16_asm(const void* gsrc, unsigned lds_dst) {
    unsigned keep; asm volatile("s_mov_b32 %0, m0\n\ts_mov_b32 m0, %2\n\ts_nop 0\n\tglobal_load_lds_dwordx4 %1, off\n\ts_mov_b32 m0, %0" : "=&s"(keep) : "v"(gsrc), "s"(lds_dst) : "memory"); }
__device__ __forceinline__ void glds16s_asm(const void* sbase, unsigned voff, unsigned lds_dst) {
    unsigned keep; asm volatile("s_mov_b32 %0, m0\n\ts_mov_b32 m0, %3\n\ts_nop 0\n\tglobal_load_lds_dwordx4 %1, %2\n\ts_mov_b32 m0, %0" : "=&s"(keep) : "v"(voff), "s"(sbase), "s"(lds_dst) : "memory"); }
__device__ __forceinline__ unsigned lds_addr(LAS unsigned char* p) { return (unsigned)__builtin_amdgcn_readfirstlane((int)(unsigned)(size_t)p); }

typedef short s16x4 __attribute__((ext_vector_type(4)));
__device__ __forceinline__ bf16x8 cat4(s16x4 a, s16x4 b) { bf16x8 r; r[0] = a[0]; r[1] = a[1]; r[2] = a[2]; r[3] = a[3]; r[4] = b[0]; r[5] = b[1]; r[6] = b[2]; r[7] = b[3]; return r; }
__device__ __forceinline__ void ret_fast_phase(LAS unsigned char* lds, const bf16_t* QT, const bf16_t* KT, const bf16_t* VT, bf16_t* RET, float* SSR, int unit) {
    int tid_ = threadIdx.x; asm volatile("" : "+v"(tid_));
    const int tid = tid_, lane = tid & 63, w = __builtin_amdgcn_readfirstlane(tid >> 6), li = lane & 15, g = lane >> 4;
    const int blk = unit & 7, h = (unit >> 3) & 3, b = unit >> 5;
    const float g64 = __expf(64.0f * gamma_log(h));
    const bool isR = w < 4; const int qt = w & 3, u = w & 3;
    constexpr int KB = 0, VB = 65536, ST = 81920;
    typedef __attribute__((address_space(3))) s16x4 lds_s16x4;
    for (int e = tid; e < 2048; e += 512) *(LAS u32x4*)(lds + ST + e * 16) = (u32x4){0u, 0u, 0u, 0u};
    f32x4 rg[16];
#pragma unroll
    for (int i = 0; i < 16; ++i) rg[i] = (f32x4){0.f, 0.f, 0.f, 0.f};
    const size_t rowb = (size_t)b * SEQ;
    const bf16_t* kbase = KT + rowb * 1024 + h * 256;
    const bf16_t* qbase = QT + (rowb + 16 * qt + li) * 1024 + h * 256 + 8 * g;
    const bf16_t* vbase = VT + ((size_t)b * 2048 + h * 512 + blk * 64 + (tid >> 3)) * SEQ + 8 * (tid & 7);
    const unsigned vw_off = (unsigned)((tid >> 3) * 128 + (((2 * (tid & 7)) ^ ((tid >> 3) & 14)) * 8));
#define KSRC(ln_, i_) ((unsigned)((16 * u + 2 * (i_) + ((ln_) >> 5)) * 2048 + ((((ln_) & 31) ^ (((2 * (i_) + ((ln_) >> 5)) & 7) << 1)) * 16)))
#define RK_DMA(n_, buf_) do { const char* kb_ = (const char*)(kbase + (size_t)(n_) * 64 * 1024); const unsigned ld_ = lds_addr(lds + KB + (buf_) * 32768 + (8 * u) * 1024); _Pragma("unroll") for (int i = 0; i < 8; ++i) \
        glds16_asm(kb_ + KSRC(lane, i), ld_ + i * 1024); } while (0)
    u32x4 vreg;
    if (!isR) { RK_DMA(0, 0); }
    vreg = *(const u32x4*)(vbase);
    if (isR) {
#pragma unroll
        for (int ks = 0; ks < 8; ++ks) rg[ks] = *(const f32x4*)(qbase + 32 * ks); }
    *(LAS u32x4*)(lds + VB + vw_off) = vreg;
    asm volatile("s_waitcnt vmcnt(0) lgkmcnt(0)" ::: "memory"); __builtin_amdgcn_s_barrier(); asm volatile("" ::: "memory");
#pragma unroll 1
    for (int n = 0; n < 32; ++n) {
        const int cur = n & 1, nxt = cur ^ 1;
        LAS unsigned char* kb = lds + KB + cur * 32768; LAS unsigned char* vb = lds + VB + cur * 8192; LAS unsigned char* sb = lds + ST + cur * 32768;
        if (n + 1 < 32) vreg = __builtin_nontemporal_load((const u32x4*)(vbase + (size_t)(n + 1) * 64));
        if (isR) {
            const bf16_t* qnx = qbase + (size_t)(n + 1 < 32 ? n + 1 : n) * 64 * 1024;
#define QLD(j_) rg[8 + (j_)] = *(const f32x4*)(qnx + 32 * (j_))
            const int sw = (li & 7) << 1;
#define LDROWS(dst, base, tile) do { const LAS unsigned char* rp_ = (base) + (16 * (tile) + li) * 512; _Pragma("unroll") for (int ks = 0; ks < 8; ++ks) dst[ks] = *(const LAS bf16x8*)(rp_ + (((4 * ks + g) ^ sw) * 16)); } while (0)
#define MMA8(acc_, fr_) do { _Pragma("unroll") for (int ks = 0; ks < 8; ++ks) acc_ = __builtin_amdgcn_mfma_f32_16x16x32_bf16(fr_[ks], __builtin_bit_cast(bf16x8, rg[ks]), acc_, 0, 0, 0); } while (0)
#define SFIN(k_, a_) do { if (qt == (k_)) { _Pragma("unroll") for (int r = 0; r < 4; ++r) a_[r] = (4 * g + r <= li) ? a_[r] : 0.f; } u32x2 pk_; pk_.x = pk2(a_[0], a_[1]); pk_.y = pk2(a_[2], a_[3]); sfr[k_] = __builtin_bit_cast(s16x4, pk_); } while (0)
#define SB_ __builtin_amdgcn_sched_barrier(0)
            bf16x8 fa[8], fb[8], fc[8]; f32x4 racc[4]; s16x4 sfr[4];
#pragma unroll
            for (int t = 0; t < 4; ++t) { racc[t] = (f32x4){0.f, 0.f, 0.f, 0.f}; sfr[t] = (s16x4){0, 0, 0, 0}; }
            LDROWS(fa, sb, 0); LDROWS(fb, sb, 1); QLD(0); SB_;
            LDROWS(fc, sb, 2); QLD(1); SB_; MMA8(racc[0], fa); SB_;
            LDROWS(fa, sb, 3); QLD(2); SB_; MMA8(racc[1], fb); SB_;
            LDROWS(fb, kb, 0); QLD(3); SB_; MMA8(racc[2], fc); SB_;
            if (qt >= 1) { LDROWS(fc, kb, 1); }
            QLD(4); QLD(5); SB_; MMA8(racc[3], fa); SB_;
            if (qt >= 2) { LDROWS(fa, kb, 2); }
            QLD(6); QLD(7); SB_;
            { f32x4 a = (f32x4){0.f, 0.f, 0.f, 0.f}; MMA8(a, fb); SFIN(0, a); }
            SB_;
            if (qt >= 1) { if (qt >= 3) { LDROWS(fb, kb, 3); } SB_; f32x4 a = (f32x4){0.f, 0.f, 0.f, 0.f}; MMA8(a, fc); SFIN(1, a); }
            SB_;
            SB_;
            if (qt >= 2) { f32x4 a = (f32x4){0.f, 0.f, 0.f, 0.f}; MMA8(a, fa); SFIN(2, a); }
            SB_;
            bf16x8 vf0[4], vf1[4];
#pragma unroll
            for (int t = 0; t < 4; ++t) { const int row = 16 * t + li; const LAS unsigned char* vp = vb + row * 128; const int f = row & 14;
                vf0[t] = cat4(*(const LAS s16x4*)(vp + (((g) ^ f) * 8)), *(const LAS s16x4*)(vp + (((4 + g) ^ f) * 8)));
                vf1[t] = cat4(*(const LAS s16x4*)(vp + (((8 + g) ^ f) * 8)), *(const LAS s16x4*)(vp + (((12 + g) ^ f) * 8))); }
            SB_;
            if (qt >= 3) { f32x4 a = (f32x4){0.f, 0.f, 0.f, 0.f}; MMA8(a, fb); SFIN(3, a); }
            SB_;
            const bf16x8 sf0 = cat4(sfr[0], sfr[1]), sf1 = cat4(sfr[2], sfr[3]);
            float ssq = 0.f; u32x2 pkt[4];
#pragma unroll
            for (int t = 0; t < 4; ++t) {
                f32x4 acc = __builtin_amdgcn_mfma_f32_16x16x32_bf16(vf0[t], sf0, racc[t], 0, 0, 0);
                if (qt >= 2) acc = __builtin_amdgcn_mfma_f32_16x16x32_bf16(vf1[t], sf1, acc, 0, 0, 0);
                ssq += (acc[0] * acc[0] + acc[1] * acc[1]) + (acc[2] * acc[2] + acc[3] * acc[3]);
                pkt[t].x = pk2(acc[0], acc[1]); pkt[t].y = pk2(acc[2], acc[3]); }
#undef LDROWS
#undef MMA8
#undef SFIN
#undef QLD
            bf16_t* rrow = RET + (rowb + n * 64 + 16 * qt + li) * 2048 + h * 512 + blk * 64 + 16 * (g & 1) + 4 * (g & 2);
#pragma unroll
            for (int pp = 0; pp < 2; ++pp) {
                const auto sx = __builtin_amdgcn_permlane16_swap(pkt[2 * pp].x, pkt[2 * pp + 1].x, false, false), sy = __builtin_amdgcn_permlane16_swap(pkt[2 * pp].y, pkt[2 * pp + 1].y, false, false);
                u32x4 w4; w4.x = sx[0]; w4.y = sy[0]; w4.z = sx[1]; w4.w = sy[1];
                *(u32x4*)(rrow + 32 * pp) = w4; }
            ssq += __shfl_xor(ssq, 16); ssq += __shfl_xor(ssq, 32);
            if (g < 2) SSR[((rowb + n * 64 + 16 * qt + li) * 4 + h) * 16 + blk * 2 + g] = g ? 0.f : ssq;
#pragma unroll
            for (int ks = 0; ks < 8; ++ks) rg[ks] = rg[8 + ks];
        } else {
            const char* kb_n = (const char*)(kbase + (size_t)(n + 1 < 32 ? n + 1 : n) * 64 * 1024); const unsigned ld_n = lds_addr(lds + KB + nxt * 32768 + (8 * u) * 1024);
            int ln_ = lane; asm volatile("" : "+v"(ln_));
#define KDMA2(i_) do { if (n + 1 < 32) { glds16_asm(kb_n + KSRC(ln_, i_), ld_n + (i_) * 1024); glds16_asm(kb_n + KSRC(ln_, (i_) + 1), ld_n + ((i_) + 1) * 1024); } } while (0)
            KDMA2(0); KDMA2(2); KDMA2(4); KDMA2(6);
            bf16x8 vf[4][2];
#pragma unroll
            for (int t = 0; t < 4; ++t)
#pragma unroll
                for (int kp = 0; kp < 2; ++kp) { const int row = 16 * t + li; const LAS unsigned char* rp = vb + row * 128; const int f = row & 14;
                    const s16x4 lo = *(const LAS s16x4*)(rp + (((8 * kp + g) ^ f) * 8)), hi = *(const LAS s16x4*)(rp + (((8 * kp + 4 + g) ^ f) * 8)); vf[t][kp] = cat4(lo, hi); }
            bf16x8 ua[4][2];
#pragma unroll
            for (int d = 0; d < 4; ++d) {
#pragma unroll
                for (int kp = 0; kp < 2; ++kp) { const int dkt = 4 * u + d;
                    const int r0 = 32 * kp + 4 * g + (li >> 2), r1 = r0 + 16;
                    const int cch = 2 * dkt + ((li >> 1) & 1), hb = (li & 1) * 8;
                    const s16x4 lo = __builtin_bit_cast(s16x4, __builtin_amdgcn_ds_read_tr16_b64_v4i16((lds_s16x4*)(kb + r0 * 512 + ((cch ^ ((r0 & 7) << 1)) * 16) + hb)));
                    const s16x4 hi = __builtin_bit_cast(s16x4, __builtin_amdgcn_ds_read_tr16_b64_v4i16((lds_s16x4*)(kb + r1 * 512 + ((cch ^ ((r1 & 7) << 1)) * 16) + hb)));
                    ua[d][kp] = cat4(lo, hi); }
                if (d == 1) __builtin_amdgcn_sched_barrier(0); }
            __builtin_amdgcn_sched_barrier(0);
#pragma unroll
            for (int d = 0; d < 4; ++d) {
                __builtin_amdgcn_sched_barrier(0);
#pragma unroll
                for (int kp = 0; kp < 2; ++kp)
#pragma unroll
                    for (int t = 0; t < 4; ++t) rg[4 * d + t] = __builtin_amdgcn_mfma_f32_16x16x32_bf16(ua[d][kp], vf[t][kp], rg[4 * d + t], 0, 0, 0);
                __builtin_amdgcn_sched_barrier(0); }
#undef KDMA2
            LAS unsigned char* sn = lds + ST + nxt * 32768;
#pragma unroll
            for (int d = 0; d < 4; ++d)
#pragma unroll
                for (int t = 0; t < 4; ++t) { rg[4 * d + t] *= g64; const int row = 16 * t + li, dkt = 4 * u + d;
                    u32x2 pk; pk.x = pk2(rg[4 * d + t][0], rg[4 * d + t][1]); pk.y = pk2(rg[4 * d + t][2], rg[4 * d + t][3]);
                    *(LAS u32x2*)(sn + row * 512 + (((2 * dkt + (g >> 1)) ^ ((row & 7) << 1)) * 16) + (g & 1) * 8) = pk; }
        }
        if (n + 1 < 32) *(LAS u32x4*)(lds + VB + nxt * 8192 + vw_off) = vreg;
        asm volatile("s_waitcnt vmcnt(0) lgkmcnt(0)" ::: "memory"); __builtin_amdgcn_s_barrier(); asm volatile("" ::: "memory");
    }
#undef RK_DMA
#undef KSRC
#undef SB_
}


#ifndef DSA_REP
#define DSA_REP 0
#endif
constexpr int DSA_SC = 0, DSA_KST = 131072, DSA_IDX = 147456, DSA_WQ = 155648;
__device__ __forceinline__ unsigned fkey(float f) { const unsigned u = __float_as_uint(f); return u ^ ((unsigned)((int)u >> 31) | 0x80000000u); }
__device__ __forceinline__ int bcnt(bool p) { return __popcll(__builtin_amdgcn_ballot_w64(p)); }
#define SUMF(a_, b_) ((a_) + (b_))
#define WAVE_RED(OP, v) do { v = OP(v, __int_as_float(__builtin_amdgcn_update_dpp(__float_as_int(v), __float_as_int(v), 0xB1, 0xf, 0xf, true))); \
        v = OP(v, __int_as_float(__builtin_amdgcn_update_dpp(__float_as_int(v), __float_as_int(v), 0x4E, 0xf, 0xf, true))); \
        v = OP(v, __int_as_float(__builtin_amdgcn_update_dpp(__float_as_int(v), __float_as_int(v), 0x141, 0xf, 0xf, true))); \
        v = OP(v, __int_as_float(__builtin_amdgcn_update_dpp(__float_as_int(v), __float_as_int(v), 0x140, 0xf, 0xf, true))); \
        v = OP(OP(__int_as_float(__builtin_amdgcn_readlane(__float_as_int(v), 0)), __int_as_float(__builtin_amdgcn_readlane(__float_as_int(v), 16))), \
               OP(__int_as_float(__builtin_amdgcn_readlane(__float_as_int(v), 32)), __int_as_float(__builtin_amdgcn_readlane(__float_as_int(v), 48)))); } while (0)

template <int NB>
__device__ __forceinline__ void dsa_load_scores(float (&v)[NB], const LAS float* sc, int limit, int lane) {
    const int nb = limit >> 6;
#pragma unroll
    for (int i = 0; i < NB; ++i) v[i] = (i < nb) ? sc[64 * i + lane] : -INFINITY;
}
template <int NB>
__device__ __forceinline__ void dsa_topk_t(const float (&v)[NB], LAS unsigned short* il, int limit, int lane) {
    const int nb = limit >> 6;
    float mn = INFINITY, mx = -INFINITY;
#pragma unroll
    for (int i = 0; i < NB; ++i) { mn = fminf(mn, (i < nb) ? v[i] : INFINITY); mx = fmaxf(mx, v[i]); }
    WAVE_RED(fminf, mn); WAVE_RED(fmaxf, mx);
    float lo = mn, hi = INFINITY; int clo = limit, chi = 0;
#pragma unroll 1
    for (int it = 0; it < 64 && clo - chi > 64; ++it) {
        const float top = (hi == INFINITY) ? mx : hi; const float mid = 0.5f * lo + 0.5f * top;
        if (!(mid > lo) || !(mid < hi)) break;
        int c = 0;
#pragma unroll
        for (int j = 0; j < NB / 4; ++j) if (4 * j < nb) {
#pragma unroll
            for (int i = 4 * j; i < 4 * j + 4; ++i) c += (v[i] >= mid) ? 1 : 0; }
        float cf = (float)c; WAVE_RED(SUMF, cf); c = (int)cf;
        if (c >= TOPK) { lo = mid; clo = c; } else { hi = mid; chi = c; }
    }
    const int r = TOPK - chi; unsigned T; int ngt, neq;
    if (clo - chi <= 64) {
        int filled = 0;
        const unsigned klo = fkey(lo), kspan = fkey(hi) - klo;
#pragma unroll
        for (int i = 0; i < NB; ++i) { const unsigned kk = fkey(v[i]); const bool in = (kk - klo) < kspan;
            const unsigned long long m = __builtin_amdgcn_ballot_w64(in); const int pos = filled + __builtin_amdgcn_mbcnt_hi((unsigned)(m >> 32), __builtin_amdgcn_mbcnt_lo((unsigned)m, 0));
            if (in) ((LAS unsigned*)il)[pos] = kk;
            filled += __popcll(m); }
        asm volatile("s_waitcnt lgkmcnt(0)" ::: "memory");
        const unsigned ck = (lane < filled) ? ((LAS unsigned*)il)[lane] : 0u;
        T = 0u;
#pragma unroll
        for (int bit = 31; bit >= 0; --bit) { const unsigned cand = T | (1u << bit); if (bcnt(ck >= cand) >= r) T = cand; }
        ngt = chi + bcnt(ck > T); neq = bcnt(ck == T);
    } else {
        T = 0u;
#pragma unroll 1
        for (int bit = 31; bit >= 0; --bit) { const unsigned cand = T | (1u << bit); int c = 0;
#pragma unroll
            for (int i = 0; i < NB; ++i) c += bcnt(i < nb && fkey(v[i]) >= cand);
            if (c >= TOPK) T = cand; }
        ngt = 0; neq = 0;
#pragma unroll
        for (int i = 0; i < NB; ++i) { const unsigned k = fkey(v[i]); ngt += bcnt(i < nb && k > T); neq += bcnt(i < nb && k == T); }
    }
    const int need_eq = TOPK - ngt;
    asm volatile("s_waitcnt lgkmcnt(0)" ::: "memory");
    int base = 0, tb = 0;
    const bool alleq = (neq == need_eq);
    if (alleq) {
        const float Tf = __uint_as_float((T & 0x80000000u) ? (T ^ 0x80000000u) : ~T);
#pragma unroll
        for (int i = 0; i < NB; ++i) if (i < nb) { const bool f = v[i] >= Tf;
            const unsigned long long mf = __builtin_amdgcn_ballot_w64(f); const int pos = base + __builtin_amdgcn_mbcnt_hi((unsigned)(mf >> 32), __builtin_amdgcn_mbcnt_lo((unsigned)mf, 0));
            if (f) il[pos] = (unsigned short)(64 * i + lane);
            base += __popcll(mf); }
    } else {
#pragma unroll
        for (int i = 0; i < NB; ++i) if (i < nb) { const unsigned k = fkey(v[i]);
            const bool eq = (k == T); const unsigned long long me = __builtin_amdgcn_ballot_w64(eq);
            const int er = tb + __builtin_amdgcn_mbcnt_hi((unsigned)(me >> 32), __builtin_amdgcn_mbcnt_lo((unsigned)me, 0));
            const bool f = (k > T) || (eq && er < need_eq); tb += __popcll(me);
            const unsigned long long mf = __builtin_amdgcn_ballot_w64(f); const int pos = base + __builtin_amdgcn_mbcnt_hi((unsigned)(mf >> 32), __builtin_amdgcn_mbcnt_lo((unsigned)mf, 0));
            if (f && pos < TOPK) il[pos] = (unsigned short)(64 * i + lane);
            base += __popcll(mf); }
    }
}

struct DsaQ { bf16x8 qf[4]; f32x4 ps; };
__device__ __forceinline__ DsaQ dsa_load_q(const bf16_t* QH, const float* PS, size_t trow, int lane) {
    const int li = lane & 15, g = lane >> 4; DsaQ q;
#pragma unroll
    for (int s = 0; s < 4; ++s) { q.qf[s] = (bf16x8){0, 0, 0, 0, 0, 0, 0, 0}; if (li < 8) q.qf[s] = *(const bf16x8*)(QH + trow * 1024 + li * 128 + 32 * s + 8 * g); }
    q.ps = (f32x4){1.f, 1.f, 1.f, 1.f};
    if (li < 8) { const float* pp = PS + (size_t)((li >> 1) * 8 + (li & 1) * 4) * M + trow; q.ps = (f32x4){pp[0], pp[(size_t)M], pp[(size_t)2 * M], pp[(size_t)3 * M]}; }
    return q;
}
__device__ __forceinline__ void dsa_attend(LAS unsigned char* wl, const LAS unsigned short* il, const LAS float* rctab, LAS float* rcl, const DsaQ& Q, const bf16_t* Cb, bf16_t* AO, size_t trow, int b, int count, float bound_l2, int lane) {
    const int li = lane & 15, g = lane >> 4;
    typedef __attribute__((address_space(3))) s16x4 lds_s16x4;
    bf16x8 qf[4];
#pragma unroll
    for (int s = 0; s < 4; ++s) qf[s] = Q.qf[s];
    const float rq = (li < 8) ? rsqrtf(((Q.ps[0] + Q.ps[1]) + (Q.ps[2] + Q.ps[3])) * (1.0f / 128.0f) + EPS) * 1.4426950408889634f : 0.f;
    const bf16_t* cbase = Cb + (size_t)b * SEQ * 128; const unsigned wlb = lds_addr(wl);
#define DSA_GATHER(ci_, buf_) do { const u32x4 kw_ = *(const LAS u32x4*)(il + 32 * (ci_) + 8 * (lane >> 4)); \
        _Pragma("unroll") for (int i = 0; i < 8; ++i) { const int row = 4 * i + (lane >> 4); const unsigned kk_ = (i < 2 ? kw_.x : i < 4 ? kw_.y : i < 6 ? kw_.z : kw_.w); const int key = (i & 1) ? (int)(kk_ >> 16) : (int)(kk_ & 0xffffu); \
        const int sc_ = (lane & 15) ^ ((row & 7) << 1); \
        glds16s_asm(cbase, (unsigned)(key * 256 + sc_ * 16), wlb + (buf_) * 8192 + i * 1024); } } while (0)
    for (int pos = lane; pos < count; pos += 64) { const int e = pos & 31; rcl[(pos & ~31) + 4 * (e & 7) + (e >> 3)] = rctab[il[pos]]; }
    asm volatile("s_waitcnt lgkmcnt(0)" ::: "memory");
    f32x4 oacc[8];
#pragma unroll
    for (int d = 0; d < 8; ++d) oacc[d] = (f32x4){0.f, 0.f, 0.f, 0.f};
    float lsum = 0.f;
    const int nch = count >> 5;
    DSA_GATHER(0, 0);
#pragma unroll 1
    for (int ci = 0; ci < nch; ++ci) {
        const int cur = ci & 1;
        if (ci + 1 < nch) { DSA_GATHER(ci + 1, cur ^ 1); if (DSA_REP & 8) { DSA_GATHER(ci + 1, cur ^ 1); asm volatile("s_waitcnt vmcnt(16)" ::: "memory"); } else asm volatile("s_waitcnt vmcnt(8)" ::: "memory"); } else { asm volatile("s_waitcnt vmcnt(0)" ::: "memory"); }
        const LAS unsigned char* ct = wl + cur * 8192;
        f32x4 lt[2];
        bf16x8 ca[2][4];
#pragma unroll
        for (int T = 0; T < 2; ++T) { const int row = 16 * T + li; const LAS unsigned char* rp = ct + row * 256; const int sw = (row & 7) << 1;
#pragma unroll
            for (int s = 0; s < 4; ++s) ca[T][s] = *(const LAS bf16x8*)(rp + (((4 * s + g) ^ sw) * 16)); }
        f32x4 rcv[2];
#pragma unroll
        for (int T = 0; T < 2; ++T) rcv[T] = *(const LAS f32x4*)(rcl + 32 * ci + 16 * T + 4 * g);
        __builtin_amdgcn_sched_barrier(0);
#pragma unroll
        for (int T = 0; T < 2; ++T) { lt[T] = (f32x4){0.f, 0.f, 0.f, 0.f};
#pragma unroll
            for (int s = 0; s < 4; ++s) lt[T] = __builtin_amdgcn_mfma_f32_16x16x32_bf16(ca[T][s], qf[s], lt[T], 0, 0, 0); }
        bf16x8 cv[8];
#pragma unroll
        for (int dt = 0; dt < 8; ++dt) {
            const int r0 = 4 * g + (li >> 2), r1 = r0 + 16; const int cch = 2 * dt + ((li >> 1) & 1), hb = (li & 1) * 8;
            const s16x4 lo = __builtin_bit_cast(s16x4, __builtin_amdgcn_ds_read_tr16_b64_v4i16((lds_s16x4*)(ct + r0 * 256 + ((cch ^ ((r0 & 7) << 1)) * 16) + hb)));
            const s16x4 hi = __builtin_bit_cast(s16x4, __builtin_amdgcn_ds_read_tr16_b64_v4i16((lds_s16x4*)(ct + r1 * 256 + ((cch ^ ((r1 & 7) << 1)) * 16) + hb)));
            cv[dt] = cat4(lo, hi); }
        __builtin_amdgcn_sched_barrier(0);
        bf16x8 pf;
#pragma unroll
        for (int T = 0; T < 2; ++T) { float pv[4];
#pragma unroll
            for (int r = 0; r < 4; ++r) { pv[r] = __builtin_amdgcn_exp2f(lt[T][r] * rq * rcv[T][r] - bound_l2); lsum += pv[r]; }
            const unsigned w0 = pk2(pv[0], pv[1]), w1 = pk2(pv[2], pv[3]);
            pf[4 * T + 0] = (short)(w0 & 0xffff); pf[4 * T + 1] = (short)(w0 >> 16); pf[4 * T + 2] = (short)(w1 & 0xffff); pf[4 * T + 3] = (short)(w1 >> 16); }
#pragma unroll
        for (int dt = 0; dt < 8; ++dt) oacc[dt] = __builtin_amdgcn_mfma_f32_16x16x32_bf16(cv[dt], pf, oacc[dt], 0, 0, 0);
    }
#undef DSA_GATHER
    lsum += __shfl_xor(lsum, 16); lsum += __shfl_xor(lsum, 32);
    const float inv = 1.0f / lsum;
    if (li < 8) {
#pragma unroll
        for (int dt = 0; dt < 8; ++dt) { u32x2 o; o.x = pk2(oacc[dt][0] * inv, oacc[dt][1] * inv); o.y = pk2(oacc[dt][2] * inv, oacc[dt][3] * inv);
            *(u32x2*)(AO + trow * 1024 + li * 128 + 16 * dt + 4 * g) = o; }
    }
}

template <int NB>
__device__ __forceinline__ void dsa_item_tail(LAS unsigned char* wl, LAS unsigned short* il0, LAS unsigned short* il1, const LAS float* rctab, LAS float* rcl, const DsaQ& Q0, const DsaQ& Q1,
                                              const bf16_t* Cb, bf16_t* AO, size_t trow0, int b, int limit, float bound_l2, int lane, int w) {
    float v0[NB], v1[NB];
    dsa_load_scores<NB>(v0, (const LAS float*)wl, limit, lane); dsa_load_scores<NB>(v1, (const LAS float*)wl + 2048, limit, lane);
    asm volatile("s_waitcnt lgkmcnt(0)" ::: "memory");
    dsa_topk_t<NB>(v0, il0, limit, lane);
    if (w < 4) dsa_attend(wl, il0, rctab, rcl, Q0, Cb, AO, trow0, b, TOPK, bound_l2, lane);
    dsa_topk_t<NB>(v1, il1, limit, lane);
    if (w >= 4) dsa_attend(wl, il0, rctab, rcl, Q0, Cb, AO, trow0, b, TOPK, bound_l2, lane);
    dsa_attend(wl, il1, rctab, rcl, Q1, Cb, AO, trow0 + 1, b, TOPK, bound_l2, lane);
}

__device__ __forceinline__ void dsa_fast_phase(LAS unsigned char* lds, const bf16_t* QH, const bf16_t* Cb, const float* PS, const bf16_t* QI, const bf16_t* KI, const float* WI, const float* CSC, bf16_t* AO, int vcu, int G, const float bound_l2) {
    int tid_ = threadIdx.x; asm volatile("" : "+v"(tid_));
    const int tid = tid_, lane0 = tid & 63, w = __builtin_amdgcn_readfirstlane(tid >> 6);
    LAS unsigned char* wl = lds + DSA_SC + w * 16384; LAS float* rctab = (LAS float*)(lds + DSA_KST);
    LAS unsigned short* il0 = (LAS unsigned short*)(lds + DSA_IDX + (2 * w) * 512); LAS unsigned short* il1 = il0 + 256;
    for (int wg = vcu; wg < 256; wg += G) {
        const int b = wg >> 5, r = wg & 31;
        __syncthreads();
        for (int k = tid; k < SEQ; k += NWAVES * 64) { const float* pp = PS + (size_t)32 * M + (size_t)b * SEQ + k;
            rctab[k] = rsqrtf(((pp[0] + pp[(size_t)M]) + (pp[(size_t)2 * M] + pp[(size_t)3 * M])) * (1.0f / 128.0f) + EPS); }
#pragma unroll 1
        for (int it = 0; it < 4; ++it) {
            int lane = lane0; asm volatile("" : "+v"(lane));
            const int li = lane & 15, g = lane >> 4;
            const int chunk = (it & 1) ? 31 - (r & 15) : (r & 15), sub = 2 * (r >> 4) + (it >> 1);
            const int t0 = chunk * 64 + sub * 16, limit = (chunk + 1) * 64;
            const size_t trow0 = (size_t)b * SEQ + t0 + 2 * w;
            const DsaQ Q0 = dsa_load_q(QH, PS, trow0, lane), Q1 = dsa_load_q(QH, PS, trow0 + 1, lane);
            LAS float* wqt = (LAS float*)(lds + DSA_WQ);
            if (limit <= TOPK) __syncthreads();
            if (limit > TOPK) {
                for (int srep = 0; srep < 1; ++srep) {
                bf16x8 af[8][2]; float wq[8][4];
                const size_t trowi = (size_t)b * SEQ + t0;
#pragma unroll
                for (int p = 0; p < 8; ++p)
#pragma unroll
                    for (int sidx = 0; sidx < 2; ++sidx) af[p][sidx] = *(const bf16x8*)(QI + (trowi + 2 * p + (li >> 3)) * 512 + (li & 7) * 64 + 32 * sidx + 8 * g);
                const int nst = limit >> 4;
                const __amdgpu_buffer_rsrc_t krs = __builtin_amdgcn_make_buffer_rsrc((void*)(KI + (size_t)b * SEQ * 64), 0, SEQ * 64 * 2, 0x00020000);
                const __amdgpu_buffer_rsrc_t prs = __builtin_amdgcn_make_buffer_rsrc((void*)(PS + (size_t)36 * M + (size_t)b * SEQ), 0, (int)(M * 4 + SEQ * 4), 0x00020000);
                const int kvo = (li * 64 + 8 * g) * 2, pvo = li * 4;
#define SW_LOAD(B0_, B1_, PK_, stx_) do { const int st_ = (stx_) < nst ? (stx_) : w;     \
                    const u32x4 r0_ = __builtin_bit_cast(u32x4, __builtin_amdgcn_raw_buffer_load_b128(krs, kvo, st_ * 2048, 0)), r1_ = __builtin_bit_cast(u32x4, __builtin_amdgcn_raw_buffer_load_b128(krs, kvo + 64, st_ * 2048, 0)); \
                    B0_ = __builtin_bit_cast(bf16x8, r0_); B1_ = __builtin_bit_cast(bf16x8, r1_); \
                    PK_ = (f32x2_t){__uint_as_float(__builtin_amdgcn_raw_buffer_load_b32(prs, pvo, st_ * 64, 0)), __uint_as_float(__builtin_amdgcn_raw_buffer_load_b32(prs, pvo, st_ * 64 + M * 4, 0))}; } while (0)
                bf16x8 x0, x1, y0, y1, z0, z1; f32x2_t xk, yk, zk;
                SW_LOAD(x0, x1, xk, w); __builtin_amdgcn_sched_barrier(0); SW_LOAD(y0, y1, yk, w + 8); __builtin_amdgcn_sched_barrier(0);
                if (tid < 128) { const int qq = tid >> 3, hh = tid & 7; const size_t row = (size_t)b * SEQ + t0 + qq;
                    const float* ps = PS + (size_t)(40 + (hh >> 2) * 8 + ((hh >> 1) & 1) * 4 + 2 * (hh & 1)) * M + row;
                    wqt[tid] = WI[row * 8 + hh] * rsqrtf((ps[0] + ps[(size_t)M]) * (1.0f / 64.0f) + EPS); }
                __syncthreads();
#pragma unroll
                for (int p = 0; p < 8; ++p) {
                    const f32x4 wv = *(const LAS f32x4*)(wqt + (2 * p + (g >> 1)) * 8 + 4 * (g & 1));
                    wq[p][0] = wv[0]; wq[p][1] = wv[1]; wq[p][2] = wv[2]; wq[p][3] = wv[3];
                    asm volatile("" ::: "memory"); }
#define RELU_(x_) __int_as_float(max(__float_as_int(x_), 0))
#define SW_BODY(C0_, C1_, PK_, st_) do { const float rk = __builtin_amdgcn_rsqf((PK_[0] + PK_[1]) * (1.0f / 64.0f) + EPS);     \
                    LAS float* so = (LAS float*)(lds + DSA_SC) + (g >> 1) * 2048 + 16 * (st_) + li; \
                    _Pragma("unroll") for (int p = 0; p < 8; ++p) { \
                        f32x4 acc = (f32x4){0.f, 0.f, 0.f, 0.f}; \
                        acc = __builtin_amdgcn_mfma_f32_16x16x32_bf16(af[p][0], C0_, acc, 0, 0, 0); acc = __builtin_amdgcn_mfma_f32_16x16x32_bf16(af[p][1], C1_, acc, 0, 0, 0); \
                        float part = (RELU_(acc[0]) * wq[p][0] + RELU_(acc[1]) * wq[p][1]) + (RELU_(acc[2]) * wq[p][2] + RELU_(acc[3]) * wq[p][3]); \
                        {   const auto sw = __builtin_amdgcn_permlane16_swap(__float_as_uint(part), __float_as_uint(part), false, false);        \
                            part = __uint_as_float(sw[0]) + __uint_as_float(sw[1]); } \
                        if ((g & 1) == 0) so[p * 4096] = part * rk + 0.0f;            \
                    } } while (0)
#pragma unroll 1
                for (int st = w; st < nst; st += 24) {
                    SW_LOAD(z0, z1, zk, st + 16);
                    SW_BODY(x0, x1, xk, st);
                    if (st + 8 >= nst) break;
                    SW_LOAD(x0, x1, xk, st + 24);
                    SW_BODY(y0, y1, yk, st + 8);
                    if (st + 16 >= nst) break;
                    SW_LOAD(y0, y1, yk, st + 32);
                    SW_BODY(z0, z1, zk, st + 16);
                }
#undef SW_LOAD
#undef SW_BODY
#undef RELU_
                __syncthreads();
                }
                LAS float* rcl = (LAS float*)(lds + DSA_KST + 8192 + w * 1024);
                if (limit <= 512) dsa_item_tail<8>(wl, il0, il1, rctab, rcl, Q0, Q1, Cb, AO, trow0, b, limit, bound_l2, lane, w);
                else if (limit <= 1024) dsa_item_tail<16>(wl, il0, il1, rctab, rcl, Q0, Q1, Cb, AO, trow0, b, limit, bound_l2, lane, w);
                else dsa_item_tail<32>(wl, il0, il1, rctab, rcl, Q0, Q1, Cb, AO, trow0, b, limit, bound_l2, lane, w);
            } else {
                for (int j = lane; j < limit; j += 64) { il0[j] = (unsigned short)j; il1[j] = (unsigned short)j; }
                dsa_attend(wl, il0, rctab, (LAS float*)(lds + DSA_KST + 8192 + w * 1024), Q0, Cb, AO, trow0, b, limit, bound_l2, lane);
                dsa_attend(wl, il1, rctab, (LAS float*)(lds + DSA_KST + 8192 + w * 1024), Q1, Cb, AO, trow0 + 1, b, limit, bound_l2, lane);
            }
        }
    }
    __syncthreads();
}

typedef const __attribute__((address_space(4))) Args* ArgsP;
__device__ __forceinline__ ArgsP fresh_args() { ArgsP p = (ArgsP)__builtin_amdgcn_kernarg_segment_ptr(); asm volatile("" : "+s"(p)); return p; }

__device__ __forceinline__ int fresh_bx() { int v = blockIdx.x; asm volatile("" : "+s"(v)); return v; }
__device__ __forceinline__ int fresh_gx() { int v = gridDim.x; asm volatile("" : "+s"(v)); return v; }
__global__ void __launch_bounds__(NWAVES * 64, 2) mega(Args args_unused) {
    extern __shared__ __attribute__((aligned(16))) unsigned char lds_raw[];
    LAS unsigned char* lds = (LAS unsigned char*)lds_raw;
    const int tid = threadIdx.x;
    for (int u = tid; u < (LDS_BYTES - LDSCTL_OFF) / 4; u += NWAVES * 64) ((LAS unsigned*)(lds + LDSCTL_OFF))[u] = 0u;
    __syncthreads();
    int lo, hi;
    {   ArgsP A = fresh_args(); lo = A->ph_lo; hi = A->ph_hi;
        if (hi - lo > 1) (void)xcd_barrier_post((unsigned*)(A->ws + WS_CTL) + CW_BAR + A->li * XCD_BAR_WORDS, (volatile LAS unsigned*)(lds + MISC_OFF) + 8); }
#ifndef PHMASK
#define PHMASK 0xffff
#endif
#define IN(k) (((PHMASK >> (k)) & 1) && lo <= (k) && (k) < hi)
#define SEAM(k) do { if (lo <= (k) && (k) + 1 < hi) { ArgsP A_ = fresh_args(); XcdBarrier b_; b_.bar = (unsigned*)(A_->ws + WS_CTL) + CW_BAR + A_->li * XCD_BAR_WORDS; b_.x = xb_xcc_id(); \
        b_.st = (volatile LAS unsigned*)(lds + MISC_OFF) + 8; xcd_barrier(b_); } } while (0)
#ifndef REPMASK
#define REPMASK 0
#endif
#define GBAR() do { ArgsP A_ = fresh_args(); XcdBarrier b_; b_.bar = (unsigned*)(A_->ws + WS_CTL) + CW_BAR + A_->li * XCD_BAR_WORDS; b_.x = xb_xcc_id(); \
        b_.st = (volatile LAS unsigned*)(lds + MISC_OFF) + 8; xcd_barrier(b_); } while (0)
#define REPEAT(k) for (int rep_ = 0; rep_ < 1 + ((REPMASK >> (k)) & 1); ++rep_)
#define REPBAR() do { if (rep_) GBAR(); } while (0)
#define GWS int t_ = threadIdx.x; asm volatile("" : "+v"(t_)); const int lane = t_ & 63, wave = __builtin_amdgcn_readfirstlane(t_ >> 6); const int G = fresh_gx(), bx = fresh_bx(); const int vcu = (G % 8 == 0) ? (bx % 8) * (G / 8) + bx / 8 : bx; \
        const int gw = vcu * NWAVES + wave, NGW = G * NWAVES; LAS float* scr = (LAS float*)(lds + wave * 16640); (void)lane; (void)gw; (void)NGW; (void)scr;
#define WCONV(Wp, K_, Nsrc_, N_, mode_, gain_, WT_) do { const int items_ = ((K_) / 64) * ((N_) / 64); \
        for (int it = gw; it < items_; it += NGW) p0_transpose_item((Wp), (K_), (Nsrc_), (N_), (mode_), (gain_), (WT_), scr, it, lane); } while (0)

    if (IN(PH_PRO)) REPEAT(PH_PRO) { REPBAR();
        GWS; ArgsP A = fresh_args(); unsigned char* ws = A->ws;
        constexpr int I0 = 16 * 28, I1 = I0 + 16 * 16, I5 = I1 + (16 * 88 - A1T), IX = I5 + M / 4;
        {   const float* x = A->in[0]; float* SS = (float*)(ws + WS_SS); bf16_t* XB = (bf16_t*)(ws + WS_XB);
#pragma unroll 1
            for (int it = gw; it < I5; it += NGW) {
                if (it < I0) p0_transpose_item(A->in[3], 1024, A_IN_COLS, A_IN_PAD, WM_AIN, A->in[1], (bf16_t*)(ws + WS_WAIN), scr, it, lane);
                else if (it < I1) p0_transpose_item(A->in[8], 1024, 1024, 1024, WM_NAT, (const float*)nullptr, (bf16_t*)(ws + WS_WAOUT), scr, it - I0, lane);
                else p0_transpose_item(A->in[12], 1024, FF2, FF2, WM_FUP, A->in[2], (bf16_t*)(ws + WS_WFUP0), scr, it - I1 + A1T, lane); }
#define X_LOAD(V_, it_) do { const int row0_ = ((it_) - I5) * 4; _Pragma("unroll") for (int r = 0; r < 4; ++r) _Pragma("unroll") for (int q = 0; q < 4; ++q) V_[r][q] = __builtin_nontemporal_load(((const f32x4*)(x + (size_t)(row0_ + r) * DM)) + q * 64 + lane); } while (0)
#define X_PROC(V_, it_) do { const int row0_ = ((it_) - I5) * 4; float mine_ = 0.f; \
                _Pragma("unroll") for (int r = 0; r < 4; ++r) _Pragma("unroll") for (int q = 0; q < 4; ++q) { const f32x4 w = V_[r][q]; float sq = (w[0] * w[0] + w[1] * w[1]) + (w[2] * w[2] + w[3] * w[3]); \
                    WAVE_RED(SUMF, sq);                   \
                    mine_ = (lane == 16 * q + r) ? sq : mine_; \
                    u32x2 o; o.x = pk2(w[0], w[1]); o.y = pk2(w[2], w[3]); *(u32x2*)(XB + (size_t)(row0_ + r) * DM + q * 256 + lane * 4) = o; } \
                SS[(size_t)(lane >> 2) * M + row0_ + (lane & 3)] = mine_; } while (0)
            {   int it = gw; while (it < I5) it += NGW;
                f32x4 va[4][4], vb[4][4];
                if (it < IX) X_LOAD(va, it);
#pragma unroll 1
                while (it < IX) {
                    int nx = it + NGW; if (nx < IX) X_LOAD(vb, nx);
                    X_PROC(va, it); it = nx; if (it >= IX) break;
                    nx = it + NGW; if (nx < IX) X_LOAD(va, nx);
                    X_PROC(vb, it); it = nx; } }
#undef X_LOAD
#undef X_PROC
        }
        {   float2* ROPE = (float2*)(ws + WS_ROPE);
            for (int e = gw * 64 + lane; e < 257 * 128; e += NGW * 64) { const int rr_ = e >> 7, i = e & 127, t = (rr_ < 256) ? 8 * rr_ : 1;
                const float inv = exp2f(-(float)(2 * i) * (13.287712379549449f / 256.0f)), ang = (float)t * inv; float sn, cs; sincosf(ang, &sn, &cs); float* rr = (float*)ROPE + (size_t)t * 256 + (i >> 2) * 8 + (i & 3); rr[0] = cs; rr[4] = sn; } }
        {   float* CSC = (float*)(ws + WS_CSC); const float* a_q_g = A->in[4]; const float* a_k_g = A->in[5]; const float* a_iq_g = A->in[6]; const float* a_ik_g = A->in[7];
            for (int n = gw * 64 + lane; n < A_IN_PAD; n += NGW * 64) { float v;
                if (n < 1024) v = a_q_g[n & 127] * a_k_g[n & 127] * 0.08838834764831845f; else if (n < 1152) v = 1.0f; else if (n < 1216) v = a_ik_g[n - 1152];
                else if (n < 1224) v = 0.044194173824159216f; else if (n < 1280) v = 0.f; else v = a_iq_g[(n - 1280) & 63];
                CSC[n] = v; } }
    }
    SEAM(PH_PRO);
    if (IN(PH_A1)) REPEAT(PH_A1) { REPBAR();
        ArgsP A = fresh_args(); unsigned char* ws = A->ws;
        pg8::Gemm g{(const bf16_t*)(ws + WS_XB), (const bf16_t*)(ws + WS_WAIN), M, A_IN_PAD, 1024}; pg8::StaticOrder S; S.init(M, A_IN_PAD, fresh_gx(), fresh_bx());
        pg8::EpiA1 E{(const float*)(ws + WS_SS), (const float*)(ws + WS_CSC), (bf16_t*)(ws + WS_QH), (bf16_t*)(ws + WS_C), (bf16_t*)(ws + WS_KI), (bf16_t*)(ws + WS_QI), (float*)(ws + WS_WI), (float*)(ws + WS_PS)};
        pg8::gemm_phase(lds, g, S, E);
        {
            int t_ = threadIdx.x; asm volatile("" : "+v"(t_)); const int lane = t_ & 63, wave = __builtin_amdgcn_readfirstlane(t_ >> 6); LAS float* scr = (LAS float*)(lds + wave * 16640);
            const int G_ = fresh_gx(), c_ = fresh_bx(); const int rem_ = ((M / 256) * (A_IN_PAD / 256)) % G_;
            if (c_ >= rem_) { const int nw_ = (G_ - rem_) * NWAVES, w0_ = (c_ - rem_) * NWAVES + wave;
#pragma unroll 1
                for (int it = w0_; it < A1T + 44 * 16; it += nw_) {
                    if (it < A1T) p0_transpose_item(A->in[12], 1024, FF2, FF2, WM_FUP, A->in[2], (bf16_t*)(ws + WS_WFUP0), scr, it, lane);
                    else p0_transpose_item(A->in[15], 2816, 1024, 1024, WM_NAT, (const float*)nullptr, (bf16_t*)(ws + WS_WFDN0), scr, it - A1T, lane); } } }
    }
    float dsa_bound_l2;
    {   ArgsP A = fresh_args(); const float* CSC = (const float*)(A->ws + WS_CSC); const int lane0 = threadIdx.x & 63; float mxs = 0.f;
        for (int i = lane0; i < 128; i += 64) mxs = fmaxf(mxs, fabsf(CSC[i]));
#pragma unroll
        for (int o = 1; o < 64; o <<= 1) mxs = fmaxf(mxs, __shfl_xor(mxs, o));
        dsa_bound_l2 = mxs * 128.0f * 1.4426950408889634f; }
    SEAM(PH_A1);
    if (IN(PH_A2)) REPEAT(PH_A2) { REPBAR();
        ArgsP A = fresh_args(); unsigned char* ws = A->ws; const int G = fresh_gx(), bx = fresh_bx(); const int vcu = (G % 8 == 0) ? (bx % 8) * (G / 8) + bx / 8 : bx;
        dsa_fast_phase(lds, (const bf16_t*)(ws + WS_QH), (const bf16_t*)(ws + WS_C), (const float*)(ws + WS_PS), (const bf16_t*)(ws + WS_QI), (const bf16_t*)(ws + WS_KI), (const float*)(ws + WS_WI), (const float*)(ws + WS_CSC), (bf16_t*)(ws + WS_AO), vcu, G, dsa_bound_l2);
    }
    SEAM(PH_A2);
    if (IN(PH_A3)) REPEAT(PH_A3) { REPBAR();
        ArgsP A = fresh_args(); unsigned char* ws = A->ws;
        pg8::Gemm g{(const bf16_t*)(ws + WS_AO), (const bf16_t*)(ws + WS_WAOUT), M, 1024, 1024}; pg8::StaticOrder S; S.init(M, 1024, fresh_gx(), fresh_bx());
        pg8::EpiRes<1> E{nullptr, nullptr, (bf16_t*)(ws + WS_XB), (float*)(ws + WS_SS)};
        pg8::gemm_phase(lds, g, S, E);
    }
    SEAM(PH_A3);
#define FFN_PHASES(LAYER, PH1, PH2) do { \
        if (IN(PH1)) REPEAT(PH1) { REPBAR(); \
            ArgsP A = fresh_args(); unsigned char* ws = A->ws; \
            pg8::Gemm g{(const bf16_t*)(ws + WS_XB), (const bf16_t*)(ws + ((LAYER) ? WS_WFUP1 : WS_WFUP0)), M, FF2, 1024}; pg8::StaticOrder S; S.init(M, FF2, fresh_gx(), fresh_bx()); \
            pg8::EpiF1 E{(const float*)(ws + WS_SS), A->in[13] + (size_t)(LAYER) * 3 * FF2, A->in[14] + (size_t)(LAYER) * FF2, (bf16_t*)(ws + ((LAYER) ? WS_H1 : WS_H0)), \
                         (float*)(ws + ((LAYER) ? WS_PART1 : WS_PART0)), (float*)(ws + ((LAYER) ? WS_HALO1 : WS_HALO0))}; \
            pg8::gemm_phase(lds, g, S, E); \
            {     \
                int t_ = threadIdx.x; asm volatile("" : "+v"(t_)); const int lane = t_ & 63, wave = __builtin_amdgcn_readfirstlane(t_ >> 6); LAS float* scr = (LAS float*)(lds + wave * 16640); \
                const int G_ = fresh_gx(), c_ = fresh_bx(); const int rem_ = ((M / 256) * (FF2 / 256)) % G_; \
                if (c_ >= rem_) { const int nw_ = (G_ - rem_) * NWAVES, w0_ = (c_ - rem_) * NWAVES + wave; \
                    if ((LAYER) == 0) { _Pragma("unroll 1") for (int it = w0_; it < 16 * 96 + 32 * 16; it += nw_) { \
                        if (it < 16 * 96) p0_transpose_item(A->in[9], 1024, B_IN_COLS, B_IN_COLS, WM_NAT, A->in[1] + 1024, (bf16_t*)(ws + WS_WBIN), scr, it, lane); \
                        else p0_transpose_item(A->in[11], 2048, 1024, 1024, WM_NAT, A->in[10], (bf16_t*)(ws + WS_WBOUT), scr, it - 16 * 96, lane); } } \
                    else { _Pragma("unroll 1") for (int it = wave * (G_ - rem_) + (c_ - rem_); it < 44 * 16; it += nw_)     \
                        p0_transpose_item(A->in[15] + (size_t)2816 * 1024, 2816, 1024, 1024, WM_NAT, (const float*)nullptr, (bf16_t*)(ws + WS_WFDN1), scr, it, lane); } } } \
        } \
        SEAM(PH1); \
        if (IN(PH2)) { \
            ArgsP A = fresh_args(); unsigned char* ws = A->ws; bf16_t* Hb = (bf16_t*)(ws + ((LAYER) ? WS_H1 : WS_H0)); \
            pg8::Gemm g{Hb, (const bf16_t*)(ws + ((LAYER) ? WS_WFDN1 : WS_WFDN0)), M, 1024, D_FF}; pg8::StaticOrder S; S.init(M, 1024, fresh_gx(), fresh_bx()); \
            {   pg8::Unit u0; if (S.next(0, u0)) ffn_fixup(u0.pm, A->in[13] + (size_t)(LAYER) * 3 * FF2, (const float*)(ws + ((LAYER) ? WS_PART1 : WS_PART0)), (const float*)(ws + ((LAYER) ? WS_HALO1 : WS_HALO0)), Hb); \
                VM_WAIT(); __syncthreads(); } \
            if ((LAYER) == 0) { pg8::EpiRes<1> E{nullptr, nullptr, (bf16_t*)(ws + WS_XB), (float*)(ws + WS_SS)}; pg8::gemm_phase(lds, g, S, E); } \
            else { pg8::EpiRes<2> E{nullptr, A->out, (bf16_t*)(ws + WS_XB), nullptr}; pg8::gemm_phase(lds, g, S, E); } \
        } \
        SEAM(PH2); } while (0)
    FFN_PHASES(0, PH_F1A, PH_F2A);
    if (IN(PH_B1)) REPEAT(PH_B1) { REPBAR();
        ArgsP A = fresh_args(); unsigned char* ws = A->ws;
        pg8::Gemm g{(const bf16_t*)(ws + WS_XB), (const bf16_t*)(ws + WS_WBIN), M, 4096, 1024}; pg8::StaticOrder S; S.init(M, 4096, fresh_gx(), fresh_bx());
        pg8::EpiB1 E{(const float*)(ws + WS_SS), (const float2*)(ws + WS_ROPE), (bf16_t*)(ws + WS_QT), (bf16_t*)(ws + WS_KT), (bf16_t*)(ws + WS_VT)};
        pg8::gemm_phase(lds, g, S, E);
    }
    SEAM(PH_B1);
    if (IN(PH_B2)) REPEAT(PH_B2) { REPBAR();
        ArgsP A = fresh_args(); unsigned char* ws = A->ws;
        { const int G = fresh_gx(), bx = fresh_bx(); const int vcu = (G % 8 == 0) ? (bx % 8) * (G / 8) + bx / 8 : bx;
          for (int u = vcu; u < 256; u += G) ret_fast_phase(lds, (const bf16_t*)(ws + WS_QT), (const bf16_t*)(ws + WS_KT), (const bf16_t*)(ws + WS_VT), (bf16_t*)(ws + WS_RET), (float*)(ws + WS_SSR), u); }
    }
    SEAM(PH_B2);
    if (IN(PH_GATE)) REPEAT(PH_GATE) { REPBAR();
#if !defined(NO_WCONV2)
        {   GWS; ArgsP A = fresh_args(); unsigned char* ws = A->ws; constexpr int J0 = 16 * 88;
#pragma unroll 1
            for (int it = wave * G + vcu; it < J0; it += NGW)
                p0_transpose_item(A->in[12] + (size_t)1024 * FF2, 1024, FF2, FF2, WM_FUP, A->in[2] + 1024, (bf16_t*)(ws + WS_WFUP1), scr, it, lane);
            __syncthreads(); }
#endif
        {   ArgsP A = fresh_args(); unsigned char* ws = A->ws;
            pg8::Gemm g{(const bf16_t*)(ws + WS_XB), (const bf16_t*)(ws + WS_WBIN) + (size_t)4096 * 1024, M, 2048, 1024}; pg8::StaticOrder S; S.init(M, 2048, fresh_gx(), fresh_bx());
            pg8::EpiGate E{(const float*)(ws + WS_SS), (const float*)(ws + WS_SSR), (bf16_t*)(ws + WS_RET)};
            pg8::gemm_phase(lds, g, S, E); }
    }
    SEAM(PH_GATE);
    if (IN(PH_B3)) REPEAT(PH_B3) { REPBAR();
        ArgsP A = fresh_args(); unsigned char* ws = A->ws;
        pg8::Gemm g{(const bf16_t*)(ws + WS_RET), (const bf16_t*)(ws + WS_WBOUT), M, 1024, 2048}; pg8::StaticOrder S; S.init(M, 1024, fresh_gx(), fresh_bx());
        pg8::EpiRes<1> E{nullptr, nullptr, (bf16_t*)(ws + WS_XB), (float*)(ws + WS_SS)};
        pg8::gemm_phase(lds, g, S, E);
    }
    SEAM(PH_B3);
    FFN_PHASES(1, PH_F1B, PH_F2B);
#undef FFN_PHASES
#undef IN
#undef SEAM
}

extern "C" void kernel_launch(void* const* d_in, const int* in_sizes, int n_in, void* d_out, int out_size, void* d_ws, size_t ws_size, hipStream_t stream) {
    static int grid = 0;
    if (grid == 0) {
        int dev = 0, cus = 0, per_cu = 0;
        (void)hipGetDevice(&dev); (void)hipDeviceGetAttribute(&cus, hipDeviceAttributeMultiprocessorCount, dev);
        (void)hipFuncSetAttribute((const void*)mega, hipFuncAttributeMaxDynamicSharedMemorySize, LDS_BYTES);
        if (hipOccupancyMaxActiveBlocksPerMultiprocessor(&per_cu, (const void*)mega, NWAVES * 64, LDS_BYTES) != hipSuccess || per_cu < 1)
            fprintf(stderr, "kernel_launch: occupancy query reports %d workgroups per CU\n", per_cu);
        (void)hipGetLastError();
        grid = cus > 0 ? cus : 256;
        if (grid != 256) fprintf(stderr, "kernel_launch: %d CUs (built for 256)\n", grid);
    }
    unsigned char* ws = (unsigned char*)d_ws;
    (void)hipMemsetAsync(ws + WS_CTL, 0, CTL_ZERO_BYTES, stream);
    Args a{};
    for (int i = 0; i < 16; ++i) a.in[i] = (const float*)d_in[i];
    a.out = (float*)d_out; a.ws = ws;
    auto launch = [&](int lo, int hi, int li) { a.ph_lo = lo; a.ph_hi = hi; a.li = li; hipLaunchKernelGGL(mega, dim3(grid), dim3(NWAVES * 64), LDS_BYTES, stream, a); };
    launch(0, PH_END, 0);
}
```
